# Optimizing an MI355X kernel written in HIP

```python
import math
import jax, jax.numpy as jnp
from jax import lax
import numpy as np

D_MODEL = 1024
BATCH = 8
SEQ = 2048
DEPTH = 2
DEC_BATCH = 1
DEC_SEQ = 16384
PAST_LEN = 128

N_META = 16
N_HEADS = 8
N_KV_HEADS = 2
GROUP = N_HEADS // N_KV_HEADS
HEAD_DIM = 64
ATTN_WIDTH = N_HEADS * HEAD_DIM
KV_WIDTH = N_KV_HEADS * HEAD_DIM
WINDOW = 128
BLOCK = 128
N_BUCKETS = 32
MAX_DISTANCE = 128
HYENA_WIDTH = D_MODEL // 2
HYENA_EMB = 33
HYENA_FILTER_HIDDEN = 64
HYENA_DECAY_TARGET = 1e-2
HYENA_FAST_DECAY = 0.3
HYENA_SLOW_DECAY = 1.5
POOL_WIDTH = D_MODEL // 2
POOL_WINDOWS = (2, 4, 8, 16)
POOL_GROUPS = len(POOL_WINDOWS)
POOL_GROUP = POOL_WIDTH // POOL_GROUPS
N_BRANCH = 3
D_FF = 2816
EPS = 1e-6
NEG = -1e30
IN_WIDTH = ATTN_WIDTH + 2 * KV_WIDTH + 3 * HYENA_WIDTH + POOL_WIDTH + N_BRANCH * D_MODEL

kernel_name = "hybrid_hyena_swa_pool_encoder"


def rmsnorm(x, g):
    xf = x.astype(jnp.float32)
    y = xf * lax.rsqrt(jnp.mean(xf * xf, axis=-1, keepdims=True) + EPS)
    return (y * g.astype(jnp.float32)).astype(x.dtype)


def dwconv3(x, w, b):
    xp = jnp.pad(x, ((0, 0), (1, 1), (0, 0)))
    return xp[:, :-2] * w[0] + xp[:, 1:-1] * w[1] + xp[:, 2:] * w[2] + b


def t5_buckets(rel):
    half = N_BUCKETS // 2
    ret = (rel > 0).astype(np.int32) * half
    n = np.abs(rel)
    max_exact = half // 2
    large = max_exact + (np.log(np.maximum(n, 1) / max_exact) / np.log(MAX_DISTANCE / max_exact)
                         * (half - max_exact)).astype(np.int32)
    large = np.minimum(large, half - 1)
    return (ret + np.where(n < max_exact, n, large)).astype(np.int32)


def window_attention(q, k, v, q_gain, k_gain, sink, rel_bias):
    B, L = q.shape[0], q.shape[1]
    front = (-L) % BLOCK
    Lp = L + front
    nb = Lp // BLOCK
    q = rmsnorm(q, q_gain)
    k = rmsnorm(k, k_gain)
    padf = lambda a: jnp.pad(a, ((0, 0), (front, 0), (0, 0), (0, 0)))
    qb = padf(q).reshape(B, nb, BLOCK, N_KV_HEADS, GROUP, HEAD_DIM)

    def windows(a):
        a = padf(a).reshape(B, nb, BLOCK, N_KV_HEADS, HEAD_DIM)
        a = jnp.pad(a, ((0, 0), (1, 1), (0, 0), (0, 0), (0, 0)))
        return jnp.concatenate([a[:, :-2], a[:, 1:-1], a[:, 2:]], axis=2)

    kw, vw = windows(k), windows(v)
    rel = np.arange(3 * BLOCK)[None, :] - BLOCK - np.arange(BLOCK)[:, None]
    band = np.abs(rel) <= WINDOW
    bias = rel_bias[t5_buckets(rel)].astype(jnp.float32)
    bias = jnp.transpose(bias, (2, 0, 1)).reshape(N_KV_HEADS, GROUP, BLOCK, 3 * BLOCK)
    kpos = (np.arange(nb)[:, None] - 1) * BLOCK + np.arange(3 * BLOCK)[None, :]
    kvalid = (kpos >= front) & (kpos < Lp)
    mask = band[None] & kvalid[:, None, :]

    s = jnp.einsum('bnqhgd,bnkhd->bnhgqk', qb, kw).astype(jnp.float32) * (HEAD_DIM ** -0.5)
    s = jnp.where(mask[None, :, None, None], s + bias, NEG)
    sink_logit = jnp.broadcast_to(sink.astype(jnp.float32).reshape(N_KV_HEADS, GROUP, 1, 1),
                                  s.shape[:-1] + (1,))
    p = jax.nn.softmax(jnp.concatenate([s, sink_logit], axis=-1), axis=-1)[..., :-1]
    o = jnp.einsum('bnhgqk,bnkhd->bnqhgd', p.astype(vw.dtype), vw)
    return o.reshape(B, Lp, ATTN_WIDTH)[:, front:]


def hyena_filter(L, w1, b1, w2, b2, w3, freq):
    t = jnp.linspace(0.0, 1.0, L, dtype=jnp.float32)[:, None]
    bands = (HYENA_EMB - 1) // 2
    f = jnp.linspace(1e-4, bands - 1, bands, dtype=jnp.float32)[None, :]
    wpos = (2.0 * math.pi / L) * jnp.arange(L, dtype=jnp.float32)[:, None]
    z = jnp.concatenate([t, jnp.cos(f * wpos), -jnp.sin(f * wpos)], axis=-1)
    h = jnp.sin(freq * (z @ w1 + b1))
    h = jnp.sin(freq * (h @ w2 + b2))
    kf = (h @ w3).astype(jnp.float32)
    deltas = jnp.abs(jnp.linspace(math.log(HYENA_DECAY_TARGET) / HYENA_FAST_DECAY,
                                  math.log(HYENA_DECAY_TARGET) / HYENA_SLOW_DECAY,
                                  HYENA_WIDTH, dtype=jnp.float32))
    decay = jnp.exp(-t * deltas[None, :])
    k_fwd = kf[:, :HYENA_WIDTH] * decay
    k_bwd = kf[:, HYENA_WIDTH:] * decay
    K = jnp.concatenate([k_fwd, jnp.zeros((1, HYENA_WIDTH), jnp.float32), k_bwd[:0:-1]], axis=0)
    return K / jnp.sum(jnp.abs(K), axis=0, keepdims=True)


def hyena_mixer(u, conv_w, conv_b, w1, b1, w2, b2, w3, freq, skip):
    L = u.shape[1]
    u = dwconv3(u, conv_w, conv_b)
    x0 = u[..., :HYENA_WIDTH]
    x1 = u[..., HYENA_WIDTH:2 * HYENA_WIDTH]
    v = u[..., 2 * HYENA_WIDTH:]
    z = (v * x1).astype(jnp.float32)
    K = hyena_filter(L, w1, b1, w2, b2, w3, freq)
    n = 2 * L
    y = jnp.fft.irfft(jnp.fft.rfft(z, n=n, axis=1) * jnp.fft.rfft(K, n=n, axis=0)[None],
                      n=n, axis=1)[:, :L]
    y = y + z * skip.astype(jnp.float32)
    return (y * x0.astype(jnp.float32)).astype(u.dtype)


def pool_mixer(u, w, scale):
    B, L, _ = u.shape
    uf = u.astype(jnp.float32).reshape(B, L, POOL_GROUPS, POOL_GROUP)
    c = jnp.pad(jnp.cumsum(uf, axis=1), ((0, 0), (1, 0), (0, 0), (0, 0)))
    t = np.arange(L)
    outs = []
    for g, win in enumerate(POOL_WINDOWS):
        lo = np.clip(t - win // 2, 0, L)
        hi = np.clip(t - win // 2 + win, 0, L)
        cnt = jnp.asarray(hi - lo, jnp.float32)[None, :, None]
        outs.append((c[:, hi, g] - c[:, lo, g]) / cnt - uf[:, :, g])
    pooled = jnp.stack(outs, axis=2)
    y = jnp.einsum('blgc,gcd->blgd', pooled, w.astype(jnp.float32)).reshape(B, L, POOL_WIDTH)
    return (y * scale.astype(jnp.float32)).astype(u.dtype)


def encoder_layer(x, rel_bias, norm_mix, w_in, q_gain, k_gain, attn_sink, hy_conv_w, hy_conv_b,
                  hy_w1, hy_b1, hy_w2, hy_b2, hy_w3, hy_freq, hy_skip, pool_w, pool_scale,
                  w_attn_o, w_hyena_o, w_pool_o, w_out, norm_ffn, w_gate, w_up, ffn_conv_w,
                  ffn_conv_b, w_down):
    B, L, _ = x.shape
    h = rmsnorm(x, norm_mix)
    proj = h @ w_in
    o1 = ATTN_WIDTH
    o2 = o1 + KV_WIDTH
    o3 = o2 + KV_WIDTH
    o4 = o3 + 3 * HYENA_WIDTH
    o5 = o4 + POOL_WIDTH
    q = proj[..., :o1].reshape(B, L, N_HEADS, HEAD_DIM)
    k = proj[..., o1:o2].reshape(B, L, N_KV_HEADS, HEAD_DIM)
    v = proj[..., o2:o3].reshape(B, L, N_KV_HEADS, HEAD_DIM)
    attn = window_attention(q, k, v, q_gain, k_gain, attn_sink, rel_bias)
    hy = hyena_mixer(proj[..., o3:o4], hy_conv_w, hy_conv_b, hy_w1, hy_b1, hy_w2, hy_b2,
                     hy_w3, hy_freq, hy_skip)
    po = pool_mixer(proj[..., o4:o5], pool_w, pool_scale)
    g = jax.nn.sigmoid(proj[..., o5:].astype(jnp.float32)).astype(x.dtype)
    g = g.reshape(B, L, N_BRANCH, D_MODEL)
    merged = (g[:, :, 0] * (attn @ w_attn_o) + g[:, :, 1] * (hy @ w_hyena_o)
              + g[:, :, 2] * (po @ w_pool_o))
    x = x + (merged @ w_out).astype(x.dtype)
    h = rmsnorm(x, norm_ffn)
    a = jax.nn.gelu(dwconv3(h @ w_gate, ffn_conv_w, ffn_conv_b), approximate=False)
    return x + ((a * (h @ w_up)) @ w_down).astype(x.dtype)


def run_trunk(x, meta_tokens, rel_bias, stacks):
    B = x.shape[0]
    meta = jnp.broadcast_to(meta_tokens.astype(x.dtype)[None], (B, N_META, D_MODEL))
    h = jnp.concatenate([meta, x], axis=1)
    for l in range(DEPTH):
        h = encoder_layer(h, rel_bias, *[p[l] for p in stacks])
    return h[:, N_META:]


def setup_inputs(seed: int = 0) -> dict:
    key = jax.random.key(seed)
    ks = jax.random.split(key, 32)
    nrm = lambda k, shape, s: jax.random.normal(k, shape, jnp.float32) * s
    gain = lambda k, shape: 1.0 + 0.02 * jax.random.normal(k, shape, jnp.float32)
    return {
        "x_prompt": nrm(ks[0], (BATCH, SEQ, D_MODEL), 1.0),
        "x_sample": nrm(ks[1], (DEC_BATCH, DEC_SEQ, D_MODEL), 1.0),
        "meta_tokens": nrm(ks[2], (N_META, D_MODEL), 1.0),
        "rel_bias": nrm(ks[3], (N_BUCKETS, N_HEADS), 0.2),
        "norm_mix": gain(ks[4], (DEPTH, D_MODEL)),
        "w_in": nrm(ks[5], (DEPTH, D_MODEL, IN_WIDTH), D_MODEL ** -0.5),
        "q_gain": gain(ks[6], (DEPTH, HEAD_DIM)),
        "k_gain": gain(ks[7], (DEPTH, HEAD_DIM)),
        "attn_sink": nrm(ks[8], (DEPTH, N_HEADS), 0.5),
        "hy_conv_w": nrm(ks[9], (DEPTH, 3, 3 * HYENA_WIDTH), 3 ** -0.5),
        "hy_conv_b": nrm(ks[10], (DEPTH, 3 * HYENA_WIDTH), 0.01),
        "hy_w1": nrm(ks[11], (DEPTH, HYENA_EMB, HYENA_FILTER_HIDDEN), HYENA_EMB ** -0.5),
        "hy_b1": nrm(ks[12], (DEPTH, HYENA_FILTER_HIDDEN), 0.01),
        "hy_w2": nrm(ks[13], (DEPTH, HYENA_FILTER_HIDDEN, HYENA_FILTER_HIDDEN), HYENA_FILTER_HIDDEN ** -0.5),
        "hy_b2": nrm(ks[14], (DEPTH, HYENA_FILTER_HIDDEN), 0.01),
        "hy_w3": nrm(ks[15], (DEPTH, HYENA_FILTER_HIDDEN, 2 * HYENA_WIDTH), HYENA_FILTER_HIDDEN ** -0.5),
        "hy_freq": gain(ks[16], (DEPTH, HYENA_FILTER_HIDDEN)),
        "hy_skip": nrm(ks[17], (DEPTH, HYENA_WIDTH), 1.0),
        "pool_w": nrm(ks[18], (DEPTH, POOL_GROUPS, POOL_GROUP, POOL_GROUP), POOL_GROUP ** -0.5),
        "pool_scale": gain(ks[19], (DEPTH, POOL_WIDTH)),
        "w_attn_o": nrm(ks[20], (DEPTH, ATTN_WIDTH, D_MODEL), ATTN_WIDTH ** -0.5),
        "w_hyena_o": nrm(ks[21], (DEPTH, HYENA_WIDTH, D_MODEL), HYENA_WIDTH ** -0.5),
        "w_pool_o": nrm(ks[22], (DEPTH, POOL_WIDTH, D_MODEL), POOL_WIDTH ** -0.5),
        "w_out": nrm(ks[23], (DEPTH, D_MODEL, D_MODEL), D_MODEL ** -0.5),
        "norm_ffn": gain(ks[24], (DEPTH, D_MODEL)),
        "w_gate": nrm(ks[25], (DEPTH, D_MODEL, D_FF), D_MODEL ** -0.5),
        "w_up": nrm(ks[26], (DEPTH, D_MODEL, D_FF), D_MODEL ** -0.5),
        "ffn_conv_w": nrm(ks[27], (DEPTH, 3, D_FF), 3 ** -0.5),
        "ffn_conv_b": nrm(ks[28], (DEPTH, D_FF), 0.01),
        "w_down": nrm(ks[29], (DEPTH, D_FF, D_MODEL), D_FF ** -0.5),
    }


def reference(x_prompt, x_sample, meta_tokens, rel_bias, norm_mix, w_in, q_gain, k_gain, attn_sink,
              hy_conv_w, hy_conv_b, hy_w1, hy_b1, hy_w2, hy_b2, hy_w3, hy_freq, hy_skip, pool_w,
              pool_scale, w_attn_o, w_hyena_o, w_pool_o, w_out, norm_ffn, w_gate, w_up,
              ffn_conv_w, ffn_conv_b, w_down):
    stacks = (norm_mix, w_in, q_gain, k_gain, attn_sink, hy_conv_w, hy_conv_b, hy_w1, hy_b1,
              hy_w2, hy_b2, hy_w3, hy_freq, hy_skip, pool_w, pool_scale, w_attn_o, w_hyena_o,
              w_pool_o, w_out, norm_ffn, w_gate, w_up, ffn_conv_w, ffn_conv_b, w_down)
    y_prompt = run_trunk(x_prompt, meta_tokens, rel_bias, stacks)
    y_sample = run_trunk(x_sample, meta_tokens, rel_bias, stacks)
    return (y_prompt, y_sample)
```

```cpp
#include <hip/hip_runtime.h>
#include <cstdio>
#include <cstdint>
#include <cmath>

#ifndef DBG
#define DBG 0
#endif
#ifndef DUP_PHASE
#define DUP_PHASE -1
#endif
#ifndef FT_RECOMPUTE
#define FT_RECOMPUTE 0
#endif
#ifndef DRYVAR
#define DRYVAR 0
#endif
#ifndef DUPMASK
#define DUPMASK 255
#endif
#define DSEL(b) (!F.dry || (DUPMASK & (b)))
#ifndef MK_N_LAUNCHES
#define MK_N_LAUNCHES 1
#endif

#define LAS __attribute__((address_space(3)))
#define GAS __attribute__((address_space(1)))
typedef unsigned short bf16_t;
typedef short bf16x8 __attribute__((ext_vector_type(8)));
typedef float f32x4 __attribute__((ext_vector_type(4)));
typedef float f32x2 __attribute__((ext_vector_type(2)));
typedef float f32x16 __attribute__((ext_vector_type(16)));
typedef unsigned u32x4 __attribute__((ext_vector_type(4)));
typedef unsigned u32x2 __attribute__((ext_vector_type(2)));

constexpr int DM = 1024, INW = 5888, DFF = 2816, NHEAD = 8, HD = 64;
constexpr int LP = 2064, LS = 16400, NMETA = 16;
constexpr int ROWS_P = 8 * LP;
constexpr int MROWS = ROWS_P + LS;
constexpr int MP = 33024;
constexpr int C_Q = 0, C_K = 512, C_V = 640, C_X0 = 768, C_X1 = 1280, C_VV = 1792, C_PU = 2304, C_G = 2816;
constexpr float EPS = 1e-6f;
constexpr int RK_PAD = 256;
constexpr int RKLEN_P = 2 * LP + 512, RKLEN_S = 2 * LS + 512;

constexpr size_t MiB = 1u << 20;
constexpr size_t WS_CTL = 0, CTL_ZERO_BYTES = 1 * MiB;
constexpr size_t WS_XM = 1 * MiB;
constexpr size_t WS_W = 3 * MiB;
constexpr size_t W_IN = 0, W_G = W_IN + (size_t)INW * DM * 2, W_U = W_G + (size_t)DFF * DM * 2, W_D = W_U + (size_t)DFF * DM * 2,
                 W_OUT = W_D + (size_t)DM * DFF * 2, W_MRG = W_OUT + (size_t)DM * DM * 2, W_END = W_MRG + (size_t)3 * DM * 512 * 2;
static_assert(WS_W + W_END <= 36 * MiB, "weights");
constexpr size_t WS_RKP = 36 * MiB;
constexpr size_t WS_RKS = WS_RKP + (size_t)512 * RKLEN_P * 2;
static_assert(WS_RKS + (size_t)512 * RKLEN_S * 2 <= 74 * MiB, "filters");
constexpr size_t WS_XNR = 74 * MiB;
constexpr size_t XNR_BYTES = (size_t)MP * DM * 2;
constexpr size_t WS_PROJ = 139 * MiB;
constexpr size_t WS_END = WS_PROJ + (size_t)MP * INW * 2;
static_assert(WS_XNR + XNR_BYTES <= WS_PROJ && WS_END <= 512 * MiB, "d_ws map");
constexpr int CW_BAR = 4096;
constexpr int CW_SUMS = 16384;

namespace pg8 {
constexpr int BM = 256, BK = 64, HALF = 128, HTB = HALF * BK * 2, STAGE_BYTES = 8 * HTB, NXCD = 8, WGM = 8;
__host__ __device__ __forceinline__ int lds_byte(int r, int c) { const int st = (r >> 4) * 2 + (c >> 5), rr = r & 15, cc = c & 31, ob = rr * 64 + cc * 2; return st * 1024 + (ob ^ (((ob >> 9) & 1) << 5)); }
__host__ __device__ __forceinline__ void stage_rc(int b, int& R, int& C) { const int st = b / 1024, sb = b % 1024, swz = sb ^ (((sb >> 9) & 1) << 5); R = (st >> 1) * 16 + swz / 64; C = (st & 1) * 32 + (swz % 64) / 2; }
__host__ __device__ __forceinline__ int perm32(int rho) { const int n = rho >> 4, i = rho & 15; return 8 * (i >> 2) + 4 * n + (i & 3); }

struct Unit { int pm, pn, sub; };
struct StaticOrder {
    int nM, nN, nwg, G, c, nsub;
    __device__ void init(int M, int N, int G_, int c_, int nsub_) { nM = M / BM; nN = N / BM; nwg = nM * nN; G = G_; c = c_; nsub = nsub_; }
    __device__ bool next(int i, Unit& u) const {
        const int tile = i / nsub; u.sub = i - tile * nsub;
        const long L = (long)tile * G + c; if (L >= nwg) return false;
        int wgid = (int)L; { const int q = nwg / NXCD, r = nwg % NXCD, xcd = wgid % NXCD, off = wgid / NXCD; wgid = (xcd < r ? xcd * (q + 1) : r * (q + 1) + (xcd - r) * q) + off; }
        const int nig = WGM * nN, gid = wgid / nig, fm = gid * WGM, gsz = (nM - fm) < WGM ? (nM - fm) : WGM;
        u.pm = fm + ((wgid % nig) % gsz); u.pn = (wgid % nig) / gsz; return true;
    }
};
__device__ __forceinline__ unsigned cvt_pk_bf16(float lo, float hi) { unsigned r; asm volatile("v_cvt_pk_bf16_f32 %0, %1, %2" : "=v"(r) : "v"(lo), "v"(hi)); return r; }
__device__ __forceinline__ f32x2 gelu_pk(f32x2 v) {
    const f32x2 av = __builtin_elementwise_abs(v), d = av * 0.2316418882f + 1.0f;
    f32x2 t; t.x = __builtin_amdgcn_rcpf(d.x); t.y = __builtin_amdgcn_rcpf(d.y);
    f32x2 q = t * 0.5307027145f + (-0.7265760135f); q = q * t + 0.7107068705f; q = q * t + (-0.142248368f); q = q * t + 0.127414796f; q = q * t;
    const f32x2 s = (v * v) * (-0.72134752044f);
    f32x2 e; e.x = __builtin_amdgcn_exp2f(s.x); e.y = __builtin_amdgcn_exp2f(s.y);
    const f32x2 m = v * (q * e), r = v - m;
    f32x2 o; o.x = v.x < 0.f ? m.x : r.x; o.y = v.y < 0.f ? m.y : r.y; return o;
}

template <class Epi, class Ops, bool ALIGN_EPI>
__device__ __forceinline__ void gemm_phase(LAS unsigned char* lds, const Ops& O, const StaticOrder& S, const Epi& E, int tid) {
    const int wid = __builtin_amdgcn_readfirstlane(tid >> 6), lane = tid & 63, wr = wid >> 2, wc = wid & 3, fr = lane & 15, fq = lane >> 4;
    const int K = O.K, nt = K / BK, lda = O.lda;
    unsigned voffA[2], voffB[2];
#pragma unroll
    for (int i = 0; i < 2; ++i) { int R, C; stage_rc(tid * 16 + i * 8192, R, C); const int Rb = (R & ~31) + perm32(R & 31);
        voffA[i] = (unsigned)(R * lda + C) * 2u; voffB[i] = (unsigned)(Rb * K + C) * 2u; }
    const size_t kstep = (size_t)(BK * 2);
    const size_t hstepA = (size_t)HALF * lda * 2, hstepB = (size_t)HALF * K * 2;
    const unsigned ldsw = (unsigned)wid * 1024u;
    const int aoff = lds_byte(wr * 64 + fr, fq * 8), boff = lds_byte(wc * 32 + fr, fq * 8);
#define PG8_SA(b, h) (((b) * 2 + (h)) * HTB)
#define PG8_SB(b, h) ((4 + (b) * 2 + (h)) * HTB)
#define PG8_STAGE(bufoff, gbase, voff) do { _Pragma("unroll") for (int _i = 0; _i < 2; ++_i) \
        __builtin_amdgcn_global_load_lds((const unsigned*)((const char*)(gbase) + (voff)[_i]), (LAS unsigned*)(lds + (bufoff) + ldsw + _i * 8192), 16, 0, 0); } while (0)
#define PG8_LDA(dst, b, h) do { _Pragma("unroll") for (int m = 0; m < 4; ++m) _Pragma("unroll") for (int k = 0; k < 2; ++k) dst[m][k] = *(const LAS bf16x8*)(lds + PG8_SA(b, h) + aoff + m * 2048 + k * 1024); } while (0)
#define PG8_LDB(dst, b, h) do { _Pragma("unroll") for (int n = 0; n < 2; ++n) _Pragma("unroll") for (int k = 0; k < 2; ++k) dst[n][k] = *(const LAS bf16x8*)(lds + PG8_SB(b, h) + boff + n * 2048 + k * 1024); } while (0)
#define PG8_MMA(ai, bj, At, Bt) do { __builtin_amdgcn_s_setprio(1); _Pragma("unroll") for (int m = 0; m < 4; ++m) _Pragma("unroll") for (int n = 0; n < 2; ++n) _Pragma("unroll") for (int k = 0; k < 2; ++k) \
        acc[ai][bj][m][n] = __builtin_amdgcn_mfma_f32_16x16x32_bf16(Bt[n][k], At[m][k], acc[ai][bj][m][n], 0, 0, 0); __builtin_amdgcn_s_setprio(0); } while (0)
#define PG8_WAIT_V(n) asm volatile("s_waitcnt vmcnt(" #n ")" ::: "memory")
#define PG8_WAIT_L(n) asm volatile("s_waitcnt lgkmcnt(" #n ")" ::: "memory")
#define PG8_BAR __builtin_amdgcn_s_barrier()
#define PG8_SCHED __builtin_amdgcn_sched_barrier(0)
    Unit cur, nxt; int ui = 0;
    if (!S.next(0, cur)) return;
    f32x4 acc[2][2][4][2];
#pragma unroll
    for (int a = 0; a < 2; ++a)
#pragma unroll
        for (int b = 0; b < 2; ++b)
#pragma unroll
            for (int m = 0; m < 4; ++m)
#pragma unroll
                for (int n = 0; n < 2; ++n) acc[a][b][m][n] = (f32x4){0.f, 0.f, 0.f, 0.f};
    bf16x8 At[4][2], B0[2][2], B1[2][2];
    const char* cA; const char* cB; O.ptrs(cur, cA, cB);
    PG8_STAGE(PG8_SB(0, 0), cB, voffB); PG8_STAGE(PG8_SB(0, 1), cB + hstepB, voffB); PG8_STAGE(PG8_SA(0, 0), cA, voffA); PG8_STAGE(PG8_SA(0, 1), cA + hstepA, voffA);
    if (wr == 1) PG8_BAR;
    PG8_WAIT_V(2); PG8_BAR;
    PG8_STAGE(PG8_SB(1, 0), cB + kstep, voffB); PG8_STAGE(PG8_SA(1, 0), cA + kstep, voffA); PG8_STAGE(PG8_SB(1, 1), cB + hstepB + kstep, voffB);
    PG8_WAIT_V(6); PG8_BAR;
    for (;;) {
        const bool has_next = S.next(ui + 1, nxt);
        const char* nA = cA; const char* nB = cB; if (has_next) O.ptrs(nxt, nA, nB);
        for (int t = 0; t < nt; t += 2) {
            const bool last = (t == nt - 2);
            const char* a1 = cA + (size_t)(t + 1) * kstep;
            const char* a2 = last ? nA : cA + (size_t)(t + 2) * kstep; const char* b2 = last ? nB : cB + (size_t)(t + 2) * kstep;
            const char* a3 = a2 + kstep; const char* b3 = b2 + kstep;
            PG8_LDB(B0, 0, 0); PG8_LDB(B1, 0, 1); PG8_SCHED; PG8_LDA(At, 0, 0); PG8_STAGE(PG8_SA(1, 1), a1 + hstepA, voffA);
            PG8_WAIT_V(8); PG8_WAIT_L(0); PG8_BAR; PG8_MMA(0, 0, At, B0); PG8_MMA(0, 1, At, B1); PG8_BAR; PG8_SCHED;
            PG8_LDA(At, 0, 1); PG8_STAGE(PG8_SB(0, 0), b2, voffB); PG8_STAGE(PG8_SB(0, 1), b2 + hstepB, voffB); PG8_STAGE(PG8_SA(0, 0), a2, voffA);
            PG8_WAIT_V(8); PG8_WAIT_L(0); PG8_BAR; PG8_MMA(1, 0, At, B0); PG8_MMA(1, 1, At, B1); PG8_BAR; PG8_SCHED;
            PG8_LDB(B0, 1, 0); PG8_LDB(B1, 1, 1); PG8_SCHED; PG8_LDA(At, 1, 0); PG8_STAGE(PG8_SA(0, 1), a2 + hstepA, voffA);
            PG8_WAIT_V(8); PG8_WAIT_L(0); PG8_BAR; PG8_MMA(0, 0, At, B0); PG8_MMA(0, 1, At, B1); PG8_BAR; PG8_SCHED;
            PG8_LDA(At, 1, 1); PG8_STAGE(PG8_SB(1, 0), b3, voffB); PG8_STAGE(PG8_SB(1, 1), b3 + hstepB, voffB); PG8_STAGE(PG8_SA(1, 0), a3, voffA);
            PG8_WAIT_V(8); PG8_WAIT_L(0); PG8_BAR; PG8_MMA(1, 0, At, B0); PG8_MMA(1, 1, At, B1); PG8_BAR; PG8_SCHED;
        }
        if constexpr (ALIGN_EPI) { if (wr == 0) PG8_BAR; }
        { int z_ = 0; asm volatile("" : "+v"(z_)); const int l2 = __builtin_amdgcn_mbcnt_hi(-1, __builtin_amdgcn_mbcnt_lo(-1, z_));
          E(acc, cur, wr, wc, l2 & 15, l2 >> 4); }
        if (!E.keep(cur)) {
#pragma unroll
            for (int a = 0; a < 2; ++a)
#pragma unroll
                for (int b = 0; b < 2; ++b)
#pragma unroll
                    for (int m = 0; m < 4; ++m)
#pragma unroll
                        for (int n = 0; n < 2; ++n) acc[a][b][m][n] = (f32x4){0.f, 0.f, 0.f, 0.f};
        }
        if (!has_next) break;
        cur = nxt; cA = nA; cB = nB; ++ui;
        if constexpr (ALIGN_EPI) { if (wr == 1) PG8_BAR; }
    }
    PG8_WAIT_V(0);
    if constexpr (!ALIGN_EPI) { if (wr == 0) PG8_BAR; }
    PG8_BAR;
#undef PG8_SA
#undef PG8_SB
#undef PG8_STAGE
#undef PG8_LDA
#undef PG8_LDB
#undef PG8_MMA
#undef PG8_WAIT_V
#undef PG8_WAIT_L
#undef PG8_BAR
#undef PG8_SCHED
}
}

constexpr int RING_BYTES_C = 131072, LDSCTL_OFF_C = 131072;
__device__ __forceinline__ int seq_of_row(int r) { return r < ROWS_P ? r / LP : 8; }
__device__ __forceinline__ int seq_base(int s) { return s < 8 ? s * LP : ROWS_P; }
__device__ __forceinline__ int seq_len(int s) { return s < 8 ? LP : LS; }
__device__ __forceinline__ float* xrow(float* xreal, float* xm, int r) {
    if (r >= MROWS) return xm + (size_t)(144 + r - MROWS) * DM;
    const int s = seq_of_row(r), p = r - seq_base(s);
    if (p < NMETA) return xm + (size_t)(s * 16 + p) * DM;
    return xreal + (size_t)(r - 16 * (s + 1)) * DM;
}
__device__ __forceinline__ float bflo(unsigned u) { return __uint_as_float(u << 16); }
__device__ __forceinline__ float bfhi(unsigned u) { return __uint_as_float(u & 0xffff0000u); }
__device__ __forceinline__ unsigned f2bf(float f) { unsigned u = __builtin_bit_cast(unsigned, f); return (u + 0x7fffu + ((u >> 16) & 1u)) >> 16; }
__device__ __forceinline__ unsigned pk2(float lo, float hi) { return f2bf(lo) | (f2bf(hi) << 16); }
__device__ __forceinline__ void unpack8(const u32x4 w, float* f) { f[0] = bflo(w.x); f[1] = bfhi(w.x); f[2] = bflo(w.y); f[3] = bfhi(w.y); f[4] = bflo(w.z); f[5] = bfhi(w.z); f[6] = bflo(w.w); f[7] = bfhi(w.w); }
__device__ __forceinline__ float shx(float v, int o, int lane) { return __int_as_float(__builtin_amdgcn_ds_bpermute((lane ^ o) << 2, __float_as_int(v))); }
__device__ __forceinline__ float wave_sum(float v, int lane) {
#pragma unroll
    for (int o = 1; o < 64; o <<= 1) v += shx(v, o, lane);
    return v;
}
#define LDS_WAIT() asm volatile("s_waitcnt lgkmcnt(0)" ::: "memory")

struct OpsPlain {
    const bf16_t* A; const bf16_t* Bt; int K, lda;
    __device__ __forceinline__ void ptrs(const pg8::Unit& u, const char*& a, const char*& b) const {
        a = (const char*)A + (size_t)u.pm * 256 * lda * 2; b = (const char*)Bt + (size_t)u.pn * 256 * K * 2; }
};
struct OpsMerge {
    const bf16_t* P; const bf16_t* WM; int K, lda;
    __device__ __forceinline__ void ptrs(const pg8::Unit& u, const char*& a, const char*& b) const {
        const int col = u.sub == 0 ? C_Q : (u.sub == 1 ? C_VV : C_X1);
        a = (const char*)P + ((size_t)u.pm * 256 * lda + col) * 2; b = (const char*)WM + ((size_t)u.sub * DM + (size_t)u.pn * 256) * 512 * 2; }
};
typedef f32x4 acc_t[2][2][4][2];
struct EpiStore {
    bf16_t* O; int ldc; int sig_pn;
    __device__ __forceinline__ bool keep(const pg8::Unit&) const { return false; }
    __device__ __forceinline__ void operator()(acc_t& acc, const pg8::Unit& u, int wr, int wc, int fr, int fq) const {
        const int row0 = u.pm * 256 + wr * 64 + fr, col0 = u.pn * 256 + wc * 32 + 8 * fq; const bool sig = u.pn >= sig_pn;
#pragma unroll
        for (int ai = 0; ai < 2; ++ai)
#pragma unroll
            for (int m = 0; m < 4; ++m) { bf16_t* rowp = O + (size_t)(row0 + ai * 128 + m * 16) * ldc + col0;
#pragma unroll
                for (int bj = 0; bj < 2; ++bj) { f32x4 v0 = acc[ai][bj][m][0], v1 = acc[ai][bj][m][1];
                    if (sig) { unsigned q[8];
#pragma unroll
                        for (int e = 0; e < 4; ++e) { q[e] = (unsigned)fminf(fmaxf(__builtin_rintf(255.f * __builtin_amdgcn_rcpf(1.f + __expf(-v0[e]))), 1.f), 255.f);
                                                      q[4 + e] = (unsigned)fminf(fmaxf(__builtin_rintf(255.f * __builtin_amdgcn_rcpf(1.f + __expf(-v1[e]))), 1.f), 255.f); }
                        u32x2 w8; w8.x = q[0] | (q[1] << 8) | (q[2] << 16) | (q[3] << 24); w8.y = q[4] | (q[5] << 8) | (q[6] << 16) | (q[7] << 24);
                        *(u32x2*)((unsigned char*)(O + (size_t)(row0 + ai * 128 + m * 16) * ldc) + C_G * 2 + (col0 + bj * 128 - C_G)) = w8; continue; }
                    u32x4 w; w.x = pg8::cvt_pk_bf16(v0[0], v0[1]); w.y = pg8::cvt_pk_bf16(v0[2], v0[3]); w.z = pg8::cvt_pk_bf16(v1[0], v1[1]); w.w = pg8::cvt_pk_bf16(v1[2], v1[3]);
                    *(u32x4*)(rowp + bj * 128) = w; } }
    }
};
struct EpiRes {
    float* xreal; float* xm; int dry;
    __device__ __forceinline__ bool keep(const pg8::Unit&) const { return false; }
    __device__ __forceinline__ void operator()(acc_t& acc, const pg8::Unit& u, int wr, int wc, int fr, int fq) const {
        const int row0 = u.pm * 256 + wr * 64 + fr, col0 = u.pn * 256 + wc * 32 + 8 * fq;
#pragma unroll
        for (int ai = 0; ai < 2; ++ai)
#pragma unroll
            for (int m = 0; m < 4; ++m) { float* p = xrow(xreal, xm, row0 + ai * 128 + m * 16) + col0;
#pragma unroll
                for (int bj = 0; bj < 2; ++bj) { f32x4 a = *(f32x4*)(p + bj * 128), b = *(f32x4*)(p + bj * 128 + 4);
                    a += acc[ai][bj][m][0]; b += acc[ai][bj][m][1]; if (!dry) { *(f32x4*)(p + bj * 128) = a; *(f32x4*)(p + bj * 128 + 4) = b; } } }
    }
};
struct EpiGeluMul {
    const bf16_t* G; const float* cw; const float* cb; bf16_t* O; int dv;
    __device__ __forceinline__ bool keep(const pg8::Unit&) const { return false; }
    __device__ __forceinline__ void operator()(acc_t& acc, const pg8::Unit& u, int wr, int wc, int fr, int fq) const {
        if (dv == 1) return;
        const int row0 = u.pm * 256 + wr * 64 + fr, col0 = u.pn * 256 + wc * 32 + 8 * fq;
#pragma unroll
        for (int ai = 0; ai < 2; ++ai)
#pragma unroll
            for (int m = 0; m < 4; ++m) { const int r = row0 + ai * 128 + m * 16;
                const int s = seq_of_row(r), p = r - seq_base(s); const bool inb = r < MROWS;
                const bool hasp = inb && p > 0, hasn = inb && p < seq_len(s) - 1;
                const float mp_ = hasp ? 1.f : 0.f, mn_ = hasn ? 1.f : 0.f;
#pragma unroll
                for (int bj = 0; bj < 2; ++bj) { const int col = col0 + bj * 128;
                    const bf16_t* gp = G + (size_t)r * DFF + col;
                    const u32x4 gm = *(const u32x4*)(gp - (hasp ? DFF : 0)), g0 = *(const u32x4*)gp, gn = *(const u32x4*)(gp + (hasn ? DFF : 0));
                    float fm[8], f0[8], fn[8]; unpack8(gm, fm); unpack8(g0, f0); unpack8(gn, fn);
                    float o[8];
#pragma unroll
                    for (int h = 0; h < 2; ++h) { const f32x4 a = *(const f32x4*)(cw + col + 4 * h), b = *(const f32x4*)(cw + DFF + col + 4 * h), c = *(const f32x4*)(cw + 2 * DFF + col + 4 * h), d = *(const f32x4*)(cb + col + 4 * h);
#pragma unroll
                        for (int e = 0; e < 4; e += 2) { f32x2 x; x.x = a[e] * mp_ * fm[4 * h + e] + b[e] * f0[4 * h + e] + c[e] * mn_ * fn[4 * h + e] + d[e];
                            x.y = a[e + 1] * mp_ * fm[4 * h + e + 1] + b[e + 1] * f0[4 * h + e + 1] + c[e + 1] * mn_ * fn[4 * h + e + 1] + d[e + 1];
                            const f32x2 g = pg8::gelu_pk(x); o[4 * h + e] = g.x; o[4 * h + e + 1] = g.y; } }
                    const f32x4 v0 = acc[ai][bj][m][0], v1 = acc[ai][bj][m][1];
                    u32x4 w; w.x = pg8::cvt_pk_bf16(o[0] * v0[0], o[1] * v0[1]); w.y = pg8::cvt_pk_bf16(o[2] * v0[2], o[3] * v0[3]);
                    w.z = pg8::cvt_pk_bf16(o[4] * v1[0], o[5] * v1[1]); w.w = pg8::cvt_pk_bf16(o[6] * v1[2], o[7] * v1[3]);
                    if (dv != 2) *(u32x4*)(O + (size_t)r * DFF + col) = w; else asm volatile("" :: "v"(w.x), "v"(w.y), "v"(w.z), "v"(w.w)); }
                if (m & 1) asm volatile("" ::: "memory"); }
    }
};
__device__ __forceinline__ void unpack8u(const u32x2 w, float* f) {
#pragma unroll
    for (int e = 0; e < 4; ++e) { f[e] = (float)((w.x >> (8 * e)) & 255u) * (1.f / 255.f); f[4 + e] = (float)((w.y >> (8 * e)) & 255u) * (1.f / 255.f); }
}
struct EpiMerge {
    const bf16_t* P; bf16_t* O;
    __device__ __forceinline__ bool keep(const pg8::Unit& u) const { return u.sub < 2; }
    __device__ __forceinline__ void operator()(acc_t& acc, const pg8::Unit& u, int wr, int wc, int fr, int fq) const {
        const int row0 = u.pm * 256 + wr * 64 + fr, col0 = u.pn * 256 + wc * 32 + 8 * fq; const int sub = u.sub;
#pragma unroll
        for (int ai = 0; ai < 2; ++ai)
#pragma unroll
            for (int m = 0; m < 4; ++m) { const int r = row0 + ai * 128 + m * 16;
#pragma unroll
                for (int bj = 0; bj < 2; ++bj) { const int col = col0 + bj * 128;
                    const unsigned char* gp = (const unsigned char*)(P + (size_t)r * INW) + C_G * 2 + col;
                    float mu[8];
                    if (sub < 2) { const u32x2 ga = *(const u32x2*)(gp + sub * DM), gb = *(const u32x2*)(gp + (sub + 1) * DM); float fa[8], fb[8]; unpack8u(ga, fa); unpack8u(gb, fb);
#pragma unroll
                        for (int e = 0; e < 8; ++e) mu[e] = fa[e] * __builtin_amdgcn_rcpf(fb[e]); }
                    else { const u32x2 ga = *(const u32x2*)(gp + 2 * DM); unpack8u(ga, mu); }
                    f32x4 v0 = acc[ai][bj][m][0], v1 = acc[ai][bj][m][1];
#pragma unroll
                    for (int e = 0; e < 4; ++e) { v0[e] *= mu[e]; v1[e] *= mu[4 + e]; }
                    if (sub < 2) { acc[ai][bj][m][0] = v0; acc[ai][bj][m][1] = v1; }
                    else { u32x4 w; w.x = pg8::cvt_pk_bf16(v0[0], v0[1]); w.y = pg8::cvt_pk_bf16(v0[2], v0[3]); w.z = pg8::cvt_pk_bf16(v1[0], v1[1]); w.w = pg8::cvt_pk_bf16(v1[2], v1[3]);
                        *(u32x4*)(O + (size_t)r * DM + col) = w; } } }
    }
};

#define XB_TMO      128
#define XB_XCNT(j)  (256  + 64 * (j))
#define XB_XSUB(j)  (1280 + 64 * (j))
#define XB_XGEN(j)  (2304 + 64 * (j))
#define XB_TOP      3328
#define XB_TOPGEN   3392
#define XCD_BAR_WORDS 3456
#define XB_SPIN_CAP (1u << 20)
__device__ __forceinline__ unsigned xb_ld(unsigned* p)              { return __hip_atomic_load(p, __ATOMIC_RELAXED, __HIP_MEMORY_SCOPE_AGENT); }
__device__ __forceinline__ unsigned xb_add(unsigned* p, unsigned v) { return __hip_atomic_fetch_add(p, v, __ATOMIC_RELAXED, __HIP_MEMORY_SCOPE_AGENT); }
__device__ __forceinline__ unsigned xb_xcc_id() { return (unsigned)__builtin_amdgcn_s_getreg((3 << 11) | 20) & 0xFu; }
#define XB_SPIN(cond, bar) do { unsigned _sp = 0; while (cond) { __builtin_amdgcn_s_sleep(1); \
    if ((++_sp & 255u) == 0u) { if (xb_ld(&(bar)[XB_TMO])) break; if (_sp > XB_SPIN_CAP) { atomicAdd(&(bar)[XB_TMO], 1u); break; } } } } while (0)
struct XcdBarrier { unsigned* bar; unsigned x; volatile LAS unsigned* st; };
__device__ __forceinline__ XcdBarrier xcd_barrier_post(unsigned* bar, volatile LAS unsigned* st) {
    XcdBarrier b; b.bar = bar; b.x = xb_xcc_id(); b.st = st;
    if (threadIdx.x == 0) (void)xb_add(&bar[XB_XCNT(b.x)], 1u);
    return b;
}
__device__ __forceinline__ void xcd_barrier_complete(unsigned* bar, unsigned x, unsigned& nloc, unsigned& nx) {
    const unsigned G = gridDim.x * gridDim.y * gridDim.z;
    unsigned sum, cnt, mine, sp = 0u;
    for (;;) {
        sum = 0u; cnt = 0u; mine = 0u;
#pragma unroll
        for (unsigned j = 0; j < 16; ++j) { const unsigned c = xb_ld(&bar[XB_XCNT(j)]); sum += c; cnt += (c > 0u) ? 1u : 0u; mine = (j == x) ? c : mine; }
        if (sum == G) break;
        __builtin_amdgcn_s_sleep(1);
        if ((++sp & 255u) == 0u) { if (xb_ld(&bar[XB_TMO])) break; if (sp > XB_SPIN_CAP) { atomicAdd(&bar[XB_TMO], 1u); break; } }
    }
    nloc = mine > 0u ? mine : 1u; nx = cnt > 0u ? cnt : 1u;
}
__device__ __forceinline__ void xcd_barrier(const XcdBarrier& b, int tid) {
    asm volatile("s_waitcnt vmcnt(0)" ::: "memory");
    __syncthreads();
    if (tid == 0) {
        unsigned* bar = b.bar;
        __builtin_amdgcn_s_waitcnt(0);
        unsigned nloc = b.st[0], nx = b.st[1];
        if (nloc == 0u) { xcd_barrier_complete(bar, b.x, nloc, nx); b.st[0] = nloc; b.st[1] = nx; }
        const unsigned old = xb_add(&bar[XB_XSUB(b.x)], 1u);
        const unsigned gen = old / nloc;
        if (old + 1u == (gen + 1u) * nloc) {
            __builtin_amdgcn_fence(__ATOMIC_RELEASE, "agent");
            asm volatile("s_waitcnt vmcnt(0)" ::: "memory");
            const unsigned og = xb_add(&bar[XB_TOP], 1u);
            const unsigned tg = og / nx;
            if (og + 1u == (tg + 1u) * nx) xb_add(&bar[XB_TOPGEN], 1u);
            else XB_SPIN(xb_ld(&bar[XB_TOPGEN]) == tg, bar);
            __builtin_amdgcn_fence(__ATOMIC_ACQUIRE, "agent");
            xb_add(&bar[XB_XGEN(b.x)], 1u);
            asm volatile("s_waitcnt vmcnt(0)" ::: "memory");
        } else {
            XB_SPIN(xb_ld(&bar[XB_XGEN(b.x)]) == gen, bar);
            __builtin_amdgcn_fence(__ATOMIC_ACQUIRE, "agent");
            asm volatile("s_waitcnt vmcnt(0)" ::: "memory");
        }
    }
    __syncthreads();
}

constexpr int NWAVES = 8;
constexpr int RING_BYTES = 131072, LDSCTL_OFF = RING_BYTES, MISC_OFF = LDSCTL_OFF + 320, LDS_BYTES = 147456;
struct Args { const float* in[30]; float* out; unsigned char* ws; int ph_lo, ph_hi, use_bar, pad; };
typedef const __attribute__((address_space(4))) Args CArgs;
struct Frame {
    LAS unsigned char* lds; int tid, lane, wave, G, vcu, bx, dry;
    float* out; unsigned char* ws; float* xm;
};
#define FIN(i) (A.in[i])

__constant__ unsigned char c_bucket[257] = {
15,15,15,15,15,15,15,15,15,15,15,15,15,15,15,15,15,15,15,15,15,15,15,15,15,15,15,15,15,15,15,15,15,15,15,15,15,15,14,14,14,14,14,14,14,14,14,14,14,14,14,14,14,14,14,14,14,14,14,14,14,14,14,14,14,13,13,13,13,13,13,13,13,13,13,13,13,13,13,13,13,13,13,12,12,12,12,12,12,12,12,12,12,12,12,12,12,11,11,11,11,11,11,11,11,11,10,10,10,10,10,10,10,9,9,9,9,8,8,8,8,7,6,5,4,3,2,1,0,17,18,19,20,21,22,23,24,24,24,24,25,25,25,25,26,26,26,26,26,26,26,27,27,27,27,27,27,27,27,27,28,28,28,28,28,28,28,28,28,28,28,28,28,28,29,29,29,29,29,29,29,29,29,29,29,29,29,29,29,29,29,29,30,30,30,30,30,30,30,30,30,30,30,30,30,30,30,30,30,30,30,30,30,30,30,30,30,30,30,31,31,31,31,31,31,31,31,31,31,31,31,31,31,31,31,31,31,31,31,31,31,31,31,31,31,31,31,31,31,31,31,31,31,31,31,31,31};

__device__ __forceinline__ void p0_transpose_item(const float* W, int K, int N, bf16_t* WT, int row_off, LAS float* scr, int item, int lane) {
    const int nblk = N / 32, kb = item / nblk, nb = item % nblk, k0 = 64 * kb, n0 = 32 * nb;
    f32x4 v[8];
#pragma unroll
    for (int i = 0; i < 8; ++i) v[i] = *(const f32x4*)(W + (size_t)(k0 + 8 * i + (lane >> 3)) * N + n0 + 4 * (lane & 7));
#pragma unroll
    for (int i = 0; i < 8; ++i) { LAS float* d = scr + (8 * i + (lane >> 3)) * 33 + 4 * (lane & 7); d[0] = v[i].x; d[1] = v[i].y; d[2] = v[i].z; d[3] = v[i].w; }
    LDS_WAIT(); asm volatile("" ::: "memory");
    const int c = lane & 7;
#pragma unroll
    for (int j = 0; j < 4; ++j) { const int n = (lane >> 3) + 8 * j; const LAS float* s = scr + (8 * c) * 33 + n;
        u32x4 o; o.x = pk2(s[0 * 33], s[1 * 33]); o.y = pk2(s[2 * 33], s[3 * 33]); o.z = pk2(s[4 * 33], s[5 * 33]); o.w = pk2(s[6 * 33], s[7 * 33]);
        *(u32x4*)(WT + (size_t)(row_off + n0 + n) * K + k0 + 8 * c) = o; }
    LDS_WAIT(); asm volatile("" ::: "memory");
}
__device__ __forceinline__ void rms_row(const f32x4 (&v)[4], const float* g, bf16_t* orow, int lane) {
    float s = 0.f;
#pragma unroll
    for (int j = 0; j < 4; ++j) s += (v[j].x * v[j].x + v[j].y * v[j].y) + (v[j].z * v[j].z + v[j].w * v[j].w);
    const float rstd = 1.0f / sqrtf(wave_sum(s, lane) * (1.f / DM) + EPS);
    unsigned long long* o8 = (unsigned long long*)orow + lane;
#pragma unroll
    for (int j = 0; j < 4; ++j) { const f32x4 gg = *((const f32x4*)g + lane + 64 * j);
        o8[64 * j] = (unsigned long long)pk2(v[j].x * rstd * gg.x, v[j].y * rstd * gg.y) | ((unsigned long long)pk2(v[j].z * rstd * gg.z, v[j].w * rstd * gg.w) << 32); }
}
constexpr size_t WS_H2F_P = 2 * MiB, WS_H2F_S = WS_END;
constexpr int NCH_P = (LP + 31) / 32, NCH_S = (LS + 31) / 32;
static_assert(WS_H2F_S + (size_t)NCH_S * 32 * 128 <= 512 * MiB && WS_H2F_P + (size_t)NCH_P * 32 * 128 <= WS_W, "h2 scratch");
__device__ __forceinline__ void filt_h2_compute(const CArgs& A, const Frame& F, int layer, int L, int tc, LAS float* h1t, int lane, float (&acc)[32]) {
    const float* w1 = FIN(11) + (size_t)layer * 33 * 64; const float* b1 = FIN(12) + layer * 64;
    const float* w2 = FIN(13) + (size_t)layer * 64 * 64; const float* b2 = FIN(14) + layer * 64; const float* fq_ = FIN(16) + layer * 64;
    const int pos = lane & 31, half = lane >> 5, jb = 32 * half;
    const float tt = (float)tc / (float)(L - 1);
    { f32x4 bv[8], wv[8];
#pragma unroll
      for (int i = 0; i < 8; ++i) { bv[i] = *(const f32x4*)(b1 + jb + 4 * i); wv[i] = *(const f32x4*)(w1 + jb + 4 * i); }
#pragma unroll
      for (int i = 0; i < 8; ++i)
#pragma unroll
          for (int e = 0; e < 4; ++e) acc[4 * i + e] = bv[i][e] + tt * wv[i][e]; }
#pragma unroll 2
    for (int k = 0; k < 16; ++k) {
        const float f = 1e-4f + (float)k * ((15.0f - 1e-4f) / 15.0f);
        const float rev = f * (float)tc * (1.0f / (float)L);
        const float sn = __builtin_amdgcn_sinf(rev), cs = __builtin_amdgcn_cosf(rev);
        f32x4 wc_[8], ws_[8];
#pragma unroll
        for (int i = 0; i < 8; ++i) { wc_[i] = *(const f32x4*)(w1 + (size_t)(1 + k) * 64 + jb + 4 * i); ws_[i] = *(const f32x4*)(w1 + (size_t)(17 + k) * 64 + jb + 4 * i); }
#pragma unroll
        for (int i = 0; i < 8; ++i)
#pragma unroll
            for (int e = 0; e < 4; ++e) acc[4 * i + e] += cs * wc_[i][e] - sn * ws_[i][e];
    }
    { f32x4 fv[8];
#pragma unroll
      for (int i = 0; i < 8; ++i) fv[i] = *(const f32x4*)(fq_ + jb + 4 * i);
#pragma unroll
      for (int i = 0; i < 8; ++i)
#pragma unroll
          for (int e = 0; e < 4; ++e) h1t[(jb + 4 * i + e) * 32 + pos] = __builtin_amdgcn_sinf(fv[i][e] * acc[4 * i + e] * 0.15915494309189535f); }
    LDS_WAIT();
    { f32x4 bv[8];
#pragma unroll
      for (int i = 0; i < 8; ++i) bv[i] = *(const f32x4*)(b2 + jb + 4 * i);
#pragma unroll
      for (int i = 0; i < 8; ++i)
#pragma unroll
          for (int e = 0; e < 4; ++e) acc[4 * i + e] = bv[i][e]; }
#pragma unroll 4
    for (int i2 = 0; i2 < 64; ++i2) { const float h = h1t[i2 * 32 + pos]; f32x4 wv[8];
#pragma unroll
        for (int i = 0; i < 8; ++i) wv[i] = *(const f32x4*)(w2 + (size_t)i2 * 64 + jb + 4 * i);
#pragma unroll
        for (int i = 0; i < 8; ++i)
#pragma unroll
            for (int e = 0; e < 4; ++e) acc[4 * i + e] += h * wv[i][e]; }
}
__device__ __forceinline__ void filt_h2_item(const CArgs& A, const Frame& F, int layer, int item, LAS float* h1t, int lane) {
    const int cls = item >= NCH_P ? 1 : 0, ch = cls ? item - NCH_P : item, L = cls ? LS : LP;
    const int pos = lane & 31, half = lane >> 5, jb = 32 * half;
    const int t = ch * 32 + pos, tc = t < L ? t : L - 1;
    const float* fq_ = FIN(16) + layer * 64;
    float acc[32];
    filt_h2_compute(A, F, layer, L, tc, h1t, lane, acc);
    { f32x4 fv[8]; unsigned hw[16];
#pragma unroll
      for (int i = 0; i < 8; ++i) fv[i] = *(const f32x4*)(fq_ + jb + 4 * i);
#pragma unroll
      for (int i = 0; i < 8; ++i)
#pragma unroll
          for (int e = 0; e < 4; e += 2) { const float a0 = __builtin_amdgcn_sinf(fv[i][e] * acc[4 * i + e] * 0.15915494309189535f), a1 = __builtin_amdgcn_sinf(fv[i][e + 1] * acc[4 * i + e + 1] * 0.15915494309189535f);
              typedef _Float16 h2_t __attribute__((ext_vector_type(2))); const h2_t hv = {(_Float16)a0, (_Float16)a1}; hw[2 * i + (e >> 1)] = __builtin_bit_cast(unsigned, hv); }
      u32x4* dst = (u32x4*)(F.ws + (cls ? WS_H2F_S : WS_H2F_P) + (size_t)t * 128 + half * 64);
#pragma unroll
      for (int i = 0; i < 4; ++i) dst[i] = (u32x4){hw[4 * i], hw[4 * i + 1], hw[4 * i + 2], hw[4 * i + 3]}; }
    LDS_WAIT();
}
constexpr int NCHF_P = (LP - 1 + 31) / 32 + 1, NCHB_P = (LP + 31) / 32, NCHF_S = (LS - 1 + 31) / 32 + 1, NCHB_S = (LS + 31) / 32;
constexpr int NFI_P = NCHF_P + NCHB_P, NFI = NFI_P + NCHF_S + NCHB_S;
__device__ __forceinline__ void filt_tile_item(const CArgs& A, const Frame& F, int layer, int item, int lane) {
    const int ct = item & 15; int cls = 0, it = item >> 4; if (it >= NFI_P) { cls = 1; it -= NFI_P; }
    const int nchf = cls ? NCHF_S : NCHF_P, L = cls ? LS : LP;
    bool bwd; int ch; if (it < nchf) { bwd = false; ch = it - 1; } else { bwd = true; ch = it - nchf; }
    const int tsh = bwd ? 0 : 1;
    const float* w3 = FIN(15) + (size_t)layer * 64 * 1024;
    const int pos = lane & 31, half = lane >> 5;
    const int t = ch * 32 + pos + tsh, tc = t < 0 ? 0 : (t < L ? t : L - 1);
    float acc[32];
#if FT_RECOMPUTE
    if (FT_RECOMPUTE == 1 || FT_RECOMPUTE == 9 || (FT_RECOMPUTE == 2 && cls == 0) || (FT_RECOMPUTE == 3 && cls == 1)) { LAS float* h1t = (LAS float*)(F.lds + F.wave * 16384); filt_h2_compute(A, F, layer, L, tc, h1t, lane, acc); const float* fq_ = FIN(16) + layer * 64;
#pragma unroll
      for (int k = 0; k < 32; ++k) acc[k] = __builtin_amdgcn_sinf(fq_[32 * half + k] * acc[k] * 0.15915494309189535f); LDS_WAIT(); }
    else
#endif
    { const u32x4* src = (const u32x4*)(F.ws + (cls ? WS_H2F_S : WS_H2F_P) + (size_t)tc * 128 + half * 64);
      u32x4 hv[4];
#pragma unroll
      for (int i = 0; i < 4; ++i) hv[i] = src[i];
#pragma unroll
      for (int i = 0; i < 4; ++i)
#pragma unroll
          for (int e = 0; e < 4; ++e) { typedef _Float16 h2_t __attribute__((ext_vector_type(2))); const unsigned wv_ = hv[i][e];
              const h2_t p = __builtin_bit_cast(h2_t, wv_); acc[8 * i + 2 * e] = (float)p[0]; acc[8 * i + 2 * e + 1] = (float)p[1]; } }
#if FT_RECOMPUTE == 9
    float bad = 0.f;
    { const u32x4* src = (const u32x4*)(F.ws + (cls ? WS_H2F_S : WS_H2F_P) + (size_t)tc * 128 + half * 64);
#pragma unroll
      for (int i = 0; i < 4; ++i) { const u32x4 hvv = src[i];
#pragma unroll
          for (int e = 0; e < 4; ++e) { typedef _Float16 h2_t __attribute__((ext_vector_type(2))); const h2_t p = __builtin_bit_cast(h2_t, hvv[e]);
              if (fabsf((float)p[0] - acc[8 * i + 2 * e]) > 2e-3f || fabsf((float)p[1] - acc[8 * i + 2 * e + 1]) > 2e-3f) bad = 1e4f; } } }
#else
    const float bad = 0.f;
#endif
    bf16_t* RK = (bf16_t*)(F.ws + (cls ? WS_RKS : WS_RKP)); const int rklen = cls ? RKLEN_S : RKLEN_P;
    float* sums = (float*)(F.ws + WS_CTL) + CW_SUMS + (layer * 2 + cls) * 512;
    const float da = -15.350567286626973f, db = -3.0701134573253945f;
    {
        const int col0 = (bwd ? 512 : 0) + ct * 32;
        float bw[32];
#pragma unroll
        for (int ks = 0; ks < 32; ++ks) bw[ks] = w3[(size_t)(32 * half + ks) * 1024 + col0 + pos];
        f32x16 d = {};
#pragma unroll
        for (int ks = 0; ks < 32; ++ks) d = __builtin_amdgcn_mfma_f32_32x32x2f32(acc[ks], bw[ks], d, 0, 0, 0);
        const int c = (col0 + pos) & 511;
        const float delta = fabsf(da + (db - da) * ((float)c / 511.0f));
        bf16_t* rk = RK + (size_t)c * rklen + RK_PAD + L;
        float asum = 0.f;
#pragma unroll
        for (int g = 0; g < 4; ++g) { const int t0 = ch * 32 + 8 * g + 4 * half + tsh; float v[4];
#pragma unroll
            for (int e = 0; e < 4; ++e) { const int tp = t0 + e; const bool ok = tp >= 0 && tp < L && !(bwd && tp == 0);
                const float tq = (float)tp / (float)(L - 1); v[e] = ok ? d[4 * g + e] * __expf(-tq * delta) + bad : 0.f; asum += fabsf(v[e]); }
            if (bwd) { if (t0 >= 4 && t0 + 3 < L) { u32x2 w; w.x = pk2(v[0], v[1]); w.y = pk2(v[2], v[3]); *(u32x2*)(rk + t0) = w; }
                       else {
#pragma unroll
                           for (int e = 0; e < 4; ++e) if (t0 + e >= 1 && t0 + e < L) rk[t0 + e] = (bf16_t)f2bf(v[e]); } }
            else { if (t0 >= 0 && t0 + 3 < L) { u32x2 w; w.x = pk2(v[3], v[2]); w.y = pk2(v[1], v[0]); *(u32x2*)(rk - t0 - 3) = w; }
                   else {
#pragma unroll
                       for (int e = 0; e < 4; ++e) if (t0 + e >= 0 && t0 + e < L) rk[-(t0 + e)] = (bf16_t)f2bf(v[e]); } } }
        asum += shx(asum, 32, lane);
        if (half == 0 && !F.dry) atomicAdd(sums + c, asum);
    }
}
__device__ __forceinline__ void p_filt_tiles(const CArgs& A, const Frame& F, int layer) {
    const int gw = F.vcu * NWAVES + F.wave, NGW = F.G * NWAVES;
    for (int it = gw; it < 16 * NFI; it += NGW) filt_tile_item(A, F, layer, it, F.lane);
}
__device__ __forceinline__ void p_prep(const CArgs& A, const Frame& F, int layer) {
    const int gw = F.vcu * NWAVES + F.wave, NGW = F.G * NWAVES, lane = F.lane;
    if (DSEL(1)) {
        const float* g = FIN(4) + layer * DM; bf16_t* XN = (bf16_t*)(F.ws + WS_XNR);
        for (int r0 = gw; r0 < MP; r0 += 2 * NGW) {
            f32x4 v[2][4]; const int rr[2] = {r0, r0 + NGW};
#pragma unroll
            for (int q = 0; q < 2; ++q) { const int r = rr[q];
                if (r >= MP) continue;
                if (r >= MROWS) {
#pragma unroll
                    for (int j = 0; j < 4; ++j) v[q][j] = (f32x4){0.f, 0.f, 0.f, 0.f};
                } else if (layer == 0) {
                    const int s = seq_of_row(r), p = r - seq_base(s);
                    const float* src = p < NMETA ? FIN(2) + (size_t)p * DM : (s < 8 ? FIN(0) + ((size_t)s * 2048 + (p - NMETA)) * DM : FIN(1) + (size_t)(p - NMETA) * DM);
                    const f32x4* sr = (const f32x4*)src + lane;
#pragma unroll
                    for (int j = 0; j < 4; ++j) v[q][j] = sr[64 * j];
                } else {
                    const f32x4* xr = (const f32x4*)xrow(F.out, F.xm, r) + lane;
#pragma unroll
                    for (int j = 0; j < 4; ++j) v[q][j] = xr[64 * j];
                } }
#pragma unroll
            for (int q = 0; q < 2; ++q) { const int r = rr[q];
                if (r >= MP) continue;
                if (layer == 0) { f32x4* xr = (f32x4*)xrow(F.out, F.xm, r) + lane;
#pragma unroll
                    for (int j = 0; j < 4; ++j) xr[64 * j] = v[q][j]; }
                rms_row(v[q], g, XN + (size_t)r * DM, lane); }
        }
    }
    {
        LAS float* scr = (LAS float*)(F.lds + F.wave * 16384);
        unsigned char* W = F.ws + WS_W;
        constexpr int I_IN = (DM / 64) * (INW / 32), I_G = (DM / 64) * (DFF / 32), I_D = (DFF / 64) * (DM / 32), I_O = (DM / 64) * (DM / 32), I_M = (512 / 64) * (DM / 32);
        constexpr int NIT = I_IN + 2 * I_G + I_D + I_O + 2 * I_M;
        if (DSEL(2)) for (int it = gw; it < NIT; it += NGW) {
            int r = it;
            if (r < I_IN) { p0_transpose_item(FIN(5) + (size_t)layer * DM * INW, DM, INW, (bf16_t*)(W + W_IN), 0, scr, r, lane); continue; } r -= I_IN;
            if (r < I_G) { p0_transpose_item(FIN(25) + (size_t)layer * DM * DFF, DM, DFF, (bf16_t*)(W + W_G), 0, scr, r, lane); continue; } r -= I_G;
            if (r < I_G) { p0_transpose_item(FIN(26) + (size_t)layer * DM * DFF, DM, DFF, (bf16_t*)(W + W_U), 0, scr, r, lane); continue; } r -= I_G;
            if (r < I_D) { p0_transpose_item(FIN(29) + (size_t)layer * DFF * DM, DFF, DM, (bf16_t*)(W + W_D), 0, scr, r, lane); continue; } r -= I_D;
            if (r < I_O) { p0_transpose_item(FIN(23) + (size_t)layer * DM * DM, DM, DM, (bf16_t*)(W + W_OUT), 0, scr, r, lane); continue; } r -= I_O;
            if (r < I_M) { p0_transpose_item(FIN(20) + (size_t)layer * 512 * DM, 512, DM, (bf16_t*)(W + W_MRG), 0, scr, r, lane); continue; } r -= I_M;
            p0_transpose_item(FIN(21) + (size_t)layer * 512 * DM, 512, DM, (bf16_t*)(W + W_MRG), DM, scr, r, lane);
        }
        const float* pw = FIN(18) + (size_t)layer * 4 * 128 * 128; const float* psc = FIN(19) + layer * 512; const float* wpo = FIN(22) + (size_t)layer * 512 * DM;
        bf16_t* WT = (bf16_t*)(W + W_MRG) + (size_t)2 * DM * 512;
        const int gt = (F.vcu * NWAVES + F.wave) * 64 + lane, NGT = NGW * 64;
        if (DSEL(4)) for (int idx = gt; idx < 512 * DM; idx += NGT) { const int j = idx & (DM - 1), c = idx >> 10, g = c >> 7, cc = c & 127;
            const float* pr = pw + ((size_t)g * 128 + cc) * 128; const float* wp = wpo + (size_t)(g * 128) * DM + j; const float* ps = psc + g * 128; float a = 0.f;
#pragma unroll 32
            for (int d = 0; d < 128; ++d) a += pr[d] * ps[d] * wp[(size_t)d * DM];
            WT[(size_t)j * 512 + c] = (bf16_t)f2bf(a); }
        for (int idx = gt; idx < 2 * 512 * 513; idx += NGT) { const int k = idx % 513, cc = (idx / 513) & 511, cls = idx / (513 * 512);
            const int L = cls ? LS : LP, rklen = cls ? RKLEN_S : RKLEN_P; bf16_t* RK = (bf16_t*)(F.ws + (cls ? WS_RKS : WS_RKP)) + (size_t)cc * rklen;
            RK[k <= 256 ? k : 256 + 2 * L + (k - 257)] = 0; }
        if (DSEL(8)) for (int it = gw; it < NCH_P + NCH_S; it += NGW) filt_h2_item(A, F, layer, it, scr, lane);
    }
}

__device__ __forceinline__ void p_attn_ref(const CArgs& A, const Frame& F, int layer) {
    bf16_t* P = (bf16_t*)(F.ws + WS_PROJ);
    const float* qg = FIN(6) + layer * HD; const float* kg = FIN(7) + layer * HD; const float* sink = FIN(8) + layer * NHEAD; const float* rb = FIN(3);
    const int gt = (F.vcu * NWAVES + F.wave) * 64 + F.lane, NGT = F.G * NWAVES * 64;
    for (int idx = gt; idx < MROWS * NHEAD; idx += NGT) {
        const int r = idx >> 3, h = idx & 7, hk = h >> 2;
        const int s = seq_of_row(r), base = seq_base(s), L = seq_len(s), p = r - base;
        unsigned qs[32]; float o[64];
        { const u32x4* qp = (const u32x4*)(P + (size_t)r * INW + C_Q + 64 * h); float ss = 0.f;
#pragma unroll
          for (int c = 0; c < 8; ++c) { const u32x4 w = qp[c]; qs[4 * c] = w.x; qs[4 * c + 1] = w.y; qs[4 * c + 2] = w.z; qs[4 * c + 3] = w.w; }
#pragma unroll
          for (int d = 0; d < 32; ++d) { const float a = bflo(qs[d]), b = bfhi(qs[d]); ss += a * a + b * b; }
          const float rs = 1.0f / sqrtf(ss * (1.f / 64) + EPS) * 0.125f;
#pragma unroll
          for (int d = 0; d < 32; ++d) { qs[d] = pk2(bflo(qs[d]) * rs * qg[2 * d], bfhi(qs[d]) * rs * qg[2 * d + 1]); o[2 * d] = 0.f; o[2 * d + 1] = 0.f; } }
        float m = sink[h], l = 1.f;
        const int lo = p - 128 < 0 ? 0 : p - 128, hi = p + 128 > L - 1 ? L - 1 : p + 128;
        for (int pk = lo; pk <= hi; ++pk) {
            const bf16_t* kr = P + (size_t)(base + pk) * INW;
            const u32x4* kp = (const u32x4*)(kr + C_K + 64 * hk); const u32x4* vp = (const u32x4*)(kr + C_V + 64 * hk);
            float ss = 0.f, dt = 0.f;
#pragma unroll
            for (int c = 0; c < 8; ++c) { float kk[8]; unpack8(kp[c], kk);
#pragma unroll
                for (int e = 0; e < 8; ++e) { ss += kk[e] * kk[e]; const unsigned qw = qs[4 * c + (e >> 1)]; dt += kk[e] * kg[8 * c + e] * ((e & 1) ? bfhi(qw) : bflo(qw)); }
                asm volatile("" ::: "memory"); }
            const float sc = dt / sqrtf(ss * (1.f / 64) + EPS) + rb[c_bucket[pk - p + 128] * NHEAD + h];
            const float mn = fmaxf(m, sc), f = __expf(m - mn), pe = __expf(sc - mn);
            l = l * f + pe; m = mn;
#pragma unroll
            for (int c = 0; c < 8; ++c) { float vv[8]; unpack8(vp[c], vv);
#pragma unroll
                for (int e = 0; e < 8; ++e) o[8 * c + e] = o[8 * c + e] * f + pe * vv[e];
                asm volatile("" ::: "memory"); }
        }
        const float il = (DBG & 4) ? 0.f : 1.f / l; u32x4* op = (u32x4*)(P + (size_t)r * INW + C_Q + 64 * h);
#pragma unroll
        for (int c = 0; c < 8; ++c) { u32x4 w; w.x = pk2(o[8 * c] * il, o[8 * c + 1] * il); w.y = pk2(o[8 * c + 2] * il, o[8 * c + 3] * il); w.z = pk2(o[8 * c + 4] * il, o[8 * c + 5] * il); w.w = pk2(o[8 * c + 6] * il, o[8 * c + 7] * il); op[c] = w; }
    }
}

constexpr int AT_K = 0, AT_V = 49152, AT_VSTR = 192, AT_B = AT_V + 384 * AT_VSTR;
typedef short v4i16_t __attribute__((ext_vector_type(4)));
__device__ __forceinline__ void p_attn(const CArgs& A, const Frame& F, int layer) {
    bf16_t* P = (bf16_t*)(F.ws + WS_PROJ);
    const float* qg = FIN(6) + layer * HD; const float* kg = FIN(7) + layer * HD; const float* sink = FIN(8) + layer * NHEAD; const float* rb = FIN(3);
    const int lane = F.lane, wave = F.wave, tid = F.tid, r32 = lane & 31, hi = lane >> 5;
    LAS unsigned char* lds = F.lds;
    for (int unit = F.vcu; unit < 265 * 4; unit += F.G) {
        const int gb = unit >> 2, hk = (unit >> 1) & 1, gh = unit & 1;
        const int s = gb < 136 ? gb / 17 : 8, nb = gb < 136 ? gb - 17 * s : gb - 136;
        const int base = seq_base(s), L = seq_len(s);
        const int pk0 = 128 * nb - 240;
        u32x4 kws[6], vws[6];
#pragma unroll
        for (int it = 0; it < 6; ++it) { const int idx = tid + it * 512, key = idx >> 3, ch = idx & 7, pk = pk0 + key; const bool ok = pk >= 0 && pk < L;
            const bf16_t* rowp = P + (size_t)(base + (ok ? pk : 0)) * INW + 64 * hk + 8 * ch;
            kws[it] = *(const u32x4*)(rowp + C_K); vws[it] = *(const u32x4*)(rowp + C_V); }
#pragma unroll
        for (int it = 0; it < 6; ++it) { const int idx = tid + it * 512, key = idx >> 3, ch = idx & 7, pk = pk0 + key; const bool ok = pk >= 0 && pk < L;
            u32x4 kw = kws[it], vw = vws[it];
            float kf[8]; unpack8(kw, kf); float ss = 0.f;
#pragma unroll
            for (int e = 0; e < 8; ++e) ss += kf[e] * kf[e];
            ss += shx(ss, 1, lane); ss += shx(ss, 2, lane); ss += shx(ss, 4, lane);
            const float rs = ok ? 1.0f / sqrtf(ss * (1.f / 64) + EPS) : 0.f;
            u32x4 ko; ko.x = pk2(kf[0] * rs * kg[8 * ch], kf[1] * rs * kg[8 * ch + 1]); ko.y = pk2(kf[2] * rs * kg[8 * ch + 2], kf[3] * rs * kg[8 * ch + 3]);
            ko.z = pk2(kf[4] * rs * kg[8 * ch + 4], kf[5] * rs * kg[8 * ch + 5]); ko.w = pk2(kf[6] * rs * kg[8 * ch + 6], kf[7] * rs * kg[8 * ch + 7]);
            *(LAS u32x4*)(lds + AT_K + key * 128 + ((ch ^ (key & 7)) << 4)) = ko;
            if (!ok) vw = (u32x4){0u, 0u, 0u, 0u};
            *(LAS u32x4*)(lds + AT_V + key * AT_VSTR + ch * 16) = vw; }
        for (int i = tid; i < 2 * 257; i += 512) { const int hh = i >= 257 ? 1 : 0, rr = i - 257 * hh; ((LAS float*)(lds + AT_B))[hh * 260 + rr] = rb[c_bucket[rr] * NHEAD + 4 * hk + 2 * gh + hh]; }
        __syncthreads();
        const int hh = wave >> 2, head = 4 * hk + 2 * gh + hh, qt = wave & 3, qi = 32 * qt + r32, pq = 128 * nb - 112 + qi; const bool qok = pq >= 0;
        const LAS float* bias = (const LAS float*)(lds + AT_B) + hh * 260;
        bf16x8 qf[4];
        { const bf16_t* qp = P + (size_t)(base + (qok ? pq : 0)) * INW + C_Q + 64 * head + 8 * hi; u32x4 qw[4]; float ss = 0.f;
#pragma unroll
          for (int ds = 0; ds < 4; ++ds) { qw[ds] = *(const u32x4*)(qp + 16 * ds); float f[8]; unpack8(qw[ds], f);
#pragma unroll
              for (int e = 0; e < 8; ++e) ss += f[e] * f[e]; }
          ss += shx(ss, 32, lane);
          const float rs = 0.125f / sqrtf(ss * (1.f / 64) + EPS);
#pragma unroll
          for (int ds = 0; ds < 4; ++ds) { float f[8]; unpack8(qw[ds], f); const float* g = qg + 16 * ds + 8 * hi; u32x4 o;
              o.x = pk2(f[0] * rs * g[0], f[1] * rs * g[1]); o.y = pk2(f[2] * rs * g[2], f[3] * rs * g[3]); o.z = pk2(f[4] * rs * g[4], f[5] * rs * g[5]); o.w = pk2(f[6] * rs * g[6], f[7] * rs * g[7]);
              qf[ds] = __builtin_bit_cast(bf16x8, o); } }
        float m = sink[head], lp = hi == 0 ? 1.f : 0.f;
        f32x16 o0 = {}, o1 = {};
        for (int kt = qt; kt <= qt + 8; ++kt) {
            f32x16 st = {};
#pragma unroll
            for (int ds = 0; ds < 4; ++ds) { const int key = 32 * kt + r32, chn = 2 * ds + hi;
                const bf16x8 kfr = *(const LAS bf16x8*)(lds + AT_K + key * 128 + ((chn ^ (key & 7)) << 4));
                st = __builtin_amdgcn_mfma_f32_32x32x16_bf16(kfr, qf[ds], st, 0, 0, 0); }
            float tmax = -1e30f;
#pragma unroll
            for (int i = 0; i < 16; ++i) { const int kj = 32 * kt + (i & 3) + 8 * (i >> 2) + 4 * hi, rel = kj - 128 - qi, pk = pk0 + kj;
                const bool ok = rel >= -128 && rel <= 128 && pk >= 0 && pk < L;
                const float v = ok ? st[i] + bias[rel + 128 < 0 ? 0 : (rel + 128 > 256 ? 256 : rel + 128)] : -1e30f;
                st[i] = v; tmax = fmaxf(tmax, v); }
            tmax = fmaxf(tmax, shx(tmax, 32, lane));
            const float mn = fmaxf(m, tmax), f = __expf(m - mn); m = mn;
            float ps = 0.f;
#pragma unroll
            for (int i = 0; i < 16; ++i) { st[i] = __expf(st[i] - mn); ps += st[i]; }
            lp = lp * f + ps;
#pragma unroll
            for (int i = 0; i < 16; ++i) { o0[i] *= f; o1[i] *= f; }
#pragma unroll
            for (int s2 = 0; s2 < 2; ++s2) {
                u32x4 pw; pw.x = pk2(st[8 * s2], st[8 * s2 + 1]); pw.y = pk2(st[8 * s2 + 2], st[8 * s2 + 3]); pw.z = pk2(st[8 * s2 + 4], st[8 * s2 + 5]); pw.w = pk2(st[8 * s2 + 6], st[8 * s2 + 7]);
                const bf16x8 pf = __builtin_bit_cast(bf16x8, pw);
#pragma unroll
                for (int dt = 0; dt < 2; ++dt) {
                    const LAS unsigned char* vp = lds + AT_V + (32 * kt + 16 * s2 + 4 * hi + ((lane & 15) >> 2)) * AT_VSTR + (32 * dt + 16 * ((lane >> 4) & 1) + 4 * (lane & 3)) * 2;
                    const v4i16_t t0 = __builtin_amdgcn_ds_read_tr16_b64_v4i16((LAS v4i16_t*)vp), t1 = __builtin_amdgcn_ds_read_tr16_b64_v4i16((LAS v4i16_t*)(vp + 8 * AT_VSTR));
                    const bf16x8 vf = (bf16x8){t0[0], t0[1], t0[2], t0[3], t1[0], t1[1], t1[2], t1[3]};
                    if (dt == 0) o0 = __builtin_amdgcn_mfma_f32_32x32x16_bf16(vf, pf, o0, 0, 0, 0); else o1 = __builtin_amdgcn_mfma_f32_32x32x16_bf16(vf, pf, o1, 0, 0, 0); }
            }
        }
        const float il = (DBG & 4) ? 0.f : 1.f / (lp + shx(lp, 32, lane));
        if (qok && !F.dry) { bf16_t* op = P + (size_t)(base + pq) * INW + C_Q + 64 * head + 4 * hi;
#pragma unroll
            for (int g = 0; g < 4; ++g) { u32x2 w0, w1; w0.x = pk2(o0[4 * g] * il, o0[4 * g + 1] * il); w0.y = pk2(o0[4 * g + 2] * il, o0[4 * g + 3] * il);
                w1.x = pk2(o1[4 * g] * il, o1[4 * g + 1] * il); w1.y = pk2(o1[4 * g + 2] * il, o1[4 * g + 3] * il);
                *(u32x2*)(op + 8 * g) = w0; *(u32x2*)(op + 32 + 8 * g) = w1; } }
        __syncthreads();
    }
}
__device__ __forceinline__ void dwconv8(const bf16_t* P, int r, int col, const float* cw, const float* cb, int ucol, float* out) {
    const int s = seq_of_row(r), p = r - seq_base(s); const bool hasp = p > 0, hasn = p < seq_len(s) - 1;
    const bf16_t* gp = P + (size_t)r * INW + col;
    const u32x4 gm = *(const u32x4*)(gp - (hasp ? INW : 0)), g0 = *(const u32x4*)gp, gn = *(const u32x4*)(gp + (hasn ? INW : 0));
    float fm[8], f0[8], fn[8]; unpack8(gm, fm); unpack8(g0, f0); unpack8(gn, fn);
    const float mp_ = hasp ? 1.f : 0.f, mn_ = hasn ? 1.f : 0.f;
#pragma unroll
    for (int e = 0; e < 8; ++e) { fm[e] *= mp_; fn[e] *= mn_; }
#pragma unroll
    for (int e = 0; e < 8; ++e) out[e] = cw[ucol + e] * fm[e] + cw[1536 + ucol + e] * f0[e] + cw[2 * 1536 + ucol + e] * fn[e] + cb[ucol + e];
}
__device__ __forceinline__ void p_h1(const CArgs& A, const Frame& F, int layer) {
    const bf16_t* P = (const bf16_t*)(F.ws + WS_PROJ); bf16_t* ZT = (bf16_t*)(F.ws + WS_XNR);
    const float* cw = FIN(9) + (size_t)layer * 3 * 1536; const float* cb = FIN(10) + layer * 1536;
    LAS bf16_t* scr = (LAS bf16_t*)(F.lds + F.wave * 16384);
    const int gw = F.vcu * NWAVES + F.wave, NGW = F.G * NWAVES, lane = F.lane, rs = lane >> 3, ck = lane & 7;
    for (int it = gw; it < (MP / 64) * 8; it += NGW) {
        const int rt = it >> 3, cc = it & 7, c0 = cc * 64 + ck * 8;
#pragma unroll 4
        for (int i8 = 0; i8 < 8; ++i8) { const int lr = i8 * 8 + rs, r = rt * 64 + lr; float z[8];
            if (r < MROWS) { float a[8], b[8]; dwconv8(P, r, C_X1 + c0, cw, cb, 512 + c0, a); dwconv8(P, r, C_VV + c0, cw, cb, 1024 + c0, b);
#pragma unroll
                for (int e = 0; e < 8; ++e) z[e] = a[e] * b[e]; }
            else {
#pragma unroll
                for (int e = 0; e < 8; ++e) z[e] = 0.f; }
#pragma unroll
            for (int e = 0; e < 8; ++e) scr[(ck * 8 + e) * 72 + lr] = (bf16_t)f2bf(z[e]); }
        LDS_WAIT();
#pragma unroll
        for (int j = 0; j < 8; ++j) { const int chn = (lane >> 3) + 8 * j, pc = lane & 7;
            const u32x4 w = *(const LAS u32x4*)(scr + chn * 72 + pc * 8);
            *(u32x4*)(ZT + (size_t)(cc * 64 + chn) * MP + rt * 64 + pc * 8) = w; }
        LDS_WAIT();
    }
}

__device__ __forceinline__ void p_h2_ref(const CArgs& A, const Frame& F) {
    const bf16_t* ZT = (const bf16_t*)(F.ws + WS_XNR); bf16_t* CT = (bf16_t*)(F.ws + WS_XNR + (size_t)512 * MP * 2);
    const int gt = (F.vcu * NWAVES + F.wave) * 64 + F.lane, NGT = F.G * NWAVES * 64;
    for (long idx = gt; idx < (long)512 * MP; idx += NGT) {
        const int c = (int)(idx / MP), r = (int)(idx - (long)c * MP);
        float acc = 0.f;
        if (r < MROWS) {
            const int s = seq_of_row(r), base = seq_base(s), L = seq_len(s), p = r - base, cls = s < 8 ? 0 : 1;
            const bf16_t* rk = (const bf16_t*)(F.ws + (cls ? WS_RKS : WS_RKP)) + (size_t)c * (cls ? RKLEN_S : RKLEN_P) + RK_PAD + L - p;
            const bf16_t* z = ZT + (size_t)c * MP + base;
            for (int s8 = 0; s8 < L; s8 += 8) { const u32x4 zw = *(const u32x4*)(z + s8); float zf[8]; unpack8(zw, zf);
#pragma unroll
                for (int e = 0; e < 8; ++e) acc += zf[e] * __uint_as_float((unsigned)rk[s8 + e] << 16); }
        }
        CT[idx] = (bf16_t)f2bf(acc);
    }
}
constexpr int H2_ZOFF_S = ((RKLEN_S * 2 + 1023) >> 10) << 10, H2_ZOFF_P = ((RKLEN_P * 2 + 1023) >> 10) << 10;
constexpr int H2_ZPADL_S = 4096, H2_ZSLOTS_S = 24704, H2_ZPADL_P = 512, H2_ZSLOTS_P = 3072, H2_SZP = 6976;
static_assert(H2_ZOFF_S + (H2_ZSLOTS_S + (H2_ZSLOTS_S >> 7) * 16) * 2 <= RING_BYTES_C && H2_ZOFF_P + 8 * H2_SZP <= RING_BYTES_C, "H2 LDS");
__device__ __forceinline__ void p_h2(const Frame& F) {
    const bf16_t* ZT = (const bf16_t*)(F.ws + WS_XNR); bf16_t* CT = (bf16_t*)(F.ws + WS_XNR + (size_t)512 * MP * 2);
    const int lane = F.lane, wave = F.wave, tid = F.tid;
    LAS float* red = (LAS float*)(F.lds + LDSCTL_OFF_C + 1024);
    for (int item = F.vcu; item < 1024; item += F.G) {
        const int cls = item < 512 ? 1 : 0, c = item & 511;
        const int L = cls ? LS : LP, rklen = cls ? RKLEN_S : RKLEN_P, ZPADL = cls ? H2_ZPADL_S : H2_ZPADL_P, zs8 = (cls ? H2_ZSLOTS_S : H2_ZSLOTS_P) / 8;
        LAS unsigned char* rkl = F.lds; LAS unsigned char* zl = F.lds + (cls ? H2_ZOFF_S : H2_ZOFF_P);
        {
          const char* rkg = (const char*)((const bf16_t*)(F.ws + (cls ? WS_RKS : WS_RKP)) + (size_t)c * rklen);
          const int npc = (rklen * 2 + 1023) >> 10;
          for (int pc = wave; pc < npc; pc += NWAVES)
              __builtin_amdgcn_global_load_lds((const unsigned*)(rkg + (size_t)pc * 1024 + lane * 16), (LAS unsigned*)(rkl + pc * 1024), 16, 0, 0);
          const int nsl = (cls ? 1 : 8) * zs8; u32x4 zv[7];
#pragma unroll
          for (int j = 0; j < 7; ++j) { const int i = tid + j * (NWAVES * 64); const int sq = i / zs8, i8 = i - sq * zs8, sp = i8 * 8 - ZPADL;
              zv[j] = (u32x4){0u, 0u, 0u, 0u};
              if (i < nsl && sp >= 0 && sp < L) zv[j] = *(const u32x4*)(ZT + (size_t)c * MP + (cls ? ROWS_P : sq * LP) + sp); }
#pragma unroll
          for (int j = 0; j < 7; ++j) { const int i = tid + j * (NWAVES * 64); const int sq = i / zs8, i8 = i - sq * zs8; const int pos = i8 * 8, el = pos + ((pos >> 7) << 4);
              if (i < nsl) *(LAS u32x4*)(zl + sq * H2_SZP + el * 2) = zv[j]; }
          asm volatile("s_waitcnt vmcnt(0)" ::: "memory"); }
        __syncthreads();
        const int n = lane & 15, h = lane >> 4, cg = wave & 3, us = wave >> 2;
        int T0a, zb, T0min, T0max, rowbase;
        const int T0g = cls ? 128 * 16 : 256; const int zg1 = (T0g + (T0g >> 7) * 16) * 2;
        if (cls) { T0min = 16 + 128 * 32 * cg; T0max = T0min + 128 * 31; T0a = T0min + 128 * n; zb = 0; rowbase = ROWS_P; }
        else { const int sq = n >> 1; T0min = 16 + 512 * cg; T0max = T0min + 384; T0a = T0min + 128 * (n & 1); zb = sq * H2_SZP; rowbase = sq * LP; }
        const int u_lo = -(((T0max + 7 + 31) >> 5) << 5), u_hi = ((L - 32 - T0min + 31) >> 5) << 5;
        const int nst = (u_hi - u_lo) / 32 + 1, nh = (nst + 1) >> 1;
        const int u_a = us ? u_lo + 32 * nh : u_lo, u_b = us ? u_hi : u_lo + 32 * (nh - 1);
        const int abase = RK_PAD + L - 8 * n + 8 * h;
        f32x4 acc[2][8];
#pragma unroll
        for (int g = 0; g < 2; ++g)
#pragma unroll
            for (int t = 0; t < 8; ++t) acc[g][t] = (f32x4){0.f, 0.f, 0.f, 0.f};
#define H2_STEP(V0, V1) do { \
            const LAS unsigned char* ap = rkl + (abase + u) * 2; \
            const u32x4 Lo = *(const LAS u32x4*)(ap - 16), Hi = *(const LAS u32x4*)ap; \
            bf16x8 Bz[2]; \
            { const int i0 = T0a + u + 8 * h + ZPADL, e0 = i0 + ((i0 >> 7) << 4); const LAS unsigned char* zp = zl + zb + e0 * 2; \
              if (V0) Bz[0] = *(const LAS bf16x8*)zp; if (V1) Bz[1] = *(const LAS bf16x8*)(zp + zg1); } \
            unsigned W[8] = {Lo.x, Lo.y, Lo.z, Lo.w, Hi.x, Hi.y, Hi.z, Hi.w}, Od[7]; \
            _Pragma("unroll") for (int k = 0; k < 7; ++k) Od[k] = __builtin_amdgcn_alignbit(W[k + 1], W[k], 16); \
            _Pragma("unroll") for (int t = 0; t < 8; ++t) { const int i = 4 - ((t + 1) >> 1); \
                const u32x4 fw = (t & 1) ? (u32x4){Od[i], Od[i + 1], Od[i + 2], Od[i + 3]} : (u32x4){W[i], W[i + 1], W[i + 2], W[i + 3]}; \
                const bf16x8 Af = __builtin_bit_cast(bf16x8, fw); \
                if (V0) acc[0][t] = __builtin_amdgcn_mfma_f32_16x16x32_bf16(Af, Bz[0], acc[0][t], 0, 0, 0); \
                if (V1) acc[1][t] = __builtin_amdgcn_mfma_f32_16x16x32_bf16(Af, Bz[1], acc[1][t], 0, 0, 0); } } while (0)
        { const int gspan = cls ? 128 * 15 : 128;
          int u0s = -(T0min + gspan + 39); u0s = u0s >= 0 ? ((u0s + 31) >> 5) << 5 : -((-u0s) >> 5 << 5);
          int u1e = L - (T0min + T0g); u1e = u1e >= 0 ? ((u1e + 31) >> 5) << 5 : -((-u1e) >> 5 << 5);
          const int ua2 = u0s > u_a ? (u0s < u_b + 32 ? u0s : u_b + 32) : u_a;
          const int ub2 = u1e < u_b + 32 ? (u1e > ua2 ? u1e : ua2) : u_b + 32;
          int u = u_a;
          for (; u < ua2; u += 32) H2_STEP(false, true);
          for (; u < ub2; u += 32) H2_STEP(true, true);
          for (; u <= u_b; u += 32) H2_STEP(true, false); }
#undef H2_STEP
        { float m[16];
#pragma unroll
          for (int t = 0; t < 16; ++t) m[t] = 0.f;
          const int nchunk = L / 8, cstep = cls ? NWAVES * 64 : 64; const int zb2 = cls ? 0 : wave * H2_SZP;
          for (int ck = cls ? tid : lane; ck < nchunk; ck += cstep) { const int s0 = ck * 8, i0 = s0 + ZPADL, e0 = i0 + ((i0 >> 7) << 4);
              const u32x4 zw = *(const LAS u32x4*)(zl + zb2 + e0 * 2);
              const LAS unsigned char* rp = rkl + (RK_PAD + L + s0 - 16) * 2;
              const u32x4 r0 = *(const LAS u32x4*)rp, r1 = *(const LAS u32x4*)(rp + 16), r2 = *(const LAS u32x4*)(rp + 32);
              float zf[8], rf[24]; unpack8(zw, zf); unpack8(r0, rf); unpack8(r1, rf + 8); unpack8(r2, rf + 16);
#pragma unroll
              for (int t = 0; t < 16; ++t)
#pragma unroll
                  for (int e = 0; e < 8; ++e) m[t] += zf[e] * rf[16 + e - t]; }
#pragma unroll
          for (int t = 0; t < 16; ++t) m[t] = wave_sum(m[t], lane);
          float mine = 0.f;
#pragma unroll
          for (int t = 0; t < 16; ++t) mine = (lane == t) ? m[t] : mine;
          if (cls) { if (lane < 16) red[wave * 16 + lane] = mine; }
          else if (lane < 16) CT[(size_t)c * MP + wave * LP + lane] = (bf16_t)f2bf(mine); }
        __syncthreads();
        if (us == 1) {
#pragma unroll
            for (int g = 0; g < 2; ++g)
#pragma unroll
                for (int t = 0; t < 8; ++t) *(LAS f32x4*)(F.lds + cg * 16384 + (g * 8 + t) * 1024 + lane * 16) = acc[g][t]; }
        if (cls && tid < 16) { float a = 0.f;
#pragma unroll
            for (int w = 0; w < 8; ++w) a += red[w * 16 + tid];
            CT[(size_t)c * MP + ROWS_P + tid] = (bf16_t)f2bf(a); }
        __syncthreads();
        if (us == 0) {
#pragma unroll
            for (int g = 0; g < 2; ++g) {
#pragma unroll
                for (int t = 0; t < 8; ++t) acc[g][t] += *(const LAS f32x4*)(F.lds + cg * 16384 + (g * 8 + t) * 1024 + lane * 16);
                bf16_t* op = CT + (size_t)c * MP + rowbase + T0a + g * T0g + 32 * h;
#pragma unroll
                for (int i = 0; i < 4; ++i) { u32x4 w; w.x = pk2(acc[g][0][i], acc[g][1][i]); w.y = pk2(acc[g][2][i], acc[g][3][i]); w.z = pk2(acc[g][4][i], acc[g][5][i]); w.w = pk2(acc[g][6][i], acc[g][7][i]);
                    *(u32x4*)(op + 8 * i) = w; } } }
        __syncthreads();
    }
}
__device__ __forceinline__ void p_pool(const CArgs& A, const Frame& F) {
    bf16_t* P = (bf16_t*)(F.ws + WS_PROJ);
    const int gw = F.vcu * NWAVES + F.wave, NGW = F.G * NWAVES, lane = F.lane, c0 = lane * 8, hw = 1 << (lane >> 4);
    for (int run = gw; run < MROWS / 16; run += NGW) {
        const int r0 = run * 16, s = seq_of_row(r0), base = seq_base(s), L = seq_len(s), p0 = r0 - base;
        const bf16_t* ub = P + (size_t)base * INW + C_PU + c0;
        float S[8];
#pragma unroll
        for (int e = 0; e < 8; ++e) S[e] = 0.f;
#pragma unroll
        for (int i = 0; i < 16; ++i) { const int pp = p0 - hw + i; const bool ok = i < 2 * hw && pp >= 0 && pp < L;
            const u32x4 w = *(const u32x4*)(ub + (size_t)(ok ? pp : p0) * INW); float f[8]; unpack8(w, f); const float mk = ok ? 1.f : 0.f;
#pragma unroll
            for (int e = 0; e < 8; ++e) S[e] += mk * f[e]; }
#pragma unroll 4
        for (int k = 0; k < 16; ++k) { const int p = p0 + k, pn = p + hw, po = p - hw; const bool okn = pn < L, oko = po >= 0;
            const u32x4 ws_ = *(const u32x4*)(ub + (size_t)p * INW), wn = *(const u32x4*)(ub + (size_t)(okn ? pn : p) * INW), wo = *(const u32x4*)(ub + (size_t)(oko ? po : p) * INW);
            float fs[8], fn[8], fo[8]; unpack8(ws_, fs); unpack8(wn, fn); unpack8(wo, fo);
            const int lo = po < 0 ? 0 : po, hi = pn > L ? L : pn; const float ic = 1.f / (float)(hi - lo);
            float a[8];
#pragma unroll
            for (int e = 0; e < 8; ++e) a[e] = (DBG & 16) ? 0.f : S[e] * ic - fs[e];
            u32x4 w; w.x = pk2(a[0], a[1]); w.y = pk2(a[2], a[3]); w.z = pk2(a[4], a[5]); w.w = pk2(a[6], a[7]);
            *(u32x4*)(P + (size_t)(r0 + k) * INW + C_X1 + c0) = w;
            const float mn = okn ? 1.f : 0.f, mo = oko ? 1.f : 0.f;
#pragma unroll
            for (int e = 0; e < 8; ++e) S[e] += mn * fn[e] - mo * fo[e]; }
    }
}
__device__ __forceinline__ void p_final(const CArgs& A, const Frame& F, int layer) {
    bf16_t* P = (bf16_t*)(F.ws + WS_PROJ); const bf16_t* ZT = (const bf16_t*)(F.ws + WS_XNR); const bf16_t* CT = ZT + (size_t)512 * MP;
    const float* cw = FIN(9) + (size_t)layer * 3 * 1536; const float* cb = FIN(10) + layer * 1536; const float* skip = FIN(17) + layer * 512;
    LAS bf16_t* sz = (LAS bf16_t*)(F.lds + F.wave * 16384); LAS bf16_t* sc = sz + 64 * 64;
    const int gw = F.vcu * NWAVES + F.wave, NGW = F.G * NWAVES, lane = F.lane, rs = lane >> 3, ck = lane & 7;
    for (int it = gw; it < (MP / 64) * 8; it += NGW) {
        const int rt = it >> 3, cc = it & 7, c0 = cc * 64 + ck * 8; const int cls = rt * 64 < ROWS_P ? 0 : 1;
        const float* sums = (const float*)(F.ws + WS_CTL) + CW_SUMS + (layer * 2 + cls) * 512;
#pragma unroll
        for (int j = 0; j < 8; ++j) { const int chn = (lane >> 3) + 8 * j, pc = lane & 7; const size_t off = (size_t)(cc * 64 + chn) * MP + rt * 64 + pc * 8;
            *(LAS u32x4*)(sz + chn * 64 + pc * 8) = *(const u32x4*)(ZT + off); *(LAS u32x4*)(sc + chn * 64 + pc * 8) = *(const u32x4*)(CT + off); }
        LDS_WAIT();
#pragma unroll 4
        for (int i8 = 0; i8 < 8; ++i8) { const int lr = i8 * 8 + rs, r = rt * 64 + lr;
            if (r < MROWS) { float x0[8]; dwconv8(P, r, C_X0 + c0, cw, cb, c0, x0); float o[8];
#pragma unroll
                for (int e = 0; e < 8; ++e) { const float z = __uint_as_float((unsigned)sz[(ck * 8 + e) * 64 + lr] << 16), cv = __uint_as_float((unsigned)sc[(ck * 8 + e) * 64 + lr] << 16);
                    o[e] = (DBG & 8) ? 0.f : (((DBG & 64) ? 0.f : cv / sums[c0 + e]) + ((DBG & 128) ? 0.f : z * skip[c0 + e])) * x0[e]; }
                u32x4 w; w.x = pk2(o[0], o[1]); w.y = pk2(o[2], o[3]); w.z = pk2(o[4], o[5]); w.w = pk2(o[6], o[7]);
                *(u32x4*)(P + (size_t)r * INW + C_VV + c0) = w; } }
        LDS_WAIT();
    }
}
__device__ __forceinline__ void p_norm2(const CArgs& A, const Frame& F, int layer) {
    const int gw = F.vcu * NWAVES + F.wave, NGW = F.G * NWAVES, lane = F.lane;
    const float* g = FIN(24) + layer * DM; bf16_t* XN = (bf16_t*)(F.ws + WS_XNR);
    for (int r0 = gw; r0 < MP; r0 += 2 * NGW) { f32x4 v[2][4]; const int r1 = r0 + NGW;
        { const f32x4* xr = (const f32x4*)xrow(F.out, F.xm, r0) + lane;
#pragma unroll
          for (int j = 0; j < 4; ++j) v[0][j] = xr[64 * j]; }
        if (r1 < MP) { const f32x4* xr = (const f32x4*)xrow(F.out, F.xm, r1) + lane;
#pragma unroll
          for (int j = 0; j < 4; ++j) v[1][j] = xr[64 * j]; }
        rms_row(v[0], g, XN + (size_t)r0 * DM, lane);
        if (r1 < MP) rms_row(v[1], g, XN + (size_t)r1 * DM, lane); }
}

constexpr int PH_PER_LAYER = 11, N_PHASES = 2 * PH_PER_LAYER;
__global__ void __launch_bounds__(NWAVES * 64, 2) fwd_kernel(Args args0) {
    extern __shared__ __attribute__((aligned(16))) unsigned char lds_raw[];
    const int wave0 = __builtin_amdgcn_readfirstlane(threadIdx.x >> 6);
    {
        for (int u = threadIdx.x; u < (LDS_BYTES - LDSCTL_OFF) / 4; u += NWAVES * 64) ((LAS unsigned*)((LAS unsigned char*)lds_raw + LDSCTL_OFF))[u] = 0u;
        __syncthreads();
    }
    XcdBarrier bar; bar.bar = (unsigned*)(args0.ws + WS_CTL) + CW_BAR; bar.x = 0; bar.st = nullptr;
    if (args0.use_bar) bar = xcd_barrier_post((unsigned*)(args0.ws + WS_CTL) + CW_BAR, (volatile LAS unsigned*)((LAS unsigned char*)lds_raw + MISC_OFF) + 8);
    for (int ph2 = 2 * args0.ph_lo; ph2 < 2 * args0.ph_hi; ++ph2) {
        const int ph = ph2 >> 1, rep = ph2 & 1;
        const int layer = ph / PH_PER_LAYER, k = ph % PH_PER_LAYER;
        if (rep == 1 && !(DUP_PHASE >= 0 && k == DUP_PHASE && args0.pad == 0)) continue;
        const __attribute__((address_space(4))) Args* ap = (const __attribute__((address_space(4))) Args*)__builtin_amdgcn_kernarg_segment_ptr();
        asm volatile("" : "+s"(ap));
        const __attribute__((address_space(4))) Args& args = *ap;
        Frame F;
        { int w_ = wave0; asm volatile("" : "+s"(w_)); int z_ = 0; asm volatile("" : "+v"(z_)); const int l_ = __builtin_amdgcn_mbcnt_hi(-1, __builtin_amdgcn_mbcnt_lo(-1, z_));
          F.lane = l_; F.wave = w_; F.tid = w_ * 64 + l_;
          int bx = blockIdx.x, G_ = gridDim.x; asm volatile("" : "+s"(bx), "+s"(G_)); F.G = G_; F.vcu = (G_ % 8 == 0) ? (bx % 8) * (G_ / 8) + bx / 8 : bx; F.bx = bx;
          F.dry = rep; F.lds = (LAS unsigned char*)lds_raw; F.ws = args.ws; F.out = args.out; F.xm = (float*)(args.ws + WS_XM); }
        unsigned char* W = F.ws + WS_W;
        bf16_t* XNR = (bf16_t*)(F.ws + WS_XNR); bf16_t* PROJ = (bf16_t*)(F.ws + WS_PROJ);
        bf16_t* GB = PROJ; bf16_t* ACT = PROJ + (size_t)MP * DFF;
#ifndef ONLY_PHASE
#define ONLY_PHASE -1
#endif
#define PHS(x) ((ONLY_PHASE < 0 || ONLY_PHASE == (x)) && k == (x) && !((DBG & 1) && (x) >= 1 && (x) <= 6) && !((DBG & 2) && (x) >= 7) && !((DBG & 32) && layer > 0))
        if (PHS(0)) p_prep(args, F, layer);
        else if (PHS(1)) { OpsPlain O{XNR, (const bf16_t*)(W + W_IN), DM, DM}; pg8::StaticOrder S; S.init(MP, INW, F.G, F.bx, 1); EpiStore E{PROJ, INW, C_G / 256};
            pg8::gemm_phase<EpiStore, OpsPlain, true>(F.lds, O, S, E, F.tid); }
        else if (PHS(2)) { if (DBG & 512) p_attn_ref(args, F, layer); else p_attn(args, F, layer); p_h1(args, F, layer); p_filt_tiles(args, F, layer); }
        else if (PHS(3)) { if (DBG & 256) p_h2_ref(args, F); else if (DSEL(16)) p_h2(F); if (DSEL(32)) p_pool(args, F); }
        else if (PHS(4)) p_final(args, F, layer);
        else if (PHS(5)) { OpsMerge O{PROJ, (const bf16_t*)(W + W_MRG), 512, INW}; pg8::StaticOrder S; S.init(MP, DM, F.G, F.bx, 3); EpiMerge E{PROJ, XNR};
            pg8::gemm_phase<EpiMerge, OpsMerge, true>(F.lds, O, S, E, F.tid); }
        else if (PHS(6)) { OpsPlain O{XNR, (const bf16_t*)(W + W_OUT), DM, DM}; pg8::StaticOrder S; S.init(MP, DM, F.G, F.bx, 1); EpiRes E{F.out, F.xm, F.dry};
            pg8::gemm_phase<EpiRes, OpsPlain, true>(F.lds, O, S, E, F.tid); }
        else if (PHS(7)) p_norm2(args, F, layer);
        else if (PHS(8)) { OpsPlain O{XNR, (const bf16_t*)(W + W_G), DM, DM}; pg8::StaticOrder S; S.init(MP, DFF, F.G, F.bx, 1); EpiStore E{GB, DFF, 1 << 20};
            pg8::gemm_phase<EpiStore, OpsPlain, true>(F.lds, O, S, E, F.tid); }
        else if (PHS(9)) { OpsPlain O{XNR, (const bf16_t*)(W + W_U), DM, DM}; pg8::StaticOrder S; S.init(MP, DFF, F.G, F.bx, 1);
            EpiGeluMul E{GB, args.in[27] + (size_t)layer * 3 * DFF, args.in[28] + layer * DFF, ACT, F.dry ? DRYVAR : 0};
            pg8::gemm_phase<EpiGeluMul, OpsPlain, true>(F.lds, O, S, E, F.tid); }
        else if (PHS(10)) { OpsPlain O{ACT, (const bf16_t*)(W + W_D), DFF, DFF}; pg8::StaticOrder S; S.init(MP, DM, F.G, F.bx, 1); EpiRes E{F.out, F.xm, F.dry};
            pg8::gemm_phase<EpiRes, OpsPlain, true>(F.lds, O, S, E, F.tid); }
        if (ph2 + 1 < 2 * args0.ph_hi) { { int z2_ = 0; asm volatile("" : "+v"(z2_)); const int tid2 = wave0 * 64 + __builtin_amdgcn_mbcnt_hi(-1, __builtin_amdgcn_mbcnt_lo(-1, z2_));
              if (args0.use_bar) xcd_barrier(bar, tid2); else __syncthreads(); } }
    }
}

__global__ void fill_k(float* o, size_t n, float v) { size_t i = (size_t)blockIdx.x * blockDim.x + threadIdx.x; for (; i < n; i += (size_t)gridDim.x * blockDim.x) o[i] = v; }
extern "C" void kernel_launch(void* const* d_in, const int* in_sizes, int n_in, void* d_out, int out_size, void* d_ws, size_t ws_size, hipStream_t stream) {
    static int grid = 0;
    if (grid == 0) {
        int dev = 0, cus = 0;
        if (n_in != 30 || out_size != 32768 * DM || ws_size < WS_END || hipGetDevice(&dev) != hipSuccess || hipDeviceGetAttribute(&cus, hipDeviceAttributeMultiprocessorCount, dev) != hipSuccess ||
            hipFuncSetAttribute((const void*)fwd_kernel, hipFuncAttributeMaxDynamicSharedMemorySize, LDS_BYTES) != hipSuccess) { fprintf(stderr, "kernel_launch: bad shapes / workspace / device\n"); grid = -1; }
        else { int per_cu = 0; (void)hipOccupancyMaxActiveBlocksPerMultiprocessor(&per_cu, (const void*)fwd_kernel, NWAVES * 64, LDS_BYTES); (void)hipGetLastError();
            grid = cus * (per_cu >= 1 ? 1 : 0); if (grid <= 0) grid = -1; }
    }
    if (grid < 0) { fill_k<<<1024, 256, 0, stream>>>((float*)d_out, (size_t)out_size, 1e6f); return; }
    (void)hipMemsetAsync((char*)d_ws + WS_CTL, 0, CTL_ZERO_BYTES, stream);
    Args a{};
    for (int i = 0; i < 30; ++i) a.in[i] = (const float*)d_in[i];
    a.out = (float*)d_out; a.ws = (unsigned char*)d_ws;
#if MK_N_LAUNCHES == 1
    a.ph_lo = 0; a.ph_hi = N_PHASES; a.use_bar = 1;
    void* kargs[] = {&a};
    hipError_t e = hipLaunchCooperativeKernel((const void*)fwd_kernel, dim3(grid), dim3(NWAVES * 64), kargs, LDS_BYTES, stream);
    if (e != hipSuccess) fprintf(stderr, "cooperative launch failed: %s\n", hipGetErrorString(e));
#else
    for (int ph = 0; ph < N_PHASES; ++ph) { a.ph_lo = ph; a.ph_hi = ph + 1; a.use_bar = 0;
        hipLaunchKernelGGL(fwd_kernel, dim3(grid), dim3(NWAVES * 64), LDS_BYTES, stream, a); }
#endif
}
```

```cpp
#include <hip/hip_runtime.h>
#include <cstdio>
#include <cstdint>
#include <cmath>

#ifndef DBG
#define DBG 0
#endif
#ifndef DUP_PHASE
#define DUP_PHASE -1
#endif
#ifndef FT_RECOMPUTE
#define FT_RECOMPUTE 0
#endif
#ifndef DRYVAR
#define DRYVAR 0
#endif
#ifndef DUPMASK
#define DUPMASK 255
#endif
#define DSEL(b) (!F.dry || (DUPMASK & (b)))
#ifndef MK_N_LAUNCHES
#define MK_N_LAUNCHES 1
#endif

#define LAS __attribute__((address_space(3)))
#define GAS __attribute__((address_space(1)))
typedef unsigned short bf16_t;
typedef short bf16x8 __attribute__((ext_vector_type(8)));
typedef float f32x4 __attribute__((ext_vector_type(4)));
typedef float f32x2 __attribute__((ext_vector_type(2)));
typedef float f32x16 __attribute__((ext_vector_type(16)));
typedef unsigned u32x4 __attribute__((ext_vector_type(4)));
typedef unsigned u32x2 __attribute__((ext_vector_type(2)));

constexpr int DM = 1024, INW = 5888, DFF = 2816, NHEAD = 8, HD = 64;
constexpr int LP = 2064, LS = 16400, NMETA = 16;
constexpr int ROWS_P = 8 * LP;
constexpr int MROWS = ROWS_P + LS;
constexpr int MP = 33024;
constexpr int C_Q = 0, C_K = 512, C_V = 640, C_X0 = 768, C_X1 = 1280, C_VV = 1792, C_PU = 2304, C_G = 2816;
constexpr float EPS = 1e-6f;
constexpr int RK_PAD = 256;
constexpr int RKLEN_P = 2 * LP + 512, RKLEN_S = 2 * LS + 512;

constexpr size_t MiB = 1u << 20;
constexpr size_t WS_CTL = 0, CTL_ZERO_BYTES = 1 * MiB;
constexpr size_t WS_XM = 1 * MiB;
constexpr size_t WS_W = 3 * MiB;
constexpr size_t W_IN = 0, W_G = W_IN + (size_t)INW * DM * 2, W_U = W_G + (size_t)DFF * DM * 2, W_D = W_U + (size_t)DFF * DM * 2,
                 W_OUT = W_D + (size_t)DM * DFF * 2, W_MRG = W_OUT + (size_t)DM * DM * 2, W_END = W_MRG + (size_t)3 * DM * 512 * 2;
static_assert(WS_W + W_END <= 36 * MiB, "weights");
constexpr size_t WS_RKP = 36 * MiB;
constexpr size_t WS_RKS = WS_RKP + (size_t)512 * RKLEN_P * 2;
static_assert(WS_RKS + (size_t)512 * RKLEN_S * 2 <= 74 * MiB, "filters");
constexpr size_t WS_XNR = 74 * MiB;
constexpr size_t XNR_BYTES = (size_t)MP * DM * 2;
constexpr size_t WS_PROJ = 139 * MiB;
constexpr size_t WS_END = WS_PROJ + (size_t)MP * INW * 2;
static_assert(WS_XNR + XNR_BYTES <= WS_PROJ && WS_END <= 512 * MiB, "d_ws map");
constexpr int CW_BAR = 4096;
constexpr int CW_SUMS = 16384;

namespace pg8 {
constexpr int BM = 256, BK = 64, HALF = 128, HTB = HALF * BK * 2, STAGE_BYTES = 8 * HTB, NXCD = 8, WGM = 8;
__host__ __device__ __forceinline__ int lds_byte(int r, int c) { const int st = (r >> 4) * 2 + (c >> 5), rr = r & 15, cc = c & 31, ob = rr * 64 + cc * 2; return st * 1024 + (ob ^ (((ob >> 9) & 1) << 5)); }
__host__ __device__ __forceinline__ void stage_rc(int b, int& R, int& C) { const int st = b / 1024, sb = b % 1024, swz = sb ^ (((sb >> 9) & 1) << 5); R = (st >> 1) * 16 + swz / 64; C = (st & 1) * 32 + (swz % 64) / 2; }
__host__ __device__ __forceinline__ int perm32(int rho) { const int n = rho >> 4, i = rho & 15; return 8 * (i >> 2) + 4 * n + (i & 3); }

struct Unit { int pm, pn, sub; };
struct StaticOrder {
    int nM, nN, nwg, G, c, nsub;
    __device__ void init(int M, int N, int G_, int c_, int nsub_) { nM = M / BM; nN = N / BM; nwg = nM * nN; G = G_; c = c_; nsub = nsub_; }
    __device__ bool next(int i, Unit& u) const {
        const int tile = i / nsub; u.sub = i - tile * nsub;
        const long L = (long)tile * G + c; if (L >= nwg) return false;
        int wgid = (int)L; { const int q = nwg / NXCD, r = nwg % NXCD, xcd = wgid % NXCD, off = wgid / NXCD; wgid = (xcd < r ? xcd * (q + 1) : r * (q + 1) + (xcd - r) * q) + off; }
        const int nig = WGM * nN, gid = wgid / nig, fm = gid * WGM, gsz = (nM - fm) < WGM ? (nM - fm) : WGM;
        u.pm = fm + ((wgid % nig) % gsz); u.pn = (wgid % nig) / gsz; return true;
    }
};
__device__ __forceinline__ unsigned cvt_pk_bf16(float lo, float hi) { unsigned r; asm volatile("v_cvt_pk_bf16_f32 %0, %1, %2" : "=v"(r) : "v"(lo), "v"(hi)); return r; }
__device__ __forceinline__ f32x2 gelu_pk(f32x2 v) {
    const f32x2 av = __builtin_elementwise_abs(v), d = av * 0.2316418882f + 1.0f;
    f32x2 t; t.x = __builtin_amdgcn_rcpf(d.x); t.y = __builtin_amdgcn_rcpf(d.y);
    f32x2 q = t * 0.5307027145f + (-0.7265760135f); q = q * t + 0.7107068705f; q = q * t + (-0.142248368f); q = q * t + 0.127414796f; q = q * t;
    const f32x2 s = (v * v) * (-0.72134752044f);
    f32x2 e; e.x = __builtin_amdgcn_exp2f(s.x); e.y = __builtin_amdgcn_exp2f(s.y);
    const f32x2 m = v * (q * e), r = v - m;
    f32x2 o; o.x = v.x < 0.f ? m.x : r.x; o.y = v.y < 0.f ? m.y : r.y; return o;
}

template <class Epi, class Ops, bool ALIGN_EPI>
__device__ __forceinline__ void gemm_phase(LAS unsigned char* lds, const Ops& O, const StaticOrder& S, const Epi& E, int tid) {
    const int wid = __builtin_amdgcn_readfirstlane(tid >> 6), lane = tid & 63, wr = wid >> 2, wc = wid & 3, fr = lane & 15, fq = lane >> 4;
    const int K = O.K, nt = K / BK, lda = O.lda;
    unsigned voffA[2], voffB[2];
#pragma unroll
    for (int i = 0; i < 2; ++i) { int R, C; stage_rc(tid * 16 + i * 8192, R, C); const int Rb = (R & ~31) + perm32(R & 31);
        voffA[i] = (unsigned)(R * lda + C) * 2u; voffB[i] = (unsigned)(Rb * K + C) * 2u; }
    const size_t kstep = (size_t)(BK * 2);
    const size_t hstepA = (size_t)HALF * lda * 2, hstepB = (size_t)HALF * K * 2;
    const unsigned ldsw = (unsigned)wid * 1024u;
    const int aoff = lds_byte(wr * 64 + fr, fq * 8), boff = lds_byte(wc * 32 + fr, fq * 8);
#define PG8_SA(b, h) (((b) * 2 + (h)) * HTB)
#define PG8_SB(b, h) ((4 + (b) * 2 + (h)) * HTB)
#define PG8_STAGE(bufoff, gbase, voff) do { _Pragma("unroll") for (int _i = 0; _i < 2; ++_i) \
        __builtin_amdgcn_global_load_lds((const unsigned*)((const char*)(gbase) + (voff)[_i]), (LAS unsigned*)(lds + (bufoff) + ldsw + _i * 8192), 16, 0, 0); } while (0)
#define PG8_LDA(dst, b, h) do { _Pragma("unroll") for (int m = 0; m < 4; ++m) _Pragma("unroll") for (int k = 0; k < 2; ++k) dst[m][k] = *(const LAS bf16x8*)(lds + PG8_SA(b, h) + aoff + m * 2048 + k * 1024); } while (0)
#define PG8_LDB(dst, b, h) do { _Pragma("unroll") for (int n = 0; n < 2; ++n) _Pragma("unroll") for (int k = 0; k < 2; ++k) dst[n][k] = *(const LAS bf16x8*)(lds + PG8_SB(b, h) + boff + n * 2048 + k * 1024); } while (0)
#define PG8_MMA(ai, bj, At, Bt) do { __builtin_amdgcn_s_setprio(1); _Pragma("unroll") for (int m = 0; m < 4; ++m) _Pragma("unroll") for (int n = 0; n < 2; ++n) _Pragma("unroll") for (int k = 0; k < 2; ++k) \
        acc[ai][bj][m][n] = __builtin_amdgcn_mfma_f32_16x16x32_bf16(Bt[n][k], At[m][k], acc[ai][bj][m][n], 0, 0, 0); __builtin_amdgcn_s_setprio(0); } while (0)
#define PG8_WAIT_V(n) asm volatile("s_waitcnt vmcnt(" #n ")" ::: "memory")
#define PG8_WAIT_L(n) asm volatile("s_waitcnt lgkmcnt(" #n ")" ::: "memory")
#define PG8_BAR __builtin_amdgcn_s_barrier()
#define PG8_SCHED __builtin_amdgcn_sched_barrier(0)
    Unit cur, nxt; int ui = 0;
    if (!S.next(0, cur)) return;
    f32x4 acc[2][2][4][2];
#pragma unroll
    for (int a = 0; a < 2; ++a)
#pragma unroll
        for (int b = 0; b < 2; ++b)
#pragma unroll
            for (int m = 0; m < 4; ++m)
#pragma unroll
                for (int n = 0; n < 2; ++n) acc[a][b][m][n] = (f32x4){0.f, 0.f, 0.f, 0.f};
    bf16x8 At[4][2], B0[2][2], B1[2][2];
    const char* cA; const char* cB; O.ptrs(cur, cA, cB);
    PG8_STAGE(PG8_SB(0, 0), cB, voffB); PG8_STAGE(PG8_SB(0, 1), cB + hstepB, voffB); PG8_STAGE(PG8_SA(0, 0), cA, voffA); PG8_STAGE(PG8_SA(0, 1), cA + hstepA, voffA);
    if (wr == 1) PG8_BAR;
    PG8_WAIT_V(2); PG8_BAR;
    PG8_STAGE(PG8_SB(1, 0), cB + kstep, voffB); PG8_STAGE(PG8_SA(1, 0), cA + kstep, voffA); PG8_STAGE(PG8_SB(1, 1), cB + hstepB + kstep, voffB);
    PG8_WAIT_V(6); PG8_BAR;
    for (;;) {
        const bool has_next = S.next(ui + 1, nxt);
        const char* nA = cA; const char* nB = cB; if (has_next) O.ptrs(nxt, nA, nB);
        for (int t = 0; t < nt; t += 2) {
            const bool last = (t == nt - 2);
            const char* a1 = cA + (size_t)(t + 1) * kstep;
            const char* a2 = last ? nA : cA + (size_t)(t + 2) * kstep; const char* b2 = last ? nB : cB + (size_t)(t + 2) * kstep;
            const char* a3 = a2 + kstep; const char* b3 = b2 + kstep;
            PG8_LDB(B0, 0, 0); PG8_LDB(B1, 0, 1); PG8_SCHED; PG8_LDA(At, 0, 0); PG8_STAGE(PG8_SA(1, 1), a1 + hstepA, voffA);
            PG8_WAIT_V(8); PG8_WAIT_L(0); PG8_BAR; PG8_MMA(0, 0, At, B0); PG8_MMA(0, 1, At, B1); PG8_BAR; PG8_SCHED;
            PG8_LDA(At, 0, 1); PG8_STAGE(PG8_SB(0, 0), b2, voffB); PG8_STAGE(PG8_SB(0, 1), b2 + hstepB, voffB); PG8_STAGE(PG8_SA(0, 0), a2, voffA);
            PG8_WAIT_V(8); PG8_WAIT_L(0); PG8_BAR; PG8_MMA(1, 0, At, B0); PG8_MMA(1, 1, At, B1); PG8_BAR; PG8_SCHED;
            PG8_LDB(B0, 1, 0); PG8_LDB(B1, 1, 1); PG8_SCHED; PG8_LDA(At, 1, 0); PG8_STAGE(PG8_SA(0, 1), a2 + hstepA, voffA);
            PG8_WAIT_V(8); PG8_WAIT_L(0); PG8_BAR; PG8_MMA(0, 0, At, B0); PG8_MMA(0, 1, At, B1); PG8_BAR; PG8_SCHED;
            PG8_LDA(At, 1, 1); PG8_STAGE(PG8_SB(1, 0), b3, voffB); PG8_STAGE(PG8_SB(1, 1), b3 + hstepB, voffB); PG8_STAGE(PG8_SA(1, 0), a3, voffA);
            PG8_WAIT_V(8); PG8_WAIT_L(0); PG8_BAR; PG8_MMA(1, 0, At, B0); PG8_MMA(1, 1, At, B1); PG8_BAR; PG8_SCHED;
        }
        if constexpr (ALIGN_EPI) { if (wr == 0) PG8_BAR; }
        { int z_ = 0; asm volatile("" : "+v"(z_)); const int l2 = __builtin_amdgcn_mbcnt_hi(-1, __builtin_amdgcn_mbcnt_lo(-1, z_));
          E(acc, cur, wr, wc, l2 & 15, l2 >> 4); }
        if (!E.keep(cur)) {
#pragma unroll
            for (int a = 0; a < 2; ++a)
#pragma unroll
                for (int b = 0; b < 2; ++b)
#pragma unroll
                    for (int m = 0; m < 4; ++m)
#pragma unroll
                        for (int n = 0; n < 2; ++n) acc[a][b][m][n] = (f32x4){0.f, 0.f, 0.f, 0.f};
        }
        if (!has_next) break;
        cur = nxt; cA = nA; cB = nB; ++ui;
        if constexpr (ALIGN_EPI) { if (wr == 1) PG8_BAR; }
    }
    PG8_WAIT_V(0);
    if constexpr (!ALIGN_EPI) { if (wr == 0) PG8_BAR; }
    PG8_BAR;
#undef PG8_SA
#undef PG8_SB
#undef PG8_STAGE
#undef PG8_LDA
#undef PG8_LDB
#undef PG8_MMA
#undef PG8_WAIT_V
#undef PG8_WAIT_L
#undef PG8_BAR
#undef PG8_SCHED
}
}

constexpr int RING_BYTES_C = 131072, LDSCTL_OFF_C = 131072;
__device__ __forceinline__ int seq_of_row(int r) { return r < ROWS_P ? r / LP : 8; }
__device__ __forceinline__ int seq_base(int s) { return s < 8 ? s * LP : ROWS_P; }
__device__ __forceinline__ int seq_len(int s) { return s < 8 ? LP : LS; }
__device__ __forceinline__ float* xrow(float* xreal, float* xm, int r) {
    if (r >= MROWS) return xm + (size_t)(144 + r - MROWS) * DM;
    const int s = seq_of_row(r), p = r - seq_base(s);
    if (p < NMETA) return xm + (size_t)(s * 16 + p) * DM;
    return xreal + (size_t)(r - 16 * (s + 1)) * DM;
}
__device__ __forceinline__ float bflo(unsigned u) { return __uint_as_float(u << 16); }
__device__ __forceinline__ float bfhi(unsigned u) { return __uint_as_float(u & 0xffff0000u); }
__device__ __forceinline__ unsigned f2bf(float f) { unsigned u = __builtin_bit_cast(unsigned, f); return (u + 0x7fffu + ((u >> 16) & 1u)) >> 16; }
__device__ __forceinline__ unsigned pk2(float lo, float hi) { return f2bf(lo) | (f2bf(hi) << 16); }
__device__ __forceinline__ void unpack8(const u32x4 w, float* f) { f[0] = bflo(w.x); f[1] = bfhi(w.x); f[2] = bflo(w.y); f[3] = bfhi(w.y); f[4] = bflo(w.z); f[5] = bfhi(w.z); f[6] = bflo(w.w); f[7] = bfhi(w.w); }
__device__ __forceinline__ float shx(float v, int o, int lane) { return __int_as_float(__builtin_amdgcn_ds_bpermute((lane ^ o) << 2, __float_as_int(v))); }
__device__ __forceinline__ float wave_sum(float v, int lane) {
#pragma unroll
    for (int o = 1; o < 64; o <<= 1) v += shx(v, o, lane);
    return v;
}
#define LDS_WAIT() asm volatile("s_waitcnt lgkmcnt(0)" ::: "memory")

struct OpsPlain {
    const bf16_t* A; const bf16_t* Bt; int K, lda;
    __device__ __forceinline__ void ptrs(const pg8::Unit& u, const char*& a, const char*& b) const {
        a = (const char*)A + (size_t)u.pm * 256 * lda * 2; b = (const char*)Bt + (size_t)u.pn * 256 * K * 2; }
};
struct OpsMerge {
    const bf16_t* P; const bf16_t* WM; int K, lda;
    __device__ __forceinline__ void ptrs(const pg8::Unit& u, const char*& a, const char*& b) const {
        const int col = u.sub == 0 ? C_Q : (u.sub == 1 ? C_VV : C_X1);
        a = (const char*)P + ((size_t)u.pm * 256 * lda + col) * 2; b = (const char*)WM + ((size_t)u.sub * DM + (size_t)u.pn * 256) * 512 * 2; }
};
typedef f32x4 acc_t[2][2][4][2];
struct EpiStore {
    bf16_t* O; int ldc; int sig_pn;
    __device__ __forceinline__ bool keep(const pg8::Unit&) const { return false; }
    __device__ __forceinline__ void operator()(acc_t& acc, const pg8::Unit& u, int wr, int wc, int fr, int fq) const {
        const int row0 = u.pm * 256 + wr * 64 + fr, col0 = u.pn * 256 + wc * 32 + 8 * fq; const bool sig = u.pn >= sig_pn;
#pragma unroll
        for (int ai = 0; ai < 2; ++ai)
#pragma unroll
            for (int m = 0; m < 4; ++m) { bf16_t* rowp = O + (size_t)(row0 + ai * 128 + m * 16) * ldc + col0;
#pragma unroll
                for (int bj = 0; bj < 2; ++bj) { f32x4 v0 = acc[ai][bj][m][0], v1 = acc[ai][bj][m][1];
                    if (sig) { unsigned q[8];
#pragma unroll
                        for (int e = 0; e < 4; ++e) { q[e] = (unsigned)fminf(fmaxf(__builtin_rintf(255.f * __builtin_amdgcn_rcpf(1.f + __expf(-v0[e]))), 1.f), 255.f);
                                                      q[4 + e] = (unsigned)fminf(fmaxf(__builtin_rintf(255.f * __builtin_amdgcn_rcpf(1.f + __expf(-v1[e]))), 1.f), 255.f); }
                        u32x2 w8; w8.x = q[0] | (q[1] << 8) | (q[2] << 16) | (q[3] << 24); w8.y = q[4] | (q[5] << 8) | (q[6] << 16) | (q[7] << 24);
                        *(u32x2*)((unsigned char*)(O + (size_t)(row0 + ai * 128 + m * 16) * ldc) + C_G * 2 + (col0 + bj * 128 - C_G)) = w8; continue; }
                    u32x4 w; w.x = pg8::cvt_pk_bf16(v0[0], v0[1]); w.y = pg8::cvt_pk_bf16(v0[2], v0[3]); w.z = pg8::cvt_pk_bf16(v1[0], v1[1]); w.w = pg8::cvt_pk_bf16(v1[2], v1[3]);
                    *(u32x4*)(rowp + bj * 128) = w; } }
    }
};
struct EpiRes {
    float* xreal; float* xm; int dry;
    __device__ __forceinline__ bool keep(const pg8::Unit&) const { return false; }
    __device__ __forceinline__ void operator()(acc_t& acc, const pg8::Unit& u, int wr, int wc, int fr, int fq) const {
        const int row0 = u.pm * 256 + wr * 64 + fr, col0 = u.pn * 256 + wc * 32 + 8 * fq;
#pragma unroll
        for (int ai = 0; ai < 2; ++ai)
#pragma unroll
            for (int m = 0; m < 4; ++m) { float* p = xrow(xreal, xm, row0 + ai * 128 + m * 16) + col0;
#pragma unroll
                for (int bj = 0; bj < 2; ++bj) { f32x4 a = *(f32x4*)(p + bj * 128), b = *(f32x4*)(p + bj * 128 + 4);
                    a += acc[ai][bj][m][0]; b += acc[ai][bj][m][1]; if (!dry) { *(f32x4*)(p + bj * 128) = a; *(f32x4*)(p + bj * 128 + 4) = b; } } }
    }
};
struct EpiGeluMul {
    const bf16_t* G; const float* cw; const float* cb; bf16_t* O; int dv;
    __device__ __forceinline__ bool keep(const pg8::Unit&) const { return false; }
    __device__ __forceinline__ void operator()(acc_t& acc, const pg8::Unit& u, int wr, int wc, int fr, int fq) const {
        if (dv == 1) return;
        const int row0 = u.pm * 256 + wr * 64 + fr, col0 = u.pn * 256 + wc * 32 + 8 * fq;
#pragma unroll
        for (int ai = 0; ai < 2; ++ai)
#pragma unroll
            for (int m = 0; m < 4; ++m) { const int r = row0 + ai * 128 + m * 16;
                const int s = seq_of_row(r), p = r - seq_base(s); const bool inb = r < MROWS;
                const bool hasp = inb && p > 0, hasn = inb && p < seq_len(s) - 1;
                const float mp_ = hasp ? 1.f : 0.f, mn_ = hasn ? 1.f : 0.f;
#pragma unroll
                for (int bj = 0; bj < 2; ++bj) { const int col = col0 + bj * 128;
                    const bf16_t* gp = G + (size_t)r * DFF + col;
                    const u32x4 gm = *(const u32x4*)(gp - (hasp ? DFF : 0)), g0 = *(const u32x4*)gp, gn = *(const u32x4*)(gp + (hasn ? DFF : 0));
                    float fm[8], f0[8], fn[8]; unpack8(gm, fm); unpack8(g0, f0); unpack8(gn, fn);
                    float o[8];
#pragma unroll
                    for (int h = 0; h < 2; ++h) { const f32x4 a = *(const f32x4*)(cw + col + 4 * h), b = *(const f32x4*)(cw + DFF + col + 4 * h), c = *(const f32x4*)(cw + 2 * DFF + col + 4 * h), d = *(const f32x4*)(cb + col + 4 * h);
#pragma unroll
                        for (int e = 0; e < 4; e += 2) { f32x2 x; x.x = a[e] * mp_ * fm[4 * h + e] + b[e] * f0[4 * h + e] + c[e] * mn_ * fn[4 * h + e] + d[e];
                            x.y = a[e + 1] * mp_ * fm[4 * h + e + 1] + b[e + 1] * f0[4 * h + e + 1] + c[e + 1] * mn_ * fn[4 * h + e + 1] + d[e + 1];
                            const f32x2 g = pg8::gelu_pk(x); o[4 * h + e] = g.x; o[4 * h + e + 1] = g.y; } }
                    const f32x4 v0 = acc[ai][bj][m][0], v1 = acc[ai][bj][m][1];
                    u32x4 w; w.x = pg8::cvt_pk_bf16(o[0] * v0[0], o[1] * v0[1]); w.y = pg8::cvt_pk_bf16(o[2] * v0[2], o[3] * v0[3]);
                    w.z = pg8::cvt_pk_bf16(o[4] * v1[0], o[5] * v1[1]); w.w = pg8::cvt_pk_bf16(o[6] * v1[2], o[7] * v1[3]);
                    if (dv != 2) *(u32x4*)(O + (size_t)r * DFF + col) = w; else asm volatile("" :: "v"(w.x), "v"(w.y), "v"(w.z), "v"(w.w)); }
                if (m & 1) asm volatile("" ::: "memory"); }
    }
};
__device__ __forceinline__ void unpack8u(const u32x2 w, float* f) {
#pragma unroll
    for (int e = 0; e < 4; ++e) { f[e] = (float)((w.x >> (8 * e)) & 255u) * (1.f / 255.f); f[4 + e] = (float)((w.y >> (8 * e)) & 255u) * (1.f / 255.f); }
}
struct EpiMerge {
    const bf16_t* P; bf16_t* O;
    __device__ __forceinline__ bool keep(const pg8::Unit& u) const { return u.sub < 2; }
    __device__ __forceinline__ void operator()(acc_t& acc, const pg8::Unit& u, int wr, int wc, int fr, int fq) const {
        const int row0 = u.pm * 256 + wr * 64 + fr, col0 = u.pn * 256 + wc * 32 + 8 * fq; const int sub = u.sub;
#pragma unroll
        for (int ai = 0; ai < 2; ++ai)
#pragma unroll
            for (int m = 0; m < 4; ++m) { const int r = row0 + ai * 128 + m * 16;
#pragma unroll
                for (int bj = 0; bj < 2; ++bj) { const int col = col0 + bj * 128;
                    const unsigned char* gp = (const unsigned char*)(P + (size_t)r * INW) + C_G * 2 + col;
                    float mu[8];
                    if (sub < 2) { const u32x2 ga = *(const u32x2*)(gp + sub * DM), gb = *(const u32x2*)(gp + (sub + 1) * DM); float fa[8], fb[8]; unpack8u(ga, fa); unpack8u(gb, fb);
#pragma unroll
                        for (int e = 0; e < 8; ++e) mu[e] = fa[e] * __builtin_amdgcn_rcpf(fb[e]); }
                    else { const u32x2 ga = *(const u32x2*)(gp + 2 * DM); unpack8u(ga, mu); }
                    f32x4 v0 = acc[ai][bj][m][0], v1 = acc[ai][bj][m][1];
#pragma unroll
                    for (int e = 0; e < 4; ++e) { v0[e] *= mu[e]; v1[e] *= mu[4 + e]; }
                    if (sub < 2) { acc[ai][bj][m][0] = v0; acc[ai][bj][m][1] = v1; }
                    else { u32x4 w; w.x = pg8::cvt_pk_bf16(v0[0], v0[1]); w.y = pg8::cvt_pk_bf16(v0[2], v0[3]); w.z = pg8::cvt_pk_bf16(v1[0], v1[1]); w.w = pg8::cvt_pk_bf16(v1[2], v1[3]);
                        *(u32x4*)(O + (size_t)r * DM + col) = w; } } }
    }
};

#define XB_TMO      128
#define XB_XCNT(j)  (256  + 64 * (j))
#define XB_XSUB(j)  (1280 + 64 * (j))
#define XB_XGEN(j)  (2304 + 64 * (j))
#define XB_TOP      3328
#define XB_TOPGEN   3392
#define XCD_BAR_WORDS 3456
#define XB_SPIN_CAP (1u << 20)
__device__ __forceinline__ unsigned xb_ld(unsigned* p)              { return __hip_atomic_load(p, __ATOMIC_RELAXED, __HIP_MEMORY_SCOPE_AGENT); }
__device__ __forceinline__ unsigned xb_add(unsigned* p, unsigned v) { return __hip_atomic_fetch_add(p, v, __ATOMIC_RELAXED, __HIP_MEMORY_SCOPE_AGENT); }
__device__ __forceinline__ unsigned xb_xcc_id() { return (unsigned)__builtin_amdgcn_s_getreg((3 << 11) | 20) & 0xFu; }
#define XB_SPIN(cond, bar) do { unsigned _sp = 0; while (cond) { __builtin_amdgcn_s_sleep(1); \
    if ((++_sp & 255u) == 0u) { if (xb_ld(&(bar)[XB_TMO])) break; if (_sp > XB_SPIN_CAP) { atomicAdd(&(bar)[XB_TMO], 1u); break; } } } } while (0)
struct XcdBarrier { unsigned* bar; unsigned x; volatile LAS unsigned* st; };
__device__ __forceinline__ XcdBarrier xcd_barrier_post(unsigned* bar, volatile LAS unsigned* st) {
    XcdBarrier b; b.bar = bar; b.x = xb_xcc_id(); b.st = st;
    if (threadIdx.x == 0) (void)xb_add(&bar[XB_XCNT(b.x)], 1u);
    return b;
}
__device__ __forceinline__ void xcd_barrier_complete(unsigned* bar, unsigned x, unsigned& nloc, unsigned& nx) {
    const unsigned G = gridDim.x * gridDim.y * gridDim.z;
    unsigned sum, cnt, mine, sp = 0u;
    for (;;) {
        sum = 0u; cnt = 0u; mine = 0u;
#pragma unroll
        for (unsigned j = 0; j < 16; ++j) { const unsigned c = xb_ld(&bar[XB_XCNT(j)]); sum += c; cnt += (c > 0u) ? 1u : 0u; mine = (j == x) ? c : mine; }
        if (sum == G) break;
        __builtin_amdgcn_s_sleep(1);
        if ((++sp & 255u) == 0u) { if (xb_ld(&bar[XB_TMO])) break; if (sp > XB_SPIN_CAP) { atomicAdd(&bar[XB_TMO], 1u); break; } }
    }
    nloc = mine > 0u ? mine : 1u; nx = cnt > 0u ? cnt : 1u;
}
__device__ __forceinline__ void xcd_barrier(const XcdBarrier& b, int tid) {
    asm volatile("s_waitcnt vmcnt(0)" ::: "memory");
    __syncthreads();
    if (tid == 0) {
        unsigned* bar = b.bar;
        __builtin_amdgcn_s_waitcnt(0);
        unsigned nloc = b.st[0], nx = b.st[1];
        if (nloc == 0u) { xcd_barrier_complete(bar, b.x, nloc, nx); b.st[0] = nloc; b.st[1] = nx; }
        const unsigned old = xb_add(&bar[XB_XSUB(b.x)], 1u);
        const unsigned gen = old / nloc;
        if (old + 1u == (gen + 1u) * nloc) {
            __builtin_amdgcn_fence(__ATOMIC_RELEASE, "agent");
            asm volatile("s_waitcnt vmcnt(0)" ::: "memory");
            const unsigned og = xb_add(&bar[XB_TOP], 1u);
            const unsigned tg = og / nx;
            if (og + 1u == (tg + 1u) * nx) xb_add(&bar[XB_TOPGEN], 1u);
            else XB_SPIN(xb_ld(&bar[XB_TOPGEN]) == tg, bar);
            __builtin_amdgcn_fence(__ATOMIC_ACQUIRE, "agent");
            xb_add(&bar[XB_XGEN(b.x)], 1u);
            asm volatile("s_waitcnt vmcnt(0)" ::: "memory");
        } else {
            XB_SPIN(xb_ld(&bar[XB_XGEN(b.x)]) == gen, bar);
            __builtin_amdgcn_fence(__ATOMIC_ACQUIRE, "agent");
            asm volatile("s_waitcnt vmcnt(0)" ::: "memory");
        }
    }
    __syncthreads();
}

constexpr int NWAVES = 8;
constexpr int RING_BYTES = 131072, LDSCTL_OFF = RING_BYTES, MISC_OFF = LDSCTL_OFF + 320, LDS_BYTES = 147456;
struct Args { const float* in[30]; float* out; unsigned char* ws; int ph_lo, ph_hi, use_bar, pad; };
typedef const __attribute__((address_space(4))) Args CArgs;
struct Frame {
    LAS unsigned char* lds; int tid, lane, wave, G, vcu, bx, dry;
    float* out; unsigned char* ws; float* xm;
};
#define FIN(i) (A.in[i])

__constant__ unsigned char c_bucket[257] = {
15,15,15,15,15,15,15,15,15,15,15,15,15,15,15,15,15,15,15,15,15,15,15,15,15,15,15,15,15,15,15,15,15,15,15,15,15,15,14,14,14,14,14,14,14,14,14,14,14,14,14,14,14,14,14,14,14,14,14,14,14,14,14,14,14,13,13,13,13,13,13,13,13,13,13,13,13,13,13,13,13,13,13,12,12,12,12,12,12,12,12,12,12,12,12,12,12,11,11,11,11,11,11,11,11,11,10,10,10,10,10,10,10,9,9,9,9,8,8,8,8,7,6,5,4,3,2,1,0,17,18,19,20,21,22,23,24,24,24,24,25,25,25,25,26,26,26,26,26,26,26,27,27,27,27,27,27,27,27,27,28,28,28,28,28,28,28,28,28,28,28,28,28,28,29,29,29,29,29,29,29,29,29,29,29,29,29,29,29,29,29,29,30,30,30,30,30,30,30,30,30,30,30,30,30,30,30,30,30,30,30,30,30,30,30,30,30,30,30,31,31,31,31,31,31,31,31,31,31,31,31,31,31,31,31,31,31,31,31,31,31,31,31,31,31,31,31,31,31,31,31,31,31,31,31,31,31};

__device__ __forceinline__ void p0_transpose_item(const float* W, int K, int N, bf16_t* WT, int row_off, LAS float* scr, int item, int lane) {
    const int nblk = N / 32, kb = item / nblk, nb = item % nblk, k0 = 64 * kb, n0 = 32 * nb;
    f32x4 v[8];
#pragma unroll
    for (int i = 0; i < 8; ++i) v[i] = *(const f32x4*)(W + (size_t)(k0 + 8 * i + (lane >> 3)) * N + n0 + 4 * (lane & 7));
#pragma unroll
    for (int i = 0; i < 8; ++i) { LAS float* d = scr + (8 * i + (lane >> 3)) * 33 + 4 * (lane & 7); d[0] = v[i].x; d[1] = v[i].y; d[2] = v[i].z; d[3] = v[i].w; }
    LDS_WAIT(); asm volatile("" ::: "memory");
    const int c = lane & 7;
#pragma unroll
    for (int j = 0; j < 4; ++j) { const int n = (lane >> 3) + 8 * j; const LAS float* s = scr + (8 * c) * 33 + n;
        u32x4 o; o.x = pk2(s[0 * 33], s[1 * 33]); o.y = pk2(s[2 * 33], s[3 * 33]); o.z = pk2(s[4 * 33], s[5 * 33]); o.w = pk2(s[6 * 33], s[7 * 33]);
        *(u32x4*)(WT + (size_t)(row_off + n0 + n) * K + k0 + 8 * c) = o; }
    LDS_WAIT(); asm volatile("" ::: "memory");
}
__device__ __forceinline__ void rms_row(const f32x4 (&v)[4], const float* g, bf16_t* orow, int lane) {
    float s = 0.f;
#pragma unroll
    for (int j = 0; j < 4; ++j) s += (v[j].x * v[j].x + v[j].y * v[j].y) + (v[j].z * v[j].z + v[j].w * v[j].w);
    const float rstd = 1.0f / sqrtf(wave_sum(s, lane) * (1.f / DM) + EPS);
    unsigned long long* o8 = (unsigned long long*)orow + lane;
#pragma unroll
    for (int j = 0; j < 4; ++j) { const f32x4 gg = *((const f32x4*)g + lane + 64 * j);
        o8[64 * j] = (unsigned long long)pk2(v[j].x * rstd * gg.x, v[j].y * rstd * gg.y) | ((unsigned long long)pk2(v[j].z * rstd * gg.z, v[j].w * rstd * gg.w) << 32); }
}
constexpr size_t WS_H2F_P = 2 * MiB, WS_H2F_S = WS_END;
constexpr int NCH_P = (LP + 31) / 32, NCH_S = (LS + 31) / 32;
static_assert(WS_H2F_S + (size_t)NCH_S * 32 * 128 <= 512 * MiB && WS_H2F_P + (size_t)NCH_P * 32 * 128 <= WS_W, "h2 scratch");
__device__ __forceinline__ void filt_h2_compute(const CArgs& A, const Frame& F, int layer, int L, int tc, LAS float* h1t, int lane, float (&acc)[32]) {
    const float* w1 = FIN(11) + (size_t)layer * 33 * 64; const float* b1 = FIN(12) + layer * 64;
    const float* w2 = FIN(13) + (size_t)layer * 64 * 64; const float* b2 = FIN(14) + layer * 64; const float* fq_ = FIN(16) + layer * 64;
    const int pos = lane & 31, half = lane >> 5, jb = 32 * half;
    const float tt = (float)tc / (float)(L - 1);
    { f32x4 bv[8], wv[8];
#pragma unroll
      for (int i = 0; i < 8; ++i) { bv[i] = *(const f32x4*)(b1 + jb + 4 * i); wv[i] = *(const f32x4*)(w1 + jb + 4 * i); }
#pragma unroll
      for (int i = 0; i < 8; ++i)
#pragma unroll
          for (int e = 0; e < 4; ++e) acc[4 * i + e] = bv[i][e] + tt * wv[i][e]; }
#pragma unroll 2
    for (int k = 0; k < 16; ++k) {
        const float f = 1e-4f + (float)k * ((15.0f - 1e-4f) / 15.0f);
        const float rev = f * (float)tc * (1.0f / (float)L);
        const float sn = __builtin_amdgcn_sinf(rev), cs = __builtin_amdgcn_cosf(rev);
        f32x4 wc_[8], ws_[8];
#pragma unroll
        for (int i = 0; i < 8; ++i) { wc_[i] = *(const f32x4*)(w1 + (size_t)(1 + k) * 64 + jb + 4 * i); ws_[i] = *(const f32x4*)(w1 + (size_t)(17 + k) * 64 + jb + 4 * i); }
#pragma unroll
        for (int i = 0; i < 8; ++i)
#pragma unroll
            for (int e = 0; e < 4; ++e) acc[4 * i + e] += cs * wc_[i][e] - sn * ws_[i][e];
    }
    { f32x4 fv[8];
#pragma unroll
      for (int i = 0; i < 8; ++i) fv[i] = *(const f32x4*)(fq_ + jb + 4 * i);
#pragma unroll
      for (int i = 0; i < 8; ++i)
#pragma unroll
          for (int e = 0; e < 4; ++e) h1t[(jb + 4 * i + e) * 32 + pos] = __builtin_amdgcn_sinf(fv[i][e] * acc[4 * i + e] * 0.15915494309189535f); }
    LDS_WAIT();
    { f32x4 bv[8];
#pragma unroll
      for (int i = 0; i < 8; ++i) bv[i] = *(const f32x4*)(b2 + jb + 4 * i);
#pragma unroll
      for (int i = 0; i < 8; ++i)
#pragma unroll
          for (int e = 0; e < 4; ++e) acc[4 * i + e] = bv[i][e]; }
#pragma unroll 4
    for (int i2 = 0; i2 < 64; ++i2) { const float h = h1t[i2 * 32 + pos]; f32x4 wv[8];
#pragma unroll
        for (int i = 0; i < 8; ++i) wv[i] = *(const f32x4*)(w2 + (size_t)i2 * 64 + jb + 4 * i);
#pragma unroll
        for (int i = 0; i < 8; ++i)
#pragma unroll
            for (int e = 0; e < 4; ++e) acc[4 * i + e] += h * wv[i][e]; }
}
__device__ __forceinline__ void filt_h2_item(const CArgs& A, const Frame& F, int layer, int item, LAS float* h1t, int lane) {
    const int cls = item >= NCH_P ? 1 : 0, ch = cls ? item - NCH_P : item, L = cls ? LS : LP;
    const int pos = lane & 31, half = lane >> 5, jb = 32 * half;
    const int t = ch * 32 + pos, tc = t < L ? t : L - 1;
    const float* fq_ = FIN(16) + layer * 64;
    float acc[32];
    filt_h2_compute(A, F, layer, L, tc, h1t, lane, acc);
    { f32x4 fv[8]; unsigned hw[16];
#pragma unroll
      for (int i = 0; i < 8; ++i) fv[i] = *(const f32x4*)(fq_ + jb + 4 * i);
#pragma unroll
      for (int i = 0; i < 8; ++i)
#pragma unroll
          for (int e = 0; e < 4; e += 2) { const float a0 = __builtin_amdgcn_sinf(fv[i][e] * acc[4 * i + e] * 0.15915494309189535f), a1 = __builtin_amdgcn_sinf(fv[i][e + 1] * acc[4 * i + e + 1] * 0.15915494309189535f);
              typedef _Float16 h2_t __attribute__((ext_vector_type(2))); const h2_t hv = {(_Float16)a0, (_Float16)a1}; hw[2 * i + (e >> 1)] = __builtin_bit_cast(unsigned, hv); }
      u32x4* dst = (u32x4*)(F.ws + (cls ? WS_H2F_S : WS_H2F_P) + (size_t)t * 128 + half * 64);
#pragma unroll
      for (int i = 0; i < 4; ++i) dst[i] = (u32x4){hw[4 * i], hw[4 * i + 1], hw[4 * i + 2], hw[4 * i + 3]}; }
    LDS_WAIT();
}
constexpr int NCHF_P = (LP - 1 + 31) / 32 + 1, NCHB_P = (LP + 31) / 32, NCHF_S = (LS - 1 + 31) / 32 + 1, NCHB_S = (LS + 31) / 32;
constexpr int NFI_P = NCHF_P + NCHB_P, NFI = NFI_P + NCHF_S + NCHB_S;
__device__ __forceinline__ void filt_tile_item(const CArgs& A, const Frame& F, int layer, int item, int lane) {
    const int ct = item & 15; int cls = 0, it = item >> 4; if (it >= NFI_P) { cls = 1; it -= NFI_P; }
    const int nchf = cls ? NCHF_S : NCHF_P, L = cls ? LS : LP;
    bool bwd; int ch; if (it < nchf) { bwd = false; ch = it - 1; } else { bwd = true; ch = it - nchf; }
    const int tsh = bwd ? 0 : 1;
    const float* w3 = FIN(15) + (size_t)layer * 64 * 1024;
    const int pos = lane & 31, half = lane >> 5;
    const int t = ch * 32 + pos + tsh, tc = t < 0 ? 0 : (t < L ? t : L - 1);
    float acc[32];
#if FT_RECOMPUTE
    if (FT_RECOMPUTE == 1 || FT_RECOMPUTE == 9 || (FT_RECOMPUTE == 2 && cls == 0) || (FT_RECOMPUTE == 3 && cls == 1)) { LAS float* h1t = (LAS float*)(F.lds + F.wave * 16384); filt_h2_compute(A, F, layer, L, tc, h1t, lane, acc); const float* fq_ = FIN(16) + layer * 64;
#pragma unroll
      for (int k = 0; k < 32; ++k) acc[k] = __builtin_amdgcn_sinf(fq_[32 * half + k] * acc[k] * 0.15915494309189535f); LDS_WAIT(); }
    else
#endif
    { const u32x4* src = (const u32x4*)(F.ws + (cls ? WS_H2F_S : WS_H2F_P) + (size_t)tc * 128 + half * 64);
      u32x4 hv[4];
#pragma unroll
      for (int i = 0; i < 4; ++i) hv[i] = src[i];
#pragma unroll
      for (int i = 0; i < 4; ++i)
#pragma unroll
          for (int e = 0; e < 4; ++e) { typedef _Float16 h2_t __attribute__((ext_vector_type(2))); const unsigned wv_ = hv[i][e];
              const h2_t p = __builtin_bit_cast(h2_t, wv_); acc[8 * i + 2 * e] = (float)p[0]; acc[8 * i + 2 * e + 1] = (float)p[1]; } }
#if FT_RECOMPUTE == 9
    float bad = 0.f;
    { const u32x4* src = (const u32x4*)(F.ws + (cls ? WS_H2F_S : WS_H2F_P) + (size_t)tc * 128 + half * 64);
#pragma unroll
      for (int i = 0; i < 4; ++i) { const u32x4 hvv = src[i];
#pragma unroll
          for (int e = 0; e < 4; ++e) { typedef _Float16 h2_t __attribute__((ext_vector_type(2))); const h2_t p = __builtin_bit_cast(h2_t, hvv[e]);
              if (fabsf((float)p[0] - acc[8 * i + 2 * e]) > 2e-3f || fabsf((float)p[1] - acc[8 * i + 2 * e + 1]) > 2e-3f) bad = 1e4f; } } }
#else
    const float bad = 0.f;
#endif
    bf16_t* RK = (bf16_t*)(F.ws + (cls ? WS_RKS : WS_RKP)); const int rklen = cls ? RKLEN_S : RKLEN_P;
    float* sums = (float*)(F.ws + WS_CTL) + CW_SUMS + (layer * 2 + cls) * 512;
    const float da = -15.350567286626973f, db = -3.0701134573253945f;
    {
        const int col0 = (bwd ? 512 : 0) + ct * 32;
        float bw[32];
#pragma unroll
        for (int ks = 0; ks < 32; ++ks) bw[ks] = w3[(size_t)(32 * half + ks) * 1024 + col0 + pos];
        f32x16 d = {};
#pragma unroll
        for (int ks = 0; ks < 32; ++ks) d = __builtin_amdgcn_mfma_f32_32x32x2f32(acc[ks], bw[ks], d, 0, 0, 0);
        const int c = (col0 + pos) & 511;
        const float delta = fabsf(da + (db - da) * ((float)c / 511.0f));
        bf16_t* rk = RK + (size_t)c * rklen + RK_PAD + L;
        float asum = 0.f;
#pragma unroll
        for (int g = 0; g < 4; ++g) { const int t0 = ch * 32 + 8 * g + 4 * half + tsh; float v[4];
#pragma unroll
            for (int e = 0; e < 4; ++e) { const int tp = t0 + e; const bool ok = tp >= 0 && tp < L && !(bwd && tp == 0);
                const float tq = (float)tp / (float)(L - 1); v[e] = ok ? d[4 * g + e] * __expf(-tq * delta) + bad : 0.f; asum += fabsf(v[e]); }
            if (bwd) { if (t0 >= 4 && t0 + 3 < L) { u32x2 w; w.x = pk2(v[0], v[1]); w.y = pk2(v[2], v[3]); *(u32x2*)(rk + t0) = w; }
                       else {
#pragma unroll
                           for (int e = 0; e < 4; ++e) if (t0 + e >= 1 && t0 + e < L) rk[t0 + e] = (bf16_t)f2bf(v[e]); } }
            else { if (t0 >= 0 && t0 + 3 < L) { u32x2 w; w.x = pk2(v[3], v[2]); w.y = pk2(v[1], v[0]); *(u32x2*)(rk - t0 - 3) = w; }
                   else {
#pragma unroll
                       for (int e = 0; e < 4; ++e) if (t0 + e >= 0 && t0 + e < L) rk[-(t0 + e)] = (bf16_t)f2bf(v[e]); } } }
        asum += shx(asum, 32, lane);
        if (half == 0 && !F.dry) atomicAdd(sums + c, asum);
    }
}
__device__ __forceinline__ void p_filt_tiles(const CArgs& A, const Frame& F, int layer) {
    const int gw = F.vcu * NWAVES + F.wave, NGW = F.G * NWAVES;
    for (int it = gw; it < 16 * NFI; it += NGW) filt_tile_item(A, F, layer, it, F.lane);
}
__device__ __forceinline__ void p_prep(const CArgs& A, const Frame& F, int layer) {
    const int gw = F.vcu * NWAVES + F.wave, NGW = F.G * NWAVES, lane = F.lane;
    if (DSEL(1)) {
        const float* g = FIN(4) + layer * DM; bf16_t* XN = (bf16_t*)(F.ws + WS_XNR);
        for (int r0 = gw; r0 < MP; r0 += 2 * NGW) {
            f32x4 v[2][4]; const int rr[2] = {r0, r0 + NGW};
#pragma unroll
            for (int q = 0; q < 2; ++q) { const int r = rr[q];
                if (r >= MP) continue;
                if (r >= MROWS) {
#pragma unroll
                    for (int j = 0; j < 4; ++j) v[q][j] = (f32x4){0.f, 0.f, 0.f, 0.f};
                } else if (layer == 0) {
                    const int s = seq_of_row(r), p = r - seq_base(s);
                    const float* src = p < NMETA ? FIN(2) + (size_t)p * DM : (s < 8 ? FIN(0) + ((size_t)s * 2048 + (p - NMETA)) * DM : FIN(1) + (size_t)(p - NMETA) * DM);
                    const f32x4* sr = (const f32x4*)src + lane;
#pragma unroll
                    for (int j = 0; j < 4; ++j) v[q][j] = sr[64 * j];
                } else {
                    const f32x4* xr = (const f32x4*)xrow(F.out, F.xm, r) + lane;
#pragma unroll
                    for (int j = 0; j < 4; ++j) v[q][j] = xr[64 * j];
                } }
#pragma unroll
            for (int q = 0; q < 2; ++q) { const int r = rr[q];
                if (r >= MP) continue;
                if (layer == 0) { f32x4* xr = (f32x4*)xrow(F.out, F.xm, r) + lane;
#pragma unroll
                    for (int j = 0; j < 4; ++j) xr[64 * j] = v[q][j]; }
                rms_row(v[q], g, XN + (size_t)r * DM, lane); }
        }
    }
    {
        LAS float* scr = (LAS float*)(F.lds + F.wave * 16384);
        unsigned char* W = F.ws + WS_W;
        constexpr int I_IN = (DM / 64) * (INW / 32), I_G = (DM / 64) * (DFF / 32), I_D = (DFF / 64) * (DM / 32), I_O = (DM / 64) * (DM / 32), I_M = (512 / 64) * (DM / 32);
        constexpr int NIT = I_IN + 2 * I_G + I_D + I_O + 2 * I_M;
        if (DSEL(2)) for (int it = gw; it < NIT; it += NGW) {
            int r = it;
            if (r < I_IN) { p0_transpose_item(FIN(5) + (size_t)layer * DM * INW, DM, INW, (bf16_t*)(W + W_IN), 0, scr, r, lane); continue; } r -= I_IN;
            if (r < I_G) { p0_transpose_item(FIN(25) + (size_t)layer * DM * DFF, DM, DFF, (bf16_t*)(W + W_G), 0, scr, r, lane); continue; } r -= I_G;
            if (r < I_G) { p0_transpose_item(FIN(26) + (size_t)layer * DM * DFF, DM, DFF, (bf16_t*)(W + W_U), 0, scr, r, lane); continue; } r -= I_G;
            if (r < I_D) { p0_transpose_item(FIN(29) + (size_t)layer * DFF * DM, DFF, DM, (bf16_t*)(W + W_D), 0, scr, r, lane); continue; } r -= I_D;
            if (r < I_O) { p0_transpose_item(FIN(23) + (size_t)layer * DM * DM, DM, DM, (bf16_t*)(W + W_OUT), 0, scr, r, lane); continue; } r -= I_O;
            if (r < I_M) { p0_transpose_item(FIN(20) + (size_t)layer * 512 * DM, 512, DM, (bf16_t*)(W + W_MRG), 0, scr, r, lane); continue; } r -= I_M;
            p0_transpose_item(FIN(21) + (size_t)layer * 512 * DM, 512, DM, (bf16_t*)(W + W_MRG), DM, scr, r, lane);
        }
        const float* pw = FIN(18) + (size_t)layer * 4 * 128 * 128; const float* psc = FIN(19) + layer * 512; const float* wpo = FIN(22) + (size_t)layer * 512 * DM;
        bf16_t* WT = (bf16_t*)(W + W_MRG) + (size_t)2 * DM * 512;
        const int gt = (F.vcu * NWAVES + F.wave) * 64 + lane, NGT = NGW * 64;
        if (DSEL(4)) for (int idx = gt; idx < 512 * DM; idx += NGT) { const int j = idx & (DM - 1), c = idx >> 10, g = c >> 7, cc = c & 127;
            const float* pr = pw + ((size_t)g * 128 + cc) * 128; const float* wp = wpo + (size_t)(g * 128) * DM + j; const float* ps = psc + g * 128; float a = 0.f;
#pragma unroll 32
            for (int d = 0; d < 128; ++d) a += pr[d] * ps[d] * wp[(size_t)d * DM];
            WT[(size_t)j * 512 + c] = (bf16_t)f2bf(a); }
        for (int idx = gt; idx < 2 * 512 * 513; idx += NGT) { const int k = idx % 513, cc = (idx / 513) & 511, cls = idx / (513 * 512);
            const int L = cls ? LS : LP, rklen = cls ? RKLEN_S : RKLEN_P; bf16_t* RK = (bf16_t*)(F.ws + (cls ? WS_RKS : WS_RKP)) + (size_t)cc * rklen;
            RK[k <= 256 ? k : 256 + 2 * L + (k - 257)] = 0; }
        if (DSEL(8)) for (int it = gw; it < NCH_P + NCH_S; it += NGW) filt_h2_item(A, F, layer, it, scr, lane);
    }
}

__device__ __forceinline__ void p_attn_ref(const CArgs& A, const Frame& F, int layer) {
    bf16_t* P = (bf16_t*)(F.ws + WS_PROJ);
    const float* qg = FIN(6) + layer * HD; const float* kg = FIN(7) + layer * HD; const float* sink = FIN(8) + layer * NHEAD; const float* rb = FIN(3);
    const int gt = (F.vcu * NWAVES + F.wave) * 64 + F.lane, NGT = F.G * NWAVES * 64;
    for (int idx = gt; idx < MROWS * NHEAD; idx += NGT) {
        const int r = idx >> 3, h = idx & 7, hk = h >> 2;
        const int s = seq_of_row(r), base = seq_base(s), L = seq_len(s), p = r - base;
        unsigned qs[32]; float o[64];
        { const u32x4* qp = (const u32x4*)(P + (size_t)r * INW + C_Q + 64 * h); float ss = 0.f;
#pragma unroll
          for (int c = 0; c < 8; ++c) { const u32x4 w = qp[c]; qs[4 * c] = w.x; qs[4 * c + 1] = w.y; qs[4 * c + 2] = w.z; qs[4 * c + 3] = w.w; }
#pragma unroll
          for (int d = 0; d < 32; ++d) { const float a = bflo(qs[d]), b = bfhi(qs[d]); ss += a * a + b * b; }
          const float rs = 1.0f / sqrtf(ss * (1.f / 64) + EPS) * 0.125f;
#pragma unroll
          for (int d = 0; d < 32; ++d) { qs[d] = pk2(bflo(qs[d]) * rs * qg[2 * d], bfhi(qs[d]) * rs * qg[2 * d + 1]); o[2 * d] = 0.f; o[2 * d + 1] = 0.f; } }
        float m = sink[h], l = 1.f;
        const int lo = p - 128 < 0 ? 0 : p - 128, hi = p + 128 > L - 1 ? L - 1 : p + 128;
        for (int pk = lo; pk <= hi; ++pk) {
            const bf16_t* kr = P + (size_t)(base + pk) * INW;
            const u32x4* kp = (const u32x4*)(kr + C_K + 64 * hk); const u32x4* vp = (const u32x4*)(kr + C_V + 64 * hk);
            float ss = 0.f, dt = 0.f;
#pragma unroll
            for (int c = 0; c < 8; ++c) { float kk[8]; unpack8(kp[c], kk);
#pragma unroll
                for (int e = 0; e < 8; ++e) { ss += kk[e] * kk[e]; const unsigned qw = qs[4 * c + (e >> 1)]; dt += kk[e] * kg[8 * c + e] * ((e & 1) ? bfhi(qw) : bflo(qw)); }
                asm volatile("" ::: "memory"); }
            const float sc = dt / sqrtf(ss * (1.f / 64) + EPS) + rb[c_bucket[pk - p + 128] * NHEAD + h];
            const float mn = fmaxf(m, sc), f = __expf(m - mn), pe = __expf(sc - mn);
            l = l * f + pe; m = mn;
#pragma unroll
            for (int c = 0; c < 8; ++c) { float vv[8]; unpack8(vp[c], vv);
#pragma unroll
                for (int e = 0; e < 8; ++e) o[8 * c + e] = o[8 * c + e] * f + pe * vv[e];
                asm volatile("" ::: "memory"); }
        }
        const float il = (DBG & 4) ? 0.f : 1.f / l; u32x4* op = (u32x4*)(P + (size_t)r * INW + C_Q + 64 * h);
#pragma unroll
        for (int c = 0; c < 8; ++c) { u32x4 w; w.x = pk2(o[8 * c] * il, o[8 * c + 1] * il); w.y = pk2(o[8 * c + 2] * il, o[8 * c + 3] * il); w.z = pk2(o[8 * c + 4] * il, o[8 * c + 5] * il); w.w = pk2(o[8 * c + 6] * il, o[8 * c + 7] * il); op[c] = w; }
    }
}

constexpr int AT_K = 0, AT_V = 49152, AT_VSTR = 776, AT_B = AT_V + 64 * AT_VSTR;
__device__ __forceinline__ void p_attn(const CArgs& A, const Frame& F, int layer) {
    bf16_t* P = (bf16_t*)(F.ws + WS_PROJ);
    const float* qg = FIN(6) + layer * HD; const float* kg = FIN(7) + layer * HD; const float* sink = FIN(8) + layer * NHEAD; const float* rb = FIN(3);
    const int lane = F.lane, wave = F.wave, tid = F.tid, r32 = lane & 31, hi = lane >> 5;
    LAS unsigned char* lds = F.lds;
    for (int unit = F.vcu; unit < 265 * 4; unit += F.G) {
        const int gb = unit >> 2, hk = (unit >> 1) & 1, gh = unit & 1;
        const int s = gb < 136 ? gb / 17 : 8, nb = gb < 136 ? gb - 17 * s : gb - 136;
        const int base = seq_base(s), L = seq_len(s);
        const int pk0 = 128 * nb - 240;
        u32x4 kws[6], vws[6];
#pragma unroll
        for (int it = 0; it < 6; ++it) { const int idx = tid + it * 512, key = idx >> 3, ch = idx & 7, pk = pk0 + key; const bool ok = pk >= 0 && pk < L;
            const bf16_t* rowp = P + (size_t)(base + (ok ? pk : 0)) * INW + 64 * hk + 8 * ch;
            kws[it] = *(const u32x4*)(rowp + C_K); vws[it] = *(const u32x4*)(rowp + C_V); }
#pragma unroll
        for (int it = 0; it < 6; ++it) { const int idx = tid + it * 512, key = idx >> 3, ch = idx & 7, pk = pk0 + key; const bool ok = pk >= 0 && pk < L;
            u32x4 kw = kws[it], vw = vws[it];
            float kf[8]; unpack8(kw, kf); float ss = 0.f;
#pragma unroll
            for (int e = 0; e < 8; ++e) ss += kf[e] * kf[e];
            ss += shx(ss, 1, lane); ss += shx(ss, 2, lane); ss += shx(ss, 4, lane);
            const float rs = ok ? 1.0f / sqrtf(ss * (1.f / 64) + EPS) : 0.f;
            u32x4 ko; ko.x = pk2(kf[0] * rs * kg[8 * ch], kf[1] * rs * kg[8 * ch + 1]); ko.y = pk2(kf[2] * rs * kg[8 * ch + 2], kf[3] * rs * kg[8 * ch + 3]);
            ko.z = pk2(kf[4] * rs * kg[8 * ch + 4], kf[5] * rs * kg[8 * ch + 5]); ko.w = pk2(kf[6] * rs * kg[8 * ch + 6], kf[7] * rs * kg[8 * ch + 7]);
            *(LAS u32x4*)(lds + AT_K + key * 128 + ((ch ^ (key & 7)) << 4)) = ko;
            if (!ok) vw = (u32x4){0u, 0u, 0u, 0u};
            LAS bf16_t* vt = (LAS bf16_t*)(lds + AT_V + (8 * ch) * AT_VSTR) + key;
            vt[0] = (bf16_t)(vw.x & 0xffffu); *(LAS bf16_t*)((LAS unsigned char*)vt + AT_VSTR) = (bf16_t)(vw.x >> 16);
            *(LAS bf16_t*)((LAS unsigned char*)vt + 2 * AT_VSTR) = (bf16_t)(vw.y & 0xffffu); *(LAS bf16_t*)((LAS unsigned char*)vt + 3 * AT_VSTR) = (bf16_t)(vw.y >> 16);
            *(LAS bf16_t*)((LAS unsigned char*)vt + 4 * AT_VSTR) = (bf16_t)(vw.z & 0xffffu); *(LAS bf16_t*)((LAS unsigned char*)vt + 5 * AT_VSTR) = (bf16_t)(vw.z >> 16);
            *(LAS bf16_t*)((LAS unsigned char*)vt + 6 * AT_VSTR) = (bf16_t)(vw.w & 0xffffu); *(LAS bf16_t*)((LAS unsigned char*)vt + 7 * AT_VSTR) = (bf16_t)(vw.w >> 16); }
        for (int i = tid; i < 2 * 257; i += 512) { const int hh = i >= 257 ? 1 : 0, rr = i - 257 * hh; ((LAS float*)(lds + AT_B))[hh * 260 + rr] = rb[c_bucket[rr] * NHEAD + 4 * hk + 2 * gh + hh]; }
        __syncthreads();
        const int hh = wave >> 2, head = 4 * hk + 2 * gh + hh, qt = wave & 3, qi = 32 * qt + r32, pq = 128 * nb - 112 + qi; const bool qok = pq >= 0;
        const LAS float* bias = (const LAS float*)(lds + AT_B) + hh * 260;
        bf16x8 qf[4];
        { const bf16_t* qp = P + (size_t)(base + (qok ? pq : 0)) * INW + C_Q + 64 * head + 8 * hi; u32x4 qw[4]; float ss = 0.f;
#pragma unroll
          for (int ds = 0; ds < 4; ++ds) { qw[ds] = *(const u32x4*)(qp + 16 * ds); float f[8]; unpack8(qw[ds], f);
#pragma unroll
              for (int e = 0; e < 8; ++e) ss += f[e] * f[e]; }
          ss += shx(ss, 32, lane);
          const float rs = 0.125f / sqrtf(ss * (1.f / 64) + EPS);
#pragma unroll
          for (int ds = 0; ds < 4; ++ds) { float f[8]; unpack8(qw[ds], f); const float* g = qg + 16 * ds + 8 * hi; u32x4 o;
              o.x = pk2(f[0] * rs * g[0], f[1] * rs * g[1]); o.y = pk2(f[2] * rs * g[2], f[3] * rs * g[3]); o.z = pk2(f[4] * rs * g[4], f[5] * rs * g[5]); o.w = pk2(f[6] * rs * g[6], f[7] * rs * g[7]);
              qf[ds] = __builtin_bit_cast(bf16x8, o); } }
        float m = sink[head], lp = hi == 0 ? 1.f : 0.f;
        f32x16 o0 = {}, o1 = {};
        for (int kt = qt; kt <= qt + 8; ++kt) {
            f32x16 st = {};
#pragma unroll
            for (int ds = 0; ds < 4; ++ds) { const int key = 32 * kt + r32, chn = 2 * ds + hi;
                const bf16x8 kfr = *(const LAS bf16x8*)(lds + AT_K + key * 128 + ((chn ^ (key & 7)) << 4));
                st = __builtin_amdgcn_mfma_f32_32x32x16_bf16(kfr, qf[ds], st, 0, 0, 0); }
            float tmax = -1e30f;
#pragma unroll
            for (int i = 0; i < 16; ++i) { const int kj = 32 * kt + (i & 3) + 8 * (i >> 2) + 4 * hi, rel = kj - 128 - qi, pk = pk0 + kj;
                const bool ok = rel >= -128 && rel <= 128 && pk >= 0 && pk < L;
                const float v = ok ? st[i] + bias[rel + 128 < 0 ? 0 : (rel + 128 > 256 ? 256 : rel + 128)] : -1e30f;
                st[i] = v; tmax = fmaxf(tmax, v); }
            tmax = fmaxf(tmax, shx(tmax, 32, lane));
            const float mn = fmaxf(m, tmax), f = __expf(m - mn); m = mn;
            float ps = 0.f;
#pragma unroll
            for (int i = 0; i < 16; ++i) { st[i] = __expf(st[i] - mn); ps += st[i]; }
            lp = lp * f + ps;
#pragma unroll
            for (int i = 0; i < 16; ++i) { o0[i] *= f; o1[i] *= f; }
#pragma unroll
            for (int s2 = 0; s2 < 2; ++s2) {
                u32x4 pw; pw.x = pk2(st[8 * s2], st[8 * s2 + 1]); pw.y = pk2(st[8 * s2 + 2], st[8 * s2 + 3]); pw.z = pk2(st[8 * s2 + 4], st[8 * s2 + 5]); pw.w = pk2(st[8 * s2 + 6], st[8 * s2 + 7]);
                const bf16x8 pf = __builtin_bit_cast(bf16x8, pw);
#pragma unroll
                for (int dt = 0; dt < 2; ++dt) { const LAS unsigned char* vp = lds + AT_V + (32 * dt + r32) * AT_VSTR + (32 * kt + 16 * s2 + 4 * hi) * 2;
                    const u32x2 a0 = *(const LAS u32x2*)vp, a1 = *(const LAS u32x2*)(vp + 16);
                    const bf16x8 vf = __builtin_bit_cast(bf16x8, (u32x4){a0.x, a0.y, a1.x, a1.y});
                    if (dt == 0) o0 = __builtin_amdgcn_mfma_f32_32x32x16_bf16(vf, pf, o0, 0, 0, 0); else o1 = __builtin_amdgcn_mfma_f32_32x32x16_bf16(vf, pf, o1, 0, 0, 0); }
            }
        }
        const float il = (DBG & 4) ? 0.f : 1.f / (lp + shx(lp, 32, lane));
        if (qok && !F.dry) { bf16_t* op = P + (size_t)(base + pq) * INW + C_Q + 64 * head + 4 * hi;
#pragma unroll
            for (int g = 0; g < 4; ++g) { u32x2 w0, w1; w0.x = pk2(o0[4 * g] * il, o0[4 * g + 1] * il); w0.y = pk2(o0[4 * g + 2] * il, o0[4 * g + 3] * il);
                w1.x = pk2(o1[4 * g] * il, o1[4 * g + 1] * il); w1.y = pk2(o1[4 * g + 2] * il, o1[4 * g + 3] * il);
                *(u32x2*)(op + 8 * g) = w0; *(u32x2*)(op + 32 + 8 * g) = w1; } }
        __syncthreads();
    }
}
__device__ __forceinline__ void dwconv8(const bf16_t* P, int r, int col, const float* cw, const float* cb, int ucol, float* out) {
    const int s = seq_of_row(r), p = r - seq_base(s); const bool hasp = p > 0, hasn = p < seq_len(s) - 1;
    const bf16_t* gp = P + (size_t)r * INW + col;
    const u32x4 gm = *(const u32x4*)(gp - (hasp ? INW : 0)), g0 = *(const u32x4*)gp, gn = *(const u32x4*)(gp + (hasn ? INW : 0));
    float fm[8], f0[8], fn[8]; unpack8(gm, fm); unpack8(g0, f0); unpack8(gn, fn);
    const float mp_ = hasp ? 1.f : 0.f, mn_ = hasn ? 1.f : 0.f;
#pragma unroll
    for (int e = 0; e < 8; ++e) { fm[e] *= mp_; fn[e] *= mn_; }
#pragma unroll
    for (int e = 0; e < 8; ++e) out[e] = cw[ucol + e] * fm[e] + cw[1536 + ucol + e] * f0[e] + cw[2 * 1536 + ucol + e] * fn[e] + cb[ucol + e];
}
__device__ __forceinline__ void p_h1(const CArgs& A, const Frame& F, int layer) {
    const bf16_t* P = (const bf16_t*)(F.ws + WS_PROJ); bf16_t* ZT = (bf16_t*)(F.ws + WS_XNR);
    const float* cw = FIN(9) + (size_t)layer * 3 * 1536; const float* cb = FIN(10) + layer * 1536;
    LAS bf16_t* scr = (LAS bf16_t*)(F.lds + F.wave * 16384);
    const int gw = F.vcu * NWAVES + F.wave, NGW = F.G * NWAVES, lane = F.lane, rs = lane >> 3, ck = lane & 7;
    for (int it = gw; it < (MP / 64) * 8; it += NGW) {
        const int rt = it >> 3, cc = it & 7, c0 = cc * 64 + ck * 8;
#pragma unroll 4
        for (int i8 = 0; i8 < 8; ++i8) { const int lr = i8 * 8 + rs, r = rt * 64 + lr; float z[8];
            if (r < MROWS) { float a[8], b[8]; dwconv8(P, r, C_X1 + c0, cw, cb, 512 + c0, a); dwconv8(P, r, C_VV + c0, cw, cb, 1024 + c0, b);
#pragma unroll
                for (int e = 0; e < 8; ++e) z[e] = a[e] * b[e]; }
            else {
#pragma unroll
                for (int e = 0; e < 8; ++e) z[e] = 0.f; }
#pragma unroll
            for (int e = 0; e < 8; ++e) scr[(ck * 8 + e) * 72 + lr] = (bf16_t)f2bf(z[e]); }
        LDS_WAIT();
#pragma unroll
        for (int j = 0; j < 8; ++j) { const int chn = (lane >> 3) + 8 * j, pc = lane & 7;
            const u32x4 w = *(const LAS u32x4*)(scr + chn * 72 + pc * 8);
            *(u32x4*)(ZT + (size_t)(cc * 64 + chn) * MP + rt * 64 + pc * 8) = w; }
        LDS_WAIT();
    }
}

__device__ __forceinline__ void p_h2_ref(const CArgs& A, const Frame& F) {
    const bf16_t* ZT = (const bf16_t*)(F.ws + WS_XNR); bf16_t* CT = (bf16_t*)(F.ws + WS_XNR + (size_t)512 * MP * 2);
    const int gt = (F.vcu * NWAVES + F.wave) * 64 + F.lane, NGT = F.G * NWAVES * 64;
    for (long idx = gt; idx < (long)512 * MP; idx += NGT) {
        const int c = (int)(idx / MP), r = (int)(idx - (long)c * MP);
        float acc = 0.f;
        if (r < MROWS) {
            const int s = seq_of_row(r), base = seq_base(s), L = seq_len(s), p = r - base, cls = s < 8 ? 0 : 1;
            const bf16_t* rk = (const bf16_t*)(F.ws + (cls ? WS_RKS : WS_RKP)) + (size_t)c * (cls ? RKLEN_S : RKLEN_P) + RK_PAD + L - p;
            const bf16_t* z = ZT + (size_t)c * MP + base;
            for (int s8 = 0; s8 < L; s8 += 8) { const u32x4 zw = *(const u32x4*)(z + s8); float zf[8]; unpack8(zw, zf);
#pragma unroll
                for (int e = 0; e < 8; ++e) acc += zf[e] * __uint_as_float((unsigned)rk[s8 + e] << 16); }
        }
        CT[idx] = (bf16_t)f2bf(acc);
    }
}
constexpr int H2_ZOFF_S = ((RKLEN_S * 2 + 1023) >> 10) << 10, H2_ZOFF_P = ((RKLEN_P * 2 + 1023) >> 10) << 10;
constexpr int H2_ZPADL_S = 4096, H2_ZSLOTS_S = 24704, H2_ZPADL_P = 512, H2_ZSLOTS_P = 3072, H2_SZP = 6976;
static_assert(H2_ZOFF_S + (H2_ZSLOTS_S + (H2_ZSLOTS_S >> 7) * 16) * 2 <= RING_BYTES_C && H2_ZOFF_P + 8 * H2_SZP <= RING_BYTES_C, "H2 LDS");
__device__ __forceinline__ void p_h2(const Frame& F) {
    const bf16_t* ZT = (const bf16_t*)(F.ws + WS_XNR); bf16_t* CT = (bf16_t*)(F.ws + WS_XNR + (size_t)512 * MP * 2);
    const int lane = F.lane, wave = F.wave, tid = F.tid;
    LAS float* red = (LAS float*)(F.lds + LDSCTL_OFF_C + 1024);
    for (int item = F.vcu; item < 1024; item += F.G) {
        const int cls = item < 512 ? 1 : 0, c = item & 511;
        const int L = cls ? LS : LP, rklen = cls ? RKLEN_S : RKLEN_P, ZPADL = cls ? H2_ZPADL_S : H2_ZPADL_P, zs8 = (cls ? H2_ZSLOTS_S : H2_ZSLOTS_P) / 8;
        LAS unsigned char* rkl = F.lds; LAS unsigned char* zl = F.lds + (cls ? H2_ZOFF_S : H2_ZOFF_P);
        {
          const char* rkg = (const char*)((const bf16_t*)(F.ws + (cls ? WS_RKS : WS_RKP)) + (size_t)c * rklen);
          const int npc = (rklen * 2 + 1023) >> 10;
          for (int pc = wave; pc < npc; pc += NWAVES)
              __builtin_amdgcn_global_load_lds((const unsigned*)(rkg + (size_t)pc * 1024 + lane * 16), (LAS unsigned*)(rkl + pc * 1024), 16, 0, 0);
          const int nsl = (cls ? 1 : 8) * zs8; u32x4 zv[7];
#pragma unroll
          for (int j = 0; j < 7; ++j) { const int i = tid + j * (NWAVES * 64); const int sq = i / zs8, i8 = i - sq * zs8, sp = i8 * 8 - ZPADL;
              zv[j] = (u32x4){0u, 0u, 0u, 0u};
              if (i < nsl && sp >= 0 && sp < L) zv[j] = *(const u32x4*)(ZT + (size_t)c * MP + (cls ? ROWS_P : sq * LP) + sp); }
#pragma unroll
          for (int j = 0; j < 7; ++j) { const int i = tid + j * (NWAVES * 64); const int sq = i / zs8, i8 = i - sq * zs8; const int pos = i8 * 8, el = pos + ((pos >> 7) << 4);
              if (i < nsl) *(LAS u32x4*)(zl + sq * H2_SZP + el * 2) = zv[j]; }
          asm volatile("s_waitcnt vmcnt(0)" ::: "memory"); }
        __syncthreads();
        const int n = lane & 15, h = lane >> 4, cg = wave & 3, us = wave >> 2;
        int T0a, zb, T0min, T0max, rowbase;
        const int T0g = cls ? 128 * 16 : 256; const int zg1 = (T0g + (T0g >> 7) * 16) * 2;
        if (cls) { T0min = 16 + 128 * 32 * cg; T0max = T0min + 128 * 31; T0a = T0min + 128 * n; zb = 0; rowbase = ROWS_P; }
        else { const int sq = n >> 1; T0min = 16 + 512 * cg; T0max = T0min + 384; T0a = T0min + 128 * (n & 1); zb = sq * H2_SZP; rowbase = sq * LP; }
        const int u_lo = -(((T0max + 7 + 31) >> 5) << 5), u_hi = ((L - 32 - T0min + 31) >> 5) << 5;
        const int nst = (u_hi - u_lo) / 32 + 1, nh = (nst + 1) >> 1;
        const int u_a = us ? u_lo + 32 * nh : u_lo, u_b = us ? u_hi : u_lo + 32 * (nh - 1);
        const int abase = RK_PAD + L - 8 * n + 8 * h;
        f32x4 acc[2][8];
#pragma unroll
        for (int g = 0; g < 2; ++g)
#pragma unroll
            for (int t = 0; t < 8; ++t) acc[g][t] = (f32x4){0.f, 0.f, 0.f, 0.f};
#define H2_STEP(V0, V1) do { \
            const LAS unsigned char* ap = rkl + (abase + u) * 2; \
            const u32x4 Lo = *(const LAS u32x4*)(ap - 16), Hi = *(const LAS u32x4*)ap; \
            bf16x8 Bz[2]; \
            { const int i0 = T0a + u + 8 * h + ZPADL, e0 = i0 + ((i0 >> 7) << 4); const LAS unsigned char* zp = zl + zb + e0 * 2; \
              if (V0) Bz[0] = *(const LAS bf16x8*)zp; if (V1) Bz[1] = *(const LAS bf16x8*)(zp + zg1); } \
            unsigned W[8] = {Lo.x, Lo.y, Lo.z, Lo.w, Hi.x, Hi.y, Hi.z, Hi.w}, Od[7]; \
            _Pragma("unroll") for (int k = 0; k < 7; ++k) Od[k] = __builtin_amdgcn_alignbit(W[k + 1], W[k], 16); \
            _Pragma("unroll") for (int t = 0; t < 8; ++t) { const int i = 4 - ((t + 1) >> 1); \
                const u32x4 fw = (t & 1) ? (u32x4){Od[i], Od[i + 1], Od[i + 2], Od[i + 3]} : (u32x4){W[i], W[i + 1], W[i + 2], W[i + 3]}; \
                const bf16x8 Af = __builtin_bit_cast(bf16x8, fw); \
                if (V0) acc[0][t] = __builtin_amdgcn_mfma_f32_16x16x32_bf16(Af, Bz[0], acc[0][t], 0, 0, 0); \
                if (V1) acc[1][t] = __builtin_amdgcn_mfma_f32_16x16x32_bf16(Af, Bz[1], acc[1][t], 0, 0, 0); } } while (0)
        { const int gspan = cls ? 128 * 15 : 128;
          int u0s = -(T0min + gspan + 39); u0s = u0s >= 0 ? ((u0s + 31) >> 5) << 5 : -((-u0s) >> 5 << 5);
          int u1e = L - (T0min + T0g); u1e = u1e >= 0 ? ((u1e + 31) >> 5) << 5 : -((-u1e) >> 5 << 5);
          const int ua2 = u0s > u_a ? (u0s < u_b + 32 ? u0s : u_b + 32) : u_a;
          const int ub2 = u1e < u_b + 32 ? (u1e > ua2 ? u1e : ua2) : u_b + 32;
          int u = u_a;
          for (; u < ua2; u += 32) H2_STEP(false, true);
          for (; u < ub2; u += 32) H2_STEP(true, true);
          for (; u <= u_b; u += 32) H2_STEP(true, false); }
#undef H2_STEP
        { float m[16];
#pragma unroll
          for (int t = 0; t < 16; ++t) m[t] = 0.f;
          const int nchunk = L / 8, cstep = cls ? NWAVES * 64 : 64; const int zb2 = cls ? 0 : wave * H2_SZP;
          for (int ck = cls ? tid : lane; ck < nchunk; ck += cstep) { const int s0 = ck * 8, i0 = s0 + ZPADL, e0 = i0 + ((i0 >> 7) << 4);
              const u32x4 zw = *(const LAS u32x4*)(zl + zb2 + e0 * 2);
              const LAS unsigned char* rp = rkl + (RK_PAD + L + s0 - 16) * 2;
              const u32x4 r0 = *(const LAS u32x4*)rp, r1 = *(const LAS u32x4*)(rp + 16), r2 = *(const LAS u32x4*)(rp + 32);
              float zf[8], rf[24]; unpack8(zw, zf); unpack8(r0, rf); unpack8(r1, rf + 8); unpack8(r2, rf + 16);
#pragma unroll
              for (int t = 0; t < 16; ++t)
#pragma unroll
                  for (int e = 0; e < 8; ++e) m[t] += zf[e] * rf[16 + e - t]; }
#pragma unroll
          for (int t = 0; t < 16; ++t) m[t] = wave_sum(m[t], lane);
          float mine = 0.f;
#pragma unroll
          for (int t = 0; t < 16; ++t) mine = (lane == t) ? m[t] : mine;
          if (cls) { if (lane < 16) red[wave * 16 + lane] = mine; }
          else if (lane < 16) CT[(size_t)c * MP + wave * LP + lane] = (bf16_t)f2bf(mine); }
        __syncthreads();
        if (us == 1) {
#pragma unroll
            for (int g = 0; g < 2; ++g)
#pragma unroll
                for (int t = 0; t < 8; ++t) *(LAS f32x4*)(F.lds + cg * 16384 + (g * 8 + t) * 1024 + lane * 16) = acc[g][t]; }
        if (cls && tid < 16) { float a = 0.f;
#pragma unroll
            for (int w = 0; w < 8; ++w) a += red[w * 16 + tid];
            CT[(size_t)c * MP + ROWS_P + tid] = (bf16_t)f2bf(a); }
        __syncthreads();
        if (us == 0) {
#pragma unroll
            for (int g = 0; g < 2; ++g) {
#pragma unroll
                for (int t = 0; t < 8; ++t) acc[g][t] += *(const LAS f32x4*)(F.lds + cg * 16384 + (g * 8 + t) * 1024 + lane * 16);
                bf16_t* op = CT + (size_t)c * MP + rowbase + T0a + g * T0g + 32 * h;
#pragma unroll
                for (int i = 0; i < 4; ++i) { u32x4 w; w.x = pk2(acc[g][0][i], acc[g][1][i]); w.y = pk2(acc[g][2][i], acc[g][3][i]); w.z = pk2(acc[g][4][i], acc[g][5][i]); w.w = pk2(acc[g][6][i], acc[g][7][i]);
                    *(u32x4*)(op + 8 * i) = w; } } }
        __syncthreads();
    }
}
__device__ __forceinline__ void p_pool(const CArgs& A, const Frame& F) {
    bf16_t* P = (bf16_t*)(F.ws + WS_PROJ);
    const int gw = F.vcu * NWAVES + F.wave, NGW = F.G * NWAVES, lane = F.lane, c0 = lane * 8, hw = 1 << (lane >> 4);
    for (int run = gw; run < MROWS / 16; run += NGW) {
        const int r0 = run * 16, s = seq_of_row(r0), base = seq_base(s), L = seq_len(s), p0 = r0 - base;
        const bf16_t* ub = P + (size_t)base * INW + C_PU + c0;
        float S[8];
#pragma unroll
        for (int e = 0; e < 8; ++e) S[e] = 0.f;
#pragma unroll
        for (int i = 0; i < 16; ++i) { const int pp = p0 - hw + i; const bool ok = i < 2 * hw && pp >= 0 && pp < L;
            const u32x4 w = *(const u32x4*)(ub + (size_t)(ok ? pp : p0) * INW); float f[8]; unpack8(w, f); const float mk = ok ? 1.f : 0.f;
#pragma unroll
            for (int e = 0; e < 8; ++e) S[e] += mk * f[e]; }
#pragma unroll 4
        for (int k = 0; k < 16; ++k) { const int p = p0 + k, pn = p + hw, po = p - hw; const bool okn = pn < L, oko = po >= 0;
            const u32x4 ws_ = *(const u32x4*)(ub + (size_t)p * INW), wn = *(const u32x4*)(ub + (size_t)(okn ? pn : p) * INW), wo = *(const u32x4*)(ub + (size_t)(oko ? po : p) * INW);
            float fs[8], fn[8], fo[8]; unpack8(ws_, fs); unpack8(wn, fn); unpack8(wo, fo);
            const int lo = po < 0 ? 0 : po, hi = pn > L ? L : pn; const float ic = 1.f / (float)(hi - lo);
            float a[8];
#pragma unroll
            for (int e = 0; e < 8; ++e) a[e] = (DBG & 16) ? 0.f : S[e] * ic - fs[e];
            u32x4 w; w.x = pk2(a[0], a[1]); w.y = pk2(a[2], a[3]); w.z = pk2(a[4], a[5]); w.w = pk2(a[6], a[7]);
            *(u32x4*)(P + (size_t)(r0 + k) * INW + C_X1 + c0) = w;
            const float mn = okn ? 1.f : 0.f, mo = oko ? 1.f : 0.f;
#pragma unroll
            for (int e = 0; e < 8; ++e) S[e] += mn * fn[e] - mo * fo[e]; }
    }
}
__device__ __forceinline__ void p_final(const CArgs& A, const Frame& F, int layer) {
    bf16_t* P = (bf16_t*)(F.ws + WS_PROJ); const bf16_t* ZT = (const bf16_t*)(F.ws + WS_XNR); const bf16_t* CT = ZT + (size_t)512 * MP;
    const float* cw = FIN(9) + (size_t)layer * 3 * 1536; const float* cb = FIN(10) + layer * 1536; const float* skip = FIN(17) + layer * 512;
    LAS bf16_t* sz = (LAS bf16_t*)(F.lds + F.wave * 16384); LAS bf16_t* sc = sz + 64 * 64;
    const int gw = F.vcu * NWAVES + F.wave, NGW = F.G * NWAVES, lane = F.lane, rs = lane >> 3, ck = lane & 7;
    for (int it = gw; it < (MP / 64) * 8; it += NGW) {
        const int rt = it >> 3, cc = it & 7, c0 = cc * 64 + ck * 8; const int cls = rt * 64 < ROWS_P ? 0 : 1;
        const float* sums = (const float*)(F.ws + WS_CTL) + CW_SUMS + (layer * 2 + cls) * 512;
#pragma unroll
        for (int j = 0; j < 8; ++j) { const int chn = (lane >> 3) + 8 * j, pc = lane & 7; const size_t off = (size_t)(cc * 64 + chn) * MP + rt * 64 + pc * 8;
            *(LAS u32x4*)(sz + chn * 64 + pc * 8) = *(const u32x4*)(ZT + off); *(LAS u32x4*)(sc + chn * 64 + pc * 8) = *(const u32x4*)(CT + off); }
        LDS_WAIT();
#pragma unroll 4
        for (int i8 = 0; i8 < 8; ++i8) { const int lr = i8 * 8 + rs, r = rt * 64 + lr;
            if (r < MROWS) { float x0[8]; dwconv8(P, r, C_X0 + c0, cw, cb, c0, x0); float o[8];
#pragma unroll
                for (int e = 0; e < 8; ++e) { const float z = __uint_as_float((unsigned)sz[(ck * 8 + e) * 64 + lr] << 16), cv = __uint_as_float((unsigned)sc[(ck * 8 + e) * 64 + lr] << 16);
                    o[e] = (DBG & 8) ? 0.f : (((DBG & 64) ? 0.f : cv / sums[c0 + e]) + ((DBG & 128) ? 0.f : z * skip[c0 + e])) * x0[e]; }
                u32x4 w; w.x = pk2(o[0], o[1]); w.y = pk2(o[2], o[3]); w.z = pk2(o[4], o[5]); w.w = pk2(o[6], o[7]);
                *(u32x4*)(P + (size_t)r * INW + C_VV + c0) = w; } }
        LDS_WAIT();
    }
}
__device__ __forceinline__ void p_norm2(const CArgs& A, const Frame& F, int layer) {
    const int gw = F.vcu * NWAVES + F.wave, NGW = F.G * NWAVES, lane = F.lane;
    const float* g = FIN(24) + layer * DM; bf16_t* XN = (bf16_t*)(F.ws + WS_XNR);
    for (int r0 = gw; r0 < MP; r0 += 2 * NGW) { f32x4 v[2][4]; const int r1 = r0 + NGW;
        { const f32x4* xr = (const f32x4*)xrow(F.out, F.xm, r0) + lane;
#pragma unroll
          for (int j = 0; j < 4; ++j) v[0][j] = xr[64 * j]; }
        if (r1 < MP) { const f32x4* xr = (const f32x4*)xrow(F.out, F.xm, r1) + lane;
#pragma unroll
          for (int j = 0; j < 4; ++j) v[1][j] = xr[64 * j]; }
        rms_row(v[0], g, XN + (size_t)r0 * DM, lane);
        if (r1 < MP) rms_row(v[1], g, XN + (size_t)r1 * DM, lane); }
}

constexpr int TAIL_ROW0 = 32768, TAIL_ITEMS = ((MROWS - TAIL_ROW0) / 16) * 16;
static_assert(MROWS - TAIL_ROW0 == 144 && TAIL_ROW0 % 256 == 0, "tail rows");
template <int NS>
__device__ __forceinline__ void tail_partial(f32x4 (&acc)[4], const bf16_t* ap, const bf16_t* bp, size_t bstride16) {
#pragma unroll
    for (int s0 = 0; s0 < NS; s0 += 4) {
        bf16x8 a[4], b[4][4];
#pragma unroll
        for (int s = 0; s < 4; ++s) if (s0 + s < NS) { a[s] = *(const bf16x8*)(ap + (s0 + s) * 32);
#pragma unroll
            for (int j = 0; j < 4; ++j) b[s][j] = *(const bf16x8*)(bp + j * bstride16 + (s0 + s) * 32); }
#pragma unroll
        for (int s = 0; s < 4; ++s) if (s0 + s < NS) {
#pragma unroll
            for (int j = 0; j < 4; ++j) acc[j] = __builtin_amdgcn_mfma_f32_16x16x32_bf16(b[s][j], a[s], acc[j], 0, 0, 0); }
        asm volatile("" ::: "memory");
    }
}
template <int K>
__device__ __forceinline__ void tail_res(const Frame& F, const bf16_t* A, const bf16_t* Bt) {
    constexpr int KW = K / 8, NS = KW / 32; static_assert(K % 256 == 0, "K split");
    const int lane = F.lane, fr = lane & 15, fq = lane >> 4, tid = F.tid;
    for (int item = F.bx; item < TAIL_ITEMS; item += F.G) {
        const int row0 = TAIL_ROW0 + (item >> 4) * 16, col0 = (item & 15) * 64;
        f32x4 acc[4];
#pragma unroll
        for (int j = 0; j < 4; ++j) acc[j] = (f32x4){0.f, 0.f, 0.f, 0.f};
        tail_partial<NS>(acc, A + (size_t)(row0 + fr) * K + F.wave * KW + fq * 8, Bt + (size_t)(col0 + fr) * K + F.wave * KW + fq * 8, (size_t)16 * K);
#pragma unroll
        for (int j = 0; j < 4; ++j) *(LAS f32x4*)(F.lds + F.wave * 4096 + j * 1024 + lane * 16) = acc[j];
        __syncthreads();
        f32x2 s = {0.f, 0.f};
#pragma unroll
        for (int w = 0; w < 8; ++w) s += *(const LAS f32x2*)(F.lds + w * 4096 + tid * 8);
        const int j = tid >> 7, l = (tid & 127) >> 1, r = (tid & 1) * 2;
        float* p = xrow(F.out, F.xm, row0 + (l & 15)) + col0 + j * 16 + 4 * (l >> 4) + r;
        f32x2 v = *(f32x2*)p; v += s; if (!F.dry) *(f32x2*)p = v;
        __syncthreads();
    }
}
__device__ __forceinline__ void tail_merge(const Frame& F, const bf16_t* P, const bf16_t* WM, bf16_t* O) {
    const int lane = F.lane, fr = lane & 15, fq = lane >> 4, tid = F.tid;
    for (int item = F.bx; item < TAIL_ITEMS; item += F.G) {
        const int row0 = TAIL_ROW0 + (item >> 4) * 16, col0 = (item & 15) * 64;
#pragma unroll
        for (int s = 0; s < 3; ++s) { const int col = s == 0 ? C_Q : (s == 1 ? C_VV : C_X1);
            f32x4 acc[4];
#pragma unroll
            for (int j = 0; j < 4; ++j) acc[j] = (f32x4){0.f, 0.f, 0.f, 0.f};
            tail_partial<2>(acc, P + (size_t)(row0 + fr) * INW + col + F.wave * 64 + fq * 8, WM + ((size_t)s * DM + col0 + fr) * 512 + F.wave * 64 + fq * 8, (size_t)16 * 512);
#pragma unroll
            for (int j = 0; j < 4; ++j) *(LAS f32x4*)(F.lds + s * 32768 + F.wave * 4096 + j * 1024 + lane * 16) = acc[j]; }
        __syncthreads();
        const int j = tid >> 7, l = (tid & 127) >> 1, r = (tid & 1) * 2, row = row0 + (l & 15), colo = col0 + j * 16 + 4 * (l >> 4) + r;
        const unsigned char* gp = (const unsigned char*)(P + (size_t)row * INW) + C_G * 2 + colo;
        f32x2 o = {0.f, 0.f};
#pragma unroll
        for (int s = 0; s < 3; ++s) { f32x2 t = {0.f, 0.f};
#pragma unroll
            for (int w = 0; w < 8; ++w) t += *(const LAS f32x2*)(F.lds + s * 32768 + w * 4096 + tid * 8);
            const unsigned g2 = *(const unsigned short*)(gp + s * DM);
            o.x += t.x * ((float)(g2 & 255u) * (1.f / 255.f)); o.y += t.y * ((float)(g2 >> 8) * (1.f / 255.f)); }
        *(unsigned*)(O + (size_t)row * DM + colo) = pg8::cvt_pk_bf16(o.x, o.y);
        __syncthreads();
    }
}

constexpr int PH_PER_LAYER = 11, N_PHASES = 2 * PH_PER_LAYER;
__global__ void __launch_bounds__(NWAVES * 64, 2) fwd_kernel(Args args0) {
    extern __shared__ __attribute__((aligned(16))) unsigned char lds_raw[];
    const int wave0 = __builtin_amdgcn_readfirstlane(threadIdx.x >> 6);
    {
        for (int u = threadIdx.x; u < (LDS_BYTES - LDSCTL_OFF) / 4; u += NWAVES * 64) ((LAS unsigned*)((LAS unsigned char*)lds_raw + LDSCTL_OFF))[u] = 0u;
        __syncthreads();
    }
    XcdBarrier bar; bar.bar = (unsigned*)(args0.ws + WS_CTL) + CW_BAR; bar.x = 0; bar.st = nullptr;
    if (args0.use_bar) bar = xcd_barrier_post((unsigned*)(args0.ws + WS_CTL) + CW_BAR, (volatile LAS unsigned*)((LAS unsigned char*)lds_raw + MISC_OFF) + 8);
    for (int ph2 = 2 * args0.ph_lo; ph2 < 2 * args0.ph_hi; ++ph2) {
        const int ph = ph2 >> 1, rep = ph2 & 1;
        const int layer = ph / PH_PER_LAYER, k = ph % PH_PER_LAYER;
        if (rep == 1 && !(DUP_PHASE >= 0 && k == DUP_PHASE && args0.pad == 0)) continue;
        const __attribute__((address_space(4))) Args* ap = (const __attribute__((address_space(4))) Args*)__builtin_amdgcn_kernarg_segment_ptr();
        asm volatile("" : "+s"(ap));
        const __attribute__((address_space(4))) Args& args = *ap;
        Frame F;
        { int w_ = wave0; asm volatile("" : "+s"(w_)); int z_ = 0; asm volatile("" : "+v"(z_)); const int l_ = __builtin_amdgcn_mbcnt_hi(-1, __builtin_amdgcn_mbcnt_lo(-1, z_));
          F.lane = l_; F.wave = w_; F.tid = w_ * 64 + l_;
          int bx = blockIdx.x, G_ = gridDim.x; asm volatile("" : "+s"(bx), "+s"(G_)); F.G = G_; F.vcu = (G_ % 8 == 0) ? (bx % 8) * (G_ / 8) + bx / 8 : bx; F.bx = bx;
          F.dry = rep; F.lds = (LAS unsigned char*)lds_raw; F.ws = args.ws; F.out = args.out; F.xm = (float*)(args.ws + WS_XM); }
        unsigned char* W = F.ws + WS_W;
        bf16_t* XNR = (bf16_t*)(F.ws + WS_XNR); bf16_t* PROJ = (bf16_t*)(F.ws + WS_PROJ);
        bf16_t* GB = PROJ; bf16_t* ACT = PROJ + (size_t)MP * DFF;
#ifndef ONLY_PHASE
#define ONLY_PHASE -1
#endif
#define PHS(x) ((ONLY_PHASE < 0 || ONLY_PHASE == (x)) && k == (x) && !((DBG & 1) && (x) >= 1 && (x) <= 6) && !((DBG & 2) && (x) >= 7) && !((DBG & 32) && layer > 0))
        if (PHS(0)) p_prep(args, F, layer);
        else if (PHS(1)) { OpsPlain O{XNR, (const bf16_t*)(W + W_IN), DM, DM}; pg8::StaticOrder S; S.init(MP, INW, F.G, F.bx, 1); EpiStore E{PROJ, INW, C_G / 256};
            pg8::gemm_phase<EpiStore, OpsPlain, true>(F.lds, O, S, E, F.tid); }
        else if (PHS(2)) { if (DBG & 512) p_attn_ref(args, F, layer); else p_attn(args, F, layer); p_h1(args, F, layer); p_filt_tiles(args, F, layer); }
        else if (PHS(3)) { if (DBG & 256) p_h2_ref(args, F); else if (DSEL(16)) p_h2(F); if (DSEL(32)) p_pool(args, F); }
        else if (PHS(4)) p_final(args, F, layer);
        else if (PHS(5)) { OpsMerge O{PROJ, (const bf16_t*)(W + W_MRG), 512, INW}; pg8::StaticOrder S; S.init(TAIL_ROW0, DM, F.G, F.bx, 3); EpiMerge E{PROJ, XNR};
            pg8::gemm_phase<EpiMerge, OpsMerge, true>(F.lds, O, S, E, F.tid); tail_merge(F, PROJ, (const bf16_t*)(W + W_MRG), XNR); }
        else if (PHS(6)) { OpsPlain O{XNR, (const bf16_t*)(W + W_OUT), DM, DM}; pg8::StaticOrder S; S.init(TAIL_ROW0, DM, F.G, F.bx, 1); EpiRes E{F.out, F.xm, F.dry};
            pg8::gemm_phase<EpiRes, OpsPlain, true>(F.lds, O, S, E, F.tid); tail_res<DM>(F, XNR, (const bf16_t*)(W + W_OUT)); }
        else if (PHS(7)) p_norm2(args, F, layer);
        else if (PHS(8)) { OpsPlain O{XNR, (const bf16_t*)(W + W_G), DM, DM}; pg8::StaticOrder S; S.init(MP, DFF, F.G, F.bx, 1); EpiStore E{GB, DFF, 1 << 20};
            pg8::gemm_phase<EpiStore, OpsPlain, true>(F.lds, O, S, E, F.tid); }
        else if (PHS(9)) { OpsPlain O{XNR, (const bf16_t*)(W + W_U), DM, DM}; pg8::StaticOrder S; S.init(MP, DFF, F.G, F.bx, 1);
            EpiGeluMul E{GB, args.in[27] + (size_t)layer * 3 * DFF, args.in[28] + layer * DFF, ACT, F.dry ? DRYVAR : 0};
            pg8::gemm_phase<EpiGeluMul, OpsPlain, true>(F.lds, O, S, E, F.tid); }
        else if (PHS(10)) { OpsPlain O{ACT, (const bf16_t*)(W + W_D), DFF, DFF}; pg8::StaticOrder S; S.init(TAIL_ROW0, DM, F.G, F.bx, 1); EpiRes E{F.out, F.xm, F.dry};
            pg8::gemm_phase<EpiRes, OpsPlain, true>(F.lds, O, S, E, F.tid); tail_res<DFF>(F, ACT, (const bf16_t*)(W + W_D)); }
        if (ph2 + 1 < 2 * args0.ph_hi) { { int z2_ = 0; asm volatile("" : "+v"(z2_)); const int tid2 = wave0 * 64 + __builtin_amdgcn_mbcnt_hi(-1, __builtin_amdgcn_mbcnt_lo(-1, z2_));
              if (args0.use_bar) xcd_barrier(bar, tid2); else __syncthreads(); } }
    }
}

__global__ void fill_k(float* o, size_t n, float v) { size_t i = (size_t)blockIdx.x * blockDim.x + threadIdx.x; for (; i < n; i += (size_t)gridDim.x * blockDim.x) o[i] = v; }
extern "C" void kernel_launch(void* const* d_in, const int* in_sizes, int n_in, void* d_out, int out_size, void* d_ws, size_t ws_size, hipStream_t stream) {
    static int grid = 0;
    if (grid == 0) {
        int dev = 0, cus = 0;
        if (n_in != 30 || out_size != 32768 * DM || ws_size < WS_END || hipGetDevice(&dev) != hipSuccess || hipDeviceGetAttribute(&cus, hipDeviceAttributeMultiprocessorCount, dev) != hipSuccess ||
            hipFuncSetAttribute((const void*)fwd_kernel, hipFuncAttributeMaxDynamicSharedMemorySize, LDS_BYTES) != hipSuccess) { fprintf(stderr, "kernel_launch: bad shapes / workspace / device\n"); grid = -1; }
        else { int per_cu = 0; (void)hipOccupancyMaxActiveBlocksPerMultiprocessor(&per_cu, (const void*)fwd_kernel, NWAVES * 64, LDS_BYTES); (void)hipGetLastError();
            grid = cus * (per_cu >= 1 ? 1 : 0); if (grid <= 0) grid = -1; }
    }
    if (grid < 0) { fill_k<<<1024, 256, 0, stream>>>((float*)d_out, (size_t)out_size, 1e6f); return; }
    (void)hipMemsetAsync((char*)d_ws + WS_CTL, 0, CTL_ZERO_BYTES, stream);
    Args a{};
    for (int i = 0; i < 30; ++i) a.in[i] = (const float*)d_in[i];
    a.out = (float*)d_out; a.ws = (unsigned char*)d_ws;
#if MK_N_LAUNCHES == 1
    a.ph_lo = 0; a.ph_hi = N_PHASES; a.use_bar = 1;
    void* kargs[] = {&a};
    hipError_t e = hipLaunchCooperativeKernel((const void*)fwd_kernel, dim3(grid), dim3(NWAVES * 64), kargs, LDS_BYTES, stream);
    if (e != hipSuccess) fprintf(stderr, "cooperative launch failed: %s\n", hipGetErrorString(e));
#else
    for (int ph = 0; ph < N_PHASES; ++ph) { a.ph_lo = ph; a.ph_hi = ph + 1; a.use_bar = 0;
        hipLaunchKernelGGL(fwd_kernel, dim3(grid), dim3(NWAVES * 64), LDS_BYTES, stream, a); }
#endif
}
```

```cpp
#include <hip/hip_runtime.h>
#include <cstdio>
#include <cstdint>
#include <cmath>

#ifndef DBG
#define DBG 0
#endif
#ifndef DUP_PHASE
#define DUP_PHASE -1
#endif
#ifndef FT_RECOMPUTE
#define FT_RECOMPUTE 0
#endif
#ifndef DRYVAR
#define DRYVAR 0
#endif
#ifndef DUPMASK
#define DUPMASK 255
#endif
#define DSEL(b) (!F.dry || (DUPMASK & (b)))
#ifndef MK_N_LAUNCHES
#define MK_N_LAUNCHES 1
#endif

#define LAS __attribute__((address_space(3)))
#define GAS __attribute__((address_space(1)))
typedef unsigned short bf16_t;
typedef short bf16x8 __attribute__((ext_vector_type(8)));
typedef float f32x4 __attribute__((ext_vector_type(4)));
typedef float f32x2 __attribute__((ext_vector_type(2)));
typedef float f32x16 __attribute__((ext_vector_type(16)));
typedef unsigned u32x4 __attribute__((ext_vector_type(4)));
typedef unsigned u32x2 __attribute__((ext_vector_type(2)));

constexpr int DM = 1024, INW = 5888, DFF = 2816, NHEAD = 8, HD = 64;
constexpr int LP = 2064, LS = 16400, NMETA = 16;
constexpr int ROWS_P = 8 * LP;
constexpr int MROWS = ROWS_P + LS;
constexpr int MP = 33024;
constexpr int C_Q = 0, C_K = 512, C_V = 640, C_X0 = 768, C_X1 = 1280, C_VV = 1792, C_PU = 2304, C_G = 2816;
constexpr float EPS = 1e-6f;
constexpr int RK_PAD = 256;
constexpr int RKLEN_P = 2 * LP + 512, RKLEN_S = 2 * LS + 512;

constexpr size_t MiB = 1u << 20;
constexpr size_t WS_CTL = 0, CTL_ZERO_BYTES = 1 * MiB;
constexpr size_t WS_XM = 1 * MiB;
constexpr size_t WS_W = 3 * MiB;
constexpr size_t W_IN = 0, W_G = W_IN + (size_t)INW * DM * 2, W_U = W_G + (size_t)DFF * DM * 2, W_D = W_U + (size_t)DFF * DM * 2,
                 W_OUT = W_D + (size_t)DM * DFF * 2, W_MRG = W_OUT + (size_t)DM * DM * 2, W_END = W_MRG + (size_t)3 * DM * 512 * 2;
static_assert(WS_W + W_END <= 36 * MiB, "weights");
constexpr size_t WS_RKP = 36 * MiB;
constexpr size_t WS_RKS = WS_RKP + (size_t)512 * RKLEN_P * 2;
static_assert(WS_RKS + (size_t)512 * RKLEN_S * 2 <= 74 * MiB, "filters");
constexpr size_t WS_XNR = 74 * MiB;
constexpr size_t XNR_BYTES = (size_t)MP * DM * 2;
constexpr size_t WS_PROJ = 139 * MiB;
constexpr size_t WS_END = WS_PROJ + (size_t)MP * INW * 2;
static_assert(WS_XNR + XNR_BYTES <= WS_PROJ && WS_END <= 512 * MiB, "d_ws map");
constexpr int CW_BAR = 4096;
constexpr int CW_SUMS = 16384;

namespace pg8 {
constexpr int BM = 256, BK = 64, HALF = 128, HTB = HALF * BK * 2, STAGE_BYTES = 8 * HTB, NXCD = 8, WGM = 8;
__host__ __device__ __forceinline__ int lds_byte(int r, int c) { const int st = (r >> 4) * 2 + (c >> 5), rr = r & 15, cc = c & 31, ob = rr * 64 + cc * 2; return st * 1024 + (ob ^ (((ob >> 9) & 1) << 5)); }
__host__ __device__ __forceinline__ void stage_rc(int b, int& R, int& C) { const int st = b / 1024, sb = b % 1024, swz = sb ^ (((sb >> 9) & 1) << 5); R = (st >> 1) * 16 + swz / 64; C = (st & 1) * 32 + (swz % 64) / 2; }
__host__ __device__ __forceinline__ int perm32(int rho) { const int n = rho >> 4, i = rho & 15; return 8 * (i >> 2) + 4 * n + (i & 3); }

struct Unit { int pm, pn, sub; };
struct StaticOrder {
    int nM, nN, nwg, G, c, nsub;
    __device__ void init(int M, int N, int G_, int c_, int nsub_) { nM = M / BM; nN = N / BM; nwg = nM * nN; G = G_; c = c_; nsub = nsub_; }
    __device__ bool next(int i, Unit& u) const {
        const int tile = i / nsub; u.sub = i - tile * nsub;
        const long L = (long)tile * G + c; if (L >= nwg) return false;
        int wgid = (int)L; { const int q = nwg / NXCD, r = nwg % NXCD, xcd = wgid % NXCD, off = wgid / NXCD; wgid = (xcd < r ? xcd * (q + 1) : r * (q + 1) + (xcd - r) * q) + off; }
        const int nig = WGM * nN, gid = wgid / nig, fm = gid * WGM, gsz = (nM - fm) < WGM ? (nM - fm) : WGM;
        u.pm = fm + ((wgid % nig) % gsz); u.pn = (wgid % nig) / gsz; return true;
    }
};
__device__ __forceinline__ unsigned cvt_pk_bf16(float lo, float hi) { unsigned r; asm volatile("v_cvt_pk_bf16_f32 %0, %1, %2" : "=v"(r) : "v"(lo), "v"(hi)); return r; }
__device__ __forceinline__ f32x2 gelu_pk(f32x2 v) {
    const f32x2 av = __builtin_elementwise_abs(v), d = av * 0.2316418882f + 1.0f;
    f32x2 t; t.x = __builtin_amdgcn_rcpf(d.x); t.y = __builtin_amdgcn_rcpf(d.y);
    f32x2 q = t * 0.5307027145f + (-0.7265760135f); q = q * t + 0.7107068705f; q = q * t + (-0.142248368f); q = q * t + 0.127414796f; q = q * t;
    const f32x2 s = (v * v) * (-0.72134752044f);
    f32x2 e; e.x = __builtin_amdgcn_exp2f(s.x); e.y = __builtin_amdgcn_exp2f(s.y);
    const f32x2 m = v * (q * e), r = v - m;
    f32x2 o; o.x = v.x < 0.f ? m.x : r.x; o.y = v.y < 0.f ? m.y : r.y; return o;
}

template <class Epi, class Ops, bool ALIGN_EPI>
__device__ __forceinline__ void gemm_phase(LAS unsigned char* lds, const Ops& O, const StaticOrder& S, const Epi& E, int tid) {
    const int wid = __builtin_amdgcn_readfirstlane(tid >> 6), lane = tid & 63, wr = wid >> 2, wc = wid & 3, fr = lane & 15, fq = lane >> 4;
    const int K = O.K, nt = K / BK, lda = O.lda;
    unsigned voffA[2], voffB[2];
#pragma unroll
    for (int i = 0; i < 2; ++i) { int R, C; stage_rc(tid * 16 + i * 8192, R, C); const int Rb = (R & ~31) + perm32(R & 31);
        voffA[i] = (unsigned)(R * lda + C) * 2u; voffB[i] = (unsigned)(Rb * K + C) * 2u; }
    const size_t kstep = (size_t)(BK * 2);
    const size_t hstepA = (size_t)HALF * lda * 2, hstepB = (size_t)HALF * K * 2;
    const unsigned ldsw = (unsigned)wid * 1024u;
    const int aoff = lds_byte(wr * 64 + fr, fq * 8), boff = lds_byte(wc * 32 + fr, fq * 8);
#define PG8_SA(b, h) (((b) * 2 + (h)) * HTB)
#define PG8_SB(b, h) ((4 + (b) * 2 + (h)) * HTB)
#define PG8_STAGE(bufoff, gbase, voff) do { _Pragma("unroll") for (int _i = 0; _i < 2; ++_i) \
        __builtin_amdgcn_global_load_lds((const unsigned*)((const char*)(gbase) + (voff)[_i]), (LAS unsigned*)(lds + (bufoff) + ldsw + _i * 8192), 16, 0, 0); } while (0)
#define PG8_LDA(dst, b, h) do { _Pragma("unroll") for (int m = 0; m < 4; ++m) _Pragma("unroll") for (int k = 0; k < 2; ++k) dst[m][k] = *(const LAS bf16x8*)(lds + PG8_SA(b, h) + aoff + m * 2048 + k * 1024); } while (0)
#define PG8_LDB(dst, b, h) do { _Pragma("unroll") for (int n = 0; n < 2; ++n) _Pragma("unroll") for (int k = 0; k < 2; ++k) dst[n][k] = *(const LAS bf16x8*)(lds + PG8_SB(b, h) + boff + n * 2048 + k * 1024); } while (0)
#define PG8_MMA(ai, bj, At, Bt) do { __builtin_amdgcn_s_setprio(1); _Pragma("unroll") for (int m = 0; m < 4; ++m) _Pragma("unroll") for (int n = 0; n < 2; ++n) _Pragma("unroll") for (int k = 0; k < 2; ++k) \
        acc[ai][bj][m][n] = __builtin_amdgcn_mfma_f32_16x16x32_bf16(Bt[n][k], At[m][k], acc[ai][bj][m][n], 0, 0, 0); __builtin_amdgcn_s_setprio(0); } while (0)
#define PG8_WAIT_V(n) asm volatile("s_waitcnt vmcnt(" #n ")" ::: "memory")
#define PG8_WAIT_L(n) asm volatile("s_waitcnt lgkmcnt(" #n ")" ::: "memory")
#define PG8_BAR __builtin_amdgcn_s_barrier()
#define PG8_SCHED __builtin_amdgcn_sched_barrier(0)
    Unit cur, nxt; int ui = 0;
    if (!S.next(0, cur)) return;
    f32x4 acc[2][2][4][2];
#pragma unroll
    for (int a = 0; a < 2; ++a)
#pragma unroll
        for (int b = 0; b < 2; ++b)
#pragma unroll
            for (int m = 0; m < 4; ++m)
#pragma unroll
                for (int n = 0; n < 2; ++n) acc[a][b][m][n] = (f32x4){0.f, 0.f, 0.f, 0.f};
    bf16x8 At[4][2], B0[2][2], B1[2][2];
    const char* cA; const char* cB; O.ptrs(cur, cA, cB);
    PG8_STAGE(PG8_SB(0, 0), cB, voffB); PG8_STAGE(PG8_SB(0, 1), cB + hstepB, voffB); PG8_STAGE(PG8_SA(0, 0), cA, voffA); PG8_STAGE(PG8_SA(0, 1), cA + hstepA, voffA);
    if (wr == 1) PG8_BAR;
    PG8_WAIT_V(2); PG8_BAR;
    PG8_STAGE(PG8_SB(1, 0), cB + kstep, voffB); PG8_STAGE(PG8_SA(1, 0), cA + kstep, voffA); PG8_STAGE(PG8_SB(1, 1), cB + hstepB + kstep, voffB);
    PG8_WAIT_V(6); PG8_BAR;
    for (;;) {
        const bool has_next = S.next(ui + 1, nxt);
        const char* nA = cA; const char* nB = cB; if (has_next) O.ptrs(nxt, nA, nB);
        for (int t = 0; t < nt; t += 2) {
            const bool last = (t == nt - 2);
            const char* a1 = cA + (size_t)(t + 1) * kstep;
            const char* a2 = last ? nA : cA + (size_t)(t + 2) * kstep; const char* b2 = last ? nB : cB + (size_t)(t + 2) * kstep;
            const char* a3 = a2 + kstep; const char* b3 = b2 + kstep;
            PG8_LDB(B0, 0, 0); PG8_LDB(B1, 0, 1); PG8_SCHED; PG8_LDA(At, 0, 0); PG8_STAGE(PG8_SA(1, 1), a1 + hstepA, voffA);
            PG8_WAIT_V(8); PG8_WAIT_L(0); PG8_BAR; PG8_MMA(0, 0, At, B0); PG8_MMA(0, 1, At, B1); PG8_BAR; PG8_SCHED;
            PG8_LDA(At, 0, 1); PG8_STAGE(PG8_SB(0, 0), b2, voffB); PG8_STAGE(PG8_SB(0, 1), b2 + hstepB, voffB); PG8_STAGE(PG8_SA(0, 0), a2, voffA);
            PG8_WAIT_V(8); PG8_WAIT_L(0); PG8_BAR; PG8_MMA(1, 0, At, B0); PG8_MMA(1, 1, At, B1); PG8_BAR; PG8_SCHED;
            PG8_LDB(B0, 1, 0); PG8_LDB(B1, 1, 1); PG8_SCHED; PG8_LDA(At, 1, 0); PG8_STAGE(PG8_SA(0, 1), a2 + hstepA, voffA);
            PG8_WAIT_V(8); PG8_WAIT_L(0); PG8_BAR; PG8_MMA(0, 0, At, B0); PG8_MMA(0, 1, At, B1); PG8_BAR; PG8_SCHED;
            PG8_LDA(At, 1, 1); PG8_STAGE(PG8_SB(1, 0), b3, voffB); PG8_STAGE(PG8_SB(1, 1), b3 + hstepB, voffB); PG8_STAGE(PG8_SA(1, 0), a3, voffA);
            PG8_WAIT_V(8); PG8_WAIT_L(0); PG8_BAR; PG8_MMA(1, 0, At, B0); PG8_MMA(1, 1, At, B1); PG8_BAR; PG8_SCHED;
        }
        if constexpr (ALIGN_EPI) { if (wr == 0) PG8_BAR; }
        { int z_ = 0; asm volatile("" : "+v"(z_)); const int l2 = __builtin_amdgcn_mbcnt_hi(-1, __builtin_amdgcn_mbcnt_lo(-1, z_));
          E(acc, cur, wr, wc, l2 & 15, l2 >> 4); }
        if (!E.keep(cur)) {
#pragma unroll
            for (int a = 0; a < 2; ++a)
#pragma unroll
                for (int b = 0; b < 2; ++b)
#pragma unroll
                    for (int m = 0; m < 4; ++m)
#pragma unroll
                        for (int n = 0; n < 2; ++n) acc[a][b][m][n] = (f32x4){0.f, 0.f, 0.f, 0.f};
        }
        if (!has_next) break;
        cur = nxt; cA = nA; cB = nB; ++ui;
        if constexpr (ALIGN_EPI) { if (wr == 1) PG8_BAR; }
    }
    PG8_WAIT_V(0);
    if constexpr (!ALIGN_EPI) { if (wr == 0) PG8_BAR; }
    PG8_BAR;
#undef PG8_SA
#undef PG8_SB
#undef PG8_STAGE
#undef PG8_LDA
#undef PG8_LDB
#undef PG8_MMA
#undef PG8_WAIT_V
#undef PG8_WAIT_L
#undef PG8_BAR
#undef PG8_SCHED
}
}

constexpr int RING_BYTES_C = 131072, LDSCTL_OFF_C = 131072;
__device__ __forceinline__ int seq_of_row(int r) { return r < ROWS_P ? r / LP : 8; }
__device__ __forceinline__ int seq_base(int s) { return s < 8 ? s * LP : ROWS_P; }
__device__ __forceinline__ int seq_len(int s) { return s < 8 ? LP : LS; }
__device__ __forceinline__ float* xrow(float* xreal, float* xm, int r) {
    if (r >= MROWS) return xm + (size_t)(144 + r - MROWS) * DM;
    const int s = seq_of_row(r), p = r - seq_base(s);
    if (p < NMETA) return xm + (size_t)(s * 16 + p) * DM;
    return xreal + (size_t)(r - 16 * (s + 1)) * DM;
}
__device__ __forceinline__ float bflo(unsigned u) { return __uint_as_float(u << 16); }
__device__ __forceinline__ float bfhi(unsigned u) { return __uint_as_float(u & 0xffff0000u); }
__device__ __forceinline__ unsigned f2bf(float f) { unsigned u = __builtin_bit_cast(unsigned, f); return (u + 0x7fffu + ((u >> 16) & 1u)) >> 16; }
__device__ __forceinline__ unsigned pk2(float lo, float hi) { return f2bf(lo) | (f2bf(hi) << 16); }
__device__ __forceinline__ void unpack8(const u32x4 w, float* f) { f[0] = bflo(w.x); f[1] = bfhi(w.x); f[2] = bflo(w.y); f[3] = bfhi(w.y); f[4] = bflo(w.z); f[5] = bfhi(w.z); f[6] = bflo(w.w); f[7] = bfhi(w.w); }
__device__ __forceinline__ float shx(float v, int o, int lane) { return __int_as_float(__builtin_amdgcn_ds_bpermute((lane ^ o) << 2, __float_as_int(v))); }
__device__ __forceinline__ float wave_sum(float v, int lane) {
#pragma unroll
    for (int o = 1; o < 64; o <<= 1) v += shx(v, o, lane);
    return v;
}
#define LDS_WAIT() asm volatile("s_waitcnt lgkmcnt(0)" ::: "memory")

struct OpsPlain {
    const bf16_t* A; const bf16_t* Bt; int K, lda;
    __device__ __forceinline__ void ptrs(const pg8::Unit& u, const char*& a, const char*& b) const {
        a = (const char*)A + (size_t)u.pm * 256 * lda * 2; b = (const char*)Bt + (size_t)u.pn * 256 * K * 2; }
};
struct OpsMerge {
    const bf16_t* P; const bf16_t* WM; int K, lda;
    __device__ __forceinline__ void ptrs(const pg8::Unit& u, const char*& a, const char*& b) const {
        const int col = u.sub == 0 ? C_Q : (u.sub == 1 ? C_VV : C_X1);
        a = (const char*)P + ((size_t)u.pm * 256 * lda + col) * 2; b = (const char*)WM + ((size_t)u.sub * DM + (size_t)u.pn * 256) * 512 * 2; }
};
typedef f32x4 acc_t[2][2][4][2];
struct EpiStore {
    bf16_t* O; int ldc; int sig_pn;
    __device__ __forceinline__ bool keep(const pg8::Unit&) const { return false; }
    __device__ __forceinline__ void operator()(acc_t& acc, const pg8::Unit& u, int wr, int wc, int fr, int fq) const {
        const int row0 = u.pm * 256 + wr * 64 + fr, col0 = u.pn * 256 + wc * 32 + 8 * fq; const bool sig = u.pn >= sig_pn;
#pragma unroll
        for (int ai = 0; ai < 2; ++ai)
#pragma unroll
            for (int m = 0; m < 4; ++m) { bf16_t* rowp = O + (size_t)(row0 + ai * 128 + m * 16) * ldc + col0;
#pragma unroll
                for (int bj = 0; bj < 2; ++bj) { f32x4 v0 = acc[ai][bj][m][0], v1 = acc[ai][bj][m][1];
                    if (sig) { unsigned q[8];
#pragma unroll
                        for (int e = 0; e < 4; ++e) { q[e] = (unsigned)fminf(fmaxf(__builtin_rintf(255.f * __builtin_amdgcn_rcpf(1.f + __expf(-v0[e]))), 1.f), 255.f);
                                                      q[4 + e] = (unsigned)fminf(fmaxf(__builtin_rintf(255.f * __builtin_amdgcn_rcpf(1.f + __expf(-v1[e]))), 1.f), 255.f); }
                        u32x2 w8; w8.x = q[0] | (q[1] << 8) | (q[2] << 16) | (q[3] << 24); w8.y = q[4] | (q[5] << 8) | (q[6] << 16) | (q[7] << 24);
                        *(u32x2*)((unsigned char*)(O + (size_t)(row0 + ai * 128 + m * 16) * ldc) + C_G * 2 + (col0 + bj * 128 - C_G)) = w8; continue; }
                    u32x4 w; w.x = pg8::cvt_pk_bf16(v0[0], v0[1]); w.y = pg8::cvt_pk_bf16(v0[2], v0[3]); w.z = pg8::cvt_pk_bf16(v1[0], v1[1]); w.w = pg8::cvt_pk_bf16(v1[2], v1[3]);
                    *(u32x4*)(rowp + bj * 128) = w; } }
    }
};
struct EpiRes {
    float* xreal; float* xm; int dry;
    __device__ __forceinline__ bool keep(const pg8::Unit&) const { return false; }
    __device__ __forceinline__ void operator()(acc_t& acc, const pg8::Unit& u, int wr, int wc, int fr, int fq) const {
        const int row0 = u.pm * 256 + wr * 64 + fr, col0 = u.pn * 256 + wc * 32 + 8 * fq;
#pragma unroll
        for (int ai = 0; ai < 2; ++ai)
#pragma unroll
            for (int m = 0; m < 4; ++m) { float* p = xrow(xreal, xm, row0 + ai * 128 + m * 16) + col0;
#pragma unroll
                for (int bj = 0; bj < 2; ++bj) { f32x4 a = *(f32x4*)(p + bj * 128), b = *(f32x4*)(p + bj * 128 + 4);
                    a += acc[ai][bj][m][0]; b += acc[ai][bj][m][1]; if (!dry) { *(f32x4*)(p + bj * 128) = a; *(f32x4*)(p + bj * 128 + 4) = b; } } }
    }
};
struct EpiGeluMul {
    const bf16_t* G; const float* cw; const float* cb; bf16_t* O; int dv;
    __device__ __forceinline__ bool keep(const pg8::Unit&) const { return false; }
    __device__ __forceinline__ void operator()(acc_t& acc, const pg8::Unit& u, int wr, int wc, int fr, int fq) const {
        if (dv == 1) return;
        const int row0 = u.pm * 256 + wr * 64 + fr, col0 = u.pn * 256 + wc * 32 + 8 * fq;
#pragma unroll
        for (int ai = 0; ai < 2; ++ai)
#pragma unroll
            for (int m = 0; m < 4; ++m) { const int r = row0 + ai * 128 + m * 16;
                const int s = seq_of_row(r), p = r - seq_base(s); const bool inb = r < MROWS;
                const bool hasp = inb && p > 0, hasn = inb && p < seq_len(s) - 1;
                const float mp_ = hasp ? 1.f : 0.f, mn_ = hasn ? 1.f : 0.f;
#pragma unroll
                for (int bj = 0; bj < 2; ++bj) { const int col = col0 + bj * 128;
                    const bf16_t* gp = G + (size_t)r * DFF + col;
                    const u32x4 gm = *(const u32x4*)(gp - (hasp ? DFF : 0)), g0 = *(const u32x4*)gp, gn = *(const u32x4*)(gp + (hasn ? DFF : 0));
                    float fm[8], f0[8], fn[8]; unpack8(gm, fm); unpack8(g0, f0); unpack8(gn, fn);
                    float o[8];
#pragma unroll
                    for (int h = 0; h < 2; ++h) { const f32x4 a = *(const f32x4*)(cw + col + 4 * h), b = *(const f32x4*)(cw + DFF + col + 4 * h), c = *(const f32x4*)(cw + 2 * DFF + col + 4 * h), d = *(const f32x4*)(cb + col + 4 * h);
#pragma unroll
                        for (int e = 0; e < 4; e += 2) { f32x2 x; x.x = a[e] * mp_ * fm[4 * h + e] + b[e] * f0[4 * h + e] + c[e] * mn_ * fn[4 * h + e] + d[e];
                            x.y = a[e + 1] * mp_ * fm[4 * h + e + 1] + b[e + 1] * f0[4 * h + e + 1] + c[e + 1] * mn_ * fn[4 * h + e + 1] + d[e + 1];
                            const f32x2 g = pg8::gelu_pk(x); o[4 * h + e] = g.x; o[4 * h + e + 1] = g.y; } }
                    const f32x4 v0 = acc[ai][bj][m][0], v1 = acc[ai][bj][m][1];
                    u32x4 w; w.x = pg8::cvt_pk_bf16(o[0] * v0[0], o[1] * v0[1]); w.y = pg8::cvt_pk_bf16(o[2] * v0[2], o[3] * v0[3]);
                    w.z = pg8::cvt_pk_bf16(o[4] * v1[0], o[5] * v1[1]); w.w = pg8::cvt_pk_bf16(o[6] * v1[2], o[7] * v1[3]);
                    if (dv != 2) *(u32x4*)(O + (size_t)r * DFF + col) = w; else asm volatile("" :: "v"(w.x), "v"(w.y), "v"(w.z), "v"(w.w)); }
                if (m & 1) asm volatile("" ::: "memory"); }
    }
};
__device__ __forceinline__ void unpack8u(const u32x2 w, float* f) {
#pragma unroll
    for (int e = 0; e < 4; ++e) { f[e] = (float)((w.x >> (8 * e)) & 255u) * (1.f / 255.f); f[4 + e] = (float)((w.y >> (8 * e)) & 255u) * (1.f / 255.f); }
}
struct EpiMerge {
    const bf16_t* P; bf16_t* O;
    __device__ __forceinline__ bool keep(const pg8::Unit& u) const { return u.sub < 2; }
    __device__ __forceinline__ void operator()(acc_t& acc, const pg8::Unit& u, int wr, int wc, int fr, int fq) const {
        const int row0 = u.pm * 256 + wr * 64 + fr, col0 = u.pn * 256 + wc * 32 + 8 * fq; const int sub = u.sub;
#pragma unroll
        for (int ai = 0; ai < 2; ++ai)
#pragma unroll
            for (int m = 0; m < 4; ++m) { const int r = row0 + ai * 128 + m * 16;
#pragma unroll
                for (int bj = 0; bj < 2; ++bj) { const int col = col0 + bj * 128;
                    const unsigned char* gp = (const unsigned char*)(P + (size_t)r * INW) + C_G * 2 + col;
                    float mu[8];
                    if (sub < 2) { const u32x2 ga = *(const u32x2*)(gp + sub * DM), gb = *(const u32x2*)(gp + (sub + 1) * DM); float fa[8], fb[8]; unpack8u(ga, fa); unpack8u(gb, fb);
#pragma unroll
                        for (int e = 0; e < 8; ++e) mu[e] = fa[e] * __builtin_amdgcn_rcpf(fb[e]); }
                    else { const u32x2 ga = *(const u32x2*)(gp + 2 * DM); unpack8u(ga, mu); }
                    f32x4 v0 = acc[ai][bj][m][0], v1 = acc[ai][bj][m][1];
#pragma unroll
                    for (int e = 0; e < 4; ++e) { v0[e] *= mu[e]; v1[e] *= mu[4 + e]; }
                    if (sub < 2) { acc[ai][bj][m][0] = v0; acc[ai][bj][m][1] = v1; }
                    else { u32x4 w; w.x = pg8::cvt_pk_bf16(v0[0], v0[1]); w.y = pg8::cvt_pk_bf16(v0[2], v0[3]); w.z = pg8::cvt_pk_bf16(v1[0], v1[1]); w.w = pg8::cvt_pk_bf16(v1[2], v1[3]);
                        *(u32x4*)(O + (size_t)r * DM + col) = w; } } }
    }
};

#define XB_TMO      128
#define XB_XCNT(j)  (256  + 64 * (j))
#define XB_XSUB(j)  (1280 + 64 * (j))
#define XB_XGEN(j)  (2304 + 64 * (j))
#define XB_TOP      3328
#define XB_TOPGEN   3392
#define XCD_BAR_WORDS 3456
#define XB_SPIN_CAP (1u << 20)
__device__ __forceinline__ unsigned xb_ld(unsigned* p)              { return __hip_atomic_load(p, __ATOMIC_RELAXED, __HIP_MEMORY_SCOPE_AGENT); }
__device__ __forceinline__ unsigned xb_add(unsigned* p, unsigned v) { return __hip_atomic_fetch_add(p, v, __ATOMIC_RELAXED, __HIP_MEMORY_SCOPE_AGENT); }
__device__ __forceinline__ unsigned xb_xcc_id() { return (unsigned)__builtin_amdgcn_s_getreg((3 << 11) | 20) & 0xFu; }
#define XB_SPIN(cond, bar) do { unsigned _sp = 0; while (cond) { __builtin_amdgcn_s_sleep(1); \
    if ((++_sp & 255u) == 0u) { if (xb_ld(&(bar)[XB_TMO])) break; if (_sp > XB_SPIN_CAP) { atomicAdd(&(bar)[XB_TMO], 1u); break; } } } } while (0)
struct XcdBarrier { unsigned* bar; unsigned x; volatile LAS unsigned* st; };
__device__ __forceinline__ XcdBarrier xcd_barrier_post(unsigned* bar, volatile LAS unsigned* st) {
    XcdBarrier b; b.bar = bar; b.x = xb_xcc_id(); b.st = st;
    if (threadIdx.x == 0) (void)xb_add(&bar[XB_XCNT(b.x)], 1u);
    return b;
}
__device__ __forceinline__ void xcd_barrier_complete(unsigned* bar, unsigned x, unsigned& nloc, unsigned& nx) {
    const unsigned G = gridDim.x * gridDim.y * gridDim.z;
    unsigned sum, cnt, mine, sp = 0u;
    for (;;) {
        sum = 0u; cnt = 0u; mine = 0u;
#pragma unroll
        for (unsigned j = 0; j < 16; ++j) { const unsigned c = xb_ld(&bar[XB_XCNT(j)]); sum += c; cnt += (c > 0u) ? 1u : 0u; mine = (j == x) ? c : mine; }
        if (sum == G) break;
        __builtin_amdgcn_s_sleep(1);
        if ((++sp & 255u) == 0u) { if (xb_ld(&bar[XB_TMO])) break; if (sp > XB_SPIN_CAP) { atomicAdd(&bar[XB_TMO], 1u); break; } }
    }
    nloc = mine > 0u ? mine : 1u; nx = cnt > 0u ? cnt : 1u;
}
__device__ __forceinline__ void xcd_barrier(const XcdBarrier& b, int tid) {
    asm volatile("s_waitcnt vmcnt(0)" ::: "memory");
    __syncthreads();
    if (tid == 0) {
        unsigned* bar = b.bar;
        __builtin_amdgcn_s_waitcnt(0);
        unsigned nloc = b.st[0], nx = b.st[1];
        if (nloc == 0u) { xcd_barrier_complete(bar, b.x, nloc, nx); b.st[0] = nloc; b.st[1] = nx; }
        const unsigned old = xb_add(&bar[XB_XSUB(b.x)], 1u);
        const unsigned gen = old / nloc;
        if (old + 1u == (gen + 1u) * nloc) {
            __builtin_amdgcn_fence(__ATOMIC_RELEASE, "agent");
            asm volatile("s_waitcnt vmcnt(0)" ::: "memory");
            const unsigned og = xb_add(&bar[XB_TOP], 1u);
            const unsigned tg = og / nx;
            if (og + 1u == (tg + 1u) * nx) xb_add(&bar[XB_TOPGEN], 1u);
            else XB_SPIN(xb_ld(&bar[XB_TOPGEN]) == tg, bar);
            __builtin_amdgcn_fence(__ATOMIC_ACQUIRE, "agent");
            xb_add(&bar[XB_XGEN(b.x)], 1u);
            asm volatile("s_waitcnt vmcnt(0)" ::: "memory");
        } else {
            XB_SPIN(xb_ld(&bar[XB_XGEN(b.x)]) == gen, bar);
            __builtin_amdgcn_fence(__ATOMIC_ACQUIRE, "agent");
            asm volatile("s_waitcnt vmcnt(0)" ::: "memory");
        }
    }
    __syncthreads();
}

constexpr int NWAVES = 8;
constexpr int RING_BYTES = 131072, LDSCTL_OFF = RING_BYTES, MISC_OFF = LDSCTL_OFF + 320, LDS_BYTES = 147456;
struct Args { const float* in[30]; float* out; unsigned char* ws; int ph_lo, ph_hi, use_bar, pad; };
typedef const __attribute__((address_space(4))) Args CArgs;
struct Frame {
    LAS unsigned char* lds; int tid, lane, wave, G, vcu, bx, dry;
    float* out; unsigned char* ws; float* xm;
};
#define FIN(i) (A.in[i])

__constant__ unsigned char c_bucket[257] = {
15,15,15,15,15,15,15,15,15,15,15,15,15,15,15,15,15,15,15,15,15,15,15,15,15,15,15,15,15,15,15,15,15,15,15,15,15,15,14,14,14,14,14,14,14,14,14,14,14,14,14,14,14,14,14,14,14,14,14,14,14,14,14,14,14,13,13,13,13,13,13,13,13,13,13,13,13,13,13,13,13,13,13,12,12,12,12,12,12,12,12,12,12,12,12,12,12,11,11,11,11,11,11,11,11,11,10,10,10,10,10,10,10,9,9,9,9,8,8,8,8,7,6,5,4,3,2,1,0,17,18,19,20,21,22,23,24,24,24,24,25,25,25,25,26,26,26,26,26,26,26,27,27,27,27,27,27,27,27,27,28,28,28,28,28,28,28,28,28,28,28,28,28,28,29,29,29,29,29,29,29,29,29,29,29,29,29,29,29,29,29,29,30,30,30,30,30,30,30,30,30,30,30,30,30,30,30,30,30,30,30,30,30,30,30,30,30,30,30,31,31,31,31,31,31,31,31,31,31,31,31,31,31,31,31,31,31,31,31,31,31,31,31,31,31,31,31,31,31,31,31,31,31,31,31,31,31};

__device__ __forceinline__ void p0_transpose_item(const float* W, int K, int N, bf16_t* WT, int row_off, LAS float* scr, int item, int lane) {
    const int nblk = N / 32, kb = item / nblk, nb = item % nblk, k0 = 64 * kb, n0 = 32 * nb;
    f32x4 v[8];
#pragma unroll
    for (int i = 0; i < 8; ++i) v[i] = *(const f32x4*)(W + (size_t)(k0 + 8 * i + (lane >> 3)) * N + n0 + 4 * (lane & 7));
#pragma unroll
    for (int i = 0; i < 8; ++i) { LAS float* d = scr + (8 * i + (lane >> 3)) * 33 + 4 * (lane & 7); d[0] = v[i].x; d[1] = v[i].y; d[2] = v[i].z; d[3] = v[i].w; }
    LDS_WAIT(); asm volatile("" ::: "memory");
    const int c = lane & 7;
#pragma unroll
    for (int j = 0; j < 4; ++j) { const int n = (lane >> 3) + 8 * j; const LAS float* s = scr + (8 * c) * 33 + n;
        u32x4 o; o.x = pk2(s[0 * 33], s[1 * 33]); o.y = pk2(s[2 * 33], s[3 * 33]); o.z = pk2(s[4 * 33], s[5 * 33]); o.w = pk2(s[6 * 33], s[7 * 33]);
        *(u32x4*)(WT + (size_t)(row_off + n0 + n) * K + k0 + 8 * c) = o; }
    LDS_WAIT(); asm volatile("" ::: "memory");
}
__device__ __forceinline__ void rms_row(const f32x4 (&v)[4], const float* g, bf16_t* orow, int lane) {
    float s = 0.f;
#pragma unroll
    for (int j = 0; j < 4; ++j) s += (v[j].x * v[j].x + v[j].y * v[j].y) + (v[j].z * v[j].z + v[j].w * v[j].w);
    const float rstd = 1.0f / sqrtf(wave_sum(s, lane) * (1.f / DM) + EPS);
    unsigned long long* o8 = (unsigned long long*)orow + lane;
#pragma unroll
    for (int j = 0; j < 4; ++j) { const f32x4 gg = *((const f32x4*)g + lane + 64 * j);
        o8[64 * j] = (unsigned long long)pk2(v[j].x * rstd * gg.x, v[j].y * rstd * gg.y) | ((unsigned long long)pk2(v[j].z * rstd * gg.z, v[j].w * rstd * gg.w) << 32); }
}
constexpr size_t WS_H2F_P = 2 * MiB, WS_H2F_S = WS_END;
constexpr int NCH_P = (LP + 31) / 32, NCH_S = (LS + 31) / 32;
static_assert(WS_H2F_S + (size_t)NCH_S * 32 * 128 <= 512 * MiB && WS_H2F_P + (size_t)NCH_P * 32 * 128 <= WS_W, "h2 scratch");
__device__ __forceinline__ void filt_h2_compute(const CArgs& A, const Frame& F, int layer, int L, int tc, LAS float* h1t, int lane, float (&acc)[32]) {
    const float* w1 = FIN(11) + (size_t)layer * 33 * 64; const float* b1 = FIN(12) + layer * 64;
    const float* w2 = FIN(13) + (size_t)layer * 64 * 64; const float* b2 = FIN(14) + layer * 64; const float* fq_ = FIN(16) + layer * 64;
    const int pos = lane & 31, half = lane >> 5, jb = 32 * half;
    const float tt = (float)tc / (float)(L - 1);
    { f32x4 bv[8], wv[8];
#pragma unroll
      for (int i = 0; i < 8; ++i) { bv[i] = *(const f32x4*)(b1 + jb + 4 * i); wv[i] = *(const f32x4*)(w1 + jb + 4 * i); }
#pragma unroll
      for (int i = 0; i < 8; ++i)
#pragma unroll
          for (int e = 0; e < 4; ++e) acc[4 * i + e] = bv[i][e] + tt * wv[i][e]; }
#pragma unroll 2
    for (int k = 0; k < 16; ++k) {
        const float f = 1e-4f + (float)k * ((15.0f - 1e-4f) / 15.0f);
        const float rev = f * (float)tc * (1.0f / (float)L);
        const float sn = __builtin_amdgcn_sinf(rev), cs = __builtin_amdgcn_cosf(rev);
        f32x4 wc_[8], ws_[8];
#pragma unroll
        for (int i = 0; i < 8; ++i) { wc_[i] = *(const f32x4*)(w1 + (size_t)(1 + k) * 64 + jb + 4 * i); ws_[i] = *(const f32x4*)(w1 + (size_t)(17 + k) * 64 + jb + 4 * i); }
#pragma unroll
        for (int i = 0; i < 8; ++i)
#pragma unroll
            for (int e = 0; e < 4; ++e) acc[4 * i + e] += cs * wc_[i][e] - sn * ws_[i][e];
    }
    { f32x4 fv[8];
#pragma unroll
      for (int i = 0; i < 8; ++i) fv[i] = *(const f32x4*)(fq_ + jb + 4 * i);
#pragma unroll
      for (int i = 0; i < 8; ++i)
#pragma unroll
          for (int e = 0; e < 4; ++e) h1t[(jb + 4 * i + e) * 32 + pos] = __builtin_amdgcn_sinf(fv[i][e] * acc[4 * i + e] * 0.15915494309189535f); }
    LDS_WAIT();
    { f32x4 bv[8];
#pragma unroll
      for (int i = 0; i < 8; ++i) bv[i] = *(const f32x4*)(b2 + jb + 4 * i);
#pragma unroll
      for (int i = 0; i < 8; ++i)
#pragma unroll
          for (int e = 0; e < 4; ++e) acc[4 * i + e] = bv[i][e]; }
#pragma unroll 4
    for (int i2 = 0; i2 < 64; ++i2) { const float h = h1t[i2 * 32 + pos]; f32x4 wv[8];
#pragma unroll
        for (int i = 0; i < 8; ++i) wv[i] = *(const f32x4*)(w2 + (size_t)i2 * 64 + jb + 4 * i);
#pragma unroll
        for (int i = 0; i < 8; ++i)
#pragma unroll
            for (int e = 0; e < 4; ++e) acc[4 * i + e] += h * wv[i][e]; }
}
__device__ __forceinline__ void filt_h2_item(const CArgs& A, const Frame& F, int layer, int item, LAS float* h1t, int lane) {
    const int cls = item >= NCH_P ? 1 : 0, ch = cls ? item - NCH_P : item, L = cls ? LS : LP;
    const int pos = lane & 31, half = lane >> 5, jb = 32 * half;
    const int t = ch * 32 + pos, tc = t < L ? t : L - 1;
    const float* fq_ = FIN(16) + layer * 64;
    float acc[32];
    filt_h2_compute(A, F, layer, L, tc, h1t, lane, acc);
    { f32x4 fv[8]; unsigned hw[16];
#pragma unroll
      for (int i = 0; i < 8; ++i) fv[i] = *(const f32x4*)(fq_ + jb + 4 * i);
#pragma unroll
      for (int i = 0; i < 8; ++i)
#pragma unroll
          for (int e = 0; e < 4; e += 2) { const float a0 = __builtin_amdgcn_sinf(fv[i][e] * acc[4 * i + e] * 0.15915494309189535f), a1 = __builtin_amdgcn_sinf(fv[i][e + 1] * acc[4 * i + e + 1] * 0.15915494309189535f);
              typedef _Float16 h2_t __attribute__((ext_vector_type(2))); const h2_t hv = {(_Float16)a0, (_Float16)a1}; hw[2 * i + (e >> 1)] = __builtin_bit_cast(unsigned, hv); }
      u32x4* dst = (u32x4*)(F.ws + (cls ? WS_H2F_S : WS_H2F_P) + (size_t)t * 128 + half * 64);
#pragma unroll
      for (int i = 0; i < 4; ++i) dst[i] = (u32x4){hw[4 * i], hw[4 * i + 1], hw[4 * i + 2], hw[4 * i + 3]}; }
    LDS_WAIT();
}
constexpr int NI8_P = LP / 8, NI8 = NI8_P + LS / 8;
static_assert(LP % 8 == 0 && LS % 8 == 0, "filter items");
__device__ __forceinline__ void filt_h2_item8(const CArgs& A, const Frame& F, int layer, int item, LAS float* h1t, int lane) {
    const int cls = item >= NI8_P ? 1 : 0, ch = cls ? item - NI8_P : item, L = cls ? LS : LP;
    const float* w1 = FIN(11) + (size_t)layer * 33 * 64; const float* b1 = FIN(12) + layer * 64;
    const float* w2 = FIN(13) + (size_t)layer * 64 * 64; const float* b2 = FIN(14) + layer * 64; const float* fq_ = FIN(16) + layer * 64;
    const int pos = lane & 7, jb = (lane >> 3) * 8, t = ch * 8 + pos;
    const float tt = (float)t / (float)(L - 1);
    float acc[8];
    { const f32x4 ba = *(const f32x4*)(b1 + jb), bb = *(const f32x4*)(b1 + jb + 4), wa = *(const f32x4*)(w1 + jb), wb = *(const f32x4*)(w1 + jb + 4);
#pragma unroll
      for (int e = 0; e < 4; ++e) { acc[e] = ba[e] + tt * wa[e]; acc[4 + e] = bb[e] + tt * wb[e]; } }
#pragma unroll
    for (int k0 = 0; k0 < 16; k0 += 4) { f32x4 ca[4], cb[4], sa[4], sb[4];
#pragma unroll
        for (int q = 0; q < 4; ++q) { const int k = k0 + q; ca[q] = *(const f32x4*)(w1 + (size_t)(1 + k) * 64 + jb); cb[q] = *(const f32x4*)(w1 + (size_t)(1 + k) * 64 + jb + 4);
            sa[q] = *(const f32x4*)(w1 + (size_t)(17 + k) * 64 + jb); sb[q] = *(const f32x4*)(w1 + (size_t)(17 + k) * 64 + jb + 4); }
        asm volatile("" ::: "memory");
#pragma unroll
        for (int q = 0; q < 4; ++q) { const int k = k0 + q;
            const float f = 1e-4f + (float)k * ((15.0f - 1e-4f) / 15.0f);
            const float rev = f * (float)t * (1.0f / (float)L);
            const float sn = __builtin_amdgcn_sinf(rev), cs = __builtin_amdgcn_cosf(rev);
#pragma unroll
            for (int e = 0; e < 4; ++e) { acc[e] += cs * ca[q][e] - sn * sa[q][e]; acc[4 + e] += cs * cb[q][e] - sn * sb[q][e]; } }
        asm volatile("" ::: "memory");
    }
    const f32x4 fa = *(const f32x4*)(fq_ + jb), fb = *(const f32x4*)(fq_ + jb + 4);
#pragma unroll
    for (int e = 0; e < 4; ++e) { h1t[(jb + e) * 8 + pos] = __builtin_amdgcn_sinf(fa[e] * acc[e] * 0.15915494309189535f); h1t[(jb + 4 + e) * 8 + pos] = __builtin_amdgcn_sinf(fb[e] * acc[4 + e] * 0.15915494309189535f); }
    LDS_WAIT();
    { const f32x4 ba = *(const f32x4*)(b2 + jb), bb = *(const f32x4*)(b2 + jb + 4);
#pragma unroll
      for (int e = 0; e < 4; ++e) { acc[e] = ba[e]; acc[4 + e] = bb[e]; } }
#pragma unroll
    for (int i0 = 0; i0 < 64; i0 += 8) { f32x4 wa[8], wb[8];
#pragma unroll
        for (int q = 0; q < 8; ++q) { wa[q] = *(const f32x4*)(w2 + (size_t)(i0 + q) * 64 + jb); wb[q] = *(const f32x4*)(w2 + (size_t)(i0 + q) * 64 + jb + 4); }
        asm volatile("" ::: "memory");
#pragma unroll
        for (int q = 0; q < 8; ++q) { const float h = h1t[(i0 + q) * 8 + pos];
#pragma unroll
            for (int e = 0; e < 4; ++e) { acc[e] += h * wa[q][e]; acc[4 + e] += h * wb[q][e]; } }
        asm volatile("" ::: "memory");
    }
    unsigned hw[4];
#pragma unroll
    for (int e = 0; e < 4; e += 2) { typedef _Float16 h2_t __attribute__((ext_vector_type(2)));
        const h2_t ha = {(_Float16)__builtin_amdgcn_sinf(fa[e] * acc[e] * 0.15915494309189535f), (_Float16)__builtin_amdgcn_sinf(fa[e + 1] * acc[e + 1] * 0.15915494309189535f)};
        const h2_t hb = {(_Float16)__builtin_amdgcn_sinf(fb[e] * acc[4 + e] * 0.15915494309189535f), (_Float16)__builtin_amdgcn_sinf(fb[e + 1] * acc[4 + e + 1] * 0.15915494309189535f)};
        hw[e >> 1] = __builtin_bit_cast(unsigned, ha); hw[2 + (e >> 1)] = __builtin_bit_cast(unsigned, hb); }
    *(u32x4*)(F.ws + (cls ? WS_H2F_S : WS_H2F_P) + (size_t)t * 128 + jb * 2) = (u32x4){hw[0], hw[1], hw[2], hw[3]};
    LDS_WAIT();
}
constexpr int NCHF_P = (LP - 1 + 31) / 32 + 1, NCHB_P = (LP + 31) / 32, NCHF_S = (LS - 1 + 31) / 32 + 1, NCHB_S = (LS + 31) / 32;
constexpr int NFI_P = NCHF_P + NCHB_P, NFI = NFI_P + NCHF_S + NCHB_S;
__device__ __forceinline__ void filt_tile_item(const CArgs& A, const Frame& F, int layer, int item, int lane) {
    const int ct = item & 15; int cls = 0, it = item >> 4; if (it >= NFI_P) { cls = 1; it -= NFI_P; }
    const int nchf = cls ? NCHF_S : NCHF_P, L = cls ? LS : LP;
    bool bwd; int ch; if (it < nchf) { bwd = false; ch = it - 1; } else { bwd = true; ch = it - nchf; }
    const int tsh = bwd ? 0 : 1;
    const float* w3 = FIN(15) + (size_t)layer * 64 * 1024;
    const int pos = lane & 31, half = lane >> 5;
    const int t = ch * 32 + pos + tsh, tc = t < 0 ? 0 : (t < L ? t : L - 1);
    float acc[32];
#if FT_RECOMPUTE
    if (FT_RECOMPUTE == 1 || FT_RECOMPUTE == 9 || (FT_RECOMPUTE == 2 && cls == 0) || (FT_RECOMPUTE == 3 && cls == 1)) { LAS float* h1t = (LAS float*)(F.lds + F.wave * 16384); filt_h2_compute(A, F, layer, L, tc, h1t, lane, acc); const float* fq_ = FIN(16) + layer * 64;
#pragma unroll
      for (int k = 0; k < 32; ++k) acc[k] = __builtin_amdgcn_sinf(fq_[32 * half + k] * acc[k] * 0.15915494309189535f); LDS_WAIT(); }
    else
#endif
    { const u32x4* src = (const u32x4*)(F.ws + (cls ? WS_H2F_S : WS_H2F_P) + (size_t)tc * 128 + half * 64);
      u32x4 hv[4];
#pragma unroll
      for (int i = 0; i < 4; ++i) hv[i] = src[i];
#pragma unroll
      for (int i = 0; i < 4; ++i)
#pragma unroll
          for (int e = 0; e < 4; ++e) { typedef _Float16 h2_t __attribute__((ext_vector_type(2))); const unsigned wv_ = hv[i][e];
              const h2_t p = __builtin_bit_cast(h2_t, wv_); acc[8 * i + 2 * e] = (float)p[0]; acc[8 * i + 2 * e + 1] = (float)p[1]; } }
#if FT_RECOMPUTE == 9
    float bad = 0.f;
    { const u32x4* src = (const u32x4*)(F.ws + (cls ? WS_H2F_S : WS_H2F_P) + (size_t)tc * 128 + half * 64);
#pragma unroll
      for (int i = 0; i < 4; ++i) { const u32x4 hvv = src[i];
#pragma unroll
          for (int e = 0; e < 4; ++e) { typedef _Float16 h2_t __attribute__((ext_vector_type(2))); const h2_t p = __builtin_bit_cast(h2_t, hvv[e]);
              if (fabsf((float)p[0] - acc[8 * i + 2 * e]) > 2e-3f || fabsf((float)p[1] - acc[8 * i + 2 * e + 1]) > 2e-3f) bad = 1e4f; } } }
#else
    const float bad = 0.f;
#endif
    bf16_t* RK = (bf16_t*)(F.ws + (cls ? WS_RKS : WS_RKP)); const int rklen = cls ? RKLEN_S : RKLEN_P;
    float* sums = (float*)(F.ws + WS_CTL) + CW_SUMS + (layer * 2 + cls) * 512;
    const float da = -15.350567286626973f, db = -3.0701134573253945f;
    {
        const int col0 = (bwd ? 512 : 0) + ct * 32;
        float bw[32];
#pragma unroll
        for (int ks = 0; ks < 32; ++ks) bw[ks] = w3[(size_t)(32 * half + ks) * 1024 + col0 + pos];
        f32x16 d = {};
#pragma unroll
        for (int ks = 0; ks < 32; ++ks) d = __builtin_amdgcn_mfma_f32_32x32x2f32(acc[ks], bw[ks], d, 0, 0, 0);
        const int c = (col0 + pos) & 511;
        const float delta = fabsf(da + (db - da) * ((float)c / 511.0f));
        bf16_t* rk = RK + (size_t)c * rklen + RK_PAD + L;
        float asum = 0.f;
#pragma unroll
        for (int g = 0; g < 4; ++g) { const int t0 = ch * 32 + 8 * g + 4 * half + tsh; float v[4];
#pragma unroll
            for (int e = 0; e < 4; ++e) { const int tp = t0 + e; const bool ok = tp >= 0 && tp < L && !(bwd && tp == 0);
                const float tq = (float)tp / (float)(L - 1); v[e] = ok ? d[4 * g + e] * __expf(-tq * delta) + bad : 0.f; asum += fabsf(v[e]); }
            if (bwd) { if (t0 >= 4 && t0 + 3 < L) { u32x2 w; w.x = pk2(v[0], v[1]); w.y = pk2(v[2], v[3]); *(u32x2*)(rk + t0) = w; }
                       else {
#pragma unroll
                           for (int e = 0; e < 4; ++e) if (t0 + e >= 1 && t0 + e < L) rk[t0 + e] = (bf16_t)f2bf(v[e]); } }
            else { if (t0 >= 0 && t0 + 3 < L) { u32x2 w; w.x = pk2(v[3], v[2]); w.y = pk2(v[1], v[0]); *(u32x2*)(rk - t0 - 3) = w; }
                   else {
#pragma unroll
                       for (int e = 0; e < 4; ++e) if (t0 + e >= 0 && t0 + e < L) rk[-(t0 + e)] = (bf16_t)f2bf(v[e]); } } }
        asum += shx(asum, 32, lane);
        if (half == 0 && !F.dry) atomicAdd(sums + c, asum);
    }
}
__device__ __forceinline__ void p_filt_tiles(const CArgs& A, const Frame& F, int layer) {
    const int gw = F.vcu * NWAVES + F.wave, NGW = F.G * NWAVES;
    for (int it = gw; it < 16 * NFI; it += NGW) filt_tile_item(A, F, layer, it, F.lane);
}
__device__ __forceinline__ void p_prep(const CArgs& A, const Frame& F, int layer) {
    const int gw = F.vcu * NWAVES + F.wave, NGW = F.G * NWAVES, lane = F.lane;
    const bool filt_first = false;
    if (filt_first && DSEL(8)) { LAS float* scr = (LAS float*)(F.lds + F.wave * 16384); for (int it = gw; it < NI8; it += NGW) filt_h2_item8(A, F, layer, it, scr, lane); }
    if (DSEL(1)) {
        const float* g = FIN(4) + layer * DM; bf16_t* XN = (bf16_t*)(F.ws + WS_XNR);
        for (int r0 = gw; r0 < MP; r0 += 2 * NGW) {
            f32x4 v[2][4]; const int rr[2] = {r0, r0 + NGW};
#pragma unroll
            for (int q = 0; q < 2; ++q) { const int r = rr[q];
                if (r >= MP) continue;
                if (r >= MROWS) {
#pragma unroll
                    for (int j = 0; j < 4; ++j) v[q][j] = (f32x4){0.f, 0.f, 0.f, 0.f};
                } else if (layer == 0) {
                    const int s = seq_of_row(r), p = r - seq_base(s);
                    const float* src = p < NMETA ? FIN(2) + (size_t)p * DM : (s < 8 ? FIN(0) + ((size_t)s * 2048 + (p - NMETA)) * DM : FIN(1) + (size_t)(p - NMETA) * DM);
                    const f32x4* sr = (const f32x4*)src + lane;
#pragma unroll
                    for (int j = 0; j < 4; ++j) v[q][j] = sr[64 * j];
                } else {
                    const f32x4* xr = (const f32x4*)xrow(F.out, F.xm, r) + lane;
#pragma unroll
                    for (int j = 0; j < 4; ++j) v[q][j] = xr[64 * j];
                } }
#pragma unroll
            for (int q = 0; q < 2; ++q) { const int r = rr[q];
                if (r >= MP) continue;
                if (layer == 0) { f32x4* xr = (f32x4*)xrow(F.out, F.xm, r) + lane;
#pragma unroll
                    for (int j = 0; j < 4; ++j) xr[64 * j] = v[q][j]; }
                rms_row(v[q], g, XN + (size_t)r * DM, lane); }
        }
    }
    {
        LAS float* scr = (LAS float*)(F.lds + F.wave * 16384);
        unsigned char* W = F.ws + WS_W;
        constexpr int I_IN = (DM / 64) * (INW / 32), I_G = (DM / 64) * (DFF / 32), I_D = (DFF / 64) * (DM / 32), I_O = (DM / 64) * (DM / 32), I_M = (512 / 64) * (DM / 32);
        constexpr int NIT = I_IN + 2 * I_G + I_D + I_O + 2 * I_M;
        if (DSEL(2)) for (int it = gw; it < NIT; it += NGW) {
            int r = it;
            if (r < I_IN) { p0_transpose_item(FIN(5) + (size_t)layer * DM * INW, DM, INW, (bf16_t*)(W + W_IN), 0, scr, r, lane); continue; } r -= I_IN;
            if (r < I_G) { p0_transpose_item(FIN(25) + (size_t)layer * DM * DFF, DM, DFF, (bf16_t*)(W + W_G), 0, scr, r, lane); continue; } r -= I_G;
            if (r < I_G) { p0_transpose_item(FIN(26) + (size_t)layer * DM * DFF, DM, DFF, (bf16_t*)(W + W_U), 0, scr, r, lane); continue; } r -= I_G;
            if (r < I_D) { p0_transpose_item(FIN(29) + (size_t)layer * DFF * DM, DFF, DM, (bf16_t*)(W + W_D), 0, scr, r, lane); continue; } r -= I_D;
            if (r < I_O) { p0_transpose_item(FIN(23) + (size_t)layer * DM * DM, DM, DM, (bf16_t*)(W + W_OUT), 0, scr, r, lane); continue; } r -= I_O;
            if (r < I_M) { p0_transpose_item(FIN(20) + (size_t)layer * 512 * DM, 512, DM, (bf16_t*)(W + W_MRG), 0, scr, r, lane); continue; } r -= I_M;
            p0_transpose_item(FIN(21) + (size_t)layer * 512 * DM, 512, DM, (bf16_t*)(W + W_MRG), DM, scr, r, lane);
        }
        const float* pw = FIN(18) + (size_t)layer * 4 * 128 * 128; const float* psc = FIN(19) + layer * 512; const float* wpo = FIN(22) + (size_t)layer * 512 * DM;
        bf16_t* WT = (bf16_t*)(W + W_MRG) + (size_t)2 * DM * 512;
        const int gt = (F.vcu * NWAVES + F.wave) * 64 + lane, NGT = NGW * 64;
        if (DSEL(4)) for (int st = NGW - 1 - gw; st < (512 / 8) * (DM / 64); st += NGW) {
            const int c0 = (st >> 4) * 8, j = (st & 15) * 64 + lane, g = c0 >> 7;
            { const int cr = lane >> 3, d0 = (lane & 7) * 16; const float* pr = pw + ((size_t)c0 + cr) * 128 + d0; const float* ps = psc + g * 128 + d0;
#pragma unroll
              for (int q = 0; q < 4; ++q) { const f32x4 a = *(const f32x4*)(pr + 4 * q), b = *(const f32x4*)(ps + 4 * q); *(LAS f32x4*)(scr + cr * 128 + d0 + 4 * q) = a * b; } }
            LDS_WAIT(); asm volatile("" ::: "memory");
            const float* wp = wpo + (size_t)(g * 128) * DM + j;
            float a[8];
#pragma unroll
            for (int c = 0; c < 8; ++c) a[c] = 0.f;
#pragma unroll 1
            for (int d0 = 0; d0 < 128; d0 += 16) { float w[16];
#pragma unroll
                for (int q = 0; q < 16; ++q) w[q] = wp[(size_t)(d0 + q) * DM];
                asm volatile("" ::: "memory");
#pragma unroll
                for (int c = 0; c < 8; ++c)
#pragma unroll
                    for (int q4 = 0; q4 < 4; ++q4) { const f32x4 cf = *(const LAS f32x4*)(scr + c * 128 + d0 + 4 * q4);
#pragma unroll
                        for (int e = 0; e < 4; ++e) a[c] += cf[e] * w[4 * q4 + e]; }
                asm volatile("" ::: "memory");
            }
            u32x4 o; o.x = pk2(a[0], a[1]); o.y = pk2(a[2], a[3]); o.z = pk2(a[4], a[5]); o.w = pk2(a[6], a[7]);
            *(u32x4*)(WT + (size_t)j * 512 + c0) = o;
            LDS_WAIT(); asm volatile("" ::: "memory");
        }
        for (int idx = gt; idx < 2 * 512 * 513; idx += NGT) { const int k = idx % 513, cc = (idx / 513) & 511, cls = idx / (513 * 512);
            const int L = cls ? LS : LP, rklen = cls ? RKLEN_S : RKLEN_P; bf16_t* RK = (bf16_t*)(F.ws + (cls ? WS_RKS : WS_RKP)) + (size_t)cc * rklen;
            RK[k <= 256 ? k : 256 + 2 * L + (k - 257)] = 0; }
        if (!filt_first && DSEL(8)) for (int it = gw; it < NI8; it += NGW) filt_h2_item8(A, F, layer, it, scr, lane);
    }
}

__device__ __forceinline__ void p_attn_ref(const CArgs& A, const Frame& F, int layer) {
    bf16_t* P = (bf16_t*)(F.ws + WS_PROJ);
    const float* qg = FIN(6) + layer * HD; const float* kg = FIN(7) + layer * HD; const float* sink = FIN(8) + layer * NHEAD; const float* rb = FIN(3);
    const int gt = (F.vcu * NWAVES + F.wave) * 64 + F.lane, NGT = F.G * NWAVES * 64;
    for (int idx = gt; idx < MROWS * NHEAD; idx += NGT) {
        const int r = idx >> 3, h = idx & 7, hk = h >> 2;
        const int s = seq_of_row(r), base = seq_base(s), L = seq_len(s), p = r - base;
        unsigned qs[32]; float o[64];
        { const u32x4* qp = (const u32x4*)(P + (size_t)r * INW + C_Q + 64 * h); float ss = 0.f;
#pragma unroll
          for (int c = 0; c < 8; ++c) { const u32x4 w = qp[c]; qs[4 * c] = w.x; qs[4 * c + 1] = w.y; qs[4 * c + 2] = w.z; qs[4 * c + 3] = w.w; }
#pragma unroll
          for (int d = 0; d < 32; ++d) { const float a = bflo(qs[d]), b = bfhi(qs[d]); ss += a * a + b * b; }
          const float rs = 1.0f / sqrtf(ss * (1.f / 64) + EPS) * 0.125f;
#pragma unroll
          for (int d = 0; d < 32; ++d) { qs[d] = pk2(bflo(qs[d]) * rs * qg[2 * d], bfhi(qs[d]) * rs * qg[2 * d + 1]); o[2 * d] = 0.f; o[2 * d + 1] = 0.f; } }
        float m = sink[h], l = 1.f;
        const int lo = p - 128 < 0 ? 0 : p - 128, hi = p + 128 > L - 1 ? L - 1 : p + 128;
        for (int pk = lo; pk <= hi; ++pk) {
            const bf16_t* kr = P + (size_t)(base + pk) * INW;
            const u32x4* kp = (const u32x4*)(kr + C_K + 64 * hk); const u32x4* vp = (const u32x4*)(kr + C_V + 64 * hk);
            float ss = 0.f, dt = 0.f;
#pragma unroll
            for (int c = 0; c < 8; ++c) { float kk[8]; unpack8(kp[c], kk);
#pragma unroll
                for (int e = 0; e < 8; ++e) { ss += kk[e] * kk[e]; const unsigned qw = qs[4 * c + (e >> 1)]; dt += kk[e] * kg[8 * c + e] * ((e & 1) ? bfhi(qw) : bflo(qw)); }
                asm volatile("" ::: "memory"); }
            const float sc = dt / sqrtf(ss * (1.f / 64) + EPS) + rb[c_bucket[pk - p + 128] * NHEAD + h];
            const float mn = fmaxf(m, sc), f = __expf(m - mn), pe = __expf(sc - mn);
            l = l * f + pe; m = mn;
#pragma unroll
            for (int c = 0; c < 8; ++c) { float vv[8]; unpack8(vp[c], vv);
#pragma unroll
                for (int e = 0; e < 8; ++e) o[8 * c + e] = o[8 * c + e] * f + pe * vv[e];
                asm volatile("" ::: "memory"); }
        }
        const float il = (DBG & 4) ? 0.f : 1.f / l; u32x4* op = (u32x4*)(P + (size_t)r * INW + C_Q + 64 * h);
#pragma unroll
        for (int c = 0; c < 8; ++c) { u32x4 w; w.x = pk2(o[8 * c] * il, o[8 * c + 1] * il); w.y = pk2(o[8 * c + 2] * il, o[8 * c + 3] * il); w.z = pk2(o[8 * c + 4] * il, o[8 * c + 5] * il); w.w = pk2(o[8 * c + 6] * il, o[8 * c + 7] * il); op[c] = w; }
    }
}

constexpr int AT_K = 0, AT_V = 49152, AT_VSTR = 776, AT_B = AT_V + 64 * AT_VSTR;
__device__ __forceinline__ void p_attn(const CArgs& A, const Frame& F, int layer) {
    bf16_t* P = (bf16_t*)(F.ws + WS_PROJ);
    const float* qg = FIN(6) + layer * HD; const float* kg = FIN(7) + layer * HD; const float* sink = FIN(8) + layer * NHEAD; const float* rb = FIN(3);
    const int lane = F.lane, wave = F.wave, tid = F.tid, r32 = lane & 31, hi = lane >> 5;
    LAS unsigned char* lds = F.lds;
    for (int unit = F.vcu; unit < 265 * 4; unit += F.G) {
        const int gb = unit >> 2, hk = (unit >> 1) & 1, gh = unit & 1;
        const int s = gb < 136 ? gb / 17 : 8, nb = gb < 136 ? gb - 17 * s : gb - 136;
        const int base = seq_base(s), L = seq_len(s);
        const int pk0 = 128 * nb - 240;
        u32x4 kws[6], vws[6];
#pragma unroll
        for (int it = 0; it < 6; ++it) { const int idx = tid + it * 512, key = idx >> 3, ch = idx & 7, pk = pk0 + key; const bool ok = pk >= 0 && pk < L;
            const bf16_t* rowp = P + (size_t)(base + (ok ? pk : 0)) * INW + 64 * hk + 8 * ch;
            kws[it] = *(const u32x4*)(rowp + C_K); vws[it] = *(const u32x4*)(rowp + C_V); }
#pragma unroll
        for (int it = 0; it < 6; ++it) { const int idx = tid + it * 512, key = idx >> 3, ch = idx & 7, pk = pk0 + key; const bool ok = pk >= 0 && pk < L;
            u32x4 kw = kws[it], vw = vws[it];
            float kf[8]; unpack8(kw, kf); float ss = 0.f;
#pragma unroll
            for (int e = 0; e < 8; ++e) ss += kf[e] * kf[e];
            ss += shx(ss, 1, lane); ss += shx(ss, 2, lane); ss += shx(ss, 4, lane);
            const float rs = ok ? 1.0f / sqrtf(ss * (1.f / 64) + EPS) : 0.f;
            u32x4 ko; ko.x = pk2(kf[0] * rs * kg[8 * ch], kf[1] * rs * kg[8 * ch + 1]); ko.y = pk2(kf[2] * rs * kg[8 * ch + 2], kf[3] * rs * kg[8 * ch + 3]);
            ko.z = pk2(kf[4] * rs * kg[8 * ch + 4], kf[5] * rs * kg[8 * ch + 5]); ko.w = pk2(kf[6] * rs * kg[8 * ch + 6], kf[7] * rs * kg[8 * ch + 7]);
            *(LAS u32x4*)(lds + AT_K + key * 128 + ((ch ^ (key & 7)) << 4)) = ko;
            if (!ok) vw = (u32x4){0u, 0u, 0u, 0u};
            LAS bf16_t* vt = (LAS bf16_t*)(lds + AT_V + (8 * ch) * AT_VSTR) + key;
            vt[0] = (bf16_t)(vw.x & 0xffffu); *(LAS bf16_t*)((LAS unsigned char*)vt + AT_VSTR) = (bf16_t)(vw.x >> 16);
            *(LAS bf16_t*)((LAS unsigned char*)vt + 2 * AT_VSTR) = (bf16_t)(vw.y & 0xffffu); *(LAS bf16_t*)((LAS unsigned char*)vt + 3 * AT_VSTR) = (bf16_t)(vw.y >> 16);
            *(LAS bf16_t*)((LAS unsigned char*)vt + 4 * AT_VSTR) = (bf16_t)(vw.z & 0xffffu); *(LAS bf16_t*)((LAS unsigned char*)vt + 5 * AT_VSTR) = (bf16_t)(vw.z >> 16);
            *(LAS bf16_t*)((LAS unsigned char*)vt + 6 * AT_VSTR) = (bf16_t)(vw.w & 0xffffu); *(LAS bf16_t*)((LAS unsigned char*)vt + 7 * AT_VSTR) = (bf16_t)(vw.w >> 16); }
        for (int i = tid; i < 2 * 257; i += 512) { const int hh = i >= 257 ? 1 : 0, rr = i - 257 * hh; ((LAS float*)(lds + AT_B))[hh * 260 + rr] = rb[c_bucket[rr] * NHEAD + 4 * hk + 2 * gh + hh]; }
        __syncthreads();
        const int hh = wave >> 2, head = 4 * hk + 2 * gh + hh, qt = wave & 3, qi = 32 * qt + r32, pq = 128 * nb - 112 + qi; const bool qok = pq >= 0;
        const LAS float* bias = (const LAS float*)(lds + AT_B) + hh * 260;
        bf16x8 qf[4];
        { const bf16_t* qp = P + (size_t)(base + (qok ? pq : 0)) * INW + C_Q + 64 * head + 8 * hi; u32x4 qw[4]; float ss = 0.f;
#pragma unroll
          for (int ds = 0; ds < 4; ++ds) { qw[ds] = *(const u32x4*)(qp + 16 * ds); float f[8]; unpack8(qw[ds], f);
#pragma unroll
              for (int e = 0; e < 8; ++e) ss += f[e] * f[e]; }
          ss += shx(ss, 32, lane);
          const float rs = 0.125f / sqrtf(ss * (1.f / 64) + EPS);
#pragma unroll
          for (int ds = 0; ds < 4; ++ds) { float f[8]; unpack8(qw[ds], f); const float* g = qg + 16 * ds + 8 * hi; u32x4 o;
              o.x = pk2(f[0] * rs * g[0], f[1] * rs * g[1]); o.y = pk2(f[2] * rs * g[2], f[3] * rs * g[3]); o.z = pk2(f[4] * rs * g[4], f[5] * rs * g[5]); o.w = pk2(f[6] * rs * g[6], f[7] * rs * g[7]);
              qf[ds] = __builtin_bit_cast(bf16x8, o); } }
        float m = sink[head], lp = hi == 0 ? 1.f : 0.f;
        f32x16 o0 = {}, o1 = {};
        for (int kt = qt; kt <= qt + 8; ++kt) {
            f32x16 st = {};
#pragma unroll
            for (int ds = 0; ds < 4; ++ds) { const int key = 32 * kt + r32, chn = 2 * ds + hi;
                const bf16x8 kfr = *(const LAS bf16x8*)(lds + AT_K + key * 128 + ((chn ^ (key & 7)) << 4));
                st = __builtin_amdgcn_mfma_f32_32x32x16_bf16(kfr, qf[ds], st, 0, 0, 0); }
            float tmax = -1e30f;
#pragma unroll
            for (int i = 0; i < 16; ++i) { const int kj = 32 * kt + (i & 3) + 8 * (i >> 2) + 4 * hi, rel = kj - 128 - qi, pk = pk0 + kj;
                const bool ok = rel >= -128 && rel <= 128 && pk >= 0 && pk < L;
                const float v = ok ? st[i] + bias[rel + 128 < 0 ? 0 : (rel + 128 > 256 ? 256 : rel + 128)] : -1e30f;
                st[i] = v; tmax = fmaxf(tmax, v); }
            tmax = fmaxf(tmax, shx(tmax, 32, lane));
            const float mn = fmaxf(m, tmax), f = __expf(m - mn); m = mn;
            float ps = 0.f;
#pragma unroll
            for (int i = 0; i < 16; ++i) { st[i] = __expf(st[i] - mn); ps += st[i]; }
            lp = lp * f + ps;
#pragma unroll
            for (int i = 0; i < 16; ++i) { o0[i] *= f; o1[i] *= f; }
#pragma unroll
            for (int s2 = 0; s2 < 2; ++s2) {
                u32x4 pw; pw.x = pk2(st[8 * s2], st[8 * s2 + 1]); pw.y = pk2(st[8 * s2 + 2], st[8 * s2 + 3]); pw.z = pk2(st[8 * s2 + 4], st[8 * s2 + 5]); pw.w = pk2(st[8 * s2 + 6], st[8 * s2 + 7]);
                const bf16x8 pf = __builtin_bit_cast(bf16x8, pw);
#pragma unroll
                for (int dt = 0; dt < 2; ++dt) { const LAS unsigned char* vp = lds + AT_V + (32 * dt + r32) * AT_VSTR + (32 * kt + 16 * s2 + 4 * hi) * 2;
                    const u32x2 a0 = *(const LAS u32x2*)vp, a1 = *(const LAS u32x2*)(vp + 16);
                    const bf16x8 vf = __builtin_bit_cast(bf16x8, (u32x4){a0.x, a0.y, a1.x, a1.y});
                    if (dt == 0) o0 = __builtin_amdgcn_mfma_f32_32x32x16_bf16(vf, pf, o0, 0, 0, 0); else o1 = __builtin_amdgcn_mfma_f32_32x32x16_bf16(vf, pf, o1, 0, 0, 0); }
            }
        }
        const float il = (DBG & 4) ? 0.f : 1.f / (lp + shx(lp, 32, lane));
        if (qok && !F.dry) { bf16_t* op = P + (size_t)(base + pq) * INW + C_Q + 64 * head + 4 * hi;
#pragma unroll
            for (int g = 0; g < 4; ++g) { u32x2 w0, w1; w0.x = pk2(o0[4 * g] * il, o0[4 * g + 1] * il); w0.y = pk2(o0[4 * g + 2] * il, o0[4 * g + 3] * il);
                w1.x = pk2(o1[4 * g] * il, o1[4 * g + 1] * il); w1.y = pk2(o1[4 * g + 2] * il, o1[4 * g + 3] * il);
                *(u32x2*)(op + 8 * g) = w0; *(u32x2*)(op + 32 + 8 * g) = w1; } }
        __syncthreads();
    }
}
__device__ __forceinline__ void dwconv8(const bf16_t* P, int r, int col, const float* cw, const float* cb, int ucol, float* out) {
    const int s = seq_of_row(r), p = r - seq_base(s); const bool hasp = p > 0, hasn = p < seq_len(s) - 1;
    const bf16_t* gp = P + (size_t)r * INW + col;
    const u32x4 gm = *(const u32x4*)(gp - (hasp ? INW : 0)), g0 = *(const u32x4*)gp, gn = *(const u32x4*)(gp + (hasn ? INW : 0));
    float fm[8], f0[8], fn[8]; unpack8(gm, fm); unpack8(g0, f0); unpack8(gn, fn);
    const float mp_ = hasp ? 1.f : 0.f, mn_ = hasn ? 1.f : 0.f;
#pragma unroll
    for (int e = 0; e < 8; ++e) { fm[e] *= mp_; fn[e] *= mn_; }
#pragma unroll
    for (int e = 0; e < 8; ++e) out[e] = cw[ucol + e] * fm[e] + cw[1536 + ucol + e] * f0[e] + cw[2 * 1536 + ucol + e] * fn[e] + cb[ucol + e];
}
__device__ __forceinline__ void p_h1(const CArgs& A, const Frame& F, int layer) {
    const bf16_t* P = (const bf16_t*)(F.ws + WS_PROJ); bf16_t* ZT = (bf16_t*)(F.ws + WS_XNR);
    const float* cw = FIN(9) + (size_t)layer * 3 * 1536; const float* cb = FIN(10) + layer * 1536;
    LAS bf16_t* scr = (LAS bf16_t*)(F.lds + F.wave * 16384);
    const int gw = F.vcu * NWAVES + F.wave, NGW = F.G * NWAVES, lane = F.lane, rs = lane >> 3, ck = lane & 7;
    for (int it = gw; it < (MP / 64) * 8; it += NGW) {
        const int rt = it >> 3, cc = it & 7, c0 = cc * 64 + ck * 8;
#pragma unroll 4
        for (int i8 = 0; i8 < 8; ++i8) { const int lr = i8 * 8 + rs, r = rt * 64 + lr; float z[8];
            if (r < MROWS) { float a[8], b[8]; dwconv8(P, r, C_X1 + c0, cw, cb, 512 + c0, a); dwconv8(P, r, C_VV + c0, cw, cb, 1024 + c0, b);
#pragma unroll
                for (int e = 0; e < 8; ++e) z[e] = a[e] * b[e]; }
            else {
#pragma unroll
                for (int e = 0; e < 8; ++e) z[e] = 0.f; }
#pragma unroll
            for (int e = 0; e < 8; ++e) scr[(ck * 8 + e) * 72 + lr] = (bf16_t)f2bf(z[e]); }
        LDS_WAIT();
#pragma unroll
        for (int j = 0; j < 8; ++j) { const int chn = (lane >> 3) + 8 * j, pc = lane & 7;
            const u32x4 w = *(const LAS u32x4*)(scr + chn * 72 + pc * 8);
            *(u32x4*)(ZT + (size_t)(cc * 64 + chn) * MP + rt * 64 + pc * 8) = w; }
        LDS_WAIT();
    }
}

__device__ __forceinline__ void p_h2_ref(const CArgs& A, const Frame& F) {
    const bf16_t* ZT = (const bf16_t*)(F.ws + WS_XNR); bf16_t* CT = (bf16_t*)(F.ws + WS_XNR + (size_t)512 * MP * 2);
    const int gt = (F.vcu * NWAVES + F.wave) * 64 + F.lane, NGT = F.G * NWAVES * 64;
    for (long idx = gt; idx < (long)512 * MP; idx += NGT) {
        const int c = (int)(idx / MP), r = (int)(idx - (long)c * MP);
        float acc = 0.f;
        if (r < MROWS) {
            const int s = seq_of_row(r), base = seq_base(s), L = seq_len(s), p = r - base, cls = s < 8 ? 0 : 1;
            const bf16_t* rk = (const bf16_t*)(F.ws + (cls ? WS_RKS : WS_RKP)) + (size_t)c * (cls ? RKLEN_S : RKLEN_P) + RK_PAD + L - p;
            const bf16_t* z = ZT + (size_t)c * MP + base;
            for (int s8 = 0; s8 < L; s8 += 8) { const u32x4 zw = *(const u32x4*)(z + s8); float zf[8]; unpack8(zw, zf);
#pragma unroll
                for (int e = 0; e < 8; ++e) acc += zf[e] * __uint_as_float((unsigned)rk[s8 + e] << 16); }
        }
        CT[idx] = (bf16_t)f2bf(acc);
    }
}
constexpr int H2_ZOFF_S = ((RKLEN_S * 2 + 1023) >> 10) << 10, H2_ZOFF_P = ((RKLEN_P * 2 + 1023) >> 10) << 10;
constexpr int H2_ZPADL_S = 4096, H2_ZSLOTS_S = 24704, H2_ZPADL_P = 512, H2_ZSLOTS_P = 3072, H2_SZP = 6976;
static_assert(H2_ZOFF_S + (H2_ZSLOTS_S + (H2_ZSLOTS_S >> 7) * 16) * 2 <= RING_BYTES_C && H2_ZOFF_P + 8 * H2_SZP <= RING_BYTES_C, "H2 LDS");
__device__ __forceinline__ void p_h2(const Frame& F) {
    const bf16_t* ZT = (const bf16_t*)(F.ws + WS_XNR); bf16_t* CT = (bf16_t*)(F.ws + WS_XNR + (size_t)512 * MP * 2);
    const int lane = F.lane, wave = F.wave, tid = F.tid;
    LAS float* red = (LAS float*)(F.lds + LDSCTL_OFF_C + 1024);
    for (int item = F.vcu; item < 1024; item += F.G) {
        const int cls = item < 512 ? 1 : 0, c = item & 511;
        const int L = cls ? LS : LP, rklen = cls ? RKLEN_S : RKLEN_P, ZPADL = cls ? H2_ZPADL_S : H2_ZPADL_P, zs8 = (cls ? H2_ZSLOTS_S : H2_ZSLOTS_P) / 8;
        LAS unsigned char* rkl = F.lds; LAS unsigned char* zl = F.lds + (cls ? H2_ZOFF_S : H2_ZOFF_P);
        {
          const char* rkg = (const char*)((const bf16_t*)(F.ws + (cls ? WS_RKS : WS_RKP)) + (size_t)c * rklen);
          const int npc = (rklen * 2 + 1023) >> 10;
          for (int pc = wave; pc < npc; pc += NWAVES)
              __builtin_amdgcn_global_load_lds((const unsigned*)(rkg + (size_t)pc * 1024 + lane * 16), (LAS unsigned*)(rkl + pc * 1024), 16, 0, 0);
          const int nsl = (cls ? 1 : 8) * zs8; u32x4 zv[7];
#pragma unroll
          for (int j = 0; j < 7; ++j) { const int i = tid + j * (NWAVES * 64); const int sq = i / zs8, i8 = i - sq * zs8, sp = i8 * 8 - ZPADL;
              zv[j] = (u32x4){0u, 0u, 0u, 0u};
              if (i < nsl && sp >= 0 && sp < L) zv[j] = *(const u32x4*)(ZT + (size_t)c * MP + (cls ? ROWS_P : sq * LP) + sp); }
#pragma unroll
          for (int j = 0; j < 7; ++j) { const int i = tid + j * (NWAVES * 64); const int sq = i / zs8, i8 = i - sq * zs8; const int pos = i8 * 8, el = pos + ((pos >> 7) << 4);
              if (i < nsl) *(LAS u32x4*)(zl + sq * H2_SZP + el * 2) = zv[j]; }
          asm volatile("s_waitcnt vmcnt(0)" ::: "memory"); }
        __syncthreads();
        const int n = lane & 15, h = lane >> 4, cg = wave & 3, us = wave >> 2;
        int T0a, zb, T0min, T0max, rowbase;
        const int T0g = cls ? 128 * 16 : 256; const int zg1 = (T0g + (T0g >> 7) * 16) * 2;
        if (cls) { T0min = 16 + 128 * 32 * cg; T0max = T0min + 128 * 31; T0a = T0min + 128 * n; zb = 0; rowbase = ROWS_P; }
        else { const int sq = n >> 1; T0min = 16 + 512 * cg; T0max = T0min + 384; T0a = T0min + 128 * (n & 1); zb = sq * H2_SZP; rowbase = sq * LP; }
        const int u_lo = -(((T0max + 7 + 31) >> 5) << 5), u_hi = ((L - 32 - T0min + 31) >> 5) << 5;
        const int nst = (u_hi - u_lo) / 32 + 1, nh = (nst + 1) >> 1;
        const int u_a = us ? u_lo + 32 * nh : u_lo, u_b = us ? u_hi : u_lo + 32 * (nh - 1);
        const int abase = RK_PAD + L - 8 * n + 8 * h;
        f32x4 acc[2][8];
#pragma unroll
        for (int g = 0; g < 2; ++g)
#pragma unroll
            for (int t = 0; t < 8; ++t) acc[g][t] = (f32x4){0.f, 0.f, 0.f, 0.f};
#define H2_STEP(V0, V1) do { \
            const LAS unsigned char* ap = rkl + (abase + u) * 2; \
            const u32x4 Lo = *(const LAS u32x4*)(ap - 16), Hi = *(const LAS u32x4*)ap; \
            bf16x8 Bz[2]; \
            { const int i0 = T0a + u + 8 * h + ZPADL, e0 = i0 + ((i0 >> 7) << 4); const LAS unsigned char* zp = zl + zb + e0 * 2; \
              if (V0) Bz[0] = *(const LAS bf16x8*)zp; if (V1) Bz[1] = *(const LAS bf16x8*)(zp + zg1); } \
            unsigned W[8] = {Lo.x, Lo.y, Lo.z, Lo.w, Hi.x, Hi.y, Hi.z, Hi.w}, Od[7]; \
            _Pragma("unroll") for (int k = 0; k < 7; ++k) Od[k] = __builtin_amdgcn_alignbit(W[k + 1], W[k], 16); \
            _Pragma("unroll") for (int t = 0; t < 8; ++t) { const int i = 4 - ((t + 1) >> 1); \
                const u32x4 fw = (t & 1) ? (u32x4){Od[i], Od[i + 1], Od[i + 2], Od[i + 3]} : (u32x4){W[i], W[i + 1], W[i + 2], W[i + 3]}; \
                const bf16x8 Af = __builtin_bit_cast(bf16x8, fw); \
                if (V0) acc[0][t] = __builtin_amdgcn_mfma_f32_16x16x32_bf16(Af, Bz[0], acc[0][t], 0, 0, 0); \
                if (V1) acc[1][t] = __builtin_amdgcn_mfma_f32_16x16x32_bf16(Af, Bz[1], acc[1][t], 0, 0, 0); } } while (0)
        { const int gspan = cls ? 128 * 15 : 128;
          int u0s = -(T0min + gspan + 39); u0s = u0s >= 0 ? ((u0s + 31) >> 5) << 5 : -((-u0s) >> 5 << 5);
          int u1e = L - (T0min + T0g); u1e = u1e >= 0 ? ((u1e + 31) >> 5) << 5 : -((-u1e) >> 5 << 5);
          const int ua2 = u0s > u_a ? (u0s < u_b + 32 ? u0s : u_b + 32) : u_a;
          const int ub2 = u1e < u_b + 32 ? (u1e > ua2 ? u1e : ua2) : u_b + 32;
          int u = u_a;
          for (; u < ua2; u += 32) H2_STEP(false, true);
          for (; u < ub2; u += 32) H2_STEP(true, true);
          for (; u <= u_b; u += 32) H2_STEP(true, false); }
#undef H2_STEP
        { float m[16];
#pragma unroll
          for (int t = 0; t < 16; ++t) m[t] = 0.f;
          const int nchunk = L / 8, cstep = cls ? NWAVES * 64 : 64; const int zb2 = cls ? 0 : wave * H2_SZP;
          for (int ck = cls ? tid : lane; ck < nchunk; ck += cstep) { const int s0 = ck * 8, i0 = s0 + ZPADL, e0 = i0 + ((i0 >> 7) << 4);
              const u32x4 zw = *(const LAS u32x4*)(zl + zb2 + e0 * 2);
              const LAS unsigned char* rp = rkl + (RK_PAD + L + s0 - 16) * 2;
              const u32x4 r0 = *(const LAS u32x4*)rp, r1 = *(const LAS u32x4*)(rp + 16), r2 = *(const LAS u32x4*)(rp + 32);
              float zf[8], rf[24]; unpack8(zw, zf); unpack8(r0, rf); unpack8(r1, rf + 8); unpack8(r2, rf + 16);
#pragma unroll
              for (int t = 0; t < 16; ++t)
#pragma unroll
                  for (int e = 0; e < 8; ++e) m[t] += zf[e] * rf[16 + e - t]; }
#pragma unroll
          for (int t = 0; t < 16; ++t) m[t] = wave_sum(m[t], lane);
          float mine = 0.f;
#pragma unroll
          for (int t = 0; t < 16; ++t) mine = (lane == t) ? m[t] : mine;
          if (cls) { if (lane < 16) red[wave * 16 + lane] = mine; }
          else if (lane < 16) CT[(size_t)c * MP + wave * LP + lane] = (bf16_t)f2bf(mine); }
        __syncthreads();
        if (us == 1) {
#pragma unroll
            for (int g = 0; g < 2; ++g)
#pragma unroll
                for (int t = 0; t < 8; ++t) *(LAS f32x4*)(F.lds + cg * 16384 + (g * 8 + t) * 1024 + lane * 16) = acc[g][t]; }
        if (cls && tid < 16) { float a = 0.f;
#pragma unroll
            for (int w = 0; w < 8; ++w) a += red[w * 16 + tid];
            CT[(size_t)c * MP + ROWS_P + tid] = (bf16_t)f2bf(a); }
        __syncthreads();
        if (us == 0) {
#pragma unroll
            for (int g = 0; g < 2; ++g) {
#pragma unroll
                for (int t = 0; t < 8; ++t) acc[g][t] += *(const LAS f32x4*)(F.lds + cg * 16384 + (g * 8 + t) * 1024 + lane * 16);
                bf16_t* op = CT + (size_t)c * MP + rowbase + T0a + g * T0g + 32 * h;
#pragma unroll
                for (int i = 0; i < 4; ++i) { u32x4 w; w.x = pk2(acc[g][0][i], acc[g][1][i]); w.y = pk2(acc[g][2][i], acc[g][3][i]); w.z = pk2(acc[g][4][i], acc[g][5][i]); w.w = pk2(acc[g][6][i], acc[g][7][i]);
                    *(u32x4*)(op + 8 * i) = w; } } }
        __syncthreads();
    }
}
__device__ __forceinline__ void p_pool(const CArgs& A, const Frame& F) {
    bf16_t* P = (bf16_t*)(F.ws + WS_PROJ);
    const int gw = F.vcu * NWAVES + F.wave, NGW = F.G * NWAVES, lane = F.lane, c0 = lane * 8, hw = 1 << (lane >> 4);
    for (int run = gw; run < MROWS / 16; run += NGW) {
        const int r0 = run * 16, s = seq_of_row(r0), base = seq_base(s), L = seq_len(s), p0 = r0 - base;
        const bf16_t* ub = P + (size_t)base * INW + C_PU + c0;
        float S[8];
#pragma unroll
        for (int e = 0; e < 8; ++e) S[e] = 0.f;
#pragma unroll
        for (int i = 0; i < 16; ++i) { const int pp = p0 - hw + i; const bool ok = i < 2 * hw && pp >= 0 && pp < L;
            const u32x4 w = *(const u32x4*)(ub + (size_t)(ok ? pp : p0) * INW); float f[8]; unpack8(w, f); const float mk = ok ? 1.f : 0.f;
#pragma unroll
            for (int e = 0; e < 8; ++e) S[e] += mk * f[e]; }
#pragma unroll 4
        for (int k = 0; k < 16; ++k) { const int p = p0 + k, pn = p + hw, po = p - hw; const bool okn = pn < L, oko = po >= 0;
            const u32x4 ws_ = *(const u32x4*)(ub + (size_t)p * INW), wn = *(const u32x4*)(ub + (size_t)(okn ? pn : p) * INW), wo = *(const u32x4*)(ub + (size_t)(oko ? po : p) * INW);
            float fs[8], fn[8], fo[8]; unpack8(ws_, fs); unpack8(wn, fn); unpack8(wo, fo);
            const int lo = po < 0 ? 0 : po, hi = pn > L ? L : pn; const float ic = 1.f / (float)(hi - lo);
            float a[8];
#pragma unroll
            for (int e = 0; e < 8; ++e) a[e] = (DBG & 16) ? 0.f : S[e] * ic - fs[e];
            u32x4 w; w.x = pk2(a[0], a[1]); w.y = pk2(a[2], a[3]); w.z = pk2(a[4], a[5]); w.w = pk2(a[6], a[7]);
            *(u32x4*)(P + (size_t)(r0 + k) * INW + C_X1 + c0) = w;
            const float mn = okn ? 1.f : 0.f, mo = oko ? 1.f : 0.f;
#pragma unroll
            for (int e = 0; e < 8; ++e) S[e] += mn * fn[e] - mo * fo[e]; }
    }
}
__device__ __forceinline__ void p_final(const CArgs& A, const Frame& F, int layer) {
    bf16_t* P = (bf16_t*)(F.ws + WS_PROJ); const bf16_t* ZT = (const bf16_t*)(F.ws + WS_XNR); const bf16_t* CT = ZT + (size_t)512 * MP;
    const float* cw = FIN(9) + (size_t)layer * 3 * 1536; const float* cb = FIN(10) + layer * 1536; const float* skip = FIN(17) + layer * 512;
    LAS bf16_t* sz = (LAS bf16_t*)(F.lds + F.wave * 16384); LAS bf16_t* sc = sz + 64 * 64;
    const int gw = F.vcu * NWAVES + F.wave, NGW = F.G * NWAVES, lane = F.lane, rs = lane >> 3, ck = lane & 7;
    for (int it = gw; it < (MP / 64) * 8; it += NGW) {
        const int rt = it >> 3, cc = it & 7, c0 = cc * 64 + ck * 8; const int cls = rt * 64 < ROWS_P ? 0 : 1;
        const float* sums = (const float*)(F.ws + WS_CTL) + CW_SUMS + (layer * 2 + cls) * 512;
#pragma unroll
        for (int j = 0; j < 8; ++j) { const int chn = (lane >> 3) + 8 * j, pc = lane & 7; const size_t off = (size_t)(cc * 64 + chn) * MP + rt * 64 + pc * 8;
            *(LAS u32x4*)(sz + chn * 64 + pc * 8) = *(const u32x4*)(ZT + off); *(LAS u32x4*)(sc + chn * 64 + pc * 8) = *(const u32x4*)(CT + off); }
        LDS_WAIT();
#pragma unroll 4
        for (int i8 = 0; i8 < 8; ++i8) { const int lr = i8 * 8 + rs, r = rt * 64 + lr;
            if (r < MROWS) { float x0[8]; dwconv8(P, r, C_X0 + c0, cw, cb, c0, x0); float o[8];
#pragma unroll
                for (int e = 0; e < 8; ++e) { const float z = __uint_as_float((unsigned)sz[(ck * 8 + e) * 64 + lr] << 16), cv = __uint_as_float((unsigned)sc[(ck * 8 + e) * 64 + lr] << 16);
                    o[e] = (DBG & 8) ? 0.f : (((DBG & 64) ? 0.f : cv / sums[c0 + e]) + ((DBG & 128) ? 0.f : z * skip[c0 + e])) * x0[e]; }
                u32x4 w; w.x = pk2(o[0], o[1]); w.y = pk2(o[2], o[3]); w.z = pk2(o[4], o[5]); w.w = pk2(o[6], o[7]);
                *(u32x4*)(P + (size_t)r * INW + C_VV + c0) = w; } }
        LDS_WAIT();
    }
}
__device__ __forceinline__ void p_norm2(const CArgs& A, const Frame& F, int layer) {
    const int gw = F.vcu * NWAVES + F.wave, NGW = F.G * NWAVES, lane = F.lane;
    const float* g = FIN(24) + layer * DM; bf16_t* XN = (bf16_t*)(F.ws + WS_XNR);
    for (int r0 = gw; r0 < MP; r0 += 2 * NGW) { f32x4 v[2][4]; const int r1 = r0 + NGW;
        { const f32x4* xr = (const f32x4*)xrow(F.out, F.xm, r0) + lane;
#pragma unroll
          for (int j = 0; j < 4; ++j) v[0][j] = xr[64 * j]; }
        if (r1 < MP) { const f32x4* xr = (const f32x4*)xrow(F.out, F.xm, r1) + lane;
#pragma unroll
          for (int j = 0; j < 4; ++j) v[1][j] = xr[64 * j]; }
        rms_row(v[0], g, XN + (size_t)r0 * DM, lane);
        if (r1 < MP) rms_row(v[1], g, XN + (size_t)r1 * DM, lane); }
}

constexpr int TAIL_ROW0 = 32768, TAIL_ITEMS = ((MROWS - TAIL_ROW0) / 16) * 16;
static_assert(MROWS - TAIL_ROW0 == 144 && TAIL_ROW0 % 256 == 0, "tail rows");
template <int NS>
__device__ __forceinline__ void tail_partial(f32x4 (&acc)[4], const bf16_t* ap, const bf16_t* bp, size_t bstride16) {
#pragma unroll
    for (int s0 = 0; s0 < NS; s0 += 4) {
        bf16x8 a[4], b[4][4];
#pragma unroll
        for (int s = 0; s < 4; ++s) if (s0 + s < NS) { a[s] = *(const bf16x8*)(ap + (s0 + s) * 32);
#pragma unroll
            for (int j = 0; j < 4; ++j) b[s][j] = *(const bf16x8*)(bp + j * bstride16 + (s0 + s) * 32); }
#pragma unroll
        for (int s = 0; s < 4; ++s) if (s0 + s < NS) {
#pragma unroll
            for (int j = 0; j < 4; ++j) acc[j] = __builtin_amdgcn_mfma_f32_16x16x32_bf16(b[s][j], a[s], acc[j], 0, 0, 0); }
        asm volatile("" ::: "memory");
    }
}
template <int K>
__device__ __forceinline__ void tail_res(const Frame& F, const bf16_t* A, const bf16_t* Bt) {
    constexpr int KW = K / 8, NS = KW / 32; static_assert(K % 256 == 0, "K split");
    const int lane = F.lane, fr = lane & 15, fq = lane >> 4, tid = F.tid;
    for (int item = F.bx; item < TAIL_ITEMS; item += F.G) {
        const int row0 = TAIL_ROW0 + (item >> 4) * 16, col0 = (item & 15) * 64;
        f32x4 acc[4];
#pragma unroll
        for (int j = 0; j < 4; ++j) acc[j] = (f32x4){0.f, 0.f, 0.f, 0.f};
        tail_partial<NS>(acc, A + (size_t)(row0 + fr) * K + F.wave * KW + fq * 8, Bt + (size_t)(col0 + fr) * K + F.wave * KW + fq * 8, (size_t)16 * K);
#pragma unroll
        for (int j = 0; j < 4; ++j) *(LAS f32x4*)(F.lds + F.wave * 4096 + j * 1024 + lane * 16) = acc[j];
        __syncthreads();
        f32x2 s = {0.f, 0.f};
#pragma unroll
        for (int w = 0; w < 8; ++w) s += *(const LAS f32x2*)(F.lds + w * 4096 + tid * 8);
        const int j = tid >> 7, l = (tid & 127) >> 1, r = (tid & 1) * 2;
        float* p = xrow(F.out, F.xm, row0 + (l & 15)) + col0 + j * 16 + 4 * (l >> 4) + r;
        f32x2 v = *(f32x2*)p; v += s; if (!F.dry) *(f32x2*)p = v;
        __syncthreads();
    }
}
__device__ __forceinline__ void tail_merge(const Frame& F, const bf16_t* P, const bf16_t* WM, bf16_t* O) {
    const int lane = F.lane, fr = lane & 15, fq = lane >> 4, tid = F.tid;
    for (int item = F.bx; item < TAIL_ITEMS; item += F.G) {
        const int row0 = TAIL_ROW0 + (item >> 4) * 16, col0 = (item & 15) * 64;
#pragma unroll
        for (int s = 0; s < 3; ++s) { const int col = s == 0 ? C_Q : (s == 1 ? C_VV : C_X1);
            f32x4 acc[4];
#pragma unroll
            for (int j = 0; j < 4; ++j) acc[j] = (f32x4){0.f, 0.f, 0.f, 0.f};
            tail_partial<2>(acc, P + (size_t)(row0 + fr) * INW + col + F.wave * 64 + fq * 8, WM + ((size_t)s * DM + col0 + fr) * 512 + F.wave * 64 + fq * 8, (size_t)16 * 512);
#pragma unroll
            for (int j = 0; j < 4; ++j) *(LAS f32x4*)(F.lds + s * 32768 + F.wave * 4096 + j * 1024 + lane * 16) = acc[j]; }
        __syncthreads();
        const int j = tid >> 7, l = (tid & 127) >> 1, r = (tid & 1) * 2, row = row0 + (l & 15), colo = col0 + j * 16 + 4 * (l >> 4) + r;
        const unsigned char* gp = (const unsigned char*)(P + (size_t)row * INW) + C_G * 2 + colo;
        f32x2 o = {0.f, 0.f};
#pragma unroll
        for (int s = 0; s < 3; ++s) { f32x2 t = {0.f, 0.f};
#pragma unroll
            for (int w = 0; w < 8; ++w) t += *(const LAS f32x2*)(F.lds + s * 32768 + w * 4096 + tid * 8);
            const unsigned g2 = *(const unsigned short*)(gp + s * DM);
            o.x += t.x * ((float)(g2 & 255u) * (1.f / 255.f)); o.y += t.y * ((float)(g2 >> 8) * (1.f / 255.f)); }
        *(unsigned*)(O + (size_t)row * DM + colo) = pg8::cvt_pk_bf16(o.x, o.y);
        __syncthreads();
    }
}

constexpr int PH_PER_LAYER = 11, N_PHASES = 2 * PH_PER_LAYER;
__global__ void __launch_bounds__(NWAVES * 64, 2) fwd_kernel(Args args0) {
    extern __shared__ __attribute__((aligned(16))) unsigned char lds_raw[];
    const int wave0 = __builtin_amdgcn_readfirstlane(threadIdx.x >> 6);
    {
        for (int u = threadIdx.x; u < (LDS_BYTES - LDSCTL_OFF) / 4; u += NWAVES * 64) ((LAS unsigned*)((LAS unsigned char*)lds_raw + LDSCTL_OFF))[u] = 0u;
        __syncthreads();
    }
    XcdBarrier bar; bar.bar = (unsigned*)(args0.ws + WS_CTL) + CW_BAR; bar.x = 0; bar.st = nullptr;
    if (args0.use_bar) bar = xcd_barrier_post((unsigned*)(args0.ws + WS_CTL) + CW_BAR, (volatile LAS unsigned*)((LAS unsigned char*)lds_raw + MISC_OFF) + 8);
    for (int ph2 = 2 * args0.ph_lo; ph2 < 2 * args0.ph_hi; ++ph2) {
        const int ph = ph2 >> 1, rep = ph2 & 1;
        const int layer = ph / PH_PER_LAYER, k = ph % PH_PER_LAYER;
        if (rep == 1 && !(DUP_PHASE >= 0 && k == DUP_PHASE && args0.pad == 0)) continue;
        const __attribute__((address_space(4))) Args* ap = (const __attribute__((address_space(4))) Args*)__builtin_amdgcn_kernarg_segment_ptr();
        asm volatile("" : "+s"(ap));
        const __attribute__((address_space(4))) Args& args = *ap;
        Frame F;
        { int w_ = wave0; asm volatile("" : "+s"(w_)); int z_ = 0; asm volatile("" : "+v"(z_)); const int l_ = __builtin_amdgcn_mbcnt_hi(-1, __builtin_amdgcn_mbcnt_lo(-1, z_));
          F.lane = l_; F.wave = w_; F.tid = w_ * 64 + l_;
          int bx = blockIdx.x, G_ = gridDim.x; asm volatile("" : "+s"(bx), "+s"(G_)); F.G = G_; F.vcu = (G_ % 8 == 0) ? (bx % 8) * (G_ / 8) + bx / 8 : bx; F.bx = bx;
          F.dry = rep; F.lds = (LAS unsigned char*)lds_raw; F.ws = args.ws; F.out = args.out; F.xm = (float*)(args.ws + WS_XM); }
        unsigned char* W = F.ws + WS_W;
        bf16_t* XNR = (bf16_t*)(F.ws + WS_XNR); bf16_t* PROJ = (bf16_t*)(F.ws + WS_PROJ);
        bf16_t* GB = PROJ; bf16_t* ACT = PROJ + (size_t)MP * DFF;
#ifndef ONLY_PHASE
#define ONLY_PHASE -1
#endif
#define PHS(x) ((ONLY_PHASE < 0 || ONLY_PHASE == (x)) && k == (x) && !((DBG & 1) && (x) >= 1 && (x) <= 6) && !((DBG & 2) && (x) >= 7) && !((DBG & 32) && layer > 0))
        if (PHS(0)) p_prep(args, F, layer);
        else if (PHS(1)) { OpsPlain O{XNR, (const bf16_t*)(W + W_IN), DM, DM}; pg8::StaticOrder S; S.init(MP, INW, F.G, F.bx, 1); EpiStore E{PROJ, INW, C_G / 256};
            pg8::gemm_phase<EpiStore, OpsPlain, true>(F.lds, O, S, E, F.tid); }
        else if (PHS(2)) { if (DBG & 512) p_attn_ref(args, F, layer); else p_attn(args, F, layer); p_h1(args, F, layer); p_filt_tiles(args, F, layer); }
        else if (PHS(3)) { if (DBG & 256) p_h2_ref(args, F); else if (DSEL(16)) p_h2(F); if (DSEL(32)) p_pool(args, F); }
        else if (PHS(4)) p_final(args, F, layer);
        else if (PHS(5)) { OpsMerge O{PROJ, (const bf16_t*)(W + W_MRG), 512, INW}; pg8::StaticOrder S; S.init(TAIL_ROW0, DM, F.G, F.bx, 3); EpiMerge E{PROJ, XNR};
            pg8::gemm_phase<EpiMerge, OpsMerge, true>(F.lds, O, S, E, F.tid); tail_merge(F, PROJ, (const bf16_t*)(W + W_MRG), XNR); }
        else if (PHS(6)) { OpsPlain O{XNR, (const bf16_t*)(W + W_OUT), DM, DM}; pg8::StaticOrder S; S.init(TAIL_ROW0, DM, F.G, F.bx, 1); EpiRes E{F.out, F.xm, F.dry};
            pg8::gemm_phase<EpiRes, OpsPlain, true>(F.lds, O, S, E, F.tid); tail_res<DM>(F, XNR, (const bf16_t*)(W + W_OUT)); }
        else if (PHS(7)) p_norm2(args, F, layer);
        else if (PHS(8)) { OpsPlain O{XNR, (const bf16_t*)(W + W_G), DM, DM}; pg8::StaticOrder S; S.init(MP, DFF, F.G, F.bx, 1); EpiStore E{GB, DFF, 1 << 20};
            pg8::gemm_phase<EpiStore, OpsPlain, true>(F.lds, O, S, E, F.tid); }
        else if (PHS(9)) { OpsPlain O{XNR, (const bf16_t*)(W + W_U), DM, DM}; pg8::StaticOrder S; S.init(MP, DFF, F.G, F.bx, 1);
            EpiGeluMul E{GB, args.in[27] + (size_t)layer * 3 * DFF, args.in[28] + layer * DFF, ACT, F.dry ? DRYVAR : 0};
            pg8::gemm_phase<EpiGeluMul, OpsPlain, true>(F.lds, O, S, E, F.tid); }
        else if (PHS(10)) { OpsPlain O{ACT, (const bf16_t*)(W + W_D), DFF, DFF}; pg8::StaticOrder S; S.init(TAIL_ROW0, DM, F.G, F.bx, 1); EpiRes E{F.out, F.xm, F.dry};
            pg8::gemm_phase<EpiRes, OpsPlain, true>(F.lds, O, S, E, F.tid); tail_res<DFF>(F, ACT, (const bf16_t*)(W + W_D)); }
        if (ph2 + 1 < 2 * args0.ph_hi) { { int z2_ = 0; asm volatile("" : "+v"(z2_)); const int tid2 = wave0 * 64 + __builtin_amdgcn_mbcnt_hi(-1, __builtin_amdgcn_mbcnt_lo(-1, z2_));
              if (args0.use_bar) xcd_barrier(bar, tid2); else __syncthreads(); } }
    }
}

__global__ void fill_k(float* o, size_t n, float v) { size_t i = (size_t)blockIdx.x * blockDim.x + threadIdx.x; for (; i < n; i += (size_t)gridDim.x * blockDim.x) o[i] = v; }
extern "C" void kernel_launch(void* const* d_in, const int* in_sizes, int n_in, void* d_out, int out_size, void* d_ws, size_t ws_size, hipStream_t stream) {
    static int grid = 0;
    if (grid == 0) {
        int dev = 0, cus = 0;
        if (n_in != 30 || out_size != 32768 * DM || ws_size < WS_END || hipGetDevice(&dev) != hipSuccess || hipDeviceGetAttribute(&cus, hipDeviceAttributeMultiprocessorCount, dev) != hipSuccess ||
            hipFuncSetAttribute((const void*)fwd_kernel, hipFuncAttributeMaxDynamicSharedMemorySize, LDS_BYTES) != hipSuccess) { fprintf(stderr, "kernel_launch: bad shapes / workspace / device\n"); grid = -1; }
        else { int per_cu = 0; (void)hipOccupancyMaxActiveBlocksPerMultiprocessor(&per_cu, (const void*)fwd_kernel, NWAVES * 64, LDS_BYTES); (void)hipGetLastError();
            grid = cus * (per_cu >= 1 ? 1 : 0); if (grid <= 0) grid = -1; }
    }
    if (grid < 0) { fill_k<<<1024, 256, 0, stream>>>((float*)d_out, (size_t)out_size, 1e6f); return; }
    (void)hipMemsetAsync((char*)d_ws + WS_CTL, 0, CTL_ZERO_BYTES, stream);
    Args a{};
    for (int i = 0; i < 30; ++i) a.in[i] = (const float*)d_in[i];
    a.out = (float*)d_out; a.ws = (unsigned char*)d_ws;
#if MK_N_LAUNCHES == 1
    a.ph_lo = 0; a.ph_hi = N_PHASES; a.use_bar = 1;
    void* kargs[] = {&a};
    hipError_t e = hipLaunchCooperativeKernel((const void*)fwd_kernel, dim3(grid), dim3(NWAVES * 64), kargs, LDS_BYTES, stream);
    if (e != hipSuccess) fprintf(stderr, "cooperative launch failed: %s\n", hipGetErrorString(e));
#else
    for (int ph = 0; ph < N_PHASES; ++ph) { a.ph_lo = ph; a.ph_hi = ph + 1; a.use_bar = 0;
        hipLaunchKernelGGL(fwd_kernel, dim3(grid), dim3(NWAVES * 64), LDS_BYTES, stream, a); }
#endif
}
```

```cpp
#include <hip/hip_runtime.h>
#include <cstdio>
#include <cstdint>
#include <cmath>

#ifndef DBG
#define DBG 0
#endif
#ifndef DUP_PHASE
#define DUP_PHASE -1
#endif
#ifndef FT_RECOMPUTE
#define FT_RECOMPUTE 0
#endif
#ifndef DRYVAR
#define DRYVAR 0
#endif
#ifndef DUPMASK
#define DUPMASK 65535
#endif
#define DSEL(b) (!F.dry || (DUPMASK & (b)))
#ifndef MK_N_LAUNCHES
#define MK_N_LAUNCHES 1
#endif

#define LAS __attribute__((address_space(3)))
#define GAS __attribute__((address_space(1)))
typedef unsigned short bf16_t;
typedef short bf16x8 __attribute__((ext_vector_type(8)));
typedef float f32x4 __attribute__((ext_vector_type(4)));
typedef float f32x2 __attribute__((ext_vector_type(2)));
typedef float f32x16 __attribute__((ext_vector_type(16)));
typedef unsigned u32x4 __attribute__((ext_vector_type(4)));
typedef unsigned u32x2 __attribute__((ext_vector_type(2)));

constexpr int DM = 1024, INW = 5888, DFF = 2816, NHEAD = 8, HD = 64;
constexpr int LP = 2064, LS = 16400, NMETA = 16;
constexpr int ROWS_P = 8 * LP;
constexpr int MROWS = ROWS_P + LS;
constexpr int MP = 33024;
constexpr int C_Q = 0, C_K = 512, C_V = 640, C_X0 = 768, C_X1 = 1280, C_VV = 1792, C_PU = 2304, C_G = 2816;
constexpr float EPS = 1e-6f;
constexpr int RK_PAD = 256;
constexpr int RKLEN_P = 2 * LP + 512, RKLEN_S = 2 * LS + 512;

constexpr size_t MiB = 1u << 20;
constexpr size_t WS_CTL = 0, CTL_ZERO_BYTES = 1 * MiB;
constexpr size_t WS_XM = 1 * MiB;
constexpr size_t WS_W = 3 * MiB;
constexpr size_t W_IN = 0, W_G = W_IN + (size_t)INW * DM * 2, W_U = W_G + (size_t)DFF * DM * 2, W_D = W_U + (size_t)DFF * DM * 2,
                 W_OUT = W_D + (size_t)DM * DFF * 2, W_MRG = W_OUT + (size_t)DM * DM * 2, W_END = W_MRG + (size_t)3 * DM * 512 * 2;
static_assert(WS_W + W_END <= 36 * MiB, "weights");
constexpr size_t WS_RKP = 36 * MiB;
constexpr size_t WS_RKS = WS_RKP + (size_t)512 * RKLEN_P * 2;
static_assert(WS_RKS + (size_t)512 * RKLEN_S * 2 <= 74 * MiB, "filters");
constexpr size_t WS_XNR = 74 * MiB;
constexpr size_t XNR_BYTES = (size_t)MP * DM * 2;
constexpr size_t WS_PROJ = 139 * MiB;
constexpr size_t WS_END = WS_PROJ + (size_t)MP * INW * 2;
static_assert(WS_XNR + XNR_BYTES <= WS_PROJ && WS_END <= 512 * MiB, "d_ws map");
constexpr int CW_BAR = 4096;
constexpr int CW_SUMS = 16384;

namespace pg8 {
constexpr int BM = 256, BK = 64, HALF = 128, HTB = HALF * BK * 2, STAGE_BYTES = 8 * HTB, NXCD = 8, WGM = 8;
__host__ __device__ __forceinline__ int lds_byte(int r, int c) { const int st = (r >> 4) * 2 + (c >> 5), rr = r & 15, cc = c & 31, ob = rr * 64 + cc * 2; return st * 1024 + (ob ^ (((ob >> 9) & 1) << 5)); }
__host__ __device__ __forceinline__ void stage_rc(int b, int& R, int& C) { const int st = b / 1024, sb = b % 1024, swz = sb ^ (((sb >> 9) & 1) << 5); R = (st >> 1) * 16 + swz / 64; C = (st & 1) * 32 + (swz % 64) / 2; }
__host__ __device__ __forceinline__ int perm32(int rho) { const int n = rho >> 4, i = rho & 15; return 8 * (i >> 2) + 4 * n + (i & 3); }

struct Unit { int pm, pn, sub; };
struct StaticOrder {
    int nM, nN, nwg, G, c, nsub;
    __device__ void init(int M, int N, int G_, int c_, int nsub_) { nM = M / BM; nN = N / BM; nwg = nM * nN; G = G_; c = c_; nsub = nsub_; }
    __device__ bool next(int i, Unit& u) const {
        const int tile = i / nsub; u.sub = i - tile * nsub;
        const long L = (long)tile * G + c; if (L >= nwg) return false;
        int wgid = (int)L; { const int q = nwg / NXCD, r = nwg % NXCD, xcd = wgid % NXCD, off = wgid / NXCD; wgid = (xcd < r ? xcd * (q + 1) : r * (q + 1) + (xcd - r) * q) + off; }
        const int nig = WGM * nN, gid = wgid / nig, fm = gid * WGM, gsz = (nM - fm) < WGM ? (nM - fm) : WGM;
        u.pm = fm + ((wgid % nig) % gsz); u.pn = (wgid % nig) / gsz; return true;
    }
};
__device__ __forceinline__ unsigned cvt_pk_bf16(float lo, float hi) { unsigned r; asm volatile("v_cvt_pk_bf16_f32 %0, %1, %2" : "=v"(r) : "v"(lo), "v"(hi)); return r; }
__device__ __forceinline__ f32x2 gelu_pk(f32x2 v) {
    const f32x2 av = __builtin_elementwise_abs(v), d = av * 0.2316418882f + 1.0f;
    f32x2 t; t.x = __builtin_amdgcn_rcpf(d.x); t.y = __builtin_amdgcn_rcpf(d.y);
    f32x2 q = t * 0.5307027145f + (-0.7265760135f); q = q * t + 0.7107068705f; q = q * t + (-0.142248368f); q = q * t + 0.127414796f; q = q * t;
    const f32x2 s = (v * v) * (-0.72134752044f);
    f32x2 e; e.x = __builtin_amdgcn_exp2f(s.x); e.y = __builtin_amdgcn_exp2f(s.y);
    const f32x2 m = v * (q * e), r = v - m;
    f32x2 o; o.x = v.x < 0.f ? m.x : r.x; o.y = v.y < 0.f ? m.y : r.y; return o;
}

template <class Epi, class Ops, bool ALIGN_EPI>
__device__ __forceinline__ void gemm_phase(LAS unsigned char* lds, const Ops& O, const StaticOrder& S, const Epi& E, int tid) {
    const int wid = __builtin_amdgcn_readfirstlane(tid >> 6), lane = tid & 63, wr = wid >> 2, wc = wid & 3, fr = lane & 15, fq = lane >> 4;
    const int K = O.K, nt = K / BK, lda = O.lda;
    unsigned voffA[2], voffB[2];
#pragma unroll
    for (int i = 0; i < 2; ++i) { int R, C; stage_rc(tid * 16 + i * 8192, R, C); const int Rb = (R & ~31) + perm32(R & 31);
        voffA[i] = (unsigned)(R * lda + C) * 2u; voffB[i] = (unsigned)(Rb * K + C) * 2u; }
    const size_t kstep = (size_t)(BK * 2);
    const size_t hstepA = (size_t)HALF * lda * 2, hstepB = (size_t)HALF * K * 2;
    const unsigned ldsw = (unsigned)wid * 1024u;
    const int aoff = lds_byte(wr * 64 + fr, fq * 8), boff = lds_byte(wc * 32 + fr, fq * 8);
#define PG8_SA(b, h) (((b) * 2 + (h)) * HTB)
#define PG8_SB(b, h) ((4 + (b) * 2 + (h)) * HTB)
#define PG8_STAGE(bufoff, gbase, voff) do { _Pragma("unroll") for (int _i = 0; _i < 2; ++_i) \
        __builtin_amdgcn_global_load_lds((const unsigned*)((const char*)(gbase) + (voff)[_i]), (LAS unsigned*)(lds + (bufoff) + ldsw + _i * 8192), 16, 0, 0); } while (0)
#define PG8_LDA(dst, b, h) do { _Pragma("unroll") for (int m = 0; m < 4; ++m) _Pragma("unroll") for (int k = 0; k < 2; ++k) dst[m][k] = *(const LAS bf16x8*)(lds + PG8_SA(b, h) + aoff + m * 2048 + k * 1024); } while (0)
#define PG8_LDB(dst, b, h) do { _Pragma("unroll") for (int n = 0; n < 2; ++n) _Pragma("unroll") for (int k = 0; k < 2; ++k) dst[n][k] = *(const LAS bf16x8*)(lds + PG8_SB(b, h) + boff + n * 2048 + k * 1024); } while (0)
#define PG8_MMA(ai, bj, At, Bt) do { __builtin_amdgcn_s_setprio(1); _Pragma("unroll") for (int m = 0; m < 4; ++m) _Pragma("unroll") for (int n = 0; n < 2; ++n) _Pragma("unroll") for (int k = 0; k < 2; ++k) \
        acc[ai][bj][m][n] = __builtin_amdgcn_mfma_f32_16x16x32_bf16(Bt[n][k], At[m][k], acc[ai][bj][m][n], 0, 0, 0); __builtin_amdgcn_s_setprio(0); } while (0)
#define PG8_WAIT_V(n) asm volatile("s_waitcnt vmcnt(" #n ")" ::: "memory")
#define PG8_WAIT_L(n) asm volatile("s_waitcnt lgkmcnt(" #n ")" ::: "memory")
#define PG8_BAR __builtin_amdgcn_s_barrier()
#define PG8_SCHED __builtin_amdgcn_sched_barrier(0)
    Unit cur, nxt; int ui = 0;
    if (!S.next(0, cur)) return;
    f32x4 acc[2][2][4][2];
#pragma unroll
    for (int a = 0; a < 2; ++a)
#pragma unroll
        for (int b = 0; b < 2; ++b)
#pragma unroll
            for (int m = 0; m < 4; ++m)
#pragma unroll
                for (int n = 0; n < 2; ++n) acc[a][b][m][n] = (f32x4){0.f, 0.f, 0.f, 0.f};
    bf16x8 At[4][2], B0[2][2], B1[2][2];
    const char* cA; const char* cB; O.ptrs(cur, cA, cB);
    PG8_STAGE(PG8_SB(0, 0), cB, voffB); PG8_STAGE(PG8_SB(0, 1), cB + hstepB, voffB); PG8_STAGE(PG8_SA(0, 0), cA, voffA); PG8_STAGE(PG8_SA(0, 1), cA + hstepA, voffA);
    if (wr == 1) PG8_BAR;
    PG8_WAIT_V(2); PG8_BAR;
    PG8_STAGE(PG8_SB(1, 0), cB + kstep, voffB); PG8_STAGE(PG8_SA(1, 0), cA + kstep, voffA); PG8_STAGE(PG8_SB(1, 1), cB + hstepB + kstep, voffB);
    PG8_WAIT_V(6); PG8_BAR;
    for (;;) {
        const bool has_next = S.next(ui + 1, nxt);
        const char* nA = cA; const char* nB = cB; if (has_next) O.ptrs(nxt, nA, nB);
        for (int t = 0; t < nt; t += 2) {
            const bool last = (t == nt - 2);
            const char* a1 = cA + (size_t)(t + 1) * kstep;
            const char* a2 = last ? nA : cA + (size_t)(t + 2) * kstep; const char* b2 = last ? nB : cB + (size_t)(t + 2) * kstep;
            const char* a3 = a2 + kstep; const char* b3 = b2 + kstep;
            PG8_LDB(B0, 0, 0); PG8_LDB(B1, 0, 1); PG8_SCHED; PG8_LDA(At, 0, 0); PG8_STAGE(PG8_SA(1, 1), a1 + hstepA, voffA);
            PG8_WAIT_V(8); PG8_WAIT_L(0); PG8_BAR; PG8_MMA(0, 0, At, B0); PG8_MMA(0, 1, At, B1); PG8_BAR; PG8_SCHED;
            PG8_LDA(At, 0, 1); PG8_STAGE(PG8_SB(0, 0), b2, voffB); PG8_STAGE(PG8_SB(0, 1), b2 + hstepB, voffB); PG8_STAGE(PG8_SA(0, 0), a2, voffA);
            PG8_WAIT_V(8); PG8_WAIT_L(0); PG8_BAR; PG8_MMA(1, 0, At, B0); PG8_MMA(1, 1, At, B1); PG8_BAR; PG8_SCHED;
            PG8_LDB(B0, 1, 0); PG8_LDB(B1, 1, 1); PG8_SCHED; PG8_LDA(At, 1, 0); PG8_STAGE(PG8_SA(0, 1), a2 + hstepA, voffA);
            PG8_WAIT_V(8); PG8_WAIT_L(0); PG8_BAR; PG8_MMA(0, 0, At, B0); PG8_MMA(0, 1, At, B1); PG8_BAR; PG8_SCHED;
            PG8_LDA(At, 1, 1); PG8_STAGE(PG8_SB(1, 0), b3, voffB); PG8_STAGE(PG8_SB(1, 1), b3 + hstepB, voffB); PG8_STAGE(PG8_SA(1, 0), a3, voffA);
            PG8_WAIT_V(8); PG8_WAIT_L(0); PG8_BAR; PG8_MMA(1, 0, At, B0); PG8_MMA(1, 1, At, B1); PG8_BAR; PG8_SCHED;
        }
        if constexpr (ALIGN_EPI) { if (wr == 0) PG8_BAR; }
        { int z_ = 0; asm volatile("" : "+v"(z_)); const int l2 = __builtin_amdgcn_mbcnt_hi(-1, __builtin_amdgcn_mbcnt_lo(-1, z_));
          E(acc, cur, wr, wc, l2 & 15, l2 >> 4); }
        if (!E.keep(cur)) {
#pragma unroll
            for (int a = 0; a < 2; ++a)
#pragma unroll
                for (int b = 0; b < 2; ++b)
#pragma unroll
                    for (int m = 0; m < 4; ++m)
#pragma unroll
                        for (int n = 0; n < 2; ++n) acc[a][b][m][n] = (f32x4){0.f, 0.f, 0.f, 0.f};
        }
        if (!has_next) break;
        cur = nxt; cA = nA; cB = nB; ++ui;
        if constexpr (ALIGN_EPI) { if (wr == 1) PG8_BAR; }
    }
    PG8_WAIT_V(0);
    if constexpr (!ALIGN_EPI) { if (wr == 0) PG8_BAR; }
    PG8_BAR;
#undef PG8_SA
#undef PG8_SB
#undef PG8_STAGE
#undef PG8_LDA
#undef PG8_LDB
#undef PG8_MMA
#undef PG8_WAIT_V
#undef PG8_WAIT_L
#undef PG8_BAR
#undef PG8_SCHED
}
}

constexpr int RING_BYTES_C = 131072, LDSCTL_OFF_C = 131072;
__device__ __forceinline__ int seq_of_row(int r) { return r < ROWS_P ? r / LP : 8; }
__device__ __forceinline__ int seq_base(int s) { return s < 8 ? s * LP : ROWS_P; }
__device__ __forceinline__ int seq_len(int s) { return s < 8 ? LP : LS; }
__device__ __forceinline__ float* xrow(float* xreal, float* xm, int r) {
    if (r >= MROWS) return xm + (size_t)(144 + r - MROWS) * DM;
    const int s = seq_of_row(r), p = r - seq_base(s);
    if (p < NMETA) return xm + (size_t)(s * 16 + p) * DM;
    return xreal + (size_t)(r - 16 * (s + 1)) * DM;
}
__device__ __forceinline__ float bflo(unsigned u) { return __uint_as_float(u << 16); }
__device__ __forceinline__ float bfhi(unsigned u) { return __uint_as_float(u & 0xffff0000u); }
__device__ __forceinline__ unsigned f2bf(float f) { unsigned u = __builtin_bit_cast(unsigned, f); return (u + 0x7fffu + ((u >> 16) & 1u)) >> 16; }
__device__ __forceinline__ unsigned pk2(float lo, float hi) { return f2bf(lo) | (f2bf(hi) << 16); }
__device__ __forceinline__ void unpack8(const u32x4 w, float* f) { f[0] = bflo(w.x); f[1] = bfhi(w.x); f[2] = bflo(w.y); f[3] = bfhi(w.y); f[4] = bflo(w.z); f[5] = bfhi(w.z); f[6] = bflo(w.w); f[7] = bfhi(w.w); }
__device__ __forceinline__ float shx(float v, int o, int lane) { return __int_as_float(__builtin_amdgcn_ds_bpermute((lane ^ o) << 2, __float_as_int(v))); }
__device__ __forceinline__ float wave_sum(float v, int lane) {
#pragma unroll
    for (int o = 1; o < 64; o <<= 1) v += shx(v, o, lane);
    return v;
}
#define LDS_WAIT() asm volatile("s_waitcnt lgkmcnt(0)" ::: "memory")

struct OpsPlain {
    const bf16_t* A; const bf16_t* Bt; int K, lda;
    __device__ __forceinline__ void ptrs(const pg8::Unit& u, const char*& a, const char*& b) const {
        a = (const char*)A + (size_t)u.pm * 256 * lda * 2; b = (const char*)Bt + (size_t)u.pn * 256 * K * 2; }
};
struct OpsMerge {
    const bf16_t* P; const bf16_t* WM; int K, lda;
    __device__ __forceinline__ void ptrs(const pg8::Unit& u, const char*& a, const char*& b) const {
        const int col = u.sub == 0 ? C_Q : (u.sub == 1 ? C_VV : C_X1);
        a = (const char*)P + ((size_t)u.pm * 256 * lda + col) * 2; b = (const char*)WM + ((size_t)u.sub * DM + (size_t)u.pn * 256) * 512 * 2; }
};
typedef f32x4 acc_t[2][2][4][2];
struct EpiStore {
    bf16_t* O; int ldc; int sig_pn;
    __device__ __forceinline__ bool keep(const pg8::Unit&) const { return false; }
    __device__ __forceinline__ void operator()(acc_t& acc, const pg8::Unit& u, int wr, int wc, int fr, int fq) const {
        const int row0 = u.pm * 256 + wr * 64 + fr, col0 = u.pn * 256 + wc * 32 + 8 * fq; const bool sig = u.pn >= sig_pn;
#pragma unroll
        for (int ai = 0; ai < 2; ++ai)
#pragma unroll
            for (int m = 0; m < 4; ++m) { bf16_t* rowp = O + (size_t)(row0 + ai * 128 + m * 16) * ldc + col0;
#pragma unroll
                for (int bj = 0; bj < 2; ++bj) { f32x4 v0 = acc[ai][bj][m][0], v1 = acc[ai][bj][m][1];
                    if (sig) { unsigned q[8];
#pragma unroll
                        for (int e = 0; e < 4; ++e) { q[e] = (unsigned)fminf(fmaxf(__builtin_rintf(255.f * __builtin_amdgcn_rcpf(1.f + __expf(-v0[e]))), 1.f), 255.f);
                                                      q[4 + e] = (unsigned)fminf(fmaxf(__builtin_rintf(255.f * __builtin_amdgcn_rcpf(1.f + __expf(-v1[e]))), 1.f), 255.f); }
                        u32x2 w8; w8.x = q[0] | (q[1] << 8) | (q[2] << 16) | (q[3] << 24); w8.y = q[4] | (q[5] << 8) | (q[6] << 16) | (q[7] << 24);
                        *(u32x2*)((unsigned char*)(O + (size_t)(row0 + ai * 128 + m * 16) * ldc) + C_G * 2 + (col0 + bj * 128 - C_G)) = w8; continue; }
                    u32x4 w; w.x = pg8::cvt_pk_bf16(v0[0], v0[1]); w.y = pg8::cvt_pk_bf16(v0[2], v0[3]); w.z = pg8::cvt_pk_bf16(v1[0], v1[1]); w.w = pg8::cvt_pk_bf16(v1[2], v1[3]);
                    *(u32x4*)(rowp + bj * 128) = w; } }
    }
};
struct EpiRes {
    float* xreal; float* xm; int dry;
    __device__ __forceinline__ bool keep(const pg8::Unit&) const { return false; }
    __device__ __forceinline__ void operator()(acc_t& acc, const pg8::Unit& u, int wr, int wc, int fr, int fq) const {
        const int row0 = u.pm * 256 + wr * 64 + fr, col0 = u.pn * 256 + wc * 32 + 8 * fq;
#pragma unroll
        for (int ai = 0; ai < 2; ++ai)
#pragma unroll
            for (int m = 0; m < 4; ++m) { float* p = xrow(xreal, xm, row0 + ai * 128 + m * 16) + col0;
#pragma unroll
                for (int bj = 0; bj < 2; ++bj) { f32x4 a = *(f32x4*)(p + bj * 128), b = *(f32x4*)(p + bj * 128 + 4);
                    a += acc[ai][bj][m][0]; b += acc[ai][bj][m][1]; if (!dry) { *(f32x4*)(p + bj * 128) = a; *(f32x4*)(p + bj * 128 + 4) = b; } } }
    }
};
struct EpiGeluMul {
    const bf16_t* G; const float* cw; const float* cb; bf16_t* O; int dv;
    __device__ __forceinline__ bool keep(const pg8::Unit&) const { return false; }
    __device__ __forceinline__ void operator()(acc_t& acc, const pg8::Unit& u, int wr, int wc, int fr, int fq) const {
        if (dv == 1) return;
        const int row0 = u.pm * 256 + wr * 64 + fr, col0 = u.pn * 256 + wc * 32 + 8 * fq;
#pragma unroll
        for (int ai = 0; ai < 2; ++ai)
#pragma unroll
            for (int m = 0; m < 4; ++m) { const int r = row0 + ai * 128 + m * 16;
                const int s = seq_of_row(r), p = r - seq_base(s); const bool inb = r < MROWS;
                const bool hasp = inb && p > 0, hasn = inb && p < seq_len(s) - 1;
                const float mp_ = hasp ? 1.f : 0.f, mn_ = hasn ? 1.f : 0.f;
#pragma unroll
                for (int bj = 0; bj < 2; ++bj) { const int col = col0 + bj * 128;
                    const bf16_t* gp = G + (size_t)r * DFF + col;
                    const u32x4 gm = *(const u32x4*)(gp - (hasp ? DFF : 0)), g0 = *(const u32x4*)gp, gn = *(const u32x4*)(gp + (hasn ? DFF : 0));
                    float fm[8], f0[8], fn[8]; unpack8(gm, fm); unpack8(g0, f0); unpack8(gn, fn);
                    float o[8];
#pragma unroll
                    for (int h = 0; h < 2; ++h) { const f32x4 a = *(const f32x4*)(cw + col + 4 * h), b = *(const f32x4*)(cw + DFF + col + 4 * h), c = *(const f32x4*)(cw + 2 * DFF + col + 4 * h), d = *(const f32x4*)(cb + col + 4 * h);
#pragma unroll
                        for (int e = 0; e < 4; e += 2) { f32x2 x; x.x = a[e] * mp_ * fm[4 * h + e] + b[e] * f0[4 * h + e] + c[e] * mn_ * fn[4 * h + e] + d[e];
                            x.y = a[e + 1] * mp_ * fm[4 * h + e + 1] + b[e + 1] * f0[4 * h + e + 1] + c[e + 1] * mn_ * fn[4 * h + e + 1] + d[e + 1];
                            const f32x2 g = pg8::gelu_pk(x); o[4 * h + e] = g.x; o[4 * h + e + 1] = g.y; } }
                    const f32x4 v0 = acc[ai][bj][m][0], v1 = acc[ai][bj][m][1];
                    u32x4 w; w.x = pg8::cvt_pk_bf16(o[0] * v0[0], o[1] * v0[1]); w.y = pg8::cvt_pk_bf16(o[2] * v0[2], o[3] * v0[3]);
                    w.z = pg8::cvt_pk_bf16(o[4] * v1[0], o[5] * v1[1]); w.w = pg8::cvt_pk_bf16(o[6] * v1[2], o[7] * v1[3]);
                    if (dv != 2) *(u32x4*)(O + (size_t)r * DFF + col) = w; else asm volatile("" :: "v"(w.x), "v"(w.y), "v"(w.z), "v"(w.w)); }
                if (m & 1) asm volatile("" ::: "memory"); }
    }
};
__device__ __forceinline__ void unpack8u(const u32x2 w, float* f) {
#pragma unroll
    for (int e = 0; e < 4; ++e) { f[e] = (float)((w.x >> (8 * e)) & 255u) * (1.f / 255.f); f[4 + e] = (float)((w.y >> (8 * e)) & 255u) * (1.f / 255.f); }
}
struct EpiMerge {
    const bf16_t* P; bf16_t* O;
    __device__ __forceinline__ bool keep(const pg8::Unit& u) const { return u.sub < 2; }
    __device__ __forceinline__ void operator()(acc_t& acc, const pg8::Unit& u, int wr, int wc, int fr, int fq) const {
        const int row0 = u.pm * 256 + wr * 64 + fr, col0 = u.pn * 256 + wc * 32 + 8 * fq; const int sub = u.sub;
#pragma unroll
        for (int ai = 0; ai < 2; ++ai)
#pragma unroll
            for (int m = 0; m < 4; ++m) { const int r = row0 + ai * 128 + m * 16;
#pragma unroll
                for (int bj = 0; bj < 2; ++bj) { const int col = col0 + bj * 128;
                    const unsigned char* gp = (const unsigned char*)(P + (size_t)r * INW) + C_G * 2 + col;
                    float mu[8];
                    if (sub < 2) { const u32x2 ga = *(const u32x2*)(gp + sub * DM), gb = *(const u32x2*)(gp + (sub + 1) * DM); float fa[8], fb[8]; unpack8u(ga, fa); unpack8u(gb, fb);
#pragma unroll
                        for (int e = 0; e < 8; ++e) mu[e] = fa[e] * __builtin_amdgcn_rcpf(fb[e]); }
                    else { const u32x2 ga = *(const u32x2*)(gp + 2 * DM); unpack8u(ga, mu); }
                    f32x4 v0 = acc[ai][bj][m][0], v1 = acc[ai][bj][m][1];
#pragma unroll
                    for (int e = 0; e < 4; ++e) { v0[e] *= mu[e]; v1[e] *= mu[4 + e]; }
                    if (sub < 2) { acc[ai][bj][m][0] = v0; acc[ai][bj][m][1] = v1; }
                    else { u32x4 w; w.x = pg8::cvt_pk_bf16(v0[0], v0[1]); w.y = pg8::cvt_pk_bf16(v0[2], v0[3]); w.z = pg8::cvt_pk_bf16(v1[0], v1[1]); w.w = pg8::cvt_pk_bf16(v1[2], v1[3]);
                        *(u32x4*)(O + (size_t)r * DM + col) = w; } } }
    }
};

#define XB_TMO      128
#define XB_XCNT(j)  (256  + 64 * (j))
#define XB_XSUB(j)  (1280 + 64 * (j))
#define XB_XGEN(j)  (2304 + 64 * (j))
#define XB_TOP      3328
#define XB_TOPGEN   3392
#define XCD_BAR_WORDS 3456
#define XB_SPIN_CAP (1u << 20)
__device__ __forceinline__ unsigned xb_ld(unsigned* p)              { return __hip_atomic_load(p, __ATOMIC_RELAXED, __HIP_MEMORY_SCOPE_AGENT); }
__device__ __forceinline__ unsigned xb_add(unsigned* p, unsigned v) { return __hip_atomic_fetch_add(p, v, __ATOMIC_RELAXED, __HIP_MEMORY_SCOPE_AGENT); }
__device__ __forceinline__ unsigned xb_xcc_id() { return (unsigned)__builtin_amdgcn_s_getreg((3 << 11) | 20) & 0xFu; }
#define XB_SPIN(cond, bar) do { unsigned _sp = 0; while (cond) { __builtin_amdgcn_s_sleep(1); \
    if ((++_sp & 255u) == 0u) { if (xb_ld(&(bar)[XB_TMO])) break; if (_sp > XB_SPIN_CAP) { atomicAdd(&(bar)[XB_TMO], 1u); break; } } } } while (0)
struct XcdBarrier { unsigned* bar; unsigned x; volatile LAS unsigned* st; };
__device__ __forceinline__ XcdBarrier xcd_barrier_post(unsigned* bar, volatile LAS unsigned* st) {
    XcdBarrier b; b.bar = bar; b.x = xb_xcc_id(); b.st = st;
    if (threadIdx.x == 0) (void)xb_add(&bar[XB_XCNT(b.x)], 1u);
    return b;
}
__device__ __forceinline__ void xcd_barrier_complete(unsigned* bar, unsigned x, unsigned& nloc, unsigned& nx) {
    const unsigned G = gridDim.x * gridDim.y * gridDim.z;
    unsigned sum, cnt, mine, sp = 0u;
    for (;;) {
        sum = 0u; cnt = 0u; mine = 0u;
#pragma unroll
        for (unsigned j = 0; j < 16; ++j) { const unsigned c = xb_ld(&bar[XB_XCNT(j)]); sum += c; cnt += (c > 0u) ? 1u : 0u; mine = (j == x) ? c : mine; }
        if (sum == G) break;
        __builtin_amdgcn_s_sleep(1);
        if ((++sp & 255u) == 0u) { if (xb_ld(&bar[XB_TMO])) break; if (sp > XB_SPIN_CAP) { atomicAdd(&bar[XB_TMO], 1u); break; } }
    }
    nloc = mine > 0u ? mine : 1u; nx = cnt > 0u ? cnt : 1u;
}
__device__ __forceinline__ void xcd_barrier(const XcdBarrier& b, int tid) {
    asm volatile("s_waitcnt vmcnt(0)" ::: "memory");
    __syncthreads();
    if (tid == 0) {
        unsigned* bar = b.bar;
        __builtin_amdgcn_s_waitcnt(0);
        unsigned nloc = b.st[0], nx = b.st[1];
        if (nloc == 0u) { xcd_barrier_complete(bar, b.x, nloc, nx); b.st[0] = nloc; b.st[1] = nx; }
        const unsigned old = xb_add(&bar[XB_XSUB(b.x)], 1u);
        const unsigned gen = old / nloc;
        if (old + 1u == (gen + 1u) * nloc) {
            __builtin_amdgcn_fence(__ATOMIC_RELEASE, "agent");
            asm volatile("s_waitcnt vmcnt(0)" ::: "memory");
            const unsigned og = xb_add(&bar[XB_TOP], 1u);
            const unsigned tg = og / nx;
            if (og + 1u == (tg + 1u) * nx) xb_add(&bar[XB_TOPGEN], 1u);
            else XB_SPIN(xb_ld(&bar[XB_TOPGEN]) == tg, bar);
            __builtin_amdgcn_fence(__ATOMIC_ACQUIRE, "agent");
            xb_add(&bar[XB_XGEN(b.x)], 1u);
            asm volatile("s_waitcnt vmcnt(0)" ::: "memory");
        } else {
            XB_SPIN(xb_ld(&bar[XB_XGEN(b.x)]) == gen, bar);
            __builtin_amdgcn_fence(__ATOMIC_ACQUIRE, "agent");
            asm volatile("s_waitcnt vmcnt(0)" ::: "memory");
        }
    }
    __syncthreads();
}

constexpr int NWAVES = 8;
constexpr int RING_BYTES = 131072, LDSCTL_OFF = RING_BYTES, MISC_OFF = LDSCTL_OFF + 320, LDS_BYTES = 147456;
struct Args { const float* in[30]; float* out; unsigned char* ws; int ph_lo, ph_hi, use_bar, pad; };
typedef const __attribute__((address_space(4))) Args CArgs;
struct Frame {
    LAS unsigned char* lds; int tid, lane, wave, G, vcu, bx, dry;
    float* out; unsigned char* ws; float* xm;
};
#define FIN(i) (A.in[i])

__constant__ unsigned char c_bucket[257] = {
15,15,15,15,15,15,15,15,15,15,15,15,15,15,15,15,15,15,15,15,15,15,15,15,15,15,15,15,15,15,15,15,15,15,15,15,15,15,14,14,14,14,14,14,14,14,14,14,14,14,14,14,14,14,14,14,14,14,14,14,14,14,14,14,14,13,13,13,13,13,13,13,13,13,13,13,13,13,13,13,13,13,13,12,12,12,12,12,12,12,12,12,12,12,12,12,12,11,11,11,11,11,11,11,11,11,10,10,10,10,10,10,10,9,9,9,9,8,8,8,8,7,6,5,4,3,2,1,0,17,18,19,20,21,22,23,24,24,24,24,25,25,25,25,26,26,26,26,26,26,26,27,27,27,27,27,27,27,27,27,28,28,28,28,28,28,28,28,28,28,28,28,28,28,29,29,29,29,29,29,29,29,29,29,29,29,29,29,29,29,29,29,30,30,30,30,30,30,30,30,30,30,30,30,30,30,30,30,30,30,30,30,30,30,30,30,30,30,30,31,31,31,31,31,31,31,31,31,31,31,31,31,31,31,31,31,31,31,31,31,31,31,31,31,31,31,31,31,31,31,31,31,31,31,31,31,31};

__device__ __forceinline__ void p0_transpose_item(const float* W, int K, int N, bf16_t* WT, int row_off, LAS float* scr, int item, int lane) {
    const int nblk = N / 32, kb = item / nblk, nb = item % nblk, k0 = 64 * kb, n0 = 32 * nb;
    f32x4 v[8];
#pragma unroll
    for (int i = 0; i < 8; ++i) v[i] = *(const f32x4*)(W + (size_t)(k0 + 8 * i + (lane >> 3)) * N + n0 + 4 * (lane & 7));
#pragma unroll
    for (int i = 0; i < 8; ++i) { LAS float* d = scr + (8 * i + (lane >> 3)) * 33 + 4 * (lane & 7); d[0] = v[i].x; d[1] = v[i].y; d[2] = v[i].z; d[3] = v[i].w; }
    LDS_WAIT(); asm volatile("" ::: "memory");
    const int c = lane & 7;
#pragma unroll
    for (int j = 0; j < 4; ++j) { const int n = (lane >> 3) + 8 * j; const LAS float* s = scr + (8 * c) * 33 + n;
        u32x4 o; o.x = pk2(s[0 * 33], s[1 * 33]); o.y = pk2(s[2 * 33], s[3 * 33]); o.z = pk2(s[4 * 33], s[5 * 33]); o.w = pk2(s[6 * 33], s[7 * 33]);
        *(u32x4*)(WT + (size_t)(row_off + n0 + n) * K + k0 + 8 * c) = o; }
    LDS_WAIT(); asm volatile("" ::: "memory");
}
__device__ __forceinline__ void rms_row(const f32x4 (&v)[4], const float* g, bf16_t* orow, int lane) {
    float s = 0.f;
#pragma unroll
    for (int j = 0; j < 4; ++j) s += (v[j].x * v[j].x + v[j].y * v[j].y) + (v[j].z * v[j].z + v[j].w * v[j].w);
    const float rstd = 1.0f / sqrtf(wave_sum(s, lane) * (1.f / DM) + EPS);
    unsigned long long* o8 = (unsigned long long*)orow + lane;
#pragma unroll
    for (int j = 0; j < 4; ++j) { const f32x4 gg = *((const f32x4*)g + lane + 64 * j);
        o8[64 * j] = (unsigned long long)pk2(v[j].x * rstd * gg.x, v[j].y * rstd * gg.y) | ((unsigned long long)pk2(v[j].z * rstd * gg.z, v[j].w * rstd * gg.w) << 32); }
}
constexpr size_t WS_H2F_P = 2 * MiB, WS_H2F_S = WS_END;
constexpr int NCH_P = (LP + 31) / 32, NCH_S = (LS + 31) / 32;
static_assert(WS_H2F_S + (size_t)NCH_S * 32 * 128 <= 512 * MiB && WS_H2F_P + (size_t)NCH_P * 32 * 128 <= WS_W, "h2 scratch");
__device__ __forceinline__ void filt_h2_compute(const CArgs& A, const Frame& F, int layer, int L, int tc, LAS float* h1t, int lane, float (&acc)[32]) {
    const float* w1 = FIN(11) + (size_t)layer * 33 * 64; const float* b1 = FIN(12) + layer * 64;
    const float* w2 = FIN(13) + (size_t)layer * 64 * 64; const float* b2 = FIN(14) + layer * 64; const float* fq_ = FIN(16) + layer * 64;
    const int pos = lane & 31, half = lane >> 5, jb = 32 * half;
    const float tt = (float)tc / (float)(L - 1);
    { f32x4 bv[8], wv[8];
#pragma unroll
      for (int i = 0; i < 8; ++i) { bv[i] = *(const f32x4*)(b1 + jb + 4 * i); wv[i] = *(const f32x4*)(w1 + jb + 4 * i); }
#pragma unroll
      for (int i = 0; i < 8; ++i)
#pragma unroll
          for (int e = 0; e < 4; ++e) acc[4 * i + e] = bv[i][e] + tt * wv[i][e]; }
#pragma unroll 2
    for (int k = 0; k < 16; ++k) {
        const float f = 1e-4f + (float)k * ((15.0f - 1e-4f) / 15.0f);
        const float rev = f * (float)tc * (1.0f / (float)L);
        const float sn = __builtin_amdgcn_sinf(rev), cs = __builtin_amdgcn_cosf(rev);
        f32x4 wc_[8], ws_[8];
#pragma unroll
        for (int i = 0; i < 8; ++i) { wc_[i] = *(const f32x4*)(w1 + (size_t)(1 + k) * 64 + jb + 4 * i); ws_[i] = *(const f32x4*)(w1 + (size_t)(17 + k) * 64 + jb + 4 * i); }
#pragma unroll
        for (int i = 0; i < 8; ++i)
#pragma unroll
            for (int e = 0; e < 4; ++e) acc[4 * i + e] += cs * wc_[i][e] - sn * ws_[i][e];
    }
    { f32x4 fv[8];
#pragma unroll
      for (int i = 0; i < 8; ++i) fv[i] = *(const f32x4*)(fq_ + jb + 4 * i);
#pragma unroll
      for (int i = 0; i < 8; ++i)
#pragma unroll
          for (int e = 0; e < 4; ++e) h1t[(jb + 4 * i + e) * 32 + pos] = __builtin_amdgcn_sinf(fv[i][e] * acc[4 * i + e] * 0.15915494309189535f); }
    LDS_WAIT();
    { f32x4 bv[8];
#pragma unroll
      for (int i = 0; i < 8; ++i) bv[i] = *(const f32x4*)(b2 + jb + 4 * i);
#pragma unroll
      for (int i = 0; i < 8; ++i)
#pragma unroll
          for (int e = 0; e < 4; ++e) acc[4 * i + e] = bv[i][e]; }
#pragma unroll 4
    for (int i2 = 0; i2 < 64; ++i2) { const float h = h1t[i2 * 32 + pos]; f32x4 wv[8];
#pragma unroll
        for (int i = 0; i < 8; ++i) wv[i] = *(const f32x4*)(w2 + (size_t)i2 * 64 + jb + 4 * i);
#pragma unroll
        for (int i = 0; i < 8; ++i)
#pragma unroll
            for (int e = 0; e < 4; ++e) acc[4 * i + e] += h * wv[i][e]; }
}
__device__ __forceinline__ void filt_h2_item(const CArgs& A, const Frame& F, int layer, int item, LAS float* h1t, int lane) {
    const int cls = item >= NCH_P ? 1 : 0, ch = cls ? item - NCH_P : item, L = cls ? LS : LP;
    const int pos = lane & 31, half = lane >> 5, jb = 32 * half;
    const int t = ch * 32 + pos, tc = t < L ? t : L - 1;
    const float* fq_ = FIN(16) + layer * 64;
    float acc[32];
    filt_h2_compute(A, F, layer, L, tc, h1t, lane, acc);
    { f32x4 fv[8]; unsigned hw[16];
#pragma unroll
      for (int i = 0; i < 8; ++i) fv[i] = *(const f32x4*)(fq_ + jb + 4 * i);
#pragma unroll
      for (int i = 0; i < 8; ++i)
#pragma unroll
          for (int e = 0; e < 4; e += 2) { const float a0 = __builtin_amdgcn_sinf(fv[i][e] * acc[4 * i + e] * 0.15915494309189535f), a1 = __builtin_amdgcn_sinf(fv[i][e + 1] * acc[4 * i + e + 1] * 0.15915494309189535f);
              typedef _Float16 h2_t __attribute__((ext_vector_type(2))); const h2_t hv = {(_Float16)a0, (_Float16)a1}; hw[2 * i + (e >> 1)] = __builtin_bit_cast(unsigned, hv); }
      u32x4* dst = (u32x4*)(F.ws + (cls ? WS_H2F_S : WS_H2F_P) + (size_t)t * 128 + half * 64);
#pragma unroll
      for (int i = 0; i < 4; ++i) dst[i] = (u32x4){hw[4 * i], hw[4 * i + 1], hw[4 * i + 2], hw[4 * i + 3]}; }
    LDS_WAIT();
}
constexpr int NI8_P = LP / 8, NI8 = NI8_P + LS / 8;
static_assert(LP % 8 == 0 && LS % 8 == 0, "filter items");
__device__ __forceinline__ void filt_h2_item8(const CArgs& A, const Frame& F, int layer, int item, LAS float* h1t, int lane) {
    const int cls = item >= NI8_P ? 1 : 0, ch = cls ? item - NI8_P : item, L = cls ? LS : LP;
    const float* w1 = FIN(11) + (size_t)layer * 33 * 64; const float* b1 = FIN(12) + layer * 64;
    const float* w2 = FIN(13) + (size_t)layer * 64 * 64; const float* b2 = FIN(14) + layer * 64; const float* fq_ = FIN(16) + layer * 64;
    const int pos = lane & 7, jb = (lane >> 3) * 8, t = ch * 8 + pos;
    const float tt = (float)t / (float)(L - 1);
    float acc[8];
    { const f32x4 ba = *(const f32x4*)(b1 + jb), bb = *(const f32x4*)(b1 + jb + 4), wa = *(const f32x4*)(w1 + jb), wb = *(const f32x4*)(w1 + jb + 4);
#pragma unroll
      for (int e = 0; e < 4; ++e) { acc[e] = ba[e] + tt * wa[e]; acc[4 + e] = bb[e] + tt * wb[e]; } }
#pragma unroll
    for (int k0 = 0; k0 < 16; k0 += 4) { f32x4 ca[4], cb[4], sa[4], sb[4];
#pragma unroll
        for (int q = 0; q < 4; ++q) { const int k = k0 + q; ca[q] = *(const f32x4*)(w1 + (size_t)(1 + k) * 64 + jb); cb[q] = *(const f32x4*)(w1 + (size_t)(1 + k) * 64 + jb + 4);
            sa[q] = *(const f32x4*)(w1 + (size_t)(17 + k) * 64 + jb); sb[q] = *(const f32x4*)(w1 + (size_t)(17 + k) * 64 + jb + 4); }
        asm volatile("" ::: "memory");
#pragma unroll
        for (int q = 0; q < 4; ++q) { const int k = k0 + q;
            const float f = 1e-4f + (float)k * ((15.0f - 1e-4f) / 15.0f);
            const float rev = f * (float)t * (1.0f / (float)L);
            const float sn = __builtin_amdgcn_sinf(rev), cs = __builtin_amdgcn_cosf(rev);
#pragma unroll
            for (int e = 0; e < 4; ++e) { acc[e] += cs * ca[q][e] - sn * sa[q][e]; acc[4 + e] += cs * cb[q][e] - sn * sb[q][e]; } }
        asm volatile("" ::: "memory");
    }
    const f32x4 fa = *(const f32x4*)(fq_ + jb), fb = *(const f32x4*)(fq_ + jb + 4);
#pragma unroll
    for (int e = 0; e < 4; ++e) { h1t[(jb + e) * 8 + pos] = __builtin_amdgcn_sinf(fa[e] * acc[e] * 0.15915494309189535f); h1t[(jb + 4 + e) * 8 + pos] = __builtin_amdgcn_sinf(fb[e] * acc[4 + e] * 0.15915494309189535f); }
    LDS_WAIT();
    { const f32x4 ba = *(const f32x4*)(b2 + jb), bb = *(const f32x4*)(b2 + jb + 4);
#pragma unroll
      for (int e = 0; e < 4; ++e) { acc[e] = ba[e]; acc[4 + e] = bb[e]; } }
#pragma unroll
    for (int i0 = 0; i0 < 64; i0 += 8) { f32x4 wa[8], wb[8];
#pragma unroll
        for (int q = 0; q < 8; ++q) { wa[q] = *(const f32x4*)(w2 + (size_t)(i0 + q) * 64 + jb); wb[q] = *(const f32x4*)(w2 + (size_t)(i0 + q) * 64 + jb + 4); }
        asm volatile("" ::: "memory");
#pragma unroll
        for (int q = 0; q < 8; ++q) { const float h = h1t[(i0 + q) * 8 + pos];
#pragma unroll
            for (int e = 0; e < 4; ++e) { acc[e] += h * wa[q][e]; acc[4 + e] += h * wb[q][e]; } }
        asm volatile("" ::: "memory");
    }
    unsigned hw[4];
#pragma unroll
    for (int e = 0; e < 4; e += 2) { typedef _Float16 h2_t __attribute__((ext_vector_type(2)));
        const h2_t ha = {(_Float16)__builtin_amdgcn_sinf(fa[e] * acc[e] * 0.15915494309189535f), (_Float16)__builtin_amdgcn_sinf(fa[e + 1] * acc[e + 1] * 0.15915494309189535f)};
        const h2_t hb = {(_Float16)__builtin_amdgcn_sinf(fb[e] * acc[4 + e] * 0.15915494309189535f), (_Float16)__builtin_amdgcn_sinf(fb[e + 1] * acc[4 + e + 1] * 0.15915494309189535f)};
        hw[e >> 1] = __builtin_bit_cast(unsigned, ha); hw[2 + (e >> 1)] = __builtin_bit_cast(unsigned, hb); }
    *(u32x4*)(F.ws + (cls ? WS_H2F_S : WS_H2F_P) + (size_t)t * 128 + jb * 2) = (u32x4){hw[0], hw[1], hw[2], hw[3]};
    LDS_WAIT();
}
constexpr int NCHF_P = (LP - 1 + 31) / 32 + 1, NCHB_P = (LP + 31) / 32, NCHF_S = (LS - 1 + 31) / 32 + 1, NCHB_S = (LS + 31) / 32;
constexpr int NFI_P = NCHF_P + NCHB_P, NFI = NFI_P + NCHF_S + NCHB_S;
__device__ __forceinline__ void filt_tile_item(const CArgs& A, const Frame& F, int layer, int item, int lane) {
    const int ct = item & 15; int cls = 0, it = item >> 4; if (it >= NFI_P) { cls = 1; it -= NFI_P; }
    const int nchf = cls ? NCHF_S : NCHF_P, L = cls ? LS : LP;
    bool bwd; int ch; if (it < nchf) { bwd = false; ch = it - 1; } else { bwd = true; ch = it - nchf; }
    const int tsh = bwd ? 0 : 1;
    const float* w3 = FIN(15) + (size_t)layer * 64 * 1024;
    const int pos = lane & 31, half = lane >> 5;
    const int t = ch * 32 + pos + tsh, tc = t < 0 ? 0 : (t < L ? t : L - 1);
    float acc[32];
#if FT_RECOMPUTE
    if (FT_RECOMPUTE == 1 || FT_RECOMPUTE == 9 || (FT_RECOMPUTE == 2 && cls == 0) || (FT_RECOMPUTE == 3 && cls == 1)) { LAS float* h1t = (LAS float*)(F.lds + F.wave * 16384); filt_h2_compute(A, F, layer, L, tc, h1t, lane, acc); const float* fq_ = FIN(16) + layer * 64;
#pragma unroll
      for (int k = 0; k < 32; ++k) acc[k] = __builtin_amdgcn_sinf(fq_[32 * half + k] * acc[k] * 0.15915494309189535f); LDS_WAIT(); }
    else
#endif
    { const u32x4* src = (const u32x4*)(F.ws + (cls ? WS_H2F_S : WS_H2F_P) + (size_t)tc * 128 + half * 64);
      u32x4 hv[4];
#pragma unroll
      for (int i = 0; i < 4; ++i) hv[i] = src[i];
#pragma unroll
      for (int i = 0; i < 4; ++i)
#pragma unroll
          for (int e = 0; e < 4; ++e) { typedef _Float16 h2_t __attribute__((ext_vector_type(2))); const unsigned wv_ = hv[i][e];
              const h2_t p = __builtin_bit_cast(h2_t, wv_); acc[8 * i + 2 * e] = (float)p[0]; acc[8 * i + 2 * e + 1] = (float)p[1]; } }
#if FT_RECOMPUTE == 9
    float bad = 0.f;
    { const u32x4* src = (const u32x4*)(F.ws + (cls ? WS_H2F_S : WS_H2F_P) + (size_t)tc * 128 + half * 64);
#pragma unroll
      for (int i = 0; i < 4; ++i) { const u32x4 hvv = src[i];
#pragma unroll
          for (int e = 0; e < 4; ++e) { typedef _Float16 h2_t __attribute__((ext_vector_type(2))); const h2_t p = __builtin_bit_cast(h2_t, hvv[e]);
              if (fabsf((float)p[0] - acc[8 * i + 2 * e]) > 2e-3f || fabsf((float)p[1] - acc[8 * i + 2 * e + 1]) > 2e-3f) bad = 1e4f; } } }
#else
    const float bad = 0.f;
#endif
    bf16_t* RK = (bf16_t*)(F.ws + (cls ? WS_RKS : WS_RKP)); const int rklen = cls ? RKLEN_S : RKLEN_P;
    float* sums = (float*)(F.ws + WS_CTL) + CW_SUMS + (layer * 2 + cls) * 512;
    const float da = -15.350567286626973f, db = -3.0701134573253945f;
    {
        const int col0 = (bwd ? 512 : 0) + ct * 32;
        float bw[32];
#pragma unroll
        for (int ks = 0; ks < 32; ++ks) bw[ks] = w3[(size_t)(32 * half + ks) * 1024 + col0 + pos];
        f32x16 d = {};
#pragma unroll
        for (int ks = 0; ks < 32; ++ks) d = __builtin_amdgcn_mfma_f32_32x32x2f32(acc[ks], bw[ks], d, 0, 0, 0);
        const int c = (col0 + pos) & 511;
        const float delta = fabsf(da + (db - da) * ((float)c / 511.0f));
        bf16_t* rk = RK + (size_t)c * rklen + RK_PAD + L;
        float asum = 0.f;
#pragma unroll
        for (int g = 0; g < 4; ++g) { const int t0 = ch * 32 + 8 * g + 4 * half + tsh; float v[4];
#pragma unroll
            for (int e = 0; e < 4; ++e) { const int tp = t0 + e; const bool ok = tp >= 0 && tp < L && !(bwd && tp == 0);
                const float tq = (float)tp / (float)(L - 1); v[e] = ok ? d[4 * g + e] * __expf(-tq * delta) + bad : 0.f; asum += fabsf(v[e]); }
            if (bwd) { if (t0 >= 4 && t0 + 3 < L) { u32x2 w; w.x = pk2(v[0], v[1]); w.y = pk2(v[2], v[3]); *(u32x2*)(rk + t0) = w; }
                       else {
#pragma unroll
                           for (int e = 0; e < 4; ++e) if (t0 + e >= 1 && t0 + e < L) rk[t0 + e] = (bf16_t)f2bf(v[e]); } }
            else { if (t0 >= 0 && t0 + 3 < L) { u32x2 w; w.x = pk2(v[3], v[2]); w.y = pk2(v[1], v[0]); *(u32x2*)(rk - t0 - 3) = w; }
                   else {
#pragma unroll
                       for (int e = 0; e < 4; ++e) if (t0 + e >= 0 && t0 + e < L) rk[-(t0 + e)] = (bf16_t)f2bf(v[e]); } } }
        asum += shx(asum, 32, lane);
        if (half == 0 && !F.dry) atomicAdd(sums + c, asum);
    }
}
__device__ __forceinline__ void p_filt_tiles(const CArgs& A, const Frame& F, int layer) {
    const int gw = F.vcu * NWAVES + F.wave, NGW = F.G * NWAVES;
    for (int it = gw; it < 16 * NFI; it += NGW) filt_tile_item(A, F, layer, it, F.lane);
}
__device__ __forceinline__ void p_prep(const CArgs& A, const Frame& F, int layer) {
    const int gw = F.vcu * NWAVES + F.wave, NGW = F.G * NWAVES, lane = F.lane;
    const bool filt_first = false;
    if (filt_first && DSEL(8)) { LAS float* scr = (LAS float*)(F.lds + F.wave * 16384); for (int it = gw; it < NI8; it += NGW) filt_h2_item8(A, F, layer, it, scr, lane); }
    if (DSEL(1)) {
        const float* g = FIN(4) + layer * DM; bf16_t* XN = (bf16_t*)(F.ws + WS_XNR);
        for (int r0 = gw; r0 < MP; r0 += 2 * NGW) {
            f32x4 v[2][4]; const int rr[2] = {r0, r0 + NGW};
#pragma unroll
            for (int q = 0; q < 2; ++q) { const int r = rr[q];
                if (r >= MP) continue;
                if (r >= MROWS) {
#pragma unroll
                    for (int j = 0; j < 4; ++j) v[q][j] = (f32x4){0.f, 0.f, 0.f, 0.f};
                } else if (layer == 0) {
                    const int s = seq_of_row(r), p = r - seq_base(s);
                    const float* src = p < NMETA ? FIN(2) + (size_t)p * DM : (s < 8 ? FIN(0) + ((size_t)s * 2048 + (p - NMETA)) * DM : FIN(1) + (size_t)(p - NMETA) * DM);
                    const f32x4* sr = (const f32x4*)src + lane;
#pragma unroll
                    for (int j = 0; j < 4; ++j) v[q][j] = sr[64 * j];
                } else {
                    const f32x4* xr = (const f32x4*)xrow(F.out, F.xm, r) + lane;
#pragma unroll
                    for (int j = 0; j < 4; ++j) v[q][j] = xr[64 * j];
                } }
#pragma unroll
            for (int q = 0; q < 2; ++q) { const int r = rr[q];
                if (r >= MP) continue;
                if (layer == 0) { f32x4* xr = (f32x4*)xrow(F.out, F.xm, r) + lane;
#pragma unroll
                    for (int j = 0; j < 4; ++j) xr[64 * j] = v[q][j]; }
                rms_row(v[q], g, XN + (size_t)r * DM, lane); }
        }
    }
    {
        LAS float* scr = (LAS float*)(F.lds + F.wave * 16384);
        unsigned char* W = F.ws + WS_W;
        constexpr int I_IN = (DM / 64) * (INW / 32), I_G = (DM / 64) * (DFF / 32), I_D = (DFF / 64) * (DM / 32), I_O = (DM / 64) * (DM / 32), I_M = (512 / 64) * (DM / 32);
        constexpr int NIT = I_IN + 2 * I_G + I_D + I_O + 2 * I_M;
        if (DSEL(2)) for (int it = gw; it < NIT; it += NGW) {
            int r = it;
            if (r < I_IN) { p0_transpose_item(FIN(5) + (size_t)layer * DM * INW, DM, INW, (bf16_t*)(W + W_IN), 0, scr, r, lane); continue; } r -= I_IN;
            if (r < I_G) { p0_transpose_item(FIN(25) + (size_t)layer * DM * DFF, DM, DFF, (bf16_t*)(W + W_G), 0, scr, r, lane); continue; } r -= I_G;
            if (r < I_G) { p0_transpose_item(FIN(26) + (size_t)layer * DM * DFF, DM, DFF, (bf16_t*)(W + W_U), 0, scr, r, lane); continue; } r -= I_G;
            if (r < I_D) { p0_transpose_item(FIN(29) + (size_t)layer * DFF * DM, DFF, DM, (bf16_t*)(W + W_D), 0, scr, r, lane); continue; } r -= I_D;
            if (r < I_O) { p0_transpose_item(FIN(23) + (size_t)layer * DM * DM, DM, DM, (bf16_t*)(W + W_OUT), 0, scr, r, lane); continue; } r -= I_O;
            if (r < I_M) { p0_transpose_item(FIN(20) + (size_t)layer * 512 * DM, 512, DM, (bf16_t*)(W + W_MRG), 0, scr, r, lane); continue; } r -= I_M;
            p0_transpose_item(FIN(21) + (size_t)layer * 512 * DM, 512, DM, (bf16_t*)(W + W_MRG), DM, scr, r, lane);
        }
        const float* pw = FIN(18) + (size_t)layer * 4 * 128 * 128; const float* psc = FIN(19) + layer * 512; const float* wpo = FIN(22) + (size_t)layer * 512 * DM;
        bf16_t* WT = (bf16_t*)(W + W_MRG) + (size_t)2 * DM * 512;
        const int gt = (F.vcu * NWAVES + F.wave) * 64 + lane, NGT = NGW * 64;
        if (DSEL(4)) for (int st = NGW - 1 - gw; st < (512 / 8) * (DM / 64); st += NGW) {
            const int c0 = (st >> 4) * 8, j = (st & 15) * 64 + lane, g = c0 >> 7;
            { const int cr = lane >> 3, d0 = (lane & 7) * 16; const float* pr = pw + ((size_t)c0 + cr) * 128 + d0; const float* ps = psc + g * 128 + d0;
#pragma unroll
              for (int q = 0; q < 4; ++q) { const f32x4 a = *(const f32x4*)(pr + 4 * q), b = *(const f32x4*)(ps + 4 * q); *(LAS f32x4*)(scr + cr * 128 + d0 + 4 * q) = a * b; } }
            LDS_WAIT(); asm volatile("" ::: "memory");
            const float* wp = wpo + (size_t)(g * 128) * DM + j;
            float a[8];
#pragma unroll
            for (int c = 0; c < 8; ++c) a[c] = 0.f;
#pragma unroll 1
            for (int d0 = 0; d0 < 128; d0 += 16) { float w[16];
#pragma unroll
                for (int q = 0; q < 16; ++q) w[q] = wp[(size_t)(d0 + q) * DM];
                asm volatile("" ::: "memory");
#pragma unroll
                for (int c = 0; c < 8; ++c)
#pragma unroll
                    for (int q4 = 0; q4 < 4; ++q4) { const f32x4 cf = *(const LAS f32x4*)(scr + c * 128 + d0 + 4 * q4);
#pragma unroll
                        for (int e = 0; e < 4; ++e) a[c] += cf[e] * w[4 * q4 + e]; }
                asm volatile("" ::: "memory");
            }
            u32x4 o; o.x = pk2(a[0], a[1]); o.y = pk2(a[2], a[3]); o.z = pk2(a[4], a[5]); o.w = pk2(a[6], a[7]);
            *(u32x4*)(WT + (size_t)j * 512 + c0) = o;
            LDS_WAIT(); asm volatile("" ::: "memory");
        }
        for (int idx = gt; idx < 2 * 512 * 513; idx += NGT) { const int k = idx % 513, cc = (idx / 513) & 511, cls = idx / (513 * 512);
            const int L = cls ? LS : LP, rklen = cls ? RKLEN_S : RKLEN_P; bf16_t* RK = (bf16_t*)(F.ws + (cls ? WS_RKS : WS_RKP)) + (size_t)cc * rklen;
            RK[k <= 256 ? k : 256 + 2 * L + (k - 257)] = 0; }
        if (!filt_first && DSEL(8)) for (int it = gw; it < NI8; it += NGW) filt_h2_item8(A, F, layer, it, scr, lane);
    }
}

__device__ __forceinline__ void p_attn_ref(const CArgs& A, const Frame& F, int layer) {
    bf16_t* P = (bf16_t*)(F.ws + WS_PROJ);
    const float* qg = FIN(6) + layer * HD; const float* kg = FIN(7) + layer * HD; const float* sink = FIN(8) + layer * NHEAD; const float* rb = FIN(3);
    const int gt = (F.vcu * NWAVES + F.wave) * 64 + F.lane, NGT = F.G * NWAVES * 64;
    for (int idx = gt; idx < MROWS * NHEAD; idx += NGT) {
        const int r = idx >> 3, h = idx & 7, hk = h >> 2;
        const int s = seq_of_row(r), base = seq_base(s), L = seq_len(s), p = r - base;
        unsigned qs[32]; float o[64];
        { const u32x4* qp = (const u32x4*)(P + (size_t)r * INW + C_Q + 64 * h); float ss = 0.f;
#pragma unroll
          for (int c = 0; c < 8; ++c) { const u32x4 w = qp[c]; qs[4 * c] = w.x; qs[4 * c + 1] = w.y; qs[4 * c + 2] = w.z; qs[4 * c + 3] = w.w; }
#pragma unroll
          for (int d = 0; d < 32; ++d) { const float a = bflo(qs[d]), b = bfhi(qs[d]); ss += a * a + b * b; }
          const float rs = 1.0f / sqrtf(ss * (1.f / 64) + EPS) * 0.125f;
#pragma unroll
          for (int d = 0; d < 32; ++d) { qs[d] = pk2(bflo(qs[d]) * rs * qg[2 * d], bfhi(qs[d]) * rs * qg[2 * d + 1]); o[2 * d] = 0.f; o[2 * d + 1] = 0.f; } }
        float m = sink[h], l = 1.f;
        const int lo = p - 128 < 0 ? 0 : p - 128, hi = p + 128 > L - 1 ? L - 1 : p + 128;
        for (int pk = lo; pk <= hi; ++pk) {
            const bf16_t* kr = P + (size_t)(base + pk) * INW;
            const u32x4* kp = (const u32x4*)(kr + C_K + 64 * hk); const u32x4* vp = (const u32x4*)(kr + C_V + 64 * hk);
            float ss = 0.f, dt = 0.f;
#pragma unroll
            for (int c = 0; c < 8; ++c) { float kk[8]; unpack8(kp[c], kk);
#pragma unroll
                for (int e = 0; e < 8; ++e) { ss += kk[e] * kk[e]; const unsigned qw = qs[4 * c + (e >> 1)]; dt += kk[e] * kg[8 * c + e] * ((e & 1) ? bfhi(qw) : bflo(qw)); }
                asm volatile("" ::: "memory"); }
            const float sc = dt / sqrtf(ss * (1.f / 64) + EPS) + rb[c_bucket[pk - p + 128] * NHEAD + h];
            const float mn = fmaxf(m, sc), f = __expf(m - mn), pe = __expf(sc - mn);
            l = l * f + pe; m = mn;
#pragma unroll
            for (int c = 0; c < 8; ++c) { float vv[8]; unpack8(vp[c], vv);
#pragma unroll
                for (int e = 0; e < 8; ++e) o[8 * c + e] = o[8 * c + e] * f + pe * vv[e];
                asm volatile("" ::: "memory"); }
        }
        const float il = (DBG & 4) ? 0.f : 1.f / l; u32x4* op = (u32x4*)(P + (size_t)r * INW + C_Q + 64 * h);
#pragma unroll
        for (int c = 0; c < 8; ++c) { u32x4 w; w.x = pk2(o[8 * c] * il, o[8 * c + 1] * il); w.y = pk2(o[8 * c + 2] * il, o[8 * c + 3] * il); w.z = pk2(o[8 * c + 4] * il, o[8 * c + 5] * il); w.w = pk2(o[8 * c + 6] * il, o[8 * c + 7] * il); op[c] = w; }
    }
}

constexpr int AT_K = 0, AT_V = 49152, AT_VSTR = 776, AT_B = AT_V + 64 * AT_VSTR;
__device__ __forceinline__ void p_attn(const CArgs& A, const Frame& F, int layer) {
    bf16_t* P = (bf16_t*)(F.ws + WS_PROJ);
    const float* qg = FIN(6) + layer * HD; const float* kg = FIN(7) + layer * HD; const float* sink = FIN(8) + layer * NHEAD; const float* rb = FIN(3);
    const int lane = F.lane, wave = F.wave, tid = F.tid, r32 = lane & 31, hi = lane >> 5;
    LAS unsigned char* lds = F.lds;
    for (int unit = F.vcu; unit < 265 * 4; unit += F.G) {
        const int gb = unit >> 2, hk = (unit >> 1) & 1, gh = unit & 1;
        const int s = gb < 136 ? gb / 17 : 8, nb = gb < 136 ? gb - 17 * s : gb - 136;
        const int base = seq_base(s), L = seq_len(s);
        const int pk0 = 128 * nb - 240;
        u32x4 kws[6], vws[6];
#pragma unroll
        for (int it = 0; it < 6; ++it) { const int idx = tid + it * 512, key = idx >> 3, ch = idx & 7, pk = pk0 + key; const bool ok = pk >= 0 && pk < L;
            const bf16_t* rowp = P + (size_t)(base + (ok ? pk : 0)) * INW + 64 * hk + 8 * ch;
            kws[it] = *(const u32x4*)(rowp + C_K); vws[it] = *(const u32x4*)(rowp + C_V); }
#pragma unroll
        for (int it = 0; it < 6; ++it) { const int idx = tid + it * 512, key = idx >> 3, ch = idx & 7, pk = pk0 + key; const bool ok = pk >= 0 && pk < L;
            u32x4 kw = kws[it], vw = vws[it];
            float kf[8]; unpack8(kw, kf); float ss = 0.f;
#pragma unroll
            for (int e = 0; e < 8; ++e) ss += kf[e] * kf[e];
            ss += shx(ss, 1, lane); ss += shx(ss, 2, lane); ss += shx(ss, 4, lane);
            const float rs = ok ? 1.0f / sqrtf(ss * (1.f / 64) + EPS) : 0.f;
            u32x4 ko; ko.x = pk2(kf[0] * rs * kg[8 * ch], kf[1] * rs * kg[8 * ch + 1]); ko.y = pk2(kf[2] * rs * kg[8 * ch + 2], kf[3] * rs * kg[8 * ch + 3]);
            ko.z = pk2(kf[4] * rs * kg[8 * ch + 4], kf[5] * rs * kg[8 * ch + 5]); ko.w = pk2(kf[6] * rs * kg[8 * ch + 6], kf[7] * rs * kg[8 * ch + 7]);
            *(LAS u32x4*)(lds + AT_K + key * 128 + ((ch ^ (key & 7)) << 4)) = ko;
            if (!ok) vw = (u32x4){0u, 0u, 0u, 0u};
            LAS bf16_t* vt = (LAS bf16_t*)(lds + AT_V + (8 * ch) * AT_VSTR) + key;
            vt[0] = (bf16_t)(vw.x & 0xffffu); *(LAS bf16_t*)((LAS unsigned char*)vt + AT_VSTR) = (bf16_t)(vw.x >> 16);
            *(LAS bf16_t*)((LAS unsigned char*)vt + 2 * AT_VSTR) = (bf16_t)(vw.y & 0xffffu); *(LAS bf16_t*)((LAS unsigned char*)vt + 3 * AT_VSTR) = (bf16_t)(vw.y >> 16);
            *(LAS bf16_t*)((LAS unsigned char*)vt + 4 * AT_VSTR) = (bf16_t)(vw.z & 0xffffu); *(LAS bf16_t*)((LAS unsigned char*)vt + 5 * AT_VSTR) = (bf16_t)(vw.z >> 16);
            *(LAS bf16_t*)((LAS unsigned char*)vt + 6 * AT_VSTR) = (bf16_t)(vw.w & 0xffffu); *(LAS bf16_t*)((LAS unsigned char*)vt + 7 * AT_VSTR) = (bf16_t)(vw.w >> 16); }
        for (int i = tid; i < 2 * 257; i += 512) { const int hh = i >= 257 ? 1 : 0, rr = i - 257 * hh; ((LAS float*)(lds + AT_B))[hh * 260 + rr] = rb[c_bucket[rr] * NHEAD + 4 * hk + 2 * gh + hh]; }
        __syncthreads();
        const int hh = wave >> 2, head = 4 * hk + 2 * gh + hh, qt = wave & 3, qi = 32 * qt + r32, pq = 128 * nb - 112 + qi; const bool qok = pq >= 0;
        const LAS float* bias = (const LAS float*)(lds + AT_B) + hh * 260;
        bf16x8 qf[4];
        { const bf16_t* qp = P + (size_t)(base + (qok ? pq : 0)) * INW + C_Q + 64 * head + 8 * hi; u32x4 qw[4]; float ss = 0.f;
#pragma unroll
          for (int ds = 0; ds < 4; ++ds) { qw[ds] = *(const u32x4*)(qp + 16 * ds); float f[8]; unpack8(qw[ds], f);
#pragma unroll
              for (int e = 0; e < 8; ++e) ss += f[e] * f[e]; }
          ss += shx(ss, 32, lane);
          const float rs = 0.125f / sqrtf(ss * (1.f / 64) + EPS);
#pragma unroll
          for (int ds = 0; ds < 4; ++ds) { float f[8]; unpack8(qw[ds], f); const float* g = qg + 16 * ds + 8 * hi; u32x4 o;
              o.x = pk2(f[0] * rs * g[0], f[1] * rs * g[1]); o.y = pk2(f[2] * rs * g[2], f[3] * rs * g[3]); o.z = pk2(f[4] * rs * g[4], f[5] * rs * g[5]); o.w = pk2(f[6] * rs * g[6], f[7] * rs * g[7]);
              qf[ds] = __builtin_bit_cast(bf16x8, o); } }
        float m = sink[head], lp = hi == 0 ? 1.f : 0.f;
        f32x16 o0 = {}, o1 = {};
        for (int kt = qt; kt <= qt + 8; ++kt) {
            f32x16 st = {};
#pragma unroll
            for (int ds = 0; ds < 4; ++ds) { const int key = 32 * kt + r32, chn = 2 * ds + hi;
                const bf16x8 kfr = *(const LAS bf16x8*)(lds + AT_K + key * 128 + ((chn ^ (key & 7)) << 4));
                st = __builtin_amdgcn_mfma_f32_32x32x16_bf16(kfr, qf[ds], st, 0, 0, 0); }
            float tmax = -1e30f;
#pragma unroll
            for (int i = 0; i < 16; ++i) { const int kj = 32 * kt + (i & 3) + 8 * (i >> 2) + 4 * hi, rel = kj - 128 - qi, pk = pk0 + kj;
                const bool ok = rel >= -128 && rel <= 128 && pk >= 0 && pk < L;
                const float v = ok ? st[i] + bias[rel + 128 < 0 ? 0 : (rel + 128 > 256 ? 256 : rel + 128)] : -1e30f;
                st[i] = v; tmax = fmaxf(tmax, v); }
            tmax = fmaxf(tmax, shx(tmax, 32, lane));
            const float mn = fmaxf(m, tmax), f = __expf(m - mn); m = mn;
            float ps = 0.f;
#pragma unroll
            for (int i = 0; i < 16; ++i) { st[i] = __expf(st[i] - mn); ps += st[i]; }
            lp = lp * f + ps;
#pragma unroll
            for (int i = 0; i < 16; ++i) { o0[i] *= f; o1[i] *= f; }
#pragma unroll
            for (int s2 = 0; s2 < 2; ++s2) {
                u32x4 pw; pw.x = pk2(st[8 * s2], st[8 * s2 + 1]); pw.y = pk2(st[8 * s2 + 2], st[8 * s2 + 3]); pw.z = pk2(st[8 * s2 + 4], st[8 * s2 + 5]); pw.w = pk2(st[8 * s2 + 6], st[8 * s2 + 7]);
                const bf16x8 pf = __builtin_bit_cast(bf16x8, pw);
#pragma unroll
                for (int dt = 0; dt < 2; ++dt) { const LAS unsigned char* vp = lds + AT_V + (32 * dt + r32) * AT_VSTR + (32 * kt + 16 * s2 + 4 * hi) * 2;
                    const u32x2 a0 = *(const LAS u32x2*)vp, a1 = *(const LAS u32x2*)(vp + 16);
                    const bf16x8 vf = __builtin_bit_cast(bf16x8, (u32x4){a0.x, a0.y, a1.x, a1.y});
                    if (dt == 0) o0 = __builtin_amdgcn_mfma_f32_32x32x16_bf16(vf, pf, o0, 0, 0, 0); else o1 = __builtin_amdgcn_mfma_f32_32x32x16_bf16(vf, pf, o1, 0, 0, 0); }
            }
        }
        const float il = (DBG & 4) ? 0.f : 1.f / (lp + shx(lp, 32, lane));
        if (qok && !F.dry) { bf16_t* op = P + (size_t)(base + pq) * INW + C_Q + 64 * head + 4 * hi;
#pragma unroll
            for (int g = 0; g < 4; ++g) { u32x2 w0, w1; w0.x = pk2(o0[4 * g] * il, o0[4 * g + 1] * il); w0.y = pk2(o0[4 * g + 2] * il, o0[4 * g + 3] * il);
                w1.x = pk2(o1[4 * g] * il, o1[4 * g + 1] * il); w1.y = pk2(o1[4 * g + 2] * il, o1[4 * g + 3] * il);
                *(u32x2*)(op + 8 * g) = w0; *(u32x2*)(op + 32 + 8 * g) = w1; } }
        __syncthreads();
    }
}
__device__ __forceinline__ void dwconv8(const bf16_t* P, int r, int col, const float* cw, const float* cb, int ucol, float* out) {
    const int s = seq_of_row(r), p = r - seq_base(s); const bool hasp = p > 0, hasn = p < seq_len(s) - 1;
    const bf16_t* gp = P + (size_t)r * INW + col;
    const u32x4 gm = *(const u32x4*)(gp - (hasp ? INW : 0)), g0 = *(const u32x4*)gp, gn = *(const u32x4*)(gp + (hasn ? INW : 0));
    float fm[8], f0[8], fn[8]; unpack8(gm, fm); unpack8(g0, f0); unpack8(gn, fn);
    const float mp_ = hasp ? 1.f : 0.f, mn_ = hasn ? 1.f : 0.f;
#pragma unroll
    for (int e = 0; e < 8; ++e) { fm[e] *= mp_; fn[e] *= mn_; }
#pragma unroll
    for (int e = 0; e < 8; ++e) out[e] = cw[ucol + e] * fm[e] + cw[1536 + ucol + e] * f0[e] + cw[2 * 1536 + ucol + e] * fn[e] + cb[ucol + e];
}
struct DwRows { u32x4 gm, g0, gn; float mp_, mn_; };
struct DwTaps { f32x4 a[2], b[2], c[2], d[2]; };
__device__ __forceinline__ void dw_load(const bf16_t* P, int r, int col, DwRows& d) {
    const int s = seq_of_row(r), p = r - seq_base(s); const bool hasp = p > 0, hasn = p < seq_len(s) - 1;
    const bf16_t* gp = P + (size_t)r * INW + col;
    d.gm = *(const u32x4*)(gp - (hasp ? INW : 0)); d.g0 = *(const u32x4*)gp; d.gn = *(const u32x4*)(gp + (hasn ? INW : 0));
    d.mp_ = hasp ? 1.f : 0.f; d.mn_ = hasn ? 1.f : 0.f;
}
__device__ __forceinline__ void dw_taps(const float* cw, const float* cb, int ucol, DwTaps& w) {
#pragma unroll
    for (int h = 0; h < 2; ++h) { w.a[h] = *(const f32x4*)(cw + ucol + 4 * h); w.b[h] = *(const f32x4*)(cw + 1536 + ucol + 4 * h); w.c[h] = *(const f32x4*)(cw + 2 * 1536 + ucol + 4 * h); w.d[h] = *(const f32x4*)(cb + ucol + 4 * h); }
}
__device__ __forceinline__ void dw_apply(const DwRows& d, const DwTaps& w, float* out) {
    float fm[8], f0[8], fn[8]; unpack8(d.gm, fm); unpack8(d.g0, f0); unpack8(d.gn, fn);
#pragma unroll
    for (int e = 0; e < 8; ++e) out[e] = w.a[e >> 2][e & 3] * (fm[e] * d.mp_) + w.b[e >> 2][e & 3] * f0[e] + w.c[e >> 2][e & 3] * (fn[e] * d.mn_) + w.d[e >> 2][e & 3];
}
__device__ __forceinline__ void p_h1(const CArgs& A, const Frame& F, int layer) {
    const bf16_t* P = (const bf16_t*)(F.ws + WS_PROJ); bf16_t* ZT = (bf16_t*)(F.ws + WS_XNR);
    const float* cw = FIN(9) + (size_t)layer * 3 * 1536; const float* cb = FIN(10) + layer * 1536;
    LAS bf16_t* scr = (LAS bf16_t*)(F.lds + F.wave * 16384);
    const int gw = F.vcu * NWAVES + F.wave, NGW = F.G * NWAVES, lane = F.lane, rs = lane >> 3, ck = lane & 7;
    for (int it = gw; it < (MP / 64) * 8; it += NGW) {
        const int rt = it >> 3, cc = it & 7, c0 = cc * 64 + ck * 8;
        DwTaps wa, wb; dw_taps(cw, cb, 512 + c0, wa); dw_taps(cw, cb, 1024 + c0, wb);
#pragma unroll
        for (int hb = 0; hb < 2; ++hb) { DwRows da[4], db[4];
#pragma unroll
            for (int q = 0; q < 4; ++q) { const int r = rt * 64 + (hb * 4 + q) * 8 + rs, rc = r < MROWS ? r : MROWS - 1; dw_load(P, rc, C_X1 + c0, da[q]); dw_load(P, rc, C_VV + c0, db[q]); }
            asm volatile("" ::: "memory");
#pragma unroll
            for (int q = 0; q < 4; ++q) { const int lr = (hb * 4 + q) * 8 + rs, r = rt * 64 + lr; float a[8], b[8]; dw_apply(da[q], wa, a); dw_apply(db[q], wb, b);
                const float ok = r < MROWS ? 1.f : 0.f;
#pragma unroll
                for (int e = 0; e < 8; ++e) scr[(ck * 8 + e) * 72 + lr] = (bf16_t)f2bf(a[e] * b[e] * ok); }
            asm volatile("" ::: "memory"); }
        LDS_WAIT();
#pragma unroll
        for (int j = 0; j < 8; ++j) { const int chn = (lane >> 3) + 8 * j, pc = lane & 7;
            const u32x4 w = *(const LAS u32x4*)(scr + chn * 72 + pc * 8);
            *(u32x4*)(ZT + (size_t)(cc * 64 + chn) * MP + rt * 64 + pc * 8) = w; }
        LDS_WAIT();
    }
}

__device__ __forceinline__ void p_h2_ref(const CArgs& A, const Frame& F) {
    const bf16_t* ZT = (const bf16_t*)(F.ws + WS_XNR); bf16_t* CT = (bf16_t*)(F.ws + WS_XNR + (size_t)512 * MP * 2);
    const int gt = (F.vcu * NWAVES + F.wave) * 64 + F.lane, NGT = F.G * NWAVES * 64;
    for (long idx = gt; idx < (long)512 * MP; idx += NGT) {
        const int c = (int)(idx / MP), r = (int)(idx - (long)c * MP);
        float acc = 0.f;
        if (r < MROWS) {
            const int s = seq_of_row(r), base = seq_base(s), L = seq_len(s), p = r - base, cls = s < 8 ? 0 : 1;
            const bf16_t* rk = (const bf16_t*)(F.ws + (cls ? WS_RKS : WS_RKP)) + (size_t)c * (cls ? RKLEN_S : RKLEN_P) + RK_PAD + L - p;
            const bf16_t* z = ZT + (size_t)c * MP + base;
            for (int s8 = 0; s8 < L; s8 += 8) { const u32x4 zw = *(const u32x4*)(z + s8); float zf[8]; unpack8(zw, zf);
#pragma unroll
                for (int e = 0; e < 8; ++e) acc += zf[e] * __uint_as_float((unsigned)rk[s8 + e] << 16); }
        }
        CT[idx] = (bf16_t)f2bf(acc);
    }
}
constexpr int H2_ZOFF_S = ((RKLEN_S * 2 + 1023) >> 10) << 10, H2_ZOFF_P = ((RKLEN_P * 2 + 1023) >> 10) << 10;
constexpr int H2_ZPADL_S = 4096, H2_ZSLOTS_S = 24704, H2_ZPADL_P = 512, H2_ZSLOTS_P = 3072, H2_SZP = 6976;
static_assert(H2_ZOFF_S + (H2_ZSLOTS_S + (H2_ZSLOTS_S >> 7) * 16) * 2 <= RING_BYTES_C && H2_ZOFF_P + 8 * H2_SZP <= RING_BYTES_C, "H2 LDS");
__device__ __forceinline__ void p_h2(const Frame& F) {
    const bf16_t* ZT = (const bf16_t*)(F.ws + WS_XNR); bf16_t* CT = (bf16_t*)(F.ws + WS_XNR + (size_t)512 * MP * 2);
    const int lane = F.lane, wave = F.wave, tid = F.tid;
    LAS float* red = (LAS float*)(F.lds + LDSCTL_OFF_C + 1024);
    for (int item = F.vcu; item < 1024; item += F.G) {
        const int cls = item < 512 ? 1 : 0, c = item & 511;
        const int L = cls ? LS : LP, rklen = cls ? RKLEN_S : RKLEN_P, ZPADL = cls ? H2_ZPADL_S : H2_ZPADL_P, zs8 = (cls ? H2_ZSLOTS_S : H2_ZSLOTS_P) / 8;
        LAS unsigned char* rkl = F.lds; LAS unsigned char* zl = F.lds + (cls ? H2_ZOFF_S : H2_ZOFF_P);
        {
          const char* rkg = (const char*)((const bf16_t*)(F.ws + (cls ? WS_RKS : WS_RKP)) + (size_t)c * rklen);
          const int npc = (rklen * 2 + 1023) >> 10;
          for (int pc = wave; pc < npc; pc += NWAVES)
              __builtin_amdgcn_global_load_lds((const unsigned*)(rkg + (size_t)pc * 1024 + lane * 16), (LAS unsigned*)(rkl + pc * 1024), 16, 0, 0);
          const int nsl = (cls ? 1 : 8) * zs8; u32x4 zv[7];
#pragma unroll
          for (int j = 0; j < 7; ++j) { const int i = tid + j * (NWAVES * 64); const int sq = i / zs8, i8 = i - sq * zs8, sp = i8 * 8 - ZPADL;
              zv[j] = (u32x4){0u, 0u, 0u, 0u};
              if (i < nsl && sp >= 0 && sp < L) zv[j] = *(const u32x4*)(ZT + (size_t)c * MP + (cls ? ROWS_P : sq * LP) + sp); }
#pragma unroll
          for (int j = 0; j < 7; ++j) { const int i = tid + j * (NWAVES * 64); const int sq = i / zs8, i8 = i - sq * zs8; const int pos = i8 * 8, el = pos + ((pos >> 7) << 4);
              if (i < nsl) *(LAS u32x4*)(zl + sq * H2_SZP + el * 2) = zv[j]; }
          asm volatile("s_waitcnt vmcnt(0)" ::: "memory"); }
        __syncthreads();
        const int n = lane & 15, h = lane >> 4, cg = wave & 3, us = wave >> 2;
        int T0a, zb, T0min, T0max, rowbase;
        const int T0g = cls ? 128 * 16 : 256; const int zg1 = (T0g + (T0g >> 7) * 16) * 2;
        if (cls) { T0min = 16 + 128 * 32 * cg; T0max = T0min + 128 * 31; T0a = T0min + 128 * n; zb = 0; rowbase = ROWS_P; }
        else { const int sq = n >> 1; T0min = 16 + 512 * cg; T0max = T0min + 384; T0a = T0min + 128 * (n & 1); zb = sq * H2_SZP; rowbase = sq * LP; }
        const int u_lo = -(((T0max + 7 + 31) >> 5) << 5), u_hi = ((L - 32 - T0min + 31) >> 5) << 5;
        const int nst = (u_hi - u_lo) / 32 + 1, nh = (nst + 1) >> 1;
        const int u_a = us ? u_lo + 32 * nh : u_lo, u_b = us ? u_hi : u_lo + 32 * (nh - 1);
        const int abase = RK_PAD + L - 8 * n + 8 * h;
        f32x4 acc[2][8];
#pragma unroll
        for (int g = 0; g < 2; ++g)
#pragma unroll
            for (int t = 0; t < 8; ++t) acc[g][t] = (f32x4){0.f, 0.f, 0.f, 0.f};
#define H2_STEP(V0, V1) do { \
            const LAS unsigned char* ap = rkl + (abase + u) * 2; \
            const u32x4 Lo = *(const LAS u32x4*)(ap - 16), Hi = *(const LAS u32x4*)ap; \
            bf16x8 Bz[2]; \
            { const int i0 = T0a + u + 8 * h + ZPADL, e0 = i0 + ((i0 >> 7) << 4); const LAS unsigned char* zp = zl + zb + e0 * 2; \
              if (V0) Bz[0] = *(const LAS bf16x8*)zp; if (V1) Bz[1] = *(const LAS bf16x8*)(zp + zg1); } \
            unsigned W[8] = {Lo.x, Lo.y, Lo.z, Lo.w, Hi.x, Hi.y, Hi.z, Hi.w}, Od[7]; \
            _Pragma("unroll") for (int k = 0; k < 7; ++k) Od[k] = __builtin_amdgcn_alignbit(W[k + 1], W[k], 16); \
            _Pragma("unroll") for (int t = 0; t < 8; ++t) { const int i = 4 - ((t + 1) >> 1); \
                const u32x4 fw = (t & 1) ? (u32x4){Od[i], Od[i + 1], Od[i + 2], Od[i + 3]} : (u32x4){W[i], W[i + 1], W[i + 2], W[i + 3]}; \
                const bf16x8 Af = __builtin_bit_cast(bf16x8, fw); \
                if (V0) acc[0][t] = __builtin_amdgcn_mfma_f32_16x16x32_bf16(Af, Bz[0], acc[0][t], 0, 0, 0); \
                if (V1) acc[1][t] = __builtin_amdgcn_mfma_f32_16x16x32_bf16(Af, Bz[1], acc[1][t], 0, 0, 0); } } while (0)
        { const int gspan = cls ? 128 * 15 : 128;
          int u0s = -(T0min + gspan + 39); u0s = u0s >= 0 ? ((u0s + 31) >> 5) << 5 : -((-u0s) >> 5 << 5);
          int u1e = L - (T0min + T0g); u1e = u1e >= 0 ? ((u1e + 31) >> 5) << 5 : -((-u1e) >> 5 << 5);
          const int ua2 = u0s > u_a ? (u0s < u_b + 32 ? u0s : u_b + 32) : u_a;
          const int ub2 = u1e < u_b + 32 ? (u1e > ua2 ? u1e : ua2) : u_b + 32;
          int u = u_a;
          for (; u < ua2; u += 32) H2_STEP(false, true);
          for (; u < ub2; u += 32) H2_STEP(true, true);
          for (; u <= u_b; u += 32) H2_STEP(true, false); }
#undef H2_STEP
        { float m[16];
#pragma unroll
          for (int t = 0; t < 16; ++t) m[t] = 0.f;
          const int nchunk = L / 8, cstep = cls ? NWAVES * 64 : 64; const int zb2 = cls ? 0 : wave * H2_SZP;
          for (int ck = cls ? tid : lane; ck < nchunk; ck += cstep) { const int s0 = ck * 8, i0 = s0 + ZPADL, e0 = i0 + ((i0 >> 7) << 4);
              const u32x4 zw = *(const LAS u32x4*)(zl + zb2 + e0 * 2);
              const LAS unsigned char* rp = rkl + (RK_PAD + L + s0 - 16) * 2;
              const u32x4 r0 = *(const LAS u32x4*)rp, r1 = *(const LAS u32x4*)(rp + 16), r2 = *(const LAS u32x4*)(rp + 32);
              float zf[8], rf[24]; unpack8(zw, zf); unpack8(r0, rf); unpack8(r1, rf + 8); unpack8(r2, rf + 16);
#pragma unroll
              for (int t = 0; t < 16; ++t)
#pragma unroll
                  for (int e = 0; e < 8; ++e) m[t] += zf[e] * rf[16 + e - t]; }
#pragma unroll
          for (int t = 0; t < 16; ++t) m[t] = wave_sum(m[t], lane);
          float mine = 0.f;
#pragma unroll
          for (int t = 0; t < 16; ++t) mine = (lane == t) ? m[t] : mine;
          if (cls) { if (lane < 16) red[wave * 16 + lane] = mine; }
          else if (lane < 16) CT[(size_t)c * MP + wave * LP + lane] = (bf16_t)f2bf(mine); }
        __syncthreads();
        if (us == 1) {
#pragma unroll
            for (int g = 0; g < 2; ++g)
#pragma unroll
                for (int t = 0; t < 8; ++t) *(LAS f32x4*)(F.lds + cg * 16384 + (g * 8 + t) * 1024 + lane * 16) = acc[g][t]; }
        if (cls && tid < 16) { float a = 0.f;
#pragma unroll
            for (int w = 0; w < 8; ++w) a += red[w * 16 + tid];
            CT[(size_t)c * MP + ROWS_P + tid] = (bf16_t)f2bf(a); }
        __syncthreads();
        if (us == 0) {
#pragma unroll
            for (int g = 0; g < 2; ++g) {
#pragma unroll
                for (int t = 0; t < 8; ++t) acc[g][t] += *(const LAS f32x4*)(F.lds + cg * 16384 + (g * 8 + t) * 1024 + lane * 16);
                bf16_t* op = CT + (size_t)c * MP + rowbase + T0a + g * T0g + 32 * h;
#pragma unroll
                for (int i = 0; i < 4; ++i) { u32x4 w; w.x = pk2(acc[g][0][i], acc[g][1][i]); w.y = pk2(acc[g][2][i], acc[g][3][i]); w.z = pk2(acc[g][4][i], acc[g][5][i]); w.w = pk2(acc[g][6][i], acc[g][7][i]);
                    *(u32x4*)(op + 8 * i) = w; } } }
        __syncthreads();
    }
}
__device__ __forceinline__ void p_pool(const CArgs& A, const Frame& F) {
    bf16_t* P = (bf16_t*)(F.ws + WS_PROJ);
    const int gw = F.vcu * NWAVES + F.wave, NGW = F.G * NWAVES, lane = F.lane, c0 = lane * 8, hw = 1 << (lane >> 4);
    for (int run = gw; run < MROWS / 16; run += NGW) {
        const int r0 = run * 16, s = seq_of_row(r0), base = seq_base(s), L = seq_len(s), p0 = r0 - base;
        const bf16_t* ub = P + (size_t)base * INW + C_PU + c0;
        float S[8];
#pragma unroll
        for (int e = 0; e < 8; ++e) S[e] = 0.f;
#pragma unroll
        for (int i = 0; i < 16; ++i) { const int pp = p0 - hw + i; const bool ok = i < 2 * hw && pp >= 0 && pp < L;
            const u32x4 w = *(const u32x4*)(ub + (size_t)(ok ? pp : p0) * INW); float f[8]; unpack8(w, f); const float mk = ok ? 1.f : 0.f;
#pragma unroll
            for (int e = 0; e < 8; ++e) S[e] += mk * f[e]; }
#pragma unroll 4
        for (int k = 0; k < 16; ++k) { const int p = p0 + k, pn = p + hw, po = p - hw; const bool okn = pn < L, oko = po >= 0;
            const u32x4 ws_ = *(const u32x4*)(ub + (size_t)p * INW), wn = *(const u32x4*)(ub + (size_t)(okn ? pn : p) * INW), wo = *(const u32x4*)(ub + (size_t)(oko ? po : p) * INW);
            float fs[8], fn[8], fo[8]; unpack8(ws_, fs); unpack8(wn, fn); unpack8(wo, fo);
            const int lo = po < 0 ? 0 : po, hi = pn > L ? L : pn; const float ic = 1.f / (float)(hi - lo);
            float a[8];
#pragma unroll
            for (int e = 0; e < 8; ++e) a[e] = (DBG & 16) ? 0.f : S[e] * ic - fs[e];
            u32x4 w; w.x = pk2(a[0], a[1]); w.y = pk2(a[2], a[3]); w.z = pk2(a[4], a[5]); w.w = pk2(a[6], a[7]);
            *(u32x4*)(P + (size_t)(r0 + k) * INW + C_X1 + c0) = w;
            const float mn = okn ? 1.f : 0.f, mo = oko ? 1.f : 0.f;
#pragma unroll
            for (int e = 0; e < 8; ++e) S[e] += mn * fn[e] - mo * fo[e]; }
    }
}
__device__ __forceinline__ void p_final(const CArgs& A, const Frame& F, int layer) {
    bf16_t* P = (bf16_t*)(F.ws + WS_PROJ); const bf16_t* ZT = (const bf16_t*)(F.ws + WS_XNR); const bf16_t* CT = ZT + (size_t)512 * MP;
    const float* cw = FIN(9) + (size_t)layer * 3 * 1536; const float* cb = FIN(10) + layer * 1536; const float* skip = FIN(17) + layer * 512;
    LAS bf16_t* sz = (LAS bf16_t*)(F.lds + F.wave * 16384); LAS bf16_t* sc = sz + 64 * 64;
    const int gw = F.vcu * NWAVES + F.wave, NGW = F.G * NWAVES, lane = F.lane, rs = lane >> 3, ck = lane & 7;
    for (int it = gw; it < (MP / 64) * 8; it += NGW) {
        const int rt = it >> 3, cc = it & 7, c0 = cc * 64 + ck * 8; const int cls = rt * 64 < ROWS_P ? 0 : 1;
        const float* sums = (const float*)(F.ws + WS_CTL) + CW_SUMS + (layer * 2 + cls) * 512;
#pragma unroll
        for (int j = 0; j < 8; ++j) { const int chn = (lane >> 3) + 8 * j, pc = lane & 7; const size_t off = (size_t)(cc * 64 + chn) * MP + rt * 64 + pc * 8;
            *(LAS u32x4*)(sz + chn * 64 + pc * 8) = *(const u32x4*)(ZT + off); *(LAS u32x4*)(sc + chn * 64 + pc * 8) = *(const u32x4*)(CT + off); }
        LDS_WAIT();
        DwTaps wt; dw_taps(cw, cb, c0, wt); float isum[8], sk[8];
        { const f32x4 s0 = *(const f32x4*)(sums + c0), s1 = *(const f32x4*)(sums + c0 + 4), k0 = *(const f32x4*)(skip + c0), k1 = *(const f32x4*)(skip + c0 + 4);
#pragma unroll
          for (int e = 0; e < 4; ++e) { isum[e] = 1.f / s0[e]; isum[4 + e] = 1.f / s1[e]; sk[e] = k0[e]; sk[4 + e] = k1[e]; } }
#pragma unroll
        for (int hb = 0; hb < 2; ++hb) { DwRows dr[4];
#pragma unroll
            for (int q = 0; q < 4; ++q) { const int r = rt * 64 + (hb * 4 + q) * 8 + rs; dw_load(P, r < MROWS ? r : MROWS - 1, C_X0 + c0, dr[q]); }
            asm volatile("" ::: "memory");
#pragma unroll
            for (int q = 0; q < 4; ++q) { const int lr = (hb * 4 + q) * 8 + rs, r = rt * 64 + lr; float x0[8], o[8]; dw_apply(dr[q], wt, x0);
#pragma unroll
                for (int e = 0; e < 8; ++e) { const float z = __uint_as_float((unsigned)sz[(ck * 8 + e) * 64 + lr] << 16), cv = __uint_as_float((unsigned)sc[(ck * 8 + e) * 64 + lr] << 16);
                    o[e] = (DBG & 8) ? 0.f : (((DBG & 64) ? 0.f : cv * isum[e]) + ((DBG & 128) ? 0.f : z * sk[e])) * x0[e]; }
                u32x4 w; w.x = pk2(o[0], o[1]); w.y = pk2(o[2], o[3]); w.z = pk2(o[4], o[5]); w.w = pk2(o[6], o[7]);
                if (r < MROWS) *(u32x4*)(P + (size_t)r * INW + C_VV + c0) = w; }
            asm volatile("" ::: "memory"); }
        LDS_WAIT();
    }
}
__device__ __forceinline__ void p_norm2(const CArgs& A, const Frame& F, int layer) {
    const int gw = F.vcu * NWAVES + F.wave, NGW = F.G * NWAVES, lane = F.lane;
    const float* g = FIN(24) + layer * DM; bf16_t* XN = (bf16_t*)(F.ws + WS_XNR);
    for (int r0 = gw; r0 < MP; r0 += 2 * NGW) { f32x4 v[2][4]; const int r1 = r0 + NGW;
        { const f32x4* xr = (const f32x4*)xrow(F.out, F.xm, r0) + lane;
#pragma unroll
          for (int j = 0; j < 4; ++j) v[0][j] = xr[64 * j]; }
        if (r1 < MP) { const f32x4* xr = (const f32x4*)xrow(F.out, F.xm, r1) + lane;
#pragma unroll
          for (int j = 0; j < 4; ++j) v[1][j] = xr[64 * j]; }
        rms_row(v[0], g, XN + (size_t)r0 * DM, lane);
        if (r1 < MP) rms_row(v[1], g, XN + (size_t)r1 * DM, lane); }
}

constexpr int TAIL_ROW0 = 32768, TAIL_ITEMS = ((MROWS - TAIL_ROW0) / 16) * 16;
static_assert(MROWS - TAIL_ROW0 == 144 && TAIL_ROW0 % 256 == 0, "tail rows");
template <int NS>
__device__ __forceinline__ void tail_partial(f32x4 (&acc)[4], const bf16_t* ap, const bf16_t* bp, size_t bstride16) {
#pragma unroll
    for (int s0 = 0; s0 < NS; s0 += 4) {
        bf16x8 a[4], b[4][4];
#pragma unroll
        for (int s = 0; s < 4; ++s) if (s0 + s < NS) { a[s] = *(const bf16x8*)(ap + (s0 + s) * 32);
#pragma unroll
            for (int j = 0; j < 4; ++j) b[s][j] = *(const bf16x8*)(bp + j * bstride16 + (s0 + s) * 32); }
#pragma unroll
        for (int s = 0; s < 4; ++s) if (s0 + s < NS) {
#pragma unroll
            for (int j = 0; j < 4; ++j) acc[j] = __builtin_amdgcn_mfma_f32_16x16x32_bf16(b[s][j], a[s], acc[j], 0, 0, 0); }
        asm volatile("" ::: "memory");
    }
}
template <int K>
__device__ __forceinline__ void tail_res(const Frame& F, const bf16_t* A, const bf16_t* Bt) {
    constexpr int KW = K / 8, NS = KW / 32; static_assert(K % 256 == 0, "K split");
    const int lane = F.lane, fr = lane & 15, fq = lane >> 4, tid = F.tid;
    for (int item = F.bx; item < TAIL_ITEMS; item += F.G) {
        const int row0 = TAIL_ROW0 + (item >> 4) * 16, col0 = (item & 15) * 64;
        f32x4 acc[4];
#pragma unroll
        for (int j = 0; j < 4; ++j) acc[j] = (f32x4){0.f, 0.f, 0.f, 0.f};
        tail_partial<NS>(acc, A + (size_t)(row0 + fr) * K + F.wave * KW + fq * 8, Bt + (size_t)(col0 + fr) * K + F.wave * KW + fq * 8, (size_t)16 * K);
#pragma unroll
        for (int j = 0; j < 4; ++j) *(LAS f32x4*)(F.lds + F.wave * 4096 + j * 1024 + lane * 16) = acc[j];
        __syncthreads();
        f32x2 s = {0.f, 0.f};
#pragma unroll
        for (int w = 0; w < 8; ++w) s += *(const LAS f32x2*)(F.lds + w * 4096 + tid * 8);
        const int j = tid >> 7, l = (tid & 127) >> 1, r = (tid & 1) * 2;
        float* p = xrow(F.out, F.xm, row0 + (l & 15)) + col0 + j * 16 + 4 * (l >> 4) + r;
        f32x2 v = *(f32x2*)p; v += s; if (!F.dry) *(f32x2*)p = v;
        __syncthreads();
    }
}
__device__ __forceinline__ void tail_merge(const Frame& F, const bf16_t* P, const bf16_t* WM, bf16_t* O) {
    const int lane = F.lane, fr = lane & 15, fq = lane >> 4, tid = F.tid;
    for (int item = F.bx; item < TAIL_ITEMS; item += F.G) {
        const int row0 = TAIL_ROW0 + (item >> 4) * 16, col0 = (item & 15) * 64;
#pragma unroll
        for (int s = 0; s < 3; ++s) { const int col = s == 0 ? C_Q : (s == 1 ? C_VV : C_X1);
            f32x4 acc[4];
#pragma unroll
            for (int j = 0; j < 4; ++j) acc[j] = (f32x4){0.f, 0.f, 0.f, 0.f};
            tail_partial<2>(acc, P + (size_t)(row0 + fr) * INW + col + F.wave * 64 + fq * 8, WM + ((size_t)s * DM + col0 + fr) * 512 + F.wave * 64 + fq * 8, (size_t)16 * 512);
#pragma unroll
            for (int j = 0; j < 4; ++j) *(LAS f32x4*)(F.lds + s * 32768 + F.wave * 4096 + j * 1024 + lane * 16) = acc[j]; }
        __syncthreads();
        const int j = tid >> 7, l = (tid & 127) >> 1, r = (tid & 1) * 2, row = row0 + (l & 15), colo = col0 + j * 16 + 4 * (l >> 4) + r;
        const unsigned char* gp = (const unsigned char*)(P + (size_t)row * INW) + C_G * 2 + colo;
        f32x2 o = {0.f, 0.f};
#pragma unroll
        for (int s = 0; s < 3; ++s) { f32x2 t = {0.f, 0.f};
#pragma unroll
            for (int w = 0; w < 8; ++w) t += *(const LAS f32x2*)(F.lds + s * 32768 + w * 4096 + tid * 8);
            const unsigned g2 = *(const unsigned short*)(gp + s * DM);
            o.x += t.x * ((float)(g2 & 255u) * (1.f / 255.f)); o.y += t.y * ((float)(g2 >> 8) * (1.f / 255.f)); }
        *(unsigned*)(O + (size_t)row * DM + colo) = pg8::cvt_pk_bf16(o.x, o.y);
        __syncthreads();
    }
}

constexpr int PH_PER_LAYER = 11, N_PHASES = 2 * PH_PER_LAYER;
__global__ void __launch_bounds__(NWAVES * 64, 2) fwd_kernel(Args args0) {
    extern __shared__ __attribute__((aligned(16))) unsigned char lds_raw[];
    const int wave0 = __builtin_amdgcn_readfirstlane(threadIdx.x >> 6);
    {
        for (int u = threadIdx.x; u < (LDS_BYTES - LDSCTL_OFF) / 4; u += NWAVES * 64) ((LAS unsigned*)((LAS unsigned char*)lds_raw + LDSCTL_OFF))[u] = 0u;
        __syncthreads();
    }
    XcdBarrier bar; bar.bar = (unsigned*)(args0.ws + WS_CTL) + CW_BAR; bar.x = 0; bar.st = nullptr;
    if (args0.use_bar) bar = xcd_barrier_post((unsigned*)(args0.ws + WS_CTL) + CW_BAR, (volatile LAS unsigned*)((LAS unsigned char*)lds_raw + MISC_OFF) + 8);
    for (int ph2 = 2 * args0.ph_lo; ph2 < 2 * args0.ph_hi; ++ph2) {
        const int ph = ph2 >> 1, rep = ph2 & 1;
        const int layer = ph / PH_PER_LAYER, k = ph % PH_PER_LAYER;
        if (rep == 1 && !(DUP_PHASE >= 0 && k == DUP_PHASE && args0.pad == 0)) continue;
        const __attribute__((address_space(4))) Args* ap = (const __attribute__((address_space(4))) Args*)__builtin_amdgcn_kernarg_segment_ptr();
        asm volatile("" : "+s"(ap));
        const __attribute__((address_space(4))) Args& args = *ap;
        Frame F;
        { int w_ = wave0; asm volatile("" : "+s"(w_)); int z_ = 0; asm volatile("" : "+v"(z_)); const int l_ = __builtin_amdgcn_mbcnt_hi(-1, __builtin_amdgcn_mbcnt_lo(-1, z_));
          F.lane = l_; F.wave = w_; F.tid = w_ * 64 + l_;
          int bx = blockIdx.x, G_ = gridDim.x; asm volatile("" : "+s"(bx), "+s"(G_)); F.G = G_; F.vcu = (G_ % 8 == 0) ? (bx % 8) * (G_ / 8) + bx / 8 : bx; F.bx = bx;
          F.dry = rep; F.lds = (LAS unsigned char*)lds_raw; F.ws = args.ws; F.out = args.out; F.xm = (float*)(args.ws + WS_XM); }
        unsigned char* W = F.ws + WS_W;
        bf16_t* XNR = (bf16_t*)(F.ws + WS_XNR); bf16_t* PROJ = (bf16_t*)(F.ws + WS_PROJ);
        bf16_t* GB = PROJ; bf16_t* ACT = PROJ + (size_t)MP * DFF;
#ifndef ONLY_PHASE
#define ONLY_PHASE -1
#endif
#define PHS(x) ((ONLY_PHASE < 0 || ONLY_PHASE == (x)) && k == (x) && !((DBG & 1) && (x) >= 1 && (x) <= 6) && !((DBG & 2) && (x) >= 7) && !((DBG & 32) && layer > 0))
        if (PHS(0)) p_prep(args, F, layer);
        else if (PHS(1)) { OpsPlain O{XNR, (const bf16_t*)(W + W_IN), DM, DM}; pg8::StaticOrder S; S.init(MP, INW, F.G, F.bx, 1); EpiStore E{PROJ, INW, C_G / 256};
            pg8::gemm_phase<EpiStore, OpsPlain, true>(F.lds, O, S, E, F.tid); }
        else if (PHS(2)) { if (DBG & 512) p_attn_ref(args, F, layer); else if (DSEL(64)) p_attn(args, F, layer); if (DSEL(128)) p_h1(args, F, layer); if (DSEL(256)) p_filt_tiles(args, F, layer); }
        else if (PHS(3)) { if (DBG & 256) p_h2_ref(args, F); else if (DSEL(16)) p_h2(F); if (DSEL(32)) p_pool(args, F); }
        else if (PHS(4)) p_final(args, F, layer);
        else if (PHS(5)) { OpsMerge O{PROJ, (const bf16_t*)(W + W_MRG), 512, INW}; pg8::StaticOrder S; S.init(TAIL_ROW0, DM, F.G, F.bx, 3); EpiMerge E{PROJ, XNR};
            pg8::gemm_phase<EpiMerge, OpsMerge, true>(F.lds, O, S, E, F.tid); tail_merge(F, PROJ, (const bf16_t*)(W + W_MRG), XNR); }
        else if (PHS(6)) { OpsPlain O{XNR, (const bf16_t*)(W + W_OUT), DM, DM}; pg8::StaticOrder S; S.init(TAIL_ROW0, DM, F.G, F.bx, 1); EpiRes E{F.out, F.xm, F.dry};
            pg8::gemm_phase<EpiRes, OpsPlain, true>(F.lds, O, S, E, F.tid); tail_res<DM>(F, XNR, (const bf16_t*)(W + W_OUT)); }
        else if (PHS(7)) p_norm2(args, F, layer);
        else if (PHS(8)) { OpsPlain O{XNR, (const bf16_t*)(W + W_G), DM, DM}; pg8::StaticOrder S; S.init(MP, DFF, F.G, F.bx, 1); EpiStore E{GB, DFF, 1 << 20};
            pg8::gemm_phase<EpiStore, OpsPlain, true>(F.lds, O, S, E, F.tid); }
        else if (PHS(9)) { OpsPlain O{XNR, (const bf16_t*)(W + W_U), DM, DM}; pg8::StaticOrder S; S.init(MP, DFF, F.G, F.bx, 1);
            EpiGeluMul E{GB, args.in[27] + (size_t)layer * 3 * DFF, args.in[28] + layer * DFF, ACT, F.dry ? DRYVAR : 0};
            pg8::gemm_phase<EpiGeluMul, OpsPlain, true>(F.lds, O, S, E, F.tid); }
        else if (PHS(10)) { OpsPlain O{ACT, (const bf16_t*)(W + W_D), DFF, DFF}; pg8::StaticOrder S; S.init(TAIL_ROW0, DM, F.G, F.bx, 1); EpiRes E{F.out, F.xm, F.dry};
            pg8::gemm_phase<EpiRes, OpsPlain, true>(F.lds, O, S, E, F.tid); tail_res<DFF>(F, ACT, (const bf16_t*)(W + W_D)); }
        if (ph2 + 1 < 2 * args0.ph_hi) { { int z2_ = 0; asm volatile("" : "+v"(z2_)); const int tid2 = wave0 * 64 + __builtin_amdgcn_mbcnt_hi(-1, __builtin_amdgcn_mbcnt_lo(-1, z2_));
              if (args0.use_bar) xcd_barrier(bar, tid2); else __syncthreads(); } }
    }
}

__global__ void fill_k(float* o, size_t n, float v) { size_t i = (size_t)blockIdx.x * blockDim.x + threadIdx.x; for (; i < n; i += (size_t)gridDim.x * blockDim.x) o[i] = v; }
extern "C" void kernel_launch(void* const* d_in, const int* in_sizes, int n_in, void* d_out, int out_size, void* d_ws, size_t ws_size, hipStream_t stream) {
    static int grid = 0;
    if (grid == 0) {
        int dev = 0, cus = 0;
        if (n_in != 30 || out_size != 32768 * DM || ws_size < WS_END || hipGetDevice(&dev) != hipSuccess || hipDeviceGetAttribute(&cus, hipDeviceAttributeMultiprocessorCount, dev) != hipSuccess ||
            hipFuncSetAttribute((const void*)fwd_kernel, hipFuncAttributeMaxDynamicSharedMemorySize, LDS_BYTES) != hipSuccess) { fprintf(stderr, "kernel_launch: bad shapes / workspace / device\n"); grid = -1; }
        else { int per_cu = 0; (void)hipOccupancyMaxActiveBlocksPerMultiprocessor(&per_cu, (const void*)fwd_kernel, NWAVES * 64, LDS_BYTES); (void)hipGetLastError();
            grid = cus * (per_cu >= 1 ? 1 : 0); if (grid <= 0) grid = -1; }
    }
    if (grid < 0) { fill_k<<<1024, 256, 0, stream>>>((float*)d_out, (size_t)out_size, 1e6f); return; }
    (void)hipMemsetAsync((char*)d_ws + WS_CTL, 0, CTL_ZERO_BYTES, stream);
    Args a{};
    for (int i = 0; i < 30; ++i) a.in[i] = (const float*)d_in[i];
    a.out = (float*)d_out; a.ws = (unsigned char*)d_ws;
#if MK_N_LAUNCHES == 1
    a.ph_lo = 0; a.ph_hi = N_PHASES; a.use_bar = 1;
    void* kargs[] = {&a};
    hipError_t e = hipLaunchCooperativeKernel((const void*)fwd_kernel, dim3(grid), dim3(NWAVES * 64), kargs, LDS_BYTES, stream);
    if (e != hipSuccess) fprintf(stderr, "cooperative launch failed: %s\n", hipGetErrorString(e));
#else
    for (int ph = 0; ph < N_PHASES; ++ph) { a.ph_lo = ph; a.ph_hi = ph + 1; a.use_bar = 0;
        hipLaunchKernelGGL(fwd_kernel, dim3(grid), dim3(NWAVES * 64), LDS_BYTES, stream, a); }
#endif
}
```

```cpp
#include <hip/hip_runtime.h>
#include <cstdio>
#include <cstdint>
#include <cmath>

#ifndef DBG
#define DBG 0
#endif
#ifndef DUP_PHASE
#define DUP_PHASE -1
#endif
#ifndef FT_RECOMPUTE
#define FT_RECOMPUTE 0
#endif
#ifndef DRYVAR
#define DRYVAR 0
#endif
#ifndef DUPMASK
#define DUPMASK 65535
#endif
#define DSEL(b) (!F.dry || (DUPMASK & (b)))
#ifndef MK_N_LAUNCHES
#define MK_N_LAUNCHES 1
#endif

#define LAS __attribute__((address_space(3)))
#define GAS __attribute__((address_space(1)))
typedef unsigned short bf16_t;
typedef short bf16x8 __attribute__((ext_vector_type(8)));
typedef float f32x4 __attribute__((ext_vector_type(4)));
typedef float f32x2 __attribute__((ext_vector_type(2)));
typedef float f32x16 __attribute__((ext_vector_type(16)));
typedef unsigned u32x4 __attribute__((ext_vector_type(4)));
typedef unsigned u32x2 __attribute__((ext_vector_type(2)));

constexpr int DM = 1024, INW = 5888, DFF = 2816, NHEAD = 8, HD = 64;
constexpr int LP = 2064, LS = 16400, NMETA = 16;
constexpr int ROWS_P = 8 * LP;
constexpr int MROWS = ROWS_P + LS;
constexpr int MP = 33024;
constexpr int C_Q = 0, C_K = 512, C_V = 640, C_X0 = 768, C_X1 = 1280, C_VV = 1792, C_PU = 2304, C_G = 2816;
constexpr float EPS = 1e-6f;
constexpr int RK_PAD = 256;
constexpr int RKLEN_P = 2 * LP + 512, RKLEN_S = 2 * LS + 512;

constexpr size_t MiB = 1u << 20;
constexpr size_t WS_CTL = 0, CTL_ZERO_BYTES = 1 * MiB;
constexpr size_t WS_XM = 1 * MiB;
constexpr size_t WS_W = 3 * MiB;
constexpr size_t W_IN = 0, W_G = W_IN + (size_t)INW * DM * 2, W_U = W_G + (size_t)DFF * DM * 2, W_D = W_U + (size_t)DFF * DM * 2,
                 W_OUT = W_D + (size_t)DM * DFF * 2, W_MRG = W_OUT + (size_t)DM * DM * 2, W_END = W_MRG + (size_t)3 * DM * 512 * 2;
static_assert(WS_W + W_END <= 36 * MiB, "weights");
constexpr size_t WS_RKP = 36 * MiB;
constexpr size_t WS_RKS = WS_RKP + (size_t)512 * RKLEN_P * 2;
static_assert(WS_RKS + (size_t)512 * RKLEN_S * 2 <= 74 * MiB, "filters");
constexpr size_t WS_XNR = 74 * MiB;
constexpr size_t XNR_BYTES = (size_t)MP * DM * 2;
constexpr size_t WS_PROJ = 139 * MiB;
constexpr size_t WS_END = WS_PROJ + (size_t)MP * INW * 2;
static_assert(WS_XNR + XNR_BYTES <= WS_PROJ && WS_END <= 512 * MiB, "d_ws map");
constexpr int CW_BAR = 4096;
constexpr int CW_SUMS = 16384;

namespace pg8 {
constexpr int BM = 256, BK = 64, HALF = 128, HTB = HALF * BK * 2, STAGE_BYTES = 8 * HTB, NXCD = 8, WGM = 8;
__host__ __device__ __forceinline__ int lds_byte(int r, int c) { const int st = (r >> 4) * 2 + (c >> 5), rr = r & 15, cc = c & 31, ob = rr * 64 + cc * 2; return st * 1024 + (ob ^ (((ob >> 9) & 1) << 5)); }
__host__ __device__ __forceinline__ void stage_rc(int b, int& R, int& C) { const int st = b / 1024, sb = b % 1024, swz = sb ^ (((sb >> 9) & 1) << 5); R = (st >> 1) * 16 + swz / 64; C = (st & 1) * 32 + (swz % 64) / 2; }
__host__ __device__ __forceinline__ int perm32(int rho) { const int n = rho >> 4, i = rho & 15; return 8 * (i >> 2) + 4 * n + (i & 3); }

struct Unit { int pm, pn, sub; };
struct StaticOrder {
    int nM, nN, nwg, G, c, nsub;
    __device__ void init(int M, int N, int G_, int c_, int nsub_) { nM = M / BM; nN = N / BM; nwg = nM * nN; G = G_; c = c_; nsub = nsub_; }
    __device__ bool next(int i, Unit& u) const {
        const int tile = i / nsub; u.sub = i - tile * nsub;
        const long L = (long)tile * G + c; if (L >= nwg) return false;
        int wgid = (int)L; { const int q = nwg / NXCD, r = nwg % NXCD, xcd = wgid % NXCD, off = wgid / NXCD; wgid = (xcd < r ? xcd * (q + 1) : r * (q + 1) + (xcd - r) * q) + off; }
        const int nig = WGM * nN, gid = wgid / nig, fm = gid * WGM, gsz = (nM - fm) < WGM ? (nM - fm) : WGM;
        u.pm = fm + ((wgid % nig) % gsz); u.pn = (wgid % nig) / gsz; return true;
    }
};
__device__ __forceinline__ unsigned cvt_pk_bf16(float lo, float hi) { unsigned r; asm volatile("v_cvt_pk_bf16_f32 %0, %1, %2" : "=v"(r) : "v"(lo), "v"(hi)); return r; }
__device__ __forceinline__ f32x2 gelu_pk(f32x2 v) {
    const f32x2 av = __builtin_elementwise_abs(v), d = av * 0.2316418882f + 1.0f;
    f32x2 t; t.x = __builtin_amdgcn_rcpf(d.x); t.y = __builtin_amdgcn_rcpf(d.y);
    f32x2 q = t * 0.5307027145f + (-0.7265760135f); q = q * t + 0.7107068705f; q = q * t + (-0.142248368f); q = q * t + 0.127414796f; q = q * t;
    const f32x2 s = (v * v) * (-0.72134752044f);
    f32x2 e; e.x = __builtin_amdgcn_exp2f(s.x); e.y = __builtin_amdgcn_exp2f(s.y);
    const f32x2 m = v * (q * e), r = v - m;
    f32x2 o; o.x = v.x < 0.f ? m.x : r.x; o.y = v.y < 0.f ? m.y : r.y; return o;
}

template <class Epi, class Ops, bool ALIGN_EPI>
__device__ __forceinline__ void gemm_phase(LAS unsigned char* lds, const Ops& O, const StaticOrder& S, const Epi& E, int tid) {
    const int wid = __builtin_amdgcn_readfirstlane(tid >> 6), lane = tid & 63, wr = wid >> 2, wc = wid & 3, fr = lane & 15, fq = lane >> 4;
    const int K = O.K, nt = K / BK, lda = O.lda;
    unsigned voffA[2], voffB[2];
#pragma unroll
    for (int i = 0; i < 2; ++i) { int R, C; stage_rc(tid * 16 + i * 8192, R, C); const int Rb = (R & ~31) + perm32(R & 31);
        voffA[i] = (unsigned)(R * lda + C) * 2u; voffB[i] = (unsigned)(Rb * K + C) * 2u; }
    const size_t kstep = (size_t)(BK * 2);
    const size_t hstepA = (size_t)HALF * lda * 2, hstepB = (size_t)HALF * K * 2;
    const unsigned ldsw = (unsigned)wid * 1024u;
    const int aoff = lds_byte(wr * 64 + fr, fq * 8), boff = lds_byte(wc * 32 + fr, fq * 8);
#define PG8_SA(b, h) (((b) * 2 + (h)) * HTB)
#define PG8_SB(b, h) ((4 + (b) * 2 + (h)) * HTB)
#define PG8_STAGE(bufoff, gbase, voff) do { _Pragma("unroll") for (int _i = 0; _i < 2; ++_i) \
        __builtin_amdgcn_global_load_lds((const unsigned*)((const char*)(gbase) + (voff)[_i]), (LAS unsigned*)(lds + (bufoff) + ldsw + _i * 8192), 16, 0, 0); } while (0)
#define PG8_LDA(dst, b, h) do { _Pragma("unroll") for (int m = 0; m < 4; ++m) _Pragma("unroll") for (int k = 0; k < 2; ++k) dst[m][k] = *(const LAS bf16x8*)(lds + PG8_SA(b, h) + aoff + m * 2048 + k * 1024); } while (0)
#define PG8_LDB(dst, b, h) do { _Pragma("unroll") for (int n = 0; n < 2; ++n) _Pragma("unroll") for (int k = 0; k < 2; ++k) dst[n][k] = *(const LAS bf16x8*)(lds + PG8_SB(b, h) + boff + n * 2048 + k * 1024); } while (0)
#define PG8_MMA(ai, bj, At, Bt) do { __builtin_amdgcn_s_setprio(1); _Pragma("unroll") for (int m = 0; m < 4; ++m) _Pragma("unroll") for (int n = 0; n < 2; ++n) _Pragma("unroll") for (int k = 0; k < 2; ++k) \
        acc[ai][bj][m][n] = __builtin_amdgcn_mfma_f32_16x16x32_bf16(Bt[n][k], At[m][k], acc[ai][bj][m][n], 0, 0, 0); __builtin_amdgcn_s_setprio(0); } while (0)
#define PG8_WAIT_V(n) asm volatile("s_waitcnt vmcnt(" #n ")" ::: "memory")
#define PG8_WAIT_L(n) asm volatile("s_waitcnt lgkmcnt(" #n ")" ::: "memory")
#define PG8_BAR __builtin_amdgcn_s_barrier()
#define PG8_SCHED __builtin_amdgcn_sched_barrier(0)
    Unit cur, nxt; int ui = 0;
    if (!S.next(0, cur)) return;
    f32x4 acc[2][2][4][2];
#pragma unroll
    for (int a = 0; a < 2; ++a)
#pragma unroll
        for (int b = 0; b < 2; ++b)
#pragma unroll
            for (int m = 0; m < 4; ++m)
#pragma unroll
                for (int n = 0; n < 2; ++n) acc[a][b][m][n] = (f32x4){0.f, 0.f, 0.f, 0.f};
    bf16x8 At[4][2], B0[2][2], B1[2][2];
    const char* cA; const char* cB; O.ptrs(cur, cA, cB);
    PG8_STAGE(PG8_SB(0, 0), cB, voffB); PG8_STAGE(PG8_SB(0, 1), cB + hstepB, voffB); PG8_STAGE(PG8_SA(0, 0), cA, voffA); PG8_STAGE(PG8_SA(0, 1), cA + hstepA, voffA);
    if (wr == 1) PG8_BAR;
    PG8_WAIT_V(2); PG8_BAR;
    PG8_STAGE(PG8_SB(1, 0), cB + kstep, voffB); PG8_STAGE(PG8_SA(1, 0), cA + kstep, voffA); PG8_STAGE(PG8_SB(1, 1), cB + hstepB + kstep, voffB);
    PG8_WAIT_V(6); PG8_BAR;
    for (;;) {
        const bool has_next = S.next(ui + 1, nxt);
        const char* nA = cA; const char* nB = cB; if (has_next) O.ptrs(nxt, nA, nB);
        for (int t = 0; t < nt; t += 2) {
            const bool last = (t == nt - 2);
            const char* a1 = cA + (size_t)(t + 1) * kstep;
            const char* a2 = last ? nA : cA + (size_t)(t + 2) * kstep; const char* b2 = last ? nB : cB + (size_t)(t + 2) * kstep;
            const char* a3 = a2 + kstep; const char* b3 = b2 + kstep;
            PG8_LDB(B0, 0, 0); PG8_LDB(B1, 0, 1); PG8_SCHED; PG8_LDA(At, 0, 0); PG8_STAGE(PG8_SA(1, 1), a1 + hstepA, voffA);
            PG8_WAIT_V(8); PG8_WAIT_L(0); PG8_BAR; PG8_MMA(0, 0, At, B0); PG8_MMA(0, 1, At, B1); PG8_BAR; PG8_SCHED;
            PG8_LDA(At, 0, 1); PG8_STAGE(PG8_SB(0, 0), b2, voffB); PG8_STAGE(PG8_SB(0, 1), b2 + hstepB, voffB); PG8_STAGE(PG8_SA(0, 0), a2, voffA);
            PG8_WAIT_V(8); PG8_WAIT_L(0); PG8_BAR; PG8_MMA(1, 0, At, B0); PG8_MMA(1, 1, At, B1); PG8_BAR; PG8_SCHED;
            PG8_LDB(B0, 1, 0); PG8_LDB(B1, 1, 1); PG8_SCHED; PG8_LDA(At, 1, 0); PG8_STAGE(PG8_SA(0, 1), a2 + hstepA, voffA);
            PG8_WAIT_V(8); PG8_WAIT_L(0); PG8_BAR; PG8_MMA(0, 0, At, B0); PG8_MMA(0, 1, At, B1); PG8_BAR; PG8_SCHED;
            PG8_LDA(At, 1, 1); PG8_STAGE(PG8_SB(1, 0), b3, voffB); PG8_STAGE(PG8_SB(1, 1), b3 + hstepB, voffB); PG8_STAGE(PG8_SA(1, 0), a3, voffA);
            PG8_WAIT_V(8); PG8_WAIT_L(0); PG8_BAR; PG8_MMA(1, 0, At, B0); PG8_MMA(1, 1, At, B1); PG8_BAR; PG8_SCHED;
        }
        if constexpr (ALIGN_EPI) { if (wr == 0) PG8_BAR; }
        { int z_ = 0; asm volatile("" : "+v"(z_)); const int l2 = __builtin_amdgcn_mbcnt_hi(-1, __builtin_amdgcn_mbcnt_lo(-1, z_));
          E(acc, cur, wr, wc, l2 & 15, l2 >> 4); }
        if (!E.keep(cur)) {
#pragma unroll
            for (int a = 0; a < 2; ++a)
#pragma unroll
                for (int b = 0; b < 2; ++b)
#pragma unroll
                    for (int m = 0; m < 4; ++m)
#pragma unroll
                        for (int n = 0; n < 2; ++n) acc[a][b][m][n] = (f32x4){0.f, 0.f, 0.f, 0.f};
        }
        if (!has_next) break;
        cur = nxt; cA = nA; cB = nB; ++ui;
        if constexpr (ALIGN_EPI) { if (wr == 1) PG8_BAR; }
    }
    PG8_WAIT_V(0);
    if constexpr (!ALIGN_EPI) { if (wr == 0) PG8_BAR; }
    PG8_BAR;
#undef PG8_SA
#undef PG8_SB
#undef PG8_STAGE
#undef PG8_LDA
#undef PG8_LDB
#undef PG8_MMA
#undef PG8_WAIT_V
#undef PG8_WAIT_L
#undef PG8_BAR
#undef PG8_SCHED
}
}

constexpr int RING_BYTES_C = 131072, LDSCTL_OFF_C = 131072;
__device__ __forceinline__ int seq_of_row(int r) { return r < ROWS_P ? r / LP : 8; }
__device__ __forceinline__ int seq_base(int s) { return s < 8 ? s * LP : ROWS_P; }
__device__ __forceinline__ int seq_len(int s) { return s < 8 ? LP : LS; }
__device__ __forceinline__ float* xrow(float* xreal, float* xm, int r) {
    if (r >= MROWS) return xm + (size_t)(144 + r - MROWS) * DM;
    const int s = seq_of_row(r), p = r - seq_base(s);
    if (p < NMETA) return xm + (size_t)(s * 16 + p) * DM;
    return xreal + (size_t)(r - 16 * (s + 1)) * DM;
}
__device__ __forceinline__ float bflo(unsigned u) { return __uint_as_float(u << 16); }
__device__ __forceinline__ float bfhi(unsigned u) { return __uint_as_float(u & 0xffff0000u); }
__device__ __forceinline__ unsigned pk2(float lo, float hi) { unsigned r; asm("v_cvt_pk_bf16_f32 %0, %1, %2" : "=v"(r) : "v"(lo), "v"(hi)); return r; }
__device__ __forceinline__ unsigned f2bf(float f) { return pk2(f, f); }
__device__ __forceinline__ void unpack8(const u32x4 w, float* f) { f[0] = bflo(w.x); f[1] = bfhi(w.x); f[2] = bflo(w.y); f[3] = bfhi(w.y); f[4] = bflo(w.z); f[5] = bfhi(w.z); f[6] = bflo(w.w); f[7] = bfhi(w.w); }
__device__ __forceinline__ float shx(float v, int o, int lane) { return __int_as_float(__builtin_amdgcn_ds_bpermute((lane ^ o) << 2, __float_as_int(v))); }
__device__ __forceinline__ float wave_sum(float v, int lane) {
#pragma unroll
    for (int o = 1; o < 64; o <<= 1) v += shx(v, o, lane);
    return v;
}
#define LDS_WAIT() asm volatile("s_waitcnt lgkmcnt(0)" ::: "memory")

struct OpsPlain {
    const bf16_t* A; const bf16_t* Bt; int K, lda;
    __device__ __forceinline__ void ptrs(const pg8::Unit& u, const char*& a, const char*& b) const {
        a = (const char*)A + (size_t)u.pm * 256 * lda * 2; b = (const char*)Bt + (size_t)u.pn * 256 * K * 2; }
};
struct OpsMerge {
    const bf16_t* P; const bf16_t* WM; int K, lda;
    __device__ __forceinline__ void ptrs(const pg8::Unit& u, const char*& a, const char*& b) const {
        const int col = u.sub == 0 ? C_Q : (u.sub == 1 ? C_VV : C_X1);
        a = (const char*)P + ((size_t)u.pm * 256 * lda + col) * 2; b = (const char*)WM + ((size_t)u.sub * DM + (size_t)u.pn * 256) * 512 * 2; }
};
typedef f32x4 acc_t[2][2][4][2];
struct EpiStore {
    bf16_t* O; int ldc; int sig_pn;
    __device__ __forceinline__ bool keep(const pg8::Unit&) const { return false; }
    __device__ __forceinline__ void operator()(acc_t& acc, const pg8::Unit& u, int wr, int wc, int fr, int fq) const {
        const int row0 = u.pm * 256 + wr * 64 + fr, col0 = u.pn * 256 + wc * 32 + 8 * fq; const bool sig = u.pn >= sig_pn;
#pragma unroll
        for (int ai = 0; ai < 2; ++ai)
#pragma unroll
            for (int m = 0; m < 4; ++m) { bf16_t* rowp = O + (size_t)(row0 + ai * 128 + m * 16) * ldc + col0;
#pragma unroll
                for (int bj = 0; bj < 2; ++bj) { f32x4 v0 = acc[ai][bj][m][0], v1 = acc[ai][bj][m][1];
                    if (sig) { unsigned q[8];
#pragma unroll
                        for (int e = 0; e < 4; ++e) { q[e] = (unsigned)fminf(fmaxf(__builtin_rintf(255.f * __builtin_amdgcn_rcpf(1.f + __expf(-v0[e]))), 1.f), 255.f);
                                                      q[4 + e] = (unsigned)fminf(fmaxf(__builtin_rintf(255.f * __builtin_amdgcn_rcpf(1.f + __expf(-v1[e]))), 1.f), 255.f); }
                        u32x2 w8; w8.x = q[0] | (q[1] << 8) | (q[2] << 16) | (q[3] << 24); w8.y = q[4] | (q[5] << 8) | (q[6] << 16) | (q[7] << 24);
                        *(u32x2*)((unsigned char*)(O + (size_t)(row0 + ai * 128 + m * 16) * ldc) + C_G * 2 + (col0 + bj * 128 - C_G)) = w8; continue; }
                    u32x4 w; w.x = pg8::cvt_pk_bf16(v0[0], v0[1]); w.y = pg8::cvt_pk_bf16(v0[2], v0[3]); w.z = pg8::cvt_pk_bf16(v1[0], v1[1]); w.w = pg8::cvt_pk_bf16(v1[2], v1[3]);
                    *(u32x4*)(rowp + bj * 128) = w; } }
    }
};
struct EpiRes {
    float* xreal; float* xm; int dry;
    __device__ __forceinline__ bool keep(const pg8::Unit&) const { return false; }
    __device__ __forceinline__ void operator()(acc_t& acc, const pg8::Unit& u, int wr, int wc, int fr, int fq) const {
        const int row0 = u.pm * 256 + wr * 64 + fr, col0 = u.pn * 256 + wc * 32 + 8 * fq;
#pragma unroll
        for (int ai = 0; ai < 2; ++ai)
#pragma unroll
            for (int m = 0; m < 4; ++m) { float* p = xrow(xreal, xm, row0 + ai * 128 + m * 16) + col0;
#pragma unroll
                for (int bj = 0; bj < 2; ++bj) { f32x4 a = *(f32x4*)(p + bj * 128), b = *(f32x4*)(p + bj * 128 + 4);
                    a += acc[ai][bj][m][0]; b += acc[ai][bj][m][1]; if (!dry) { *(f32x4*)(p + bj * 128) = a; *(f32x4*)(p + bj * 128 + 4) = b; } } }
    }
};
struct EpiGeluMul {
    const bf16_t* G; const float* cw; const float* cb; bf16_t* O; int dv;
    __device__ __forceinline__ bool keep(const pg8::Unit&) const { return false; }
    __device__ __forceinline__ void operator()(acc_t& acc, const pg8::Unit& u, int wr, int wc, int fr, int fq) const {
        if (dv == 1) return;
        const int row0 = u.pm * 256 + wr * 64 + fr, col0 = u.pn * 256 + wc * 32 + 8 * fq;
#pragma unroll
        for (int ai = 0; ai < 2; ++ai)
#pragma unroll
            for (int m = 0; m < 4; ++m) { const int r = row0 + ai * 128 + m * 16;
                const int s = seq_of_row(r), p = r - seq_base(s); const bool inb = r < MROWS;
                const bool hasp = inb && p > 0, hasn = inb && p < seq_len(s) - 1;
                const float mp_ = hasp ? 1.f : 0.f, mn_ = hasn ? 1.f : 0.f;
#pragma unroll
                for (int bj = 0; bj < 2; ++bj) { const int col = col0 + bj * 128;
                    const bf16_t* gp = G + (size_t)r * DFF + col;
                    const u32x4 gm = *(const u32x4*)(gp - (hasp ? DFF : 0)), g0 = *(const u32x4*)gp, gn = *(const u32x4*)(gp + (hasn ? DFF : 0));
                    float fm[8], f0[8], fn[8]; unpack8(gm, fm); unpack8(g0, f0); unpack8(gn, fn);
                    float o[8];
#pragma unroll
                    for (int h = 0; h < 2; ++h) { const f32x4 a = *(const f32x4*)(cw + col + 4 * h), b = *(const f32x4*)(cw + DFF + col + 4 * h), c = *(const f32x4*)(cw + 2 * DFF + col + 4 * h), d = *(const f32x4*)(cb + col + 4 * h);
#pragma unroll
                        for (int e = 0; e < 4; e += 2) { f32x2 x; x.x = a[e] * mp_ * fm[4 * h + e] + b[e] * f0[4 * h + e] + c[e] * mn_ * fn[4 * h + e] + d[e];
                            x.y = a[e + 1] * mp_ * fm[4 * h + e + 1] + b[e + 1] * f0[4 * h + e + 1] + c[e + 1] * mn_ * fn[4 * h + e + 1] + d[e + 1];
                            const f32x2 g = pg8::gelu_pk(x); o[4 * h + e] = g.x; o[4 * h + e + 1] = g.y; } }
                    const f32x4 v0 = acc[ai][bj][m][0], v1 = acc[ai][bj][m][1];
                    u32x4 w; w.x = pg8::cvt_pk_bf16(o[0] * v0[0], o[1] * v0[1]); w.y = pg8::cvt_pk_bf16(o[2] * v0[2], o[3] * v0[3]);
                    w.z = pg8::cvt_pk_bf16(o[4] * v1[0], o[5] * v1[1]); w.w = pg8::cvt_pk_bf16(o[6] * v1[2], o[7] * v1[3]);
                    if (dv != 2) *(u32x4*)(O + (size_t)r * DFF + col) = w; else asm volatile("" :: "v"(w.x), "v"(w.y), "v"(w.z), "v"(w.w)); }
                if (m & 1) asm volatile("" ::: "memory"); }
    }
};
__device__ __forceinline__ void unpack8u(const u32x2 w, float* f) {
#pragma unroll
    for (int e = 0; e < 4; ++e) { f[e] = (float)((w.x >> (8 * e)) & 255u) * (1.f / 255.f); f[4 + e] = (float)((w.y >> (8 * e)) & 255u) * (1.f / 255.f); }
}
struct EpiMerge {
    const bf16_t* P; bf16_t* O;
    __device__ __forceinline__ bool keep(const pg8::Unit& u) const { return u.sub < 2; }
    __device__ __forceinline__ void operator()(acc_t& acc, const pg8::Unit& u, int wr, int wc, int fr, int fq) const {
        const int row0 = u.pm * 256 + wr * 64 + fr, col0 = u.pn * 256 + wc * 32 + 8 * fq; const int sub = u.sub;
#pragma unroll
        for (int ai = 0; ai < 2; ++ai)
#pragma unroll
            for (int m = 0; m < 4; ++m) { const int r = row0 + ai * 128 + m * 16;
#pragma unroll
                for (int bj = 0; bj < 2; ++bj) { const int col = col0 + bj * 128;
                    const unsigned char* gp = (const unsigned char*)(P + (size_t)r * INW) + C_G * 2 + col;
                    float mu[8];
                    if (sub < 2) { const u32x2 ga = *(const u32x2*)(gp + sub * DM), gb = *(const u32x2*)(gp + (sub + 1) * DM); float fa[8], fb[8]; unpack8u(ga, fa); unpack8u(gb, fb);
#pragma unroll
                        for (int e = 0; e < 8; ++e) mu[e] = fa[e] * __builtin_amdgcn_rcpf(fb[e]); }
                    else { const u32x2 ga = *(const u32x2*)(gp + 2 * DM); unpack8u(ga, mu); }
                    f32x4 v0 = acc[ai][bj][m][0], v1 = acc[ai][bj][m][1];
#pragma unroll
                    for (int e = 0; e < 4; ++e) { v0[e] *= mu[e]; v1[e] *= mu[4 + e]; }
                    if (sub < 2) { acc[ai][bj][m][0] = v0; acc[ai][bj][m][1] = v1; }
                    else { u32x4 w; w.x = pg8::cvt_pk_bf16(v0[0], v0[1]); w.y = pg8::cvt_pk_bf16(v0[2], v0[3]); w.z = pg8::cvt_pk_bf16(v1[0], v1[1]); w.w = pg8::cvt_pk_bf16(v1[2], v1[3]);
                        *(u32x4*)(O + (size_t)r * DM + col) = w; } } }
    }
};

#define XB_TMO      128
#define XB_XCNT(j)  (256  + 64 * (j))
#define XB_XSUB(j)  (1280 + 64 * (j))
#define XB_XGEN(j)  (2304 + 64 * (j))
#define XB_TOP      3328
#define XB_TOPGEN   3392
#define XCD_BAR_WORDS 3456
#define XB_SPIN_CAP (1u << 20)
__device__ __forceinline__ unsigned xb_ld(unsigned* p)              { return __hip_atomic_load(p, __ATOMIC_RELAXED, __HIP_MEMORY_SCOPE_AGENT); }
__device__ __forceinline__ unsigned xb_add(unsigned* p, unsigned v) { return __hip_atomic_fetch_add(p, v, __ATOMIC_RELAXED, __HIP_MEMORY_SCOPE_AGENT); }
__device__ __forceinline__ unsigned xb_xcc_id() { return (unsigned)__builtin_amdgcn_s_getreg((3 << 11) | 20) & 0xFu; }
#define XB_SPIN(cond, bar) do { unsigned _sp = 0; while (cond) { __builtin_amdgcn_s_sleep(1); \
    if ((++_sp & 255u) == 0u) { if (xb_ld(&(bar)[XB_TMO])) break; if (_sp > XB_SPIN_CAP) { atomicAdd(&(bar)[XB_TMO], 1u); break; } } } } while (0)
struct XcdBarrier { unsigned* bar; unsigned x; volatile LAS unsigned* st; };
__device__ __forceinline__ XcdBarrier xcd_barrier_post(unsigned* bar, volatile LAS unsigned* st) {
    XcdBarrier b; b.bar = bar; b.x = xb_xcc_id(); b.st = st;
    if (threadIdx.x == 0) (void)xb_add(&bar[XB_XCNT(b.x)], 1u);
    return b;
}
__device__ __forceinline__ void xcd_barrier_complete(unsigned* bar, unsigned x, unsigned& nloc, unsigned& nx) {
    const unsigned G = gridDim.x * gridDim.y * gridDim.z;
    unsigned sum, cnt, mine, sp = 0u;
    for (;;) {
        sum = 0u; cnt = 0u; mine = 0u;
#pragma unroll
        for (unsigned j = 0; j < 16; ++j) { const unsigned c = xb_ld(&bar[XB_XCNT(j)]); sum += c; cnt += (c > 0u) ? 1u : 0u; mine = (j == x) ? c : mine; }
        if (sum == G) break;
        __builtin_amdgcn_s_sleep(1);
        if ((++sp & 255u) == 0u) { if (xb_ld(&bar[XB_TMO])) break; if (sp > XB_SPIN_CAP) { atomicAdd(&bar[XB_TMO], 1u); break; } }
    }
    nloc = mine > 0u ? mine : 1u; nx = cnt > 0u ? cnt : 1u;
}
__device__ __forceinline__ void xcd_barrier(const XcdBarrier& b, int tid) {
    asm volatile("s_waitcnt vmcnt(0)" ::: "memory");
    __syncthreads();
    if (tid == 0) {
        unsigned* bar = b.bar;
        __builtin_amdgcn_s_waitcnt(0);
        unsigned nloc = b.st[0], nx = b.st[1];
        if (nloc == 0u) { xcd_barrier_complete(bar, b.x, nloc, nx); b.st[0] = nloc; b.st[1] = nx; }
        const unsigned old = xb_add(&bar[XB_XSUB(b.x)], 1u);
        const unsigned gen = old / nloc;
        if (old + 1u == (gen + 1u) * nloc) {
            __builtin_amdgcn_fence(__ATOMIC_RELEASE, "agent");
            asm volatile("s_waitcnt vmcnt(0)" ::: "memory");
            const unsigned og = xb_add(&bar[XB_TOP], 1u);
            const unsigned tg = og / nx;
            if (og + 1u == (tg + 1u) * nx) xb_add(&bar[XB_TOPGEN], 1u);
            else XB_SPIN(xb_ld(&bar[XB_TOPGEN]) == tg, bar);
            __builtin_amdgcn_fence(__ATOMIC_ACQUIRE, "agent");
            xb_add(&bar[XB_XGEN(b.x)], 1u);
            asm volatile("s_waitcnt vmcnt(0)" ::: "memory");
        } else {
            XB_SPIN(xb_ld(&bar[XB_XGEN(b.x)]) == gen, bar);
            __builtin_amdgcn_fence(__ATOMIC_ACQUIRE, "agent");
            asm volatile("s_waitcnt vmcnt(0)" ::: "memory");
        }
    }
    __syncthreads();
}

constexpr int NWAVES = 8;
constexpr int RING_BYTES = 131072, LDSCTL_OFF = RING_BYTES, MISC_OFF = LDSCTL_OFF + 320, LDS_BYTES = 147456;
struct Args { const float* in[30]; float* out; unsigned char* ws; int ph_lo, ph_hi, use_bar, pad; };
typedef const __attribute__((address_space(4))) Args CArgs;
struct Frame {
    LAS unsigned char* lds; int tid, lane, wave, G, vcu, bx, dry;
    float* out; unsigned char* ws; float* xm;
};
#define FIN(i) (A.in[i])

__constant__ unsigned char c_bucket[257] = {
15,15,15,15,15,15,15,15,15,15,15,15,15,15,15,15,15,15,15,15,15,15,15,15,15,15,15,15,15,15,15,15,15,15,15,15,15,15,14,14,14,14,14,14,14,14,14,14,14,14,14,14,14,14,14,14,14,14,14,14,14,14,14,14,14,13,13,13,13,13,13,13,13,13,13,13,13,13,13,13,13,13,13,12,12,12,12,12,12,12,12,12,12,12,12,12,12,11,11,11,11,11,11,11,11,11,10,10,10,10,10,10,10,9,9,9,9,8,8,8,8,7,6,5,4,3,2,1,0,17,18,19,20,21,22,23,24,24,24,24,25,25,25,25,26,26,26,26,26,26,26,27,27,27,27,27,27,27,27,27,28,28,28,28,28,28,28,28,28,28,28,28,28,28,29,29,29,29,29,29,29,29,29,29,29,29,29,29,29,29,29,29,30,30,30,30,30,30,30,30,30,30,30,30,30,30,30,30,30,30,30,30,30,30,30,30,30,30,30,31,31,31,31,31,31,31,31,31,31,31,31,31,31,31,31,31,31,31,31,31,31,31,31,31,31,31,31,31,31,31,31,31,31,31,31,31,31};

__device__ __forceinline__ void p0_transpose_item(const float* W, int K, int N, bf16_t* WT, int row_off, LAS float* scr, int item, int lane) {
    const int nblk = N / 32, kb = item / nblk, nb = item % nblk, k0 = 64 * kb, n0 = 32 * nb;
    f32x4 v[8];
#pragma unroll
    for (int i = 0; i < 8; ++i) v[i] = *(const f32x4*)(W + (size_t)(k0 + 8 * i + (lane >> 3)) * N + n0 + 4 * (lane & 7));
#pragma unroll
    for (int i = 0; i < 8; ++i) { LAS float* d = scr + (8 * i + (lane >> 3)) * 33 + 4 * (lane & 7); d[0] = v[i].x; d[1] = v[i].y; d[2] = v[i].z; d[3] = v[i].w; }
    LDS_WAIT(); asm volatile("" ::: "memory");
    const int c = lane & 7;
#pragma unroll
    for (int j = 0; j < 4; ++j) { const int n = (lane >> 3) + 8 * j; const LAS float* s = scr + (8 * c) * 33 + n;
        u32x4 o; o.x = pk2(s[0 * 33], s[1 * 33]); o.y = pk2(s[2 * 33], s[3 * 33]); o.z = pk2(s[4 * 33], s[5 * 33]); o.w = pk2(s[6 * 33], s[7 * 33]);
        *(u32x4*)(WT + (size_t)(row_off + n0 + n) * K + k0 + 8 * c) = o; }
    LDS_WAIT(); asm volatile("" ::: "memory");
}
__device__ __forceinline__ void rms_row(const f32x4 (&v)[4], const float* g, bf16_t* orow, int lane) {
    float s = 0.f;
#pragma unroll
    for (int j = 0; j < 4; ++j) s += (v[j].x * v[j].x + v[j].y * v[j].y) + (v[j].z * v[j].z + v[j].w * v[j].w);
    const float rstd = 1.0f / sqrtf(wave_sum(s, lane) * (1.f / DM) + EPS);
    unsigned long long* o8 = (unsigned long long*)orow + lane;
#pragma unroll
    for (int j = 0; j < 4; ++j) { const f32x4 gg = *((const f32x4*)g + lane + 64 * j);
        o8[64 * j] = (unsigned long long)pk2(v[j].x * rstd * gg.x, v[j].y * rstd * gg.y) | ((unsigned long long)pk2(v[j].z * rstd * gg.z, v[j].w * rstd * gg.w) << 32); }
}
constexpr size_t WS_H2F_P = 2 * MiB, WS_H2F_S = WS_END;
constexpr int NCH_P = (LP + 31) / 32, NCH_S = (LS + 31) / 32;
static_assert(WS_H2F_S + (size_t)NCH_S * 32 * 128 <= 512 * MiB && WS_H2F_P + (size_t)NCH_P * 32 * 128 <= WS_W, "h2 scratch");
__device__ __forceinline__ void filt_h2_compute(const CArgs& A, const Frame& F, int layer, int L, int tc, LAS float* h1t, int lane, float (&acc)[32]) {
    const float* w1 = FIN(11) + (size_t)layer * 33 * 64; const float* b1 = FIN(12) + layer * 64;
    const float* w2 = FIN(13) + (size_t)layer * 64 * 64; const float* b2 = FIN(14) + layer * 64; const float* fq_ = FIN(16) + layer * 64;
    const int pos = lane & 31, half = lane >> 5, jb = 32 * half;
    const float tt = (float)tc / (float)(L - 1);
    { f32x4 bv[8], wv[8];
#pragma unroll
      for (int i = 0; i < 8; ++i) { bv[i] = *(const f32x4*)(b1 + jb + 4 * i); wv[i] = *(const f32x4*)(w1 + jb + 4 * i); }
#pragma unroll
      for (int i = 0; i < 8; ++i)
#pragma unroll
          for (int e = 0; e < 4; ++e) acc[4 * i + e] = bv[i][e] + tt * wv[i][e]; }
#pragma unroll 2
    for (int k = 0; k < 16; ++k) {
        const float f = 1e-4f + (float)k * ((15.0f - 1e-4f) / 15.0f);
        const float rev = f * (float)tc * (1.0f / (float)L);
        const float sn = __builtin_amdgcn_sinf(rev), cs = __builtin_amdgcn_cosf(rev);
        f32x4 wc_[8], ws_[8];
#pragma unroll
        for (int i = 0; i < 8; ++i) { wc_[i] = *(const f32x4*)(w1 + (size_t)(1 + k) * 64 + jb + 4 * i); ws_[i] = *(const f32x4*)(w1 + (size_t)(17 + k) * 64 + jb + 4 * i); }
#pragma unroll
        for (int i = 0; i < 8; ++i)
#pragma unroll
            for (int e = 0; e < 4; ++e) acc[4 * i + e] += cs * wc_[i][e] - sn * ws_[i][e];
    }
    { f32x4 fv[8];
#pragma unroll
      for (int i = 0; i < 8; ++i) fv[i] = *(const f32x4*)(fq_ + jb + 4 * i);
#pragma unroll
      for (int i = 0; i < 8; ++i)
#pragma unroll
          for (int e = 0; e < 4; ++e) h1t[(jb + 4 * i + e) * 32 + pos] = __builtin_amdgcn_sinf(fv[i][e] * acc[4 * i + e] * 0.15915494309189535f); }
    LDS_WAIT();
    { f32x4 bv[8];
#pragma unroll
      for (int i = 0; i < 8; ++i) bv[i] = *(const f32x4*)(b2 + jb + 4 * i);
#pragma unroll
      for (int i = 0; i < 8; ++i)
#pragma unroll
          for (int e = 0; e < 4; ++e) acc[4 * i + e] = bv[i][e]; }
#pragma unroll 4
    for (int i2 = 0; i2 < 64; ++i2) { const float h = h1t[i2 * 32 + pos]; f32x4 wv[8];
#pragma unroll
        for (int i = 0; i < 8; ++i) wv[i] = *(const f32x4*)(w2 + (size_t)i2 * 64 + jb + 4 * i);
#pragma unroll
        for (int i = 0; i < 8; ++i)
#pragma unroll
            for (int e = 0; e < 4; ++e) acc[4 * i + e] += h * wv[i][e]; }
}
__device__ __forceinline__ void filt_h2_item(const CArgs& A, const Frame& F, int layer, int item, LAS float* h1t, int lane) {
    const int cls = item >= NCH_P ? 1 : 0, ch = cls ? item - NCH_P : item, L = cls ? LS : LP;
    const int pos = lane & 31, half = lane >> 5, jb = 32 * half;
    const int t = ch * 32 + pos, tc = t < L ? t : L - 1;
    const float* fq_ = FIN(16) + layer * 64;
    float acc[32];
    filt_h2_compute(A, F, layer, L, tc, h1t, lane, acc);
    { f32x4 fv[8]; unsigned hw[16];
#pragma unroll
      for (int i = 0; i < 8; ++i) fv[i] = *(const f32x4*)(fq_ + jb + 4 * i);
#pragma unroll
      for (int i = 0; i < 8; ++i)
#pragma unroll
          for (int e = 0; e < 4; e += 2) { const float a0 = __builtin_amdgcn_sinf(fv[i][e] * acc[4 * i + e] * 0.15915494309189535f), a1 = __builtin_amdgcn_sinf(fv[i][e + 1] * acc[4 * i + e + 1] * 0.15915494309189535f);
              typedef _Float16 h2_t __attribute__((ext_vector_type(2))); const h2_t hv = {(_Float16)a0, (_Float16)a1}; hw[2 * i + (e >> 1)] = __builtin_bit_cast(unsigned, hv); }
      u32x4* dst = (u32x4*)(F.ws + (cls ? WS_H2F_S : WS_H2F_P) + (size_t)t * 128 + half * 64);
#pragma unroll
      for (int i = 0; i < 4; ++i) dst[i] = (u32x4){hw[4 * i], hw[4 * i + 1], hw[4 * i + 2], hw[4 * i + 3]}; }
    LDS_WAIT();
}
constexpr int NI8_P = LP / 8, NI8 = NI8_P + LS / 8;
static_assert(LP % 8 == 0 && LS % 8 == 0, "filter items");
__device__ __forceinline__ void filt_h2_item8(const CArgs& A, const Frame& F, int layer, int item, LAS float* h1t, int lane) {
    const int cls = item >= NI8_P ? 1 : 0, ch = cls ? item - NI8_P : item, L = cls ? LS : LP;
    const float* w1 = FIN(11) + (size_t)layer * 33 * 64; const float* b1 = FIN(12) + layer * 64;
    const float* w2 = FIN(13) + (size_t)layer * 64 * 64; const float* b2 = FIN(14) + layer * 64; const float* fq_ = FIN(16) + layer * 64;
    const int pos = lane & 7, jb = (lane >> 3) * 8, t = ch * 8 + pos;
    const float tt = (float)t / (float)(L - 1);
    float acc[8];
    { const f32x4 ba = *(const f32x4*)(b1 + jb), bb = *(const f32x4*)(b1 + jb + 4), wa = *(const f32x4*)(w1 + jb), wb = *(const f32x4*)(w1 + jb + 4);
#pragma unroll
      for (int e = 0; e < 4; ++e) { acc[e] = ba[e] + tt * wa[e]; acc[4 + e] = bb[e] + tt * wb[e]; } }
#pragma unroll
    for (int k0 = 0; k0 < 16; k0 += 4) { f32x4 ca[4], cb[4], sa[4], sb[4];
#pragma unroll
        for (int q = 0; q < 4; ++q) { const int k = k0 + q; ca[q] = *(const f32x4*)(w1 + (size_t)(1 + k) * 64 + jb); cb[q] = *(const f32x4*)(w1 + (size_t)(1 + k) * 64 + jb + 4);
            sa[q] = *(const f32x4*)(w1 + (size_t)(17 + k) * 64 + jb); sb[q] = *(const f32x4*)(w1 + (size_t)(17 + k) * 64 + jb + 4); }
        asm volatile("" ::: "memory");
#pragma unroll
        for (int q = 0; q < 4; ++q) { const int k = k0 + q;
            const float f = 1e-4f + (float)k * ((15.0f - 1e-4f) / 15.0f);
            const float rev = f * (float)t * (1.0f / (float)L);
            const float sn = __builtin_amdgcn_sinf(rev), cs = __builtin_amdgcn_cosf(rev);
#pragma unroll
            for (int e = 0; e < 4; ++e) { acc[e] += cs * ca[q][e] - sn * sa[q][e]; acc[4 + e] += cs * cb[q][e] - sn * sb[q][e]; } }
        asm volatile("" ::: "memory");
    }
    const f32x4 fa = *(const f32x4*)(fq_ + jb), fb = *(const f32x4*)(fq_ + jb + 4);
#pragma unroll
    for (int e = 0; e < 4; ++e) { h1t[(jb + e) * 8 + pos] = __builtin_amdgcn_sinf(fa[e] * acc[e] * 0.15915494309189535f); h1t[(jb + 4 + e) * 8 + pos] = __builtin_amdgcn_sinf(fb[e] * acc[4 + e] * 0.15915494309189535f); }
    LDS_WAIT();
    { const f32x4 ba = *(const f32x4*)(b2 + jb), bb = *(const f32x4*)(b2 + jb + 4);
#pragma unroll
      for (int e = 0; e < 4; ++e) { acc[e] = ba[e]; acc[4 + e] = bb[e]; } }
#pragma unroll
    for (int i0 = 0; i0 < 64; i0 += 8) { f32x4 wa[8], wb[8];
#pragma unroll
        for (int q = 0; q < 8; ++q) { wa[q] = *(const f32x4*)(w2 + (size_t)(i0 + q) * 64 + jb); wb[q] = *(const f32x4*)(w2 + (size_t)(i0 + q) * 64 + jb + 4); }
        asm volatile("" ::: "memory");
#pragma unroll
        for (int q = 0; q < 8; ++q) { const float h = h1t[(i0 + q) * 8 + pos];
#pragma unroll
            for (int e = 0; e < 4; ++e) { acc[e] += h * wa[q][e]; acc[4 + e] += h * wb[q][e]; } }
        asm volatile("" ::: "memory");
    }
    unsigned hw[4];
#pragma unroll
    for (int e = 0; e < 4; e += 2) { typedef _Float16 h2_t __attribute__((ext_vector_type(2)));
        const h2_t ha = {(_Float16)__builtin_amdgcn_sinf(fa[e] * acc[e] * 0.15915494309189535f), (_Float16)__builtin_amdgcn_sinf(fa[e + 1] * acc[e + 1] * 0.15915494309189535f)};
        const h2_t hb = {(_Float16)__builtin_amdgcn_sinf(fb[e] * acc[4 + e] * 0.15915494309189535f), (_Float16)__builtin_amdgcn_sinf(fb[e + 1] * acc[4 + e + 1] * 0.15915494309189535f)};
        hw[e >> 1] = __builtin_bit_cast(unsigned, ha); hw[2 + (e >> 1)] = __builtin_bit_cast(unsigned, hb); }
    *(u32x4*)(F.ws + (cls ? WS_H2F_S : WS_H2F_P) + (size_t)t * 128 + jb * 2) = (u32x4){hw[0], hw[1], hw[2], hw[3]};
    LDS_WAIT();
}
constexpr int NCHF_P = (LP - 1 + 31) / 32 + 1, NCHB_P = (LP + 31) / 32, NCHF_S = (LS - 1 + 31) / 32 + 1, NCHB_S = (LS + 31) / 32;
constexpr int NFI_P = NCHF_P + NCHB_P, NFI = NFI_P + NCHF_S + NCHB_S;
__device__ __forceinline__ void filt_tile_item(const CArgs& A, const Frame& F, int layer, int item, int lane) {
    const int ct = item & 15; int cls = 0, it = item >> 4; if (it >= NFI_P) { cls = 1; it -= NFI_P; }
    const int nchf = cls ? NCHF_S : NCHF_P, L = cls ? LS : LP;
    bool bwd; int ch; if (it < nchf) { bwd = false; ch = it - 1; } else { bwd = true; ch = it - nchf; }
    const int tsh = bwd ? 0 : 1;
    const float* w3 = FIN(15) + (size_t)layer * 64 * 1024;
    const int pos = lane & 31, half = lane >> 5;
    const int t = ch * 32 + pos + tsh, tc = t < 0 ? 0 : (t < L ? t : L - 1);
    float acc[32];
#if FT_RECOMPUTE
    if (FT_RECOMPUTE == 1 || FT_RECOMPUTE == 9 || (FT_RECOMPUTE == 2 && cls == 0) || (FT_RECOMPUTE == 3 && cls == 1)) { LAS float* h1t = (LAS float*)(F.lds + F.wave * 16384); filt_h2_compute(A, F, layer, L, tc, h1t, lane, acc); const float* fq_ = FIN(16) + layer * 64;
#pragma unroll
      for (int k = 0; k < 32; ++k) acc[k] = __builtin_amdgcn_sinf(fq_[32 * half + k] * acc[k] * 0.15915494309189535f); LDS_WAIT(); }
    else
#endif
    { const u32x4* src = (const u32x4*)(F.ws + (cls ? WS_H2F_S : WS_H2F_P) + (size_t)tc * 128 + half * 64);
      u32x4 hv[4];
#pragma unroll
      for (int i = 0; i < 4; ++i) hv[i] = src[i];
#pragma unroll
      for (int i = 0; i < 4; ++i)
#pragma unroll
          for (int e = 0; e < 4; ++e) { typedef _Float16 h2_t __attribute__((ext_vector_type(2))); const unsigned wv_ = hv[i][e];
              const h2_t p = __builtin_bit_cast(h2_t, wv_); acc[8 * i + 2 * e] = (float)p[0]; acc[8 * i + 2 * e + 1] = (float)p[1]; } }
#if FT_RECOMPUTE == 9
    float bad = 0.f;
    { const u32x4* src = (const u32x4*)(F.ws + (cls ? WS_H2F_S : WS_H2F_P) + (size_t)tc * 128 + half * 64);
#pragma unroll
      for (int i = 0; i < 4; ++i) { const u32x4 hvv = src[i];
#pragma unroll
          for (int e = 0; e < 4; ++e) { typedef _Float16 h2_t __attribute__((ext_vector_type(2))); const h2_t p = __builtin_bit_cast(h2_t, hvv[e]);
              if (fabsf((float)p[0] - acc[8 * i + 2 * e]) > 2e-3f || fabsf((float)p[1] - acc[8 * i + 2 * e + 1]) > 2e-3f) bad = 1e4f; } } }
#else
    const float bad = 0.f;
#endif
    bf16_t* RK = (bf16_t*)(F.ws + (cls ? WS_RKS : WS_RKP)); const int rklen = cls ? RKLEN_S : RKLEN_P;
    float* sums = (float*)(F.ws + WS_CTL) + CW_SUMS + (layer * 2 + cls) * 512;
    const float da = -15.350567286626973f, db = -3.0701134573253945f;
    {
        const int col0 = (bwd ? 512 : 0) + ct * 32;
        float bw[32];
#pragma unroll
        for (int ks = 0; ks < 32; ++ks) bw[ks] = w3[(size_t)(32 * half + ks) * 1024 + col0 + pos];
        f32x16 d = {};
#pragma unroll
        for (int ks = 0; ks < 32; ++ks) d = __builtin_amdgcn_mfma_f32_32x32x2f32(acc[ks], bw[ks], d, 0, 0, 0);
        const int c = (col0 + pos) & 511;
        const float delta = fabsf(da + (db - da) * ((float)c / 511.0f));
        bf16_t* rk = RK + (size_t)c * rklen + RK_PAD + L;
        float asum = 0.f;
#pragma unroll
        for (int g = 0; g < 4; ++g) { const int t0 = ch * 32 + 8 * g + 4 * half + tsh; float v[4];
#pragma unroll
            for (int e = 0; e < 4; ++e) { const int tp = t0 + e; const bool ok = tp >= 0 && tp < L && !(bwd && tp == 0);
                const float tq = (float)tp / (float)(L - 1); v[e] = ok ? d[4 * g + e] * __expf(-tq * delta) + bad : 0.f; asum += fabsf(v[e]); }
            if (bwd) { if (t0 >= 4 && t0 + 3 < L) { u32x2 w; w.x = pk2(v[0], v[1]); w.y = pk2(v[2], v[3]); *(u32x2*)(rk + t0) = w; }
                       else {
#pragma unroll
                           for (int e = 0; e < 4; ++e) if (t0 + e >= 1 && t0 + e < L) rk[t0 + e] = (bf16_t)f2bf(v[e]); } }
            else { if (t0 >= 0 && t0 + 3 < L) { u32x2 w; w.x = pk2(v[3], v[2]); w.y = pk2(v[1], v[0]); *(u32x2*)(rk - t0 - 3) = w; }
                   else {
#pragma unroll
                       for (int e = 0; e < 4; ++e) if (t0 + e >= 0 && t0 + e < L) rk[-(t0 + e)] = (bf16_t)f2bf(v[e]); } } }
        asum += shx(asum, 32, lane);
        if (half == 0 && !F.dry) atomicAdd(sums + c, asum);
    }
}
__device__ __forceinline__ void p_filt_tiles(const CArgs& A, const Frame& F, int layer) {
    const int gw = F.vcu * NWAVES + F.wave, NGW = F.G * NWAVES;
    for (int it = gw; it < 16 * NFI; it += NGW) filt_tile_item(A, F, layer, it, F.lane);
}
__device__ __forceinline__ void p_prep(const CArgs& A, const Frame& F, int layer) {
    const int gw = F.vcu * NWAVES + F.wave, NGW = F.G * NWAVES, lane = F.lane;
    const bool filt_first = false;
    if (filt_first && DSEL(8)) { LAS float* scr = (LAS float*)(F.lds + F.wave * 16384); for (int it = gw; it < NI8; it += NGW) filt_h2_item8(A, F, layer, it, scr, lane); }
    if (DSEL(1)) {
        const float* g = FIN(4) + layer * DM; bf16_t* XN = (bf16_t*)(F.ws + WS_XNR);
        for (int r0 = gw; r0 < MP; r0 += 2 * NGW) {
            f32x4 v[2][4]; const int rr[2] = {r0, r0 + NGW};
#pragma unroll
            for (int q = 0; q < 2; ++q) { const int r = rr[q];
                if (r >= MP) continue;
                if (r >= MROWS) {
#pragma unroll
                    for (int j = 0; j < 4; ++j) v[q][j] = (f32x4){0.f, 0.f, 0.f, 0.f};
                } else if (layer == 0) {
                    const int s = seq_of_row(r), p = r - seq_base(s);
                    const float* src = p < NMETA ? FIN(2) + (size_t)p * DM : (s < 8 ? FIN(0) + ((size_t)s * 2048 + (p - NMETA)) * DM : FIN(1) + (size_t)(p - NMETA) * DM);
                    const f32x4* sr = (const f32x4*)src + lane;
#pragma unroll
                    for (int j = 0; j < 4; ++j) v[q][j] = sr[64 * j];
                } else {
                    const f32x4* xr = (const f32x4*)xrow(F.out, F.xm, r) + lane;
#pragma unroll
                    for (int j = 0; j < 4; ++j) v[q][j] = xr[64 * j];
                } }
#pragma unroll
            for (int q = 0; q < 2; ++q) { const int r = rr[q];
                if (r >= MP) continue;
                if (layer == 0) { f32x4* xr = (f32x4*)xrow(F.out, F.xm, r) + lane;
#pragma unroll
                    for (int j = 0; j < 4; ++j) xr[64 * j] = v[q][j]; }
                rms_row(v[q], g, XN + (size_t)r * DM, lane); }
        }
    }
    {
        LAS float* scr = (LAS float*)(F.lds + F.wave * 16384);
        unsigned char* W = F.ws + WS_W;
        constexpr int I_IN = (DM / 64) * (INW / 32), I_G = (DM / 64) * (DFF / 32), I_D = (DFF / 64) * (DM / 32), I_O = (DM / 64) * (DM / 32), I_M = (512 / 64) * (DM / 32);
        constexpr int NIT = I_IN + 2 * I_G + I_D + I_O + 2 * I_M;
        if (DSEL(2)) for (int it = gw; it < NIT; it += NGW) {
            int r = it;
            if (r < I_IN) { p0_transpose_item(FIN(5) + (size_t)layer * DM * INW, DM, INW, (bf16_t*)(W + W_IN), 0, scr, r, lane); continue; } r -= I_IN;
            if (r < I_G) { p0_transpose_item(FIN(25) + (size_t)layer * DM * DFF, DM, DFF, (bf16_t*)(W + W_G), 0, scr, r, lane); continue; } r -= I_G;
            if (r < I_G) { p0_transpose_item(FIN(26) + (size_t)layer * DM * DFF, DM, DFF, (bf16_t*)(W + W_U), 0, scr, r, lane); continue; } r -= I_G;
            if (r < I_D) { p0_transpose_item(FIN(29) + (size_t)layer * DFF * DM, DFF, DM, (bf16_t*)(W + W_D), 0, scr, r, lane); continue; } r -= I_D;
            if (r < I_O) { p0_transpose_item(FIN(23) + (size_t)layer * DM * DM, DM, DM, (bf16_t*)(W + W_OUT), 0, scr, r, lane); continue; } r -= I_O;
            if (r < I_M) { p0_transpose_item(FIN(20) + (size_t)layer * 512 * DM, 512, DM, (bf16_t*)(W + W_MRG), 0, scr, r, lane); continue; } r -= I_M;
            p0_transpose_item(FIN(21) + (size_t)layer * 512 * DM, 512, DM, (bf16_t*)(W + W_MRG), DM, scr, r, lane);
        }
        const float* pw = FIN(18) + (size_t)layer * 4 * 128 * 128; const float* psc = FIN(19) + layer * 512; const float* wpo = FIN(22) + (size_t)layer * 512 * DM;
        bf16_t* WT = (bf16_t*)(W + W_MRG) + (size_t)2 * DM * 512;
        const int gt = (F.vcu * NWAVES + F.wave) * 64 + lane, NGT = NGW * 64;
        if (DSEL(4)) for (int st = NGW - 1 - gw; st < (512 / 8) * (DM / 64); st += NGW) {
            const int c0 = (st >> 4) * 8, j = (st & 15) * 64 + lane, g = c0 >> 7;
            { const int cr = lane >> 3, d0 = (lane & 7) * 16; const float* pr = pw + ((size_t)c0 + cr) * 128 + d0; const float* ps = psc + g * 128 + d0;
#pragma unroll
              for (int q = 0; q < 4; ++q) { const f32x4 a = *(const f32x4*)(pr + 4 * q), b = *(const f32x4*)(ps + 4 * q); *(LAS f32x4*)(scr + cr * 128 + d0 + 4 * q) = a * b; } }
            LDS_WAIT(); asm volatile("" ::: "memory");
            const float* wp = wpo + (size_t)(g * 128) * DM + j;
            float a[8];
#pragma unroll
            for (int c = 0; c < 8; ++c) a[c] = 0.f;
#pragma unroll 1
            for (int d0 = 0; d0 < 128; d0 += 16) { float w[16];
#pragma unroll
                for (int q = 0; q < 16; ++q) w[q] = wp[(size_t)(d0 + q) * DM];
                asm volatile("" ::: "memory");
#pragma unroll
                for (int c = 0; c < 8; ++c)
#pragma unroll
                    for (int q4 = 0; q4 < 4; ++q4) { const f32x4 cf = *(const LAS f32x4*)(scr + c * 128 + d0 + 4 * q4);
#pragma unroll
                        for (int e = 0; e < 4; ++e) a[c] += cf[e] * w[4 * q4 + e]; }
                asm volatile("" ::: "memory");
            }
            u32x4 o; o.x = pk2(a[0], a[1]); o.y = pk2(a[2], a[3]); o.z = pk2(a[4], a[5]); o.w = pk2(a[6], a[7]);
            *(u32x4*)(WT + (size_t)j * 512 + c0) = o;
            LDS_WAIT(); asm volatile("" ::: "memory");
        }
        for (int idx = gt; idx < 2 * 512 * 513; idx += NGT) { const int k = idx % 513, cc = (idx / 513) & 511, cls = idx / (513 * 512);
            const int L = cls ? LS : LP, rklen = cls ? RKLEN_S : RKLEN_P; bf16_t* RK = (bf16_t*)(F.ws + (cls ? WS_RKS : WS_RKP)) + (size_t)cc * rklen;
            RK[k <= 256 ? k : 256 + 2 * L + (k - 257)] = 0; }
        if (!filt_first && DSEL(8)) for (int it = gw; it < NI8; it += NGW) filt_h2_item8(A, F, layer, it, scr, lane);
    }
}

__device__ __forceinline__ void p_attn_ref(const CArgs& A, const Frame& F, int layer) {
    bf16_t* P = (bf16_t*)(F.ws + WS_PROJ);
    const float* qg = FIN(6) + layer * HD; const float* kg = FIN(7) + layer * HD; const float* sink = FIN(8) + layer * NHEAD; const float* rb = FIN(3);
    const int gt = (F.vcu * NWAVES + F.wave) * 64 + F.lane, NGT = F.G * NWAVES * 64;
    for (int idx = gt; idx < MROWS * NHEAD; idx += NGT) {
        const int r = idx >> 3, h = idx & 7, hk = h >> 2;
        const int s = seq_of_row(r), base = seq_base(s), L = seq_len(s), p = r - base;
        unsigned qs[32]; float o[64];
        { const u32x4* qp = (const u32x4*)(P + (size_t)r * INW + C_Q + 64 * h); float ss = 0.f;
#pragma unroll
          for (int c = 0; c < 8; ++c) { const u32x4 w = qp[c]; qs[4 * c] = w.x; qs[4 * c + 1] = w.y; qs[4 * c + 2] = w.z; qs[4 * c + 3] = w.w; }
#pragma unroll
          for (int d = 0; d < 32; ++d) { const float a = bflo(qs[d]), b = bfhi(qs[d]); ss += a * a + b * b; }
          const float rs = 1.0f / sqrtf(ss * (1.f / 64) + EPS) * 0.125f;
#pragma unroll
          for (int d = 0; d < 32; ++d) { qs[d] = pk2(bflo(qs[d]) * rs * qg[2 * d], bfhi(qs[d]) * rs * qg[2 * d + 1]); o[2 * d] = 0.f; o[2 * d + 1] = 0.f; } }
        float m = sink[h], l = 1.f;
        const int lo = p - 128 < 0 ? 0 : p - 128, hi = p + 128 > L - 1 ? L - 1 : p + 128;
        for (int pk = lo; pk <= hi; ++pk) {
            const bf16_t* kr = P + (size_t)(base + pk) * INW;
            const u32x4* kp = (const u32x4*)(kr + C_K + 64 * hk); const u32x4* vp = (const u32x4*)(kr + C_V + 64 * hk);
            float ss = 0.f, dt = 0.f;
#pragma unroll
            for (int c = 0; c < 8; ++c) { float kk[8]; unpack8(kp[c], kk);
#pragma unroll
                for (int e = 0; e < 8; ++e) { ss += kk[e] * kk[e]; const unsigned qw = qs[4 * c + (e >> 1)]; dt += kk[e] * kg[8 * c + e] * ((e & 1) ? bfhi(qw) : bflo(qw)); }
                asm volatile("" ::: "memory"); }
            const float sc = dt / sqrtf(ss * (1.f / 64) + EPS) + rb[c_bucket[pk - p + 128] * NHEAD + h];
            const float mn = fmaxf(m, sc), f = __expf(m - mn), pe = __expf(sc - mn);
            l = l * f + pe; m = mn;
#pragma unroll
            for (int c = 0; c < 8; ++c) { float vv[8]; unpack8(vp[c], vv);
#pragma unroll
                for (int e = 0; e < 8; ++e) o[8 * c + e] = o[8 * c + e] * f + pe * vv[e];
                asm volatile("" ::: "memory"); }
        }
        const float il = (DBG & 4) ? 0.f : 1.f / l; u32x4* op = (u32x4*)(P + (size_t)r * INW + C_Q + 64 * h);
#pragma unroll
        for (int c = 0; c < 8; ++c) { u32x4 w; w.x = pk2(o[8 * c] * il, o[8 * c + 1] * il); w.y = pk2(o[8 * c + 2] * il, o[8 * c + 3] * il); w.z = pk2(o[8 * c + 4] * il, o[8 * c + 5] * il); w.w = pk2(o[8 * c + 6] * il, o[8 * c + 7] * il); op[c] = w; }
    }
}

constexpr int AT_K = 0, AT_V = 49152, AT_VSTR = 776, AT_B = AT_V + 64 * AT_VSTR;
__device__ __forceinline__ void p_attn(const CArgs& A, const Frame& F, int layer) {
    bf16_t* P = (bf16_t*)(F.ws + WS_PROJ);
    const float* qg = FIN(6) + layer * HD; const float* kg = FIN(7) + layer * HD; const float* sink = FIN(8) + layer * NHEAD; const float* rb = FIN(3);
    const int lane = F.lane, wave = F.wave, tid = F.tid, r32 = lane & 31, hi = lane >> 5;
    LAS unsigned char* lds = F.lds;
    for (int unit = F.vcu; unit < 265 * 4; unit += F.G) {
        const int gb = unit >> 2, hk = (unit >> 1) & 1, gh = unit & 1;
        const int s = gb < 136 ? gb / 17 : 8, nb = gb < 136 ? gb - 17 * s : gb - 136;
        const int base = seq_base(s), L = seq_len(s);
        const int pk0 = 128 * nb - 240;
        u32x4 kws[6], vws[6];
#pragma unroll
        for (int it = 0; it < 6; ++it) { const int idx = tid + it * 512, key = idx >> 3, ch = idx & 7, pk = pk0 + key; const bool ok = pk >= 0 && pk < L;
            const bf16_t* rowp = P + (size_t)(base + (ok ? pk : 0)) * INW + 64 * hk + 8 * ch;
            kws[it] = *(const u32x4*)(rowp + C_K); vws[it] = *(const u32x4*)(rowp + C_V); }
#pragma unroll
        for (int it = 0; it < 6; ++it) { const int idx = tid + it * 512, key = idx >> 3, ch = idx & 7, pk = pk0 + key; const bool ok = pk >= 0 && pk < L;
            u32x4 kw = kws[it], vw = vws[it];
            float kf[8]; unpack8(kw, kf); float ss = 0.f;
#pragma unroll
            for (int e = 0; e < 8; ++e) ss += kf[e] * kf[e];
            ss += shx(ss, 1, lane); ss += shx(ss, 2, lane); ss += shx(ss, 4, lane);
            const float rs = ok ? 1.0f / sqrtf(ss * (1.f / 64) + EPS) : 0.f;
            u32x4 ko; ko.x = pk2(kf[0] * rs * kg[8 * ch], kf[1] * rs * kg[8 * ch + 1]); ko.y = pk2(kf[2] * rs * kg[8 * ch + 2], kf[3] * rs * kg[8 * ch + 3]);
            ko.z = pk2(kf[4] * rs * kg[8 * ch + 4], kf[5] * rs * kg[8 * ch + 5]); ko.w = pk2(kf[6] * rs * kg[8 * ch + 6], kf[7] * rs * kg[8 * ch + 7]);
            *(LAS u32x4*)(lds + AT_K + key * 128 + ((ch ^ (key & 7)) << 4)) = ko;
            if (!ok) vw = (u32x4){0u, 0u, 0u, 0u};
            LAS bf16_t* vt = (LAS bf16_t*)(lds + AT_V + (8 * ch) * AT_VSTR) + key;
            vt[0] = (bf16_t)(vw.x & 0xffffu); *(LAS bf16_t*)((LAS unsigned char*)vt + AT_VSTR) = (bf16_t)(vw.x >> 16);
            *(LAS bf16_t*)((LAS unsigned char*)vt + 2 * AT_VSTR) = (bf16_t)(vw.y & 0xffffu); *(LAS bf16_t*)((LAS unsigned char*)vt + 3 * AT_VSTR) = (bf16_t)(vw.y >> 16);
            *(LAS bf16_t*)((LAS unsigned char*)vt + 4 * AT_VSTR) = (bf16_t)(vw.z & 0xffffu); *(LAS bf16_t*)((LAS unsigned char*)vt + 5 * AT_VSTR) = (bf16_t)(vw.z >> 16);
            *(LAS bf16_t*)((LAS unsigned char*)vt + 6 * AT_VSTR) = (bf16_t)(vw.w & 0xffffu); *(LAS bf16_t*)((LAS unsigned char*)vt + 7 * AT_VSTR) = (bf16_t)(vw.w >> 16); }
        for (int i = tid; i < 2 * 257; i += 512) { const int hh = i >= 257 ? 1 : 0, rr = i - 257 * hh; ((LAS float*)(lds + AT_B))[hh * 260 + rr] = rb[c_bucket[rr] * NHEAD + 4 * hk + 2 * gh + hh]; }
        __syncthreads();
        const int hh = wave >> 2, head = 4 * hk + 2 * gh + hh, qt = wave & 3, qi = 32 * qt + r32, pq = 128 * nb - 112 + qi; const bool qok = pq >= 0;
        const LAS float* bias = (const LAS float*)(lds + AT_B) + hh * 260;
        bf16x8 qf[4];
        { const bf16_t* qp = P + (size_t)(base + (qok ? pq : 0)) * INW + C_Q + 64 * head + 8 * hi; u32x4 qw[4]; float ss = 0.f;
#pragma unroll
          for (int ds = 0; ds < 4; ++ds) { qw[ds] = *(const u32x4*)(qp + 16 * ds); float f[8]; unpack8(qw[ds], f);
#pragma unroll
              for (int e = 0; e < 8; ++e) ss += f[e] * f[e]; }
          ss += shx(ss, 32, lane);
          const float rs = 0.125f / sqrtf(ss * (1.f / 64) + EPS);
#pragma unroll
          for (int ds = 0; ds < 4; ++ds) { float f[8]; unpack8(qw[ds], f); const float* g = qg + 16 * ds + 8 * hi; u32x4 o;
              o.x = pk2(f[0] * rs * g[0], f[1] * rs * g[1]); o.y = pk2(f[2] * rs * g[2], f[3] * rs * g[3]); o.z = pk2(f[4] * rs * g[4], f[5] * rs * g[5]); o.w = pk2(f[6] * rs * g[6], f[7] * rs * g[7]);
              qf[ds] = __builtin_bit_cast(bf16x8, o); } }
        float m = sink[head], lp = hi == 0 ? 1.f : 0.f;
        f32x16 o0 = {}, o1 = {};
        for (int kt = qt; kt <= qt + 8; ++kt) {
            f32x16 st = {};
#pragma unroll
            for (int ds = 0; ds < 4; ++ds) { const int key = 32 * kt + r32, chn = 2 * ds + hi;
                const bf16x8 kfr = *(const LAS bf16x8*)(lds + AT_K + key * 128 + ((chn ^ (key & 7)) << 4));
                st = __builtin_amdgcn_mfma_f32_32x32x16_bf16(kfr, qf[ds], st, 0, 0, 0); }
            float tmax = -1e30f;
#pragma unroll
            for (int i = 0; i < 16; ++i) { const int kj = 32 * kt + (i & 3) + 8 * (i >> 2) + 4 * hi, rel = kj - 128 - qi, pk = pk0 + kj;
                const bool ok = rel >= -128 && rel <= 128 && pk >= 0 && pk < L;
                const float v = ok ? st[i] + bias[rel + 128 < 0 ? 0 : (rel + 128 > 256 ? 256 : rel + 128)] : -1e30f;
                st[i] = v; tmax = fmaxf(tmax, v); }
            tmax = fmaxf(tmax, shx(tmax, 32, lane));
            const float mn = fmaxf(m, tmax), f = __expf(m - mn); m = mn;
            float ps = 0.f;
#pragma unroll
            for (int i = 0; i < 16; ++i) { st[i] = __expf(st[i] - mn); ps += st[i]; }
            lp = lp * f + ps;
#pragma unroll
            for (int i = 0; i < 16; ++i) { o0[i] *= f; o1[i] *= f; }
#pragma unroll
            for (int s2 = 0; s2 < 2; ++s2) {
                u32x4 pw; pw.x = pk2(st[8 * s2], st[8 * s2 + 1]); pw.y = pk2(st[8 * s2 + 2], st[8 * s2 + 3]); pw.z = pk2(st[8 * s2 + 4], st[8 * s2 + 5]); pw.w = pk2(st[8 * s2 + 6], st[8 * s2 + 7]);
                const bf16x8 pf = __builtin_bit_cast(bf16x8, pw);
#pragma unroll
                for (int dt = 0; dt < 2; ++dt) { const LAS unsigned char* vp = lds + AT_V + (32 * dt + r32) * AT_VSTR + (32 * kt + 16 * s2 + 4 * hi) * 2;
                    const u32x2 a0 = *(const LAS u32x2*)vp, a1 = *(const LAS u32x2*)(vp + 16);
                    const bf16x8 vf = __builtin_bit_cast(bf16x8, (u32x4){a0.x, a0.y, a1.x, a1.y});
                    if (dt == 0) o0 = __builtin_amdgcn_mfma_f32_32x32x16_bf16(vf, pf, o0, 0, 0, 0); else o1 = __builtin_amdgcn_mfma_f32_32x32x16_bf16(vf, pf, o1, 0, 0, 0); }
            }
        }
        const float il = (DBG & 4) ? 0.f : 1.f / (lp + shx(lp, 32, lane));
        if (qok && !F.dry) { bf16_t* op = P + (size_t)(base + pq) * INW + C_Q + 64 * head + 4 * hi;
#pragma unroll
            for (int g = 0; g < 4; ++g) { u32x2 w0, w1; w0.x = pk2(o0[4 * g] * il, o0[4 * g + 1] * il); w0.y = pk2(o0[4 * g + 2] * il, o0[4 * g + 3] * il);
                w1.x = pk2(o1[4 * g] * il, o1[4 * g + 1] * il); w1.y = pk2(o1[4 * g + 2] * il, o1[4 * g + 3] * il);
                *(u32x2*)(op + 8 * g) = w0; *(u32x2*)(op + 32 + 8 * g) = w1; } }
        __syncthreads();
    }
}
__device__ __forceinline__ void dwconv8(const bf16_t* P, int r, int col, const float* cw, const float* cb, int ucol, float* out) {
    const int s = seq_of_row(r), p = r - seq_base(s); const bool hasp = p > 0, hasn = p < seq_len(s) - 1;
    const bf16_t* gp = P + (size_t)r * INW + col;
    const u32x4 gm = *(const u32x4*)(gp - (hasp ? INW : 0)), g0 = *(const u32x4*)gp, gn = *(const u32x4*)(gp + (hasn ? INW : 0));
    float fm[8], f0[8], fn[8]; unpack8(gm, fm); unpack8(g0, f0); unpack8(gn, fn);
    const float mp_ = hasp ? 1.f : 0.f, mn_ = hasn ? 1.f : 0.f;
#pragma unroll
    for (int e = 0; e < 8; ++e) { fm[e] *= mp_; fn[e] *= mn_; }
#pragma unroll
    for (int e = 0; e < 8; ++e) out[e] = cw[ucol + e] * fm[e] + cw[1536 + ucol + e] * f0[e] + cw[2 * 1536 + ucol + e] * fn[e] + cb[ucol + e];
}
struct DwRows { u32x4 gm, g0, gn; float mp_, mn_; };
struct DwTaps { f32x4 a[2], b[2], c[2], d[2]; };
__device__ __forceinline__ void dw_load(const bf16_t* P, int r, int col, DwRows& d) {
    const int s = seq_of_row(r), p = r - seq_base(s); const bool hasp = p > 0, hasn = p < seq_len(s) - 1;
    const bf16_t* gp = P + (size_t)r * INW + col;
    d.gm = *(const u32x4*)(gp - (hasp ? INW : 0)); d.g0 = *(const u32x4*)gp; d.gn = *(const u32x4*)(gp + (hasn ? INW : 0));
    d.mp_ = hasp ? 1.f : 0.f; d.mn_ = hasn ? 1.f : 0.f;
}
__device__ __forceinline__ void dw_taps(const float* cw, const float* cb, int ucol, DwTaps& w) {
#pragma unroll
    for (int h = 0; h < 2; ++h) { w.a[h] = *(const f32x4*)(cw + ucol + 4 * h); w.b[h] = *(const f32x4*)(cw + 1536 + ucol + 4 * h); w.c[h] = *(const f32x4*)(cw + 2 * 1536 + ucol + 4 * h); w.d[h] = *(const f32x4*)(cb + ucol + 4 * h); }
}
__device__ __forceinline__ void dw_apply(const DwRows& d, const DwTaps& w, float* out) {
    float fm[8], f0[8], fn[8]; unpack8(d.gm, fm); unpack8(d.g0, f0); unpack8(d.gn, fn);
#pragma unroll
    for (int e = 0; e < 8; ++e) out[e] = w.a[e >> 2][e & 3] * (fm[e] * d.mp_) + w.b[e >> 2][e & 3] * f0[e] + w.c[e >> 2][e & 3] * (fn[e] * d.mn_) + w.d[e >> 2][e & 3];
}
__device__ __forceinline__ void p_h1(const CArgs& A, const Frame& F, int layer) {
    const bf16_t* P = (const bf16_t*)(F.ws + WS_PROJ); bf16_t* ZT = (bf16_t*)(F.ws + WS_XNR);
    const float* cw = FIN(9) + (size_t)layer * 3 * 1536; const float* cb = FIN(10) + layer * 1536;
    LAS bf16_t* scr = (LAS bf16_t*)(F.lds + F.wave * 16384);
    const int gw = F.vcu * NWAVES + F.wave, NGW = F.G * NWAVES, lane = F.lane, rs = lane >> 3, ck = lane & 7;
    for (int it = gw; it < (MP / 64) * 8; it += NGW) {
        const int rt = it >> 3, cc = it & 7, c0 = cc * 64 + ck * 8;
        DwTaps wa, wb; dw_taps(cw, cb, 512 + c0, wa); dw_taps(cw, cb, 1024 + c0, wb);
#pragma unroll
        for (int hb = 0; hb < 2; ++hb) { DwRows da[4], db[4];
#pragma unroll
            for (int q = 0; q < 4; ++q) { const int r = rt * 64 + (hb * 4 + q) * 8 + rs, rc = r < MROWS ? r : MROWS - 1; dw_load(P, rc, C_X1 + c0, da[q]); dw_load(P, rc, C_VV + c0, db[q]); }
            asm volatile("" ::: "memory");
#pragma unroll
            for (int q = 0; q < 4; ++q) { const int lr = (hb * 4 + q) * 8 + rs, r = rt * 64 + lr; float a[8], b[8]; dw_apply(da[q], wa, a); dw_apply(db[q], wb, b);
                const float ok = r < MROWS ? 1.f : 0.f;
#pragma unroll
                for (int e = 0; e < 8; ++e) scr[(ck * 8 + e) * 72 + lr] = (bf16_t)f2bf(a[e] * b[e] * ok); }
            asm volatile("" ::: "memory"); }
        LDS_WAIT();
#pragma unroll
        for (int j = 0; j < 8; ++j) { const int chn = (lane >> 3) + 8 * j, pc = lane & 7;
            const u32x4 w = *(const LAS u32x4*)(scr + chn * 72 + pc * 8);
            *(u32x4*)(ZT + (size_t)(cc * 64 + chn) * MP + rt * 64 + pc * 8) = w; }
        LDS_WAIT();
    }
}

__device__ __forceinline__ void p_h2_ref(const CArgs& A, const Frame& F) {
    const bf16_t* ZT = (const bf16_t*)(F.ws + WS_XNR); bf16_t* CT = (bf16_t*)(F.ws + WS_XNR + (size_t)512 * MP * 2);
    const int gt = (F.vcu * NWAVES + F.wave) * 64 + F.lane, NGT = F.G * NWAVES * 64;
    for (long idx = gt; idx < (long)512 * MP; idx += NGT) {
        const int c = (int)(idx / MP), r = (int)(idx - (long)c * MP);
        float acc = 0.f;
        if (r < MROWS) {
            const int s = seq_of_row(r), base = seq_base(s), L = seq_len(s), p = r - base, cls = s < 8 ? 0 : 1;
            const bf16_t* rk = (const bf16_t*)(F.ws + (cls ? WS_RKS : WS_RKP)) + (size_t)c * (cls ? RKLEN_S : RKLEN_P) + RK_PAD + L - p;
            const bf16_t* z = ZT + (size_t)c * MP + base;
            for (int s8 = 0; s8 < L; s8 += 8) { const u32x4 zw = *(const u32x4*)(z + s8); float zf[8]; unpack8(zw, zf);
#pragma unroll
                for (int e = 0; e < 8; ++e) acc += zf[e] * __uint_as_float((unsigned)rk[s8 + e] << 16); }
        }
        CT[idx] = (bf16_t)f2bf(acc);
    }
}
constexpr int H2_ZOFF_S = ((RKLEN_S * 2 + 1023) >> 10) << 10, H2_ZOFF_P = ((RKLEN_P * 2 + 1023) >> 10) << 10;
constexpr int H2_ZPADL_S = 4096, H2_ZSLOTS_S = 24704, H2_ZPADL_P = 512, H2_ZSLOTS_P = 3072, H2_SZP = 6976;
static_assert(H2_ZOFF_S + (H2_ZSLOTS_S + (H2_ZSLOTS_S >> 7) * 16) * 2 <= RING_BYTES_C && H2_ZOFF_P + 8 * H2_SZP <= RING_BYTES_C, "H2 LDS");
__device__ __forceinline__ void p_h2(const Frame& F) {
    const bf16_t* ZT = (const bf16_t*)(F.ws + WS_XNR); bf16_t* CT = (bf16_t*)(F.ws + WS_XNR + (size_t)512 * MP * 2);
    const int lane = F.lane, wave = F.wave, tid = F.tid;
    LAS float* red = (LAS float*)(F.lds + LDSCTL_OFF_C + 1024);
    for (int item = F.vcu; item < 1024; item += F.G) {
        const int cls = item < 512 ? 1 : 0, c = item & 511;
        const int L = cls ? LS : LP, rklen = cls ? RKLEN_S : RKLEN_P, ZPADL = cls ? H2_ZPADL_S : H2_ZPADL_P, zs8 = (cls ? H2_ZSLOTS_S : H2_ZSLOTS_P) / 8;
        LAS unsigned char* rkl = F.lds; LAS unsigned char* zl = F.lds + (cls ? H2_ZOFF_S : H2_ZOFF_P);
        {
          const char* rkg = (const char*)((const bf16_t*)(F.ws + (cls ? WS_RKS : WS_RKP)) + (size_t)c * rklen);
          const int npc = (rklen * 2 + 1023) >> 10;
          for (int pc = wave; pc < npc; pc += NWAVES)
              __builtin_amdgcn_global_load_lds((const unsigned*)(rkg + (size_t)pc * 1024 + lane * 16), (LAS unsigned*)(rkl + pc * 1024), 16, 0, 0);
          const int nsl = (cls ? 1 : 8) * zs8; u32x4 zv[7];
#pragma unroll
          for (int j = 0; j < 7; ++j) { const int i = tid + j * (NWAVES * 64); const int sq = i / zs8, i8 = i - sq * zs8, sp = i8 * 8 - ZPADL;
              zv[j] = (u32x4){0u, 0u, 0u, 0u};
              if (i < nsl && sp >= 0 && sp < L) zv[j] = *(const u32x4*)(ZT + (size_t)c * MP + (cls ? ROWS_P : sq * LP) + sp); }
#pragma unroll
          for (int j = 0; j < 7; ++j) { const int i = tid + j * (NWAVES * 64); const int sq = i / zs8, i8 = i - sq * zs8; const int pos = i8 * 8, el = pos + ((pos >> 7) << 4);
              if (i < nsl) *(LAS u32x4*)(zl + sq * H2_SZP + el * 2) = zv[j]; }
          asm volatile("s_waitcnt vmcnt(0)" ::: "memory"); }
        __syncthreads();
        const int n = lane & 15, h = lane >> 4, cg = wave & 3, us = wave >> 2;
        int T0a, zb, T0min, T0max, rowbase;
        const int T0g = cls ? 128 * 16 : 256; const int zg1 = (T0g + (T0g >> 7) * 16) * 2;
        if (cls) { T0min = 16 + 128 * 32 * cg; T0max = T0min + 128 * 31; T0a = T0min + 128 * n; zb = 0; rowbase = ROWS_P; }
        else { const int sq = n >> 1; T0min = 16 + 512 * cg; T0max = T0min + 384; T0a = T0min + 128 * (n & 1); zb = sq * H2_SZP; rowbase = sq * LP; }
        const int u_lo = -(((T0max + 7 + 31) >> 5) << 5), u_hi = ((L - 32 - T0min + 31) >> 5) << 5;
        const int nst = (u_hi - u_lo) / 32 + 1, nh = (nst + 1) >> 1;
        const int u_a = us ? u_lo + 32 * nh : u_lo, u_b = us ? u_hi : u_lo + 32 * (nh - 1);
        const int abase = RK_PAD + L - 8 * n + 8 * h;
        f32x4 acc[2][8];
#pragma unroll
        for (int g = 0; g < 2; ++g)
#pragma unroll
            for (int t = 0; t < 8; ++t) acc[g][t] = (f32x4){0.f, 0.f, 0.f, 0.f};
#define H2_STEP(V0, V1) do { \
            const LAS unsigned char* ap = rkl + (abase + u) * 2; \
            const u32x4 Lo = *(const LAS u32x4*)(ap - 16), Hi = *(const LAS u32x4*)ap; \
            bf16x8 Bz[2]; \
            { const int i0 = T0a + u + 8 * h + ZPADL, e0 = i0 + ((i0 >> 7) << 4); const LAS unsigned char* zp = zl + zb + e0 * 2; \
              if (V0) Bz[0] = *(const LAS bf16x8*)zp; if (V1) Bz[1] = *(const LAS bf16x8*)(zp + zg1); } \
            unsigned W[8] = {Lo.x, Lo.y, Lo.z, Lo.w, Hi.x, Hi.y, Hi.z, Hi.w}, Od[7]; \
            _Pragma("unroll") for (int k = 0; k < 7; ++k) Od[k] = __builtin_amdgcn_alignbit(W[k + 1], W[k], 16); \
            _Pragma("unroll") for (int t = 0; t < 8; ++t) { const int i = 4 - ((t + 1) >> 1); \
                const u32x4 fw = (t & 1) ? (u32x4){Od[i], Od[i + 1], Od[i + 2], Od[i + 3]} : (u32x4){W[i], W[i + 1], W[i + 2], W[i + 3]}; \
                const bf16x8 Af = __builtin_bit_cast(bf16x8, fw); \
                if (V0) acc[0][t] = __builtin_amdgcn_mfma_f32_16x16x32_bf16(Af, Bz[0], acc[0][t], 0, 0, 0); \
                if (V1) acc[1][t] = __builtin_amdgcn_mfma_f32_16x16x32_bf16(Af, Bz[1], acc[1][t], 0, 0, 0); } } while (0)
        { const int gspan = cls ? 128 * 15 : 128;
          int u0s = -(T0min + gspan + 39); u0s = u0s >= 0 ? ((u0s + 31) >> 5) << 5 : -((-u0s) >> 5 << 5);
          int u1e = L - (T0min + T0g); u1e = u1e >= 0 ? ((u1e + 31) >> 5) << 5 : -((-u1e) >> 5 << 5);
          const int ua2 = u0s > u_a ? (u0s < u_b + 32 ? u0s : u_b + 32) : u_a;
          const int ub2 = u1e < u_b + 32 ? (u1e > ua2 ? u1e : ua2) : u_b + 32;
          int u = u_a;
          for (; u < ua2; u += 32) H2_STEP(false, true);
          for (; u < ub2; u += 32) H2_STEP(true, true);
          for (; u <= u_b; u += 32) H2_STEP(true, false); }
#undef H2_STEP
        { float m[16];
#pragma unroll
          for (int t = 0; t < 16; ++t) m[t] = 0.f;
          const int nchunk = L / 8, cstep = cls ? NWAVES * 64 : 64; const int zb2 = cls ? 0 : wave * H2_SZP;
          for (int ck = cls ? tid : lane; ck < nchunk; ck += cstep) { const int s0 = ck * 8, i0 = s0 + ZPADL, e0 = i0 + ((i0 >> 7) << 4);
              const u32x4 zw = *(const LAS u32x4*)(zl + zb2 + e0 * 2);
              const LAS unsigned char* rp = rkl + (RK_PAD + L + s0 - 16) * 2;
              const u32x4 r0 = *(const LAS u32x4*)rp, r1 = *(const LAS u32x4*)(rp + 16), r2 = *(const LAS u32x4*)(rp + 32);
              float zf[8], rf[24]; unpack8(zw, zf); unpack8(r0, rf); unpack8(r1, rf + 8); unpack8(r2, rf + 16);
#pragma unroll
              for (int t = 0; t < 16; ++t)
#pragma unroll
                  for (int e = 0; e < 8; ++e) m[t] += zf[e] * rf[16 + e - t]; }
#pragma unroll
          for (int t = 0; t < 16; ++t) m[t] = wave_sum(m[t], lane);
          float mine = 0.f;
#pragma unroll
          for (int t = 0; t < 16; ++t) mine = (lane == t) ? m[t] : mine;
          if (cls) { if (lane < 16) red[wave * 16 + lane] = mine; }
          else if (lane < 16) CT[(size_t)c * MP + wave * LP + lane] = (bf16_t)f2bf(mine); }
        __syncthreads();
        if (us == 1) {
#pragma unroll
            for (int g = 0; g < 2; ++g)
#pragma unroll
                for (int t = 0; t < 8; ++t) *(LAS f32x4*)(F.lds + cg * 16384 + (g * 8 + t) * 1024 + lane * 16) = acc[g][t]; }
        if (cls && tid < 16) { float a = 0.f;
#pragma unroll
            for (int w = 0; w < 8; ++w) a += red[w * 16 + tid];
            CT[(size_t)c * MP + ROWS_P + tid] = (bf16_t)f2bf(a); }
        __syncthreads();
        if (us == 0) {
#pragma unroll
            for (int g = 0; g < 2; ++g) {
#pragma unroll
                for (int t = 0; t < 8; ++t) acc[g][t] += *(const LAS f32x4*)(F.lds + cg * 16384 + (g * 8 + t) * 1024 + lane * 16);
                bf16_t* op = CT + (size_t)c * MP + rowbase + T0a + g * T0g + 32 * h;
#pragma unroll
                for (int i = 0; i < 4; ++i) { u32x4 w; w.x = pk2(acc[g][0][i], acc[g][1][i]); w.y = pk2(acc[g][2][i], acc[g][3][i]); w.z = pk2(acc[g][4][i], acc[g][5][i]); w.w = pk2(acc[g][6][i], acc[g][7][i]);
                    *(u32x4*)(op + 8 * i) = w; } } }
        __syncthreads();
    }
}
__device__ __forceinline__ void p_pool(const CArgs& A, const Frame& F) {
    bf16_t* P = (bf16_t*)(F.ws + WS_PROJ);
    const int gw = F.vcu * NWAVES + F.wave, NGW = F.G * NWAVES, lane = F.lane, c0 = lane * 8, hw = 1 << (lane >> 4);
    for (int run = gw; run < MROWS / 16; run += NGW) {
        const int r0 = run * 16, s = seq_of_row(r0), base = seq_base(s), L = seq_len(s), p0 = r0 - base;
        const bf16_t* ub = P + (size_t)base * INW + C_PU + c0;
        float S[8];
#pragma unroll
        for (int e = 0; e < 8; ++e) S[e] = 0.f;
#pragma unroll
        for (int i = 0; i < 16; ++i) { const int pp = p0 - hw + i; const bool ok = i < 2 * hw && pp >= 0 && pp < L;
            const u32x4 w = *(const u32x4*)(ub + (size_t)(ok ? pp : p0) * INW); float f[8]; unpack8(w, f); const float mk = ok ? 1.f : 0.f;
#pragma unroll
            for (int e = 0; e < 8; ++e) S[e] += mk * f[e]; }
#pragma unroll 4
        for (int k = 0; k < 16; ++k) { const int p = p0 + k, pn = p + hw, po = p - hw; const bool okn = pn < L, oko = po >= 0;
            const u32x4 ws_ = *(const u32x4*)(ub + (size_t)p * INW), wn = *(const u32x4*)(ub + (size_t)(okn ? pn : p) * INW), wo = *(const u32x4*)(ub + (size_t)(oko ? po : p) * INW);
            float fs[8], fn[8], fo[8]; unpack8(ws_, fs); unpack8(wn, fn); unpack8(wo, fo);
            const int lo = po < 0 ? 0 : po, hi = pn > L ? L : pn; const float ic = 1.f / (float)(hi - lo);
            float a[8];
#pragma unroll
            for (int e = 0; e < 8; ++e) a[e] = (DBG & 16) ? 0.f : S[e] * ic - fs[e];
            u32x4 w; w.x = pk2(a[0], a[1]); w.y = pk2(a[2], a[3]); w.z = pk2(a[4], a[5]); w.w = pk2(a[6], a[7]);
            *(u32x4*)(P + (size_t)(r0 + k) * INW + C_X1 + c0) = w;
            const float mn = okn ? 1.f : 0.f, mo = oko ? 1.f : 0.f;
#pragma unroll
            for (int e = 0; e < 8; ++e) S[e] += mn * fn[e] - mo * fo[e]; }
    }
}
__device__ __forceinline__ void p_final(const CArgs& A, const Frame& F, int layer) {
    bf16_t* P = (bf16_t*)(F.ws + WS_PROJ); const bf16_t* ZT = (const bf16_t*)(F.ws + WS_XNR); const bf16_t* CT = ZT + (size_t)512 * MP;
    const float* cw = FIN(9) + (size_t)layer * 3 * 1536; const float* cb = FIN(10) + layer * 1536; const float* skip = FIN(17) + layer * 512;
    LAS bf16_t* sz = (LAS bf16_t*)(F.lds + F.wave * 16384); LAS bf16_t* sc = sz + 64 * 64;
    const int gw = F.vcu * NWAVES + F.wave, NGW = F.G * NWAVES, lane = F.lane, rs = lane >> 3, ck = lane & 7;
    for (int it = gw; it < (MP / 64) * 8; it += NGW) {
        const int rt = it >> 3, cc = it & 7, c0 = cc * 64 + ck * 8; const int cls = rt * 64 < ROWS_P ? 0 : 1;
        const float* sums = (const float*)(F.ws + WS_CTL) + CW_SUMS + (layer * 2 + cls) * 512;
#pragma unroll
        for (int j = 0; j < 8; ++j) { const int chn = (lane >> 3) + 8 * j, pc = lane & 7; const size_t off = (size_t)(cc * 64 + chn) * MP + rt * 64 + pc * 8;
            *(LAS u32x4*)(sz + chn * 64 + pc * 8) = *(const u32x4*)(ZT + off); *(LAS u32x4*)(sc + chn * 64 + pc * 8) = *(const u32x4*)(CT + off); }
        LDS_WAIT();
        DwTaps wt; dw_taps(cw, cb, c0, wt); float isum[8], sk[8];
        { const f32x4 s0 = *(const f32x4*)(sums + c0), s1 = *(const f32x4*)(sums + c0 + 4), k0 = *(const f32x4*)(skip + c0), k1 = *(const f32x4*)(skip + c0 + 4);
#pragma unroll
          for (int e = 0; e < 4; ++e) { isum[e] = 1.f / s0[e]; isum[4 + e] = 1.f / s1[e]; sk[e] = k0[e]; sk[4 + e] = k1[e]; } }
#pragma unroll
        for (int hb = 0; hb < 2; ++hb) { DwRows dr[4];
#pragma unroll
            for (int q = 0; q < 4; ++q) { const int r = rt * 64 + (hb * 4 + q) * 8 + rs; dw_load(P, r < MROWS ? r : MROWS - 1, C_X0 + c0, dr[q]); }
            asm volatile("" ::: "memory");
#pragma unroll
            for (int q = 0; q < 4; ++q) { const int lr = (hb * 4 + q) * 8 + rs, r = rt * 64 + lr; float x0[8], o[8]; dw_apply(dr[q], wt, x0);
#pragma unroll
                for (int e = 0; e < 8; ++e) { const float z = __uint_as_float((unsigned)sz[(ck * 8 + e) * 64 + lr] << 16), cv = __uint_as_float((unsigned)sc[(ck * 8 + e) * 64 + lr] << 16);
                    o[e] = (DBG & 8) ? 0.f : (((DBG & 64) ? 0.f : cv * isum[e]) + ((DBG & 128) ? 0.f : z * sk[e])) * x0[e]; }
                u32x4 w; w.x = pk2(o[0], o[1]); w.y = pk2(o[2], o[3]); w.z = pk2(o[4], o[5]); w.w = pk2(o[6], o[7]);
                if (r < MROWS) *(u32x4*)(P + (size_t)r * INW + C_VV + c0) = w; }
            asm volatile("" ::: "memory"); }
        LDS_WAIT();
    }
}
__device__ __forceinline__ void p_norm2(const CArgs& A, const Frame& F, int layer) {
    const int gw = F.vcu * NWAVES + F.wave, NGW = F.G * NWAVES, lane = F.lane;
    const float* g = FIN(24) + layer * DM; bf16_t* XN = (bf16_t*)(F.ws + WS_XNR);
    for (int r0 = gw; r0 < MP; r0 += 2 * NGW) { f32x4 v[2][4]; const int r1 = r0 + NGW;
        { const f32x4* xr = (const f32x4*)xrow(F.out, F.xm, r0) + lane;
#pragma unroll
          for (int j = 0; j < 4; ++j) v[0][j] = xr[64 * j]; }
        if (r1 < MP) { const f32x4* xr = (const f32x4*)xrow(F.out, F.xm, r1) + lane;
#pragma unroll
          for (int j = 0; j < 4; ++j) v[1][j] = xr[64 * j]; }
        rms_row(v[0], g, XN + (size_t)r0 * DM, lane);
        if (r1 < MP) rms_row(v[1], g, XN + (size_t)r1 * DM, lane); }
}

constexpr int TAIL_ROW0 = 32768, TAIL_ITEMS = ((MROWS - TAIL_ROW0) / 16) * 16;
static_assert(MROWS - TAIL_ROW0 == 144 && TAIL_ROW0 % 256 == 0, "tail rows");
template <int NS>
__device__ __forceinline__ void tail_partial(f32x4 (&acc)[4], const bf16_t* ap, const bf16_t* bp, size_t bstride16) {
#pragma unroll
    for (int s0 = 0; s0 < NS; s0 += 4) {
        bf16x8 a[4], b[4][4];
#pragma unroll
        for (int s = 0; s < 4; ++s) if (s0 + s < NS) { a[s] = *(const bf16x8*)(ap + (s0 + s) * 32);
#pragma unroll
            for (int j = 0; j < 4; ++j) b[s][j] = *(const bf16x8*)(bp + j * bstride16 + (s0 + s) * 32); }
#pragma unroll
        for (int s = 0; s < 4; ++s) if (s0 + s < NS) {
#pragma unroll
            for (int j = 0; j < 4; ++j) acc[j] = __builtin_amdgcn_mfma_f32_16x16x32_bf16(b[s][j], a[s], acc[j], 0, 0, 0); }
        asm volatile("" ::: "memory");
    }
}
template <int K>
__device__ __forceinline__ void tail_res(const Frame& F, const bf16_t* A, const bf16_t* Bt) {
    constexpr int KW = K / 8, NS = KW / 32; static_assert(K % 256 == 0, "K split");
    const int lane = F.lane, fr = lane & 15, fq = lane >> 4, tid = F.tid;
    for (int item = F.bx; item < TAIL_ITEMS; item += F.G) {
        const int row0 = TAIL_ROW0 + (item >> 4) * 16, col0 = (item & 15) * 64;
        f32x4 acc[4];
#pragma unroll
        for (int j = 0; j < 4; ++j) acc[j] = (f32x4){0.f, 0.f, 0.f, 0.f};
        tail_partial<NS>(acc, A + (size_t)(row0 + fr) * K + F.wave * KW + fq * 8, Bt + (size_t)(col0 + fr) * K + F.wave * KW + fq * 8, (size_t)16 * K);
#pragma unroll
        for (int j = 0; j < 4; ++j) *(LAS f32x4*)(F.lds + F.wave * 4096 + j * 1024 + lane * 16) = acc[j];
        __syncthreads();
        f32x2 s = {0.f, 0.f};
#pragma unroll
        for (int w = 0; w < 8; ++w) s += *(const LAS f32x2*)(F.lds + w * 4096 + tid * 8);
        const int j = tid >> 7, l = (tid & 127) >> 1, r = (tid & 1) * 2;
        float* p = xrow(F.out, F.xm, row0 + (l & 15)) + col0 + j * 16 + 4 * (l >> 4) + r;
        f32x2 v = *(f32x2*)p; v += s; if (!F.dry) *(f32x2*)p = v;
        __syncthreads();
    }
}
__device__ __forceinline__ void tail_merge(const Frame& F, const bf16_t* P, const bf16_t* WM, bf16_t* O) {
    const int lane = F.lane, fr = lane & 15, fq = lane >> 4, tid = F.tid;
    for (int item = F.bx; item < TAIL_ITEMS; item += F.G) {
        const int row0 = TAIL_ROW0 + (item >> 4) * 16, col0 = (item & 15) * 64;
#pragma unroll
        for (int s = 0; s < 3; ++s) { const int col = s == 0 ? C_Q : (s == 1 ? C_VV : C_X1);
            f32x4 acc[4];
#pragma unroll
            for (int j = 0; j < 4; ++j) acc[j] = (f32x4){0.f, 0.f, 0.f, 0.f};
            tail_partial<2>(acc, P + (size_t)(row0 + fr) * INW + col + F.wave * 64 + fq * 8, WM + ((size_t)s * DM + col0 + fr) * 512 + F.wave * 64 + fq * 8, (size_t)16 * 512);
#pragma unroll
            for (int j = 0; j < 4; ++j) *(LAS f32x4*)(F.lds + s * 32768 + F.wave * 4096 + j * 1024 + lane * 16) = acc[j]; }
        __syncthreads();
        const int j = tid >> 7, l = (tid & 127) >> 1, r = (tid & 1) * 2, row = row0 + (l & 15), colo = col0 + j * 16 + 4 * (l >> 4) + r;
        const unsigned char* gp = (const unsigned char*)(P + (size_t)row * INW) + C_G * 2 + colo;
        f32x2 o = {0.f, 0.f};
#pragma unroll
        for (int s = 0; s < 3; ++s) { f32x2 t = {0.f, 0.f};
#pragma unroll
            for (int w = 0; w < 8; ++w) t += *(const LAS f32x2*)(F.lds + s * 32768 + w * 4096 + tid * 8);
            const unsigned g2 = *(const unsigned short*)(gp + s * DM);
            o.x += t.x * ((float)(g2 & 255u) * (1.f / 255.f)); o.y += t.y * ((float)(g2 >> 8) * (1.f / 255.f)); }
        *(unsigned*)(O + (size_t)row * DM + colo) = pg8::cvt_pk_bf16(o.x, o.y);
        __syncthreads();
    }
}

constexpr int PH_PER_LAYER = 11, N_PHASES = 2 * PH_PER_LAYER;
__global__ void __launch_bounds__(NWAVES * 64, 2) fwd_kernel(Args args0) {
    extern __shared__ __attribute__((aligned(16))) unsigned char lds_raw[];
    const int wave0 = __builtin_amdgcn_readfirstlane(threadIdx.x >> 6);
    {
        for (int u = threadIdx.x; u < (LDS_BYTES - LDSCTL_OFF) / 4; u += NWAVES * 64) ((LAS unsigned*)((LAS unsigned char*)lds_raw + LDSCTL_OFF))[u] = 0u;
        __syncthreads();
    }
    XcdBarrier bar; bar.bar = (unsigned*)(args0.ws + WS_CTL) + CW_BAR; bar.x = 0; bar.st = nullptr;
    if (args0.use_bar) bar = xcd_barrier_post((unsigned*)(args0.ws + WS_CTL) + CW_BAR, (volatile LAS unsigned*)((LAS unsigned char*)lds_raw + MISC_OFF) + 8);
    for (int ph2 = 2 * args0.ph_lo; ph2 < 2 * args0.ph_hi; ++ph2) {
        const int ph = ph2 >> 1, rep = ph2 & 1;
        const int layer = ph / PH_PER_LAYER, k = ph % PH_PER_LAYER;
        if (rep == 1 && !(DUP_PHASE >= 0 && k == DUP_PHASE && args0.pad == 0)) continue;
        const __attribute__((address_space(4))) Args* ap = (const __attribute__((address_space(4))) Args*)__builtin_amdgcn_kernarg_segment_ptr();
        asm volatile("" : "+s"(ap));
        const __attribute__((address_space(4))) Args& args = *ap;
        Frame F;
        { int w_ = wave0; asm volatile("" : "+s"(w_)); int z_ = 0; asm volatile("" : "+v"(z_)); const int l_ = __builtin_amdgcn_mbcnt_hi(-1, __builtin_amdgcn_mbcnt_lo(-1, z_));
          F.lane = l_; F.wave = w_; F.tid = w_ * 64 + l_;
          int bx = blockIdx.x, G_ = gridDim.x; asm volatile("" : "+s"(bx), "+s"(G_)); F.G = G_; F.vcu = (G_ % 8 == 0) ? (bx % 8) * (G_ / 8) + bx / 8 : bx; F.bx = bx;
          F.dry = rep; F.lds = (LAS unsigned char*)lds_raw; F.ws = args.ws; F.out = args.out; F.xm = (float*)(args.ws + WS_XM); }
        unsigned char* W = F.ws + WS_W;
        bf16_t* XNR = (bf16_t*)(F.ws + WS_XNR); bf16_t* PROJ = (bf16_t*)(F.ws + WS_PROJ);
        bf16_t* GB = PROJ; bf16_t* ACT = PROJ + (size_t)MP * DFF;
#ifndef ONLY_PHASE
#define ONLY_PHASE -1
#endif
#define PHS(x) ((ONLY_PHASE < 0 || ONLY_PHASE == (x)) && k == (x) && !((DBG & 1) && (x) >= 1 && (x) <= 6) && !((DBG & 2) && (x) >= 7) && !((DBG & 32) && layer > 0))
        if (PHS(0)) p_prep(args, F, layer);
        else if (PHS(1)) { OpsPlain O{XNR, (const bf16_t*)(W + W_IN), DM, DM}; pg8::StaticOrder S; S.init(MP, INW, F.G, F.bx, 1); EpiStore E{PROJ, INW, C_G / 256};
            pg8::gemm_phase<EpiStore, OpsPlain, true>(F.lds, O, S, E, F.tid); }
        else if (PHS(2)) { if (DBG & 512) p_attn_ref(args, F, layer); else if (DSEL(64)) p_attn(args, F, layer); if (DSEL(128)) p_h1(args, F, layer); if (DSEL(256)) p_filt_tiles(args, F, layer); }
        else if (PHS(3)) { if (DBG & 256) p_h2_ref(args, F); else if (DSEL(16)) p_h2(F); if (DSEL(32)) p_pool(args, F); }
        else if (PHS(4)) p_final(args, F, layer);
        else if (PHS(5)) { OpsMerge O{PROJ, (const bf16_t*)(W + W_MRG), 512, INW}; pg8::StaticOrder S; S.init(TAIL_ROW0, DM, F.G, F.bx, 3); EpiMerge E{PROJ, XNR};
            pg8::gemm_phase<EpiMerge, OpsMerge, true>(F.lds, O, S, E, F.tid); tail_merge(F, PROJ, (const bf16_t*)(W + W_MRG), XNR); }
        else if (PHS(6)) { OpsPlain O{XNR, (const bf16_t*)(W + W_OUT), DM, DM}; pg8::StaticOrder S; S.init(TAIL_ROW0, DM, F.G, F.bx, 1); EpiRes E{F.out, F.xm, F.dry};
            pg8::gemm_phase<EpiRes, OpsPlain, true>(F.lds, O, S, E, F.tid); tail_res<DM>(F, XNR, (const bf16_t*)(W + W_OUT)); }
        else if (PHS(7)) p_norm2(args, F, layer);
        else if (PHS(8)) { OpsPlain O{XNR, (const bf16_t*)(W + W_G), DM, DM}; pg8::StaticOrder S; S.init(MP, DFF, F.G, F.bx, 1); EpiStore E{GB, DFF, 1 << 20};
            pg8::gemm_phase<EpiStore, OpsPlain, true>(F.lds, O, S, E, F.tid); }
        else if (PHS(9)) { OpsPlain O{XNR, (const bf16_t*)(W + W_U), DM, DM}; pg8::StaticOrder S; S.init(MP, DFF, F.G, F.bx, 1);
            EpiGeluMul E{GB, args.in[27] + (size_t)layer * 3 * DFF, args.in[28] + layer * DFF, ACT, F.dry ? DRYVAR : 0};
            pg8::gemm_phase<EpiGeluMul, OpsPlain, true>(F.lds, O, S, E, F.tid); }
        else if (PHS(10)) { OpsPlain O{ACT, (const bf16_t*)(W + W_D), DFF, DFF}; pg8::StaticOrder S; S.init(TAIL_ROW0, DM, F.G, F.bx, 1); EpiRes E{F.out, F.xm, F.dry};
            pg8::gemm_phase<EpiRes, OpsPlain, true>(F.lds, O, S, E, F.tid); tail_res<DFF>(F, ACT, (const bf16_t*)(W + W_D)); }
        if (ph2 + 1 < 2 * args0.ph_hi) { { int z2_ = 0; asm volatile("" : "+v"(z2_)); const int tid2 = wave0 * 64 + __builtin_amdgcn_mbcnt_hi(-1, __builtin_amdgcn_mbcnt_lo(-1, z2_));
              if (args0.use_bar) xcd_barrier(bar, tid2); else __syncthreads(); } }
    }
}

__global__ void fill_k(float* o, size_t n, float v) { size_t i = (size_t)blockIdx.x * blockDim.x + threadIdx.x; for (; i < n; i += (size_t)gridDim.x * blockDim.x) o[i] = v; }
extern "C" void kernel_launch(void* const* d_in, const int* in_sizes, int n_in, void* d_out, int out_size, void* d_ws, size_t ws_size, hipStream_t stream) {
    static int grid = 0;
    if (grid == 0) {
        int dev = 0, cus = 0;
        if (n_in != 30 || out_size != 32768 * DM || ws_size < WS_END || hipGetDevice(&dev) != hipSuccess || hipDeviceGetAttribute(&cus, hipDeviceAttributeMultiprocessorCount, dev) != hipSuccess ||
            hipFuncSetAttribute((const void*)fwd_kernel, hipFuncAttributeMaxDynamicSharedMemorySize, LDS_BYTES) != hipSuccess) { fprintf(stderr, "kernel_launch: bad shapes / workspace / device\n"); grid = -1; }
        else { int per_cu = 0; (void)hipOccupancyMaxActiveBlocksPerMultiprocessor(&per_cu, (const void*)fwd_kernel, NWAVES * 64, LDS_BYTES); (void)hipGetLastError();
            grid = cus * (per_cu >= 1 ? 1 : 0); if (grid <= 0) grid = -1; }
    }
    if (grid < 0) { fill_k<<<1024, 256, 0, stream>>>((float*)d_out, (size_t)out_size, 1e6f); return; }
    (void)hipMemsetAsync((char*)d_ws + WS_CTL, 0, CTL_ZERO_BYTES, stream);
    Args a{};
    for (int i = 0; i < 30; ++i) a.in[i] = (const float*)d_in[i];
    a.out = (float*)d_out; a.ws = (unsigned char*)d_ws;
#if MK_N_LAUNCHES == 1
    a.ph_lo = 0; a.ph_hi = N_PHASES; a.use_bar = 1;
    void* kargs[] = {&a};
    hipError_t e = hipLaunchCooperativeKernel((const void*)fwd_kernel, dim3(grid), dim3(NWAVES * 64), kargs, LDS_BYTES, stream);
    if (e != hipSuccess) fprintf(stderr, "cooperative launch failed: %s\n", hipGetErrorString(e));
#else
    for (int ph = 0; ph < N_PHASES; ++ph) { a.ph_lo = ph; a.ph_hi = ph + 1; a.use_bar = 0;
        hipLaunchKernelGGL(fwd_kernel, dim3(grid), dim3(NWAVES * 64), LDS_BYTES, stream, a); }
#endif
}
```

```cpp
#include <hip/hip_runtime.h>
#include <cstdio>
#include <cstdint>
#include <cmath>

#ifndef DBG
#define DBG 0
#endif
#ifndef DUP_PHASE
#define DUP_PHASE -1
#endif
#ifndef FT_RECOMPUTE
#define FT_RECOMPUTE 0
#endif
#ifndef DRYVAR
#define DRYVAR 0
#endif
#ifndef DUPMASK
#define DUPMASK 65535
#endif
#define DSEL(b) (!F.dry || (DUPMASK & (b)))
#ifndef MK_N_LAUNCHES
#define MK_N_LAUNCHES 1
#endif

#define LAS __attribute__((address_space(3)))
#define GAS __attribute__((address_space(1)))
typedef unsigned short bf16_t;
typedef short bf16x8 __attribute__((ext_vector_type(8)));
typedef float f32x4 __attribute__((ext_vector_type(4)));
typedef float f32x2 __attribute__((ext_vector_type(2)));
typedef float f32x16 __attribute__((ext_vector_type(16)));
typedef unsigned u32x4 __attribute__((ext_vector_type(4)));
typedef unsigned u32x2 __attribute__((ext_vector_type(2)));

constexpr int DM = 1024, INW = 5888, DFF = 2816, NHEAD = 8, HD = 64;
constexpr int LP = 2064, LS = 16400, NMETA = 16;
constexpr int ROWS_P = 8 * LP;
constexpr int MROWS = ROWS_P + LS;
constexpr int MP = 33024;
constexpr int C_Q = 0, C_K = 512, C_V = 640, C_X0 = 768, C_X1 = 1280, C_VV = 1792, C_PU = 2304, C_G = 2816;
constexpr float EPS = 1e-6f;
constexpr int RK_PAD = 256;
constexpr int RKLEN_P = 2 * LP + 512, RKLEN_S = 2 * LS + 512;

constexpr size_t MiB = 1u << 20;
constexpr size_t WS_CTL = 0, CTL_ZERO_BYTES = 1 * MiB;
constexpr size_t WS_XM = 1 * MiB;
constexpr size_t WS_W = 3 * MiB;
constexpr size_t W_IN = 0, W_G = W_IN + (size_t)INW * DM * 2, W_U = W_G + (size_t)DFF * DM * 2, W_D = W_U + (size_t)DFF * DM * 2,
                 W_OUT = W_D + (size_t)DM * DFF * 2, W_MRG = W_OUT + (size_t)DM * DM * 2, W_END = W_MRG + (size_t)3 * DM * 512 * 2;
static_assert(WS_W + W_END <= 36 * MiB, "weights");
constexpr size_t WS_RKP = 36 * MiB;
constexpr size_t WS_RKS = WS_RKP + (size_t)512 * RKLEN_P * 2;
static_assert(WS_RKS + (size_t)512 * RKLEN_S * 2 <= 74 * MiB, "filters");
constexpr size_t WS_XNR = 74 * MiB;
constexpr size_t XNR_BYTES = (size_t)MP * DM * 2;
constexpr size_t WS_PROJ = 139 * MiB;
constexpr size_t WS_END = WS_PROJ + (size_t)MP * INW * 2;
static_assert(WS_XNR + XNR_BYTES <= WS_PROJ && WS_END <= 512 * MiB, "d_ws map");
constexpr int CW_BAR = 4096;
constexpr int CW_SUMS = 16384;

namespace pg8 {
constexpr int BM = 256, BK = 64, HALF = 128, HTB = HALF * BK * 2, STAGE_BYTES = 8 * HTB, NXCD = 8, WGM = 8;
__host__ __device__ __forceinline__ int lds_byte(int r, int c) { const int st = (r >> 4) * 2 + (c >> 5), rr = r & 15, cc = c & 31, ob = rr * 64 + cc * 2; return st * 1024 + (ob ^ (((ob >> 9) & 1) << 5)); }
__host__ __device__ __forceinline__ void stage_rc(int b, int& R, int& C) { const int st = b / 1024, sb = b % 1024, swz = sb ^ (((sb >> 9) & 1) << 5); R = (st >> 1) * 16 + swz / 64; C = (st & 1) * 32 + (swz % 64) / 2; }
__host__ __device__ __forceinline__ int perm32(int rho) { const int n = rho >> 4, i = rho & 15; return 8 * (i >> 2) + 4 * n + (i & 3); }

struct Unit { int pm, pn, sub; };
struct StaticOrder {
    int nM, nN, nwg, G, c, nsub;
    __device__ void init(int M, int N, int G_, int c_, int nsub_) { nM = M / BM; nN = N / BM; nwg = nM * nN; G = G_; c = c_; nsub = nsub_; }
    __device__ bool next(int i, Unit& u) const {
        const int tile = i / nsub; u.sub = i - tile * nsub;
        const long L = (long)tile * G + c; if (L >= nwg) return false;
        int wgid = (int)L; { const int q = nwg / NXCD, r = nwg % NXCD, xcd = wgid % NXCD, off = wgid / NXCD; wgid = (xcd < r ? xcd * (q + 1) : r * (q + 1) + (xcd - r) * q) + off; }
        const int nig = WGM * nN, gid = wgid / nig, fm = gid * WGM, gsz = (nM - fm) < WGM ? (nM - fm) : WGM;
        u.pm = fm + ((wgid % nig) % gsz); u.pn = (wgid % nig) / gsz; return true;
    }
};
__device__ __forceinline__ unsigned cvt_pk_bf16(float lo, float hi) { unsigned r; asm volatile("v_cvt_pk_bf16_f32 %0, %1, %2" : "=v"(r) : "v"(lo), "v"(hi)); return r; }
__device__ __forceinline__ f32x2 gelu_pk(f32x2 v) {
    const f32x2 av = __builtin_elementwise_abs(v), d = av * 0.2316418882f + 1.0f;
    f32x2 t; t.x = __builtin_amdgcn_rcpf(d.x); t.y = __builtin_amdgcn_rcpf(d.y);
    f32x2 q = t * 0.5307027145f + (-0.7265760135f); q = q * t + 0.7107068705f; q = q * t + (-0.142248368f); q = q * t + 0.127414796f; q = q * t;
    const f32x2 s = (v * v) * (-0.72134752044f);
    f32x2 e; e.x = __builtin_amdgcn_exp2f(s.x); e.y = __builtin_amdgcn_exp2f(s.y);
    const f32x2 m = v * (q * e), r = v - m;
    f32x2 o; o.x = v.x < 0.f ? m.x : r.x; o.y = v.y < 0.f ? m.y : r.y; return o;
}

template <class Epi, class Ops, bool ALIGN_EPI>
__device__ __forceinline__ void gemm_phase(LAS unsigned char* lds, const Ops& O, const StaticOrder& S, const Epi& E, int tid) {
    const int wid = __builtin_amdgcn_readfirstlane(tid >> 6), lane = tid & 63, wr = wid >> 2, wc = wid & 3, fr = lane & 15, fq = lane >> 4;
    const int K = O.K, nt = K / BK, lda = O.lda;
    unsigned voffA[2], voffB[2];
#pragma unroll
    for (int i = 0; i < 2; ++i) { int R, C; stage_rc(tid * 16 + i * 8192, R, C); const int Rb = (R & ~31) + perm32(R & 31);
        voffA[i] = (unsigned)(R * lda + C) * 2u; voffB[i] = (unsigned)(Rb * K + C) * 2u; }
    const size_t kstep = (size_t)(BK * 2);
    const size_t hstepA = (size_t)HALF * lda * 2, hstepB = (size_t)HALF * K * 2;
    const unsigned ldsw = (unsigned)wid * 1024u;
    const int aoff = lds_byte(wr * 64 + fr, fq * 8), boff = lds_byte(wc * 32 + fr, fq * 8);
#define PG8_SA(b, h) (((b) * 2 + (h)) * HTB)
#define PG8_SB(b, h) ((4 + (b) * 2 + (h)) * HTB)
#define PG8_STAGE(bufoff, gbase, voff) do { _Pragma("unroll") for (int _i = 0; _i < 2; ++_i) \
        __builtin_amdgcn_global_load_lds((const unsigned*)((const char*)(gbase) + (voff)[_i]), (LAS unsigned*)(lds + (bufoff) + ldsw + _i * 8192), 16, 0, 0); } while (0)
#define PG8_LDA(dst, b, h) do { _Pragma("unroll") for (int m = 0; m < 4; ++m) _Pragma("unroll") for (int k = 0; k < 2; ++k) dst[m][k] = *(const LAS bf16x8*)(lds + PG8_SA(b, h) + aoff + m * 2048 + k * 1024); } while (0)
#define PG8_LDB(dst, b, h) do { _Pragma("unroll") for (int n = 0; n < 2; ++n) _Pragma("unroll") for (int k = 0; k < 2; ++k) dst[n][k] = *(const LAS bf16x8*)(lds + PG8_SB(b, h) + boff + n * 2048 + k * 1024); } while (0)
#define PG8_MMA(ai, bj, At, Bt) do { __builtin_amdgcn_s_setprio(1); _Pragma("unroll") for (int m = 0; m < 4; ++m) _Pragma("unroll") for (int n = 0; n < 2; ++n) _Pragma("unroll") for (int k = 0; k < 2; ++k) \
        acc[ai][bj][m][n] = __builtin_amdgcn_mfma_f32_16x16x32_bf16(Bt[n][k], At[m][k], acc[ai][bj][m][n], 0, 0, 0); __builtin_amdgcn_s_setprio(0); } while (0)
#define PG8_WAIT_V(n) asm volatile("s_waitcnt vmcnt(" #n ")" ::: "memory")
#define PG8_WAIT_L(n) asm volatile("s_waitcnt lgkmcnt(" #n ")" ::: "memory")
#define PG8_BAR __builtin_amdgcn_s_barrier()
#define PG8_SCHED __builtin_amdgcn_sched_barrier(0)
    Unit cur, nxt; int ui = 0;
    if (!S.next(0, cur)) return;
    f32x4 acc[2][2][4][2];
#pragma unroll
    for (int a = 0; a < 2; ++a)
#pragma unroll
        for (int b = 0; b < 2; ++b)
#pragma unroll
            for (int m = 0; m < 4; ++m)
#pragma unroll
                for (int n = 0; n < 2; ++n) acc[a][b][m][n] = (f32x4){0.f, 0.f, 0.f, 0.f};
    bf16x8 At[4][2], B0[2][2], B1[2][2];
    const char* cA; const char* cB; O.ptrs(cur, cA, cB);
    PG8_STAGE(PG8_SB(0, 0), cB, voffB); PG8_STAGE(PG8_SB(0, 1), cB + hstepB, voffB); PG8_STAGE(PG8_SA(0, 0), cA, voffA); PG8_STAGE(PG8_SA(0, 1), cA + hstepA, voffA);
    if (wr == 1) PG8_BAR;
    PG8_WAIT_V(2); PG8_BAR;
    PG8_STAGE(PG8_SB(1, 0), cB + kstep, voffB); PG8_STAGE(PG8_SA(1, 0), cA + kstep, voffA); PG8_STAGE(PG8_SB(1, 1), cB + hstepB + kstep, voffB);
    PG8_WAIT_V(6); PG8_BAR;
    for (;;) {
        const bool has_next = S.next(ui + 1, nxt);
        const char* nA = cA; const char* nB = cB; if (has_next) O.ptrs(nxt, nA, nB);
        for (int t = 0; t < nt; t += 2) {
            const bool last = (t == nt - 2);
            const char* a1 = cA + (size_t)(t + 1) * kstep;
            const char* a2 = last ? nA : cA + (size_t)(t + 2) * kstep; const char* b2 = last ? nB : cB + (size_t)(t + 2) * kstep;
            const char* a3 = a2 + kstep; const char* b3 = b2 + kstep;
            PG8_LDB(B0, 0, 0); PG8_LDB(B1, 0, 1); PG8_SCHED; PG8_LDA(At, 0, 0); PG8_STAGE(PG8_SA(1, 1), a1 + hstepA, voffA);
            PG8_WAIT_V(8); PG8_WAIT_L(0); PG8_BAR; PG8_MMA(0, 0, At, B0); PG8_MMA(0, 1, At, B1); PG8_BAR; PG8_SCHED;
            PG8_LDA(At, 0, 1); PG8_STAGE(PG8_SB(0, 0), b2, voffB); PG8_STAGE(PG8_SB(0, 1), b2 + hstepB, voffB); PG8_STAGE(PG8_SA(0, 0), a2, voffA);
            PG8_WAIT_V(8); PG8_WAIT_L(0); PG8_BAR; PG8_MMA(1, 0, At, B0); PG8_MMA(1, 1, At, B1); PG8_BAR; PG8_SCHED;
            PG8_LDB(B0, 1, 0); PG8_LDB(B1, 1, 1); PG8_SCHED; PG8_LDA(At, 1, 0); PG8_STAGE(PG8_SA(0, 1), a2 + hstepA, voffA);
            PG8_WAIT_V(8); PG8_WAIT_L(0); PG8_BAR; PG8_MMA(0, 0, At, B0); PG8_MMA(0, 1, At, B1); PG8_BAR; PG8_SCHED;
            PG8_LDA(At, 1, 1); PG8_STAGE(PG8_SB(1, 0), b3, voffB); PG8_STAGE(PG8_SB(1, 1), b3 + hstepB, voffB); PG8_STAGE(PG8_SA(1, 0), a3, voffA);
            PG8_WAIT_V(8); PG8_WAIT_L(0); PG8_BAR; PG8_MMA(1, 0, At, B0); PG8_MMA(1, 1, At, B1); PG8_BAR; PG8_SCHED;
        }
        if constexpr (ALIGN_EPI) { if (wr == 0) PG8_BAR; }
        { int z_ = 0; asm volatile("" : "+v"(z_)); const int l2 = __builtin_amdgcn_mbcnt_hi(-1, __builtin_amdgcn_mbcnt_lo(-1, z_));
          E(acc, cur, wr, wc, l2 & 15, l2 >> 4); }
        if (!E.keep(cur)) {
#pragma unroll
            for (int a = 0; a < 2; ++a)
#pragma unroll
                for (int b = 0; b < 2; ++b)
#pragma unroll
                    for (int m = 0; m < 4; ++m)
#pragma unroll
                        for (int n = 0; n < 2; ++n) acc[a][b][m][n] = (f32x4){0.f, 0.f, 0.f, 0.f};
        }
        if (!has_next) break;
        cur = nxt; cA = nA; cB = nB; ++ui;
        if constexpr (ALIGN_EPI) { if (wr == 1) PG8_BAR; }
    }
    PG8_WAIT_V(0);
    if constexpr (!ALIGN_EPI) { if (wr == 0) PG8_BAR; }
    PG8_BAR;
#undef PG8_SA
#undef PG8_SB
#undef PG8_STAGE
#undef PG8_LDA
#undef PG8_LDB
#undef PG8_MMA
#undef PG8_WAIT_V
#undef PG8_WAIT_L
#undef PG8_BAR
#undef PG8_SCHED
}
}

constexpr int RING_BYTES_C = 131072, LDSCTL_OFF_C = 131072;
__device__ __forceinline__ int seq_of_row(int r) { return r < ROWS_P ? r / LP : 8; }
__device__ __forceinline__ int seq_base(int s) { return s < 8 ? s * LP : ROWS_P; }
__device__ __forceinline__ int seq_len(int s) { return s < 8 ? LP : LS; }
__device__ __forceinline__ float* xrow(float* xreal, float* xm, int r) {
    if (r >= MROWS) return xm + (size_t)(144 + r - MROWS) * DM;
    const int s = seq_of_row(r), p = r - seq_base(s);
    if (p < NMETA) return xm + (size_t)(s * 16 + p) * DM;
    return xreal + (size_t)(r - 16 * (s + 1)) * DM;
}
__device__ __forceinline__ float bflo(unsigned u) { return __uint_as_float(u << 16); }
__device__ __forceinline__ float bfhi(unsigned u) { return __uint_as_float(u & 0xffff0000u); }
__device__ __forceinline__ unsigned pk2(float lo, float hi) { unsigned r; asm("v_cvt_pk_bf16_f32 %0, %1, %2" : "=v"(r) : "v"(lo), "v"(hi)); return r; }
__device__ __forceinline__ unsigned f2bf(float f) { return pk2(f, f); }
__device__ __forceinline__ void unpack8(const u32x4 w, float* f) { f[0] = bflo(w.x); f[1] = bfhi(w.x); f[2] = bflo(w.y); f[3] = bfhi(w.y); f[4] = bflo(w.z); f[5] = bfhi(w.z); f[6] = bflo(w.w); f[7] = bfhi(w.w); }
__device__ __forceinline__ float shx(float v, int o, int lane) { return __int_as_float(__builtin_amdgcn_ds_bpermute((lane ^ o) << 2, __float_as_int(v))); }
__device__ __forceinline__ float wave_sum(float v, int lane) {
#pragma unroll
    for (int o = 1; o < 64; o <<= 1) v += shx(v, o, lane);
    return v;
}
#define LDS_WAIT() asm volatile("s_waitcnt lgkmcnt(0)" ::: "memory")

struct OpsPlain {
    const bf16_t* A; const bf16_t* Bt; int K, lda;
    __device__ __forceinline__ void ptrs(const pg8::Unit& u, const char*& a, const char*& b) const {
        a = (const char*)A + (size_t)u.pm * 256 * lda * 2; b = (const char*)Bt + (size_t)u.pn * 256 * K * 2; }
};
struct OpsMerge {
    const bf16_t* P; const bf16_t* WM; int K, lda;
    __device__ __forceinline__ void ptrs(const pg8::Unit& u, const char*& a, const char*& b) const {
        const int col = u.sub == 0 ? C_Q : (u.sub == 1 ? C_VV : C_X1);
        a = (const char*)P + ((size_t)u.pm * 256 * lda + col) * 2; b = (const char*)WM + ((size_t)u.sub * DM + (size_t)u.pn * 256) * 512 * 2; }
};
typedef f32x4 acc_t[2][2][4][2];
struct EpiStore {
    bf16_t* O; int ldc; int sig_pn;
    __device__ __forceinline__ bool keep(const pg8::Unit&) const { return false; }
    __device__ __forceinline__ void operator()(acc_t& acc, const pg8::Unit& u, int wr, int wc, int fr, int fq) const {
        const int row0 = u.pm * 256 + wr * 64 + fr, col0 = u.pn * 256 + wc * 32 + 8 * fq; const bool sig = u.pn >= sig_pn;
#pragma unroll
        for (int ai = 0; ai < 2; ++ai)
#pragma unroll
            for (int m = 0; m < 4; ++m) { bf16_t* rowp = O + (size_t)(row0 + ai * 128 + m * 16) * ldc + col0;
#pragma unroll
                for (int bj = 0; bj < 2; ++bj) { f32x4 v0 = acc[ai][bj][m][0], v1 = acc[ai][bj][m][1];
                    if (sig) { unsigned q[8];
#pragma unroll
                        for (int e = 0; e < 4; ++e) { q[e] = (unsigned)fminf(fmaxf(__builtin_rintf(255.f * __builtin_amdgcn_rcpf(1.f + __expf(-v0[e]))), 1.f), 255.f);
                                                      q[4 + e] = (unsigned)fminf(fmaxf(__builtin_rintf(255.f * __builtin_amdgcn_rcpf(1.f + __expf(-v1[e]))), 1.f), 255.f); }
                        u32x2 w8; w8.x = q[0] | (q[1] << 8) | (q[2] << 16) | (q[3] << 24); w8.y = q[4] | (q[5] << 8) | (q[6] << 16) | (q[7] << 24);
                        *(u32x2*)((unsigned char*)(O + (size_t)(row0 + ai * 128 + m * 16) * ldc) + C_G * 2 + (col0 + bj * 128 - C_G)) = w8; continue; }
                    u32x4 w; w.x = pg8::cvt_pk_bf16(v0[0], v0[1]); w.y = pg8::cvt_pk_bf16(v0[2], v0[3]); w.z = pg8::cvt_pk_bf16(v1[0], v1[1]); w.w = pg8::cvt_pk_bf16(v1[2], v1[3]);
                    *(u32x4*)(rowp + bj * 128) = w; } }
    }
};
struct EpiRes {
    float* xreal; float* xm; int dry;
    __device__ __forceinline__ bool keep(const pg8::Unit&) const { return false; }
    __device__ __forceinline__ void operator()(acc_t& acc, const pg8::Unit& u, int wr, int wc, int fr, int fq) const {
        const int row0 = u.pm * 256 + wr * 64 + fr, col0 = u.pn * 256 + wc * 32 + 8 * fq;
#pragma unroll
        for (int ai = 0; ai < 2; ++ai)
#pragma unroll
            for (int m = 0; m < 4; ++m) { float* p = xrow(xreal, xm, row0 + ai * 128 + m * 16) + col0;
#pragma unroll
                for (int bj = 0; bj < 2; ++bj) { f32x4 a = *(f32x4*)(p + bj * 128), b = *(f32x4*)(p + bj * 128 + 4);
                    a += acc[ai][bj][m][0]; b += acc[ai][bj][m][1]; if (!dry) { *(f32x4*)(p + bj * 128) = a; *(f32x4*)(p + bj * 128 + 4) = b; } } }
    }
};
struct EpiGeluMul {
    const bf16_t* G; const float* cw; const float* cb; bf16_t* O; int dv;
    __device__ __forceinline__ bool keep(const pg8::Unit&) const { return false; }
    __device__ __forceinline__ void operator()(acc_t& acc, const pg8::Unit& u, int wr, int wc, int fr, int fq) const {
        if (dv == 1) return;
        const int row0 = u.pm * 256 + wr * 64 + fr, col0 = u.pn * 256 + wc * 32 + 8 * fq;
#pragma unroll
        for (int ai = 0; ai < 2; ++ai)
#pragma unroll
            for (int m = 0; m < 4; ++m) { const int r = row0 + ai * 128 + m * 16;
                const int s = seq_of_row(r), p = r - seq_base(s); const bool inb = r < MROWS;
                const bool hasp = inb && p > 0, hasn = inb && p < seq_len(s) - 1;
                const float mp_ = hasp ? 1.f : 0.f, mn_ = hasn ? 1.f : 0.f;
#pragma unroll
                for (int bj = 0; bj < 2; ++bj) { const int col = col0 + bj * 128;
                    const bf16_t* gp = G + (size_t)r * DFF + col;
                    const u32x4 gm = *(const u32x4*)(gp - (hasp ? DFF : 0)), g0 = *(const u32x4*)gp, gn = *(const u32x4*)(gp + (hasn ? DFF : 0));
                    float fm[8], f0[8], fn[8]; unpack8(gm, fm); unpack8(g0, f0); unpack8(gn, fn);
                    float o[8];
#pragma unroll
                    for (int h = 0; h < 2; ++h) { const f32x4 a = *(const f32x4*)(cw + col + 4 * h), b = *(const f32x4*)(cw + DFF + col + 4 * h), c = *(const f32x4*)(cw + 2 * DFF + col + 4 * h), d = *(const f32x4*)(cb + col + 4 * h);
#pragma unroll
                        for (int e = 0; e < 4; e += 2) { f32x2 x; x.x = a[e] * mp_ * fm[4 * h + e] + b[e] * f0[4 * h + e] + c[e] * mn_ * fn[4 * h + e] + d[e];
                            x.y = a[e + 1] * mp_ * fm[4 * h + e + 1] + b[e + 1] * f0[4 * h + e + 1] + c[e + 1] * mn_ * fn[4 * h + e + 1] + d[e + 1];
                            const f32x2 g = pg8::gelu_pk(x); o[4 * h + e] = g.x; o[4 * h + e + 1] = g.y; } }
                    const f32x4 v0 = acc[ai][bj][m][0], v1 = acc[ai][bj][m][1];
                    u32x4 w; w.x = pg8::cvt_pk_bf16(o[0] * v0[0], o[1] * v0[1]); w.y = pg8::cvt_pk_bf16(o[2] * v0[2], o[3] * v0[3]);
                    w.z = pg8::cvt_pk_bf16(o[4] * v1[0], o[5] * v1[1]); w.w = pg8::cvt_pk_bf16(o[6] * v1[2], o[7] * v1[3]);
                    if (dv != 2) *(u32x4*)(O + (size_t)r * DFF + col) = w; else asm volatile("" :: "v"(w.x), "v"(w.y), "v"(w.z), "v"(w.w)); }
                if (m & 1) asm volatile("" ::: "memory"); }
    }
};
__device__ __forceinline__ void unpack8u(const u32x2 w, float* f) {
#pragma unroll
    for (int e = 0; e < 4; ++e) { f[e] = (float)((w.x >> (8 * e)) & 255u) * (1.f / 255.f); f[4 + e] = (float)((w.y >> (8 * e)) & 255u) * (1.f / 255.f); }
}
struct EpiMerge {
    const bf16_t* P; bf16_t* O;
    __device__ __forceinline__ bool keep(const pg8::Unit& u) const { return u.sub < 2; }
    __device__ __forceinline__ void operator()(acc_t& acc, const pg8::Unit& u, int wr, int wc, int fr, int fq) const {
        const int row0 = u.pm * 256 + wr * 64 + fr, col0 = u.pn * 256 + wc * 32 + 8 * fq; const int sub = u.sub;
#pragma unroll
        for (int ai = 0; ai < 2; ++ai)
#pragma unroll
            for (int m = 0; m < 4; ++m) { const int r = row0 + ai * 128 + m * 16;
#pragma unroll
                for (int bj = 0; bj < 2; ++bj) { const int col = col0 + bj * 128;
                    const unsigned char* gp = (const unsigned char*)(P + (size_t)r * INW) + C_G * 2 + col;
                    float mu[8];
                    if (sub < 2) { const u32x2 ga = *(const u32x2*)(gp + sub * DM), gb = *(const u32x2*)(gp + (sub + 1) * DM); float fa[8], fb[8]; unpack8u(ga, fa); unpack8u(gb, fb);
#pragma unroll
                        for (int e = 0; e < 8; ++e) mu[e] = fa[e] * __builtin_amdgcn_rcpf(fb[e]); }
                    else { const u32x2 ga = *(const u32x2*)(gp + 2 * DM); unpack8u(ga, mu); }
                    f32x4 v0 = acc[ai][bj][m][0], v1 = acc[ai][bj][m][1];
#pragma unroll
                    for (int e = 0; e < 4; ++e) { v0[e] *= mu[e]; v1[e] *= mu[4 + e]; }
                    if (sub < 2) { acc[ai][bj][m][0] = v0; acc[ai][bj][m][1] = v1; }
                    else { u32x4 w; w.x = pg8::cvt_pk_bf16(v0[0], v0[1]); w.y = pg8::cvt_pk_bf16(v0[2], v0[3]); w.z = pg8::cvt_pk_bf16(v1[0], v1[1]); w.w = pg8::cvt_pk_bf16(v1[2], v1[3]);
                        *(u32x4*)(O + (size_t)r * DM + col) = w; } } }
    }
};

#define XB_TMO      128
#define XB_XCNT(j)  (256  + 64 * (j))
#define XB_XSUB(j)  (1280 + 64 * (j))
#define XB_XGEN(j)  (2304 + 64 * (j))
#define XB_TOP      3328
#define XB_TOPGEN   3392
#define XCD_BAR_WORDS 3456
#define XB_SPIN_CAP (1u << 20)
__device__ __forceinline__ unsigned xb_ld(unsigned* p)              { return __hip_atomic_load(p, __ATOMIC_RELAXED, __HIP_MEMORY_SCOPE_AGENT); }
__device__ __forceinline__ unsigned xb_add(unsigned* p, unsigned v) { return __hip_atomic_fetch_add(p, v, __ATOMIC_RELAXED, __HIP_MEMORY_SCOPE_AGENT); }
__device__ __forceinline__ unsigned xb_xcc_id() { return (unsigned)__builtin_amdgcn_s_getreg((3 << 11) | 20) & 0xFu; }
#define XB_SPIN(cond, bar) do { unsigned _sp = 0; while (cond) { __builtin_amdgcn_s_sleep(1); \
    if ((++_sp & 255u) == 0u) { if (xb_ld(&(bar)[XB_TMO])) break; if (_sp > XB_SPIN_CAP) { atomicAdd(&(bar)[XB_TMO], 1u); break; } } } } while (0)
struct XcdBarrier { unsigned* bar; unsigned x; volatile LAS unsigned* st; };
__device__ __forceinline__ XcdBarrier xcd_barrier_post(unsigned* bar, volatile LAS unsigned* st) {
    XcdBarrier b; b.bar = bar; b.x = xb_xcc_id(); b.st = st;
    if (threadIdx.x == 0) (void)xb_add(&bar[XB_XCNT(b.x)], 1u);
    return b;
}
__device__ __forceinline__ void xcd_barrier_complete(unsigned* bar, unsigned x, unsigned& nloc, unsigned& nx) {
    const unsigned G = gridDim.x * gridDim.y * gridDim.z;
    unsigned sum, cnt, mine, sp = 0u;
    for (;;) {
        sum = 0u; cnt = 0u; mine = 0u;
#pragma unroll
        for (unsigned j = 0; j < 16; ++j) { const unsigned c = xb_ld(&bar[XB_XCNT(j)]); sum += c; cnt += (c > 0u) ? 1u : 0u; mine = (j == x) ? c : mine; }
        if (sum == G) break;
        __builtin_amdgcn_s_sleep(1);
        if ((++sp & 255u) == 0u) { if (xb_ld(&bar[XB_TMO])) break; if (sp > XB_SPIN_CAP) { atomicAdd(&bar[XB_TMO], 1u); break; } }
    }
    nloc = mine > 0u ? mine : 1u; nx = cnt > 0u ? cnt : 1u;
}
__device__ __forceinline__ void xcd_barrier(const XcdBarrier& b, int tid) {
    asm volatile("s_waitcnt vmcnt(0)" ::: "memory");
    __syncthreads();
    if (tid == 0) {
        unsigned* bar = b.bar;
        __builtin_amdgcn_s_waitcnt(0);
        unsigned nloc = b.st[0], nx = b.st[1];
        if (nloc == 0u) { xcd_barrier_complete(bar, b.x, nloc, nx); b.st[0] = nloc; b.st[1] = nx; }
        const unsigned old = xb_add(&bar[XB_XSUB(b.x)], 1u);
        const unsigned gen = old / nloc;
        if (old + 1u == (gen + 1u) * nloc) {
            __builtin_amdgcn_fence(__ATOMIC_RELEASE, "agent");
            asm volatile("s_waitcnt vmcnt(0)" ::: "memory");
            const unsigned og = xb_add(&bar[XB_TOP], 1u);
            const unsigned tg = og / nx;
            if (og + 1u == (tg + 1u) * nx) xb_add(&bar[XB_TOPGEN], 1u);
            else XB_SPIN(xb_ld(&bar[XB_TOPGEN]) == tg, bar);
            __builtin_amdgcn_fence(__ATOMIC_ACQUIRE, "agent");
            xb_add(&bar[XB_XGEN(b.x)], 1u);
            asm volatile("s_waitcnt vmcnt(0)" ::: "memory");
        } else {
            XB_SPIN(xb_ld(&bar[XB_XGEN(b.x)]) == gen, bar);
            __builtin_amdgcn_fence(__ATOMIC_ACQUIRE, "agent");
            asm volatile("s_waitcnt vmcnt(0)" ::: "memory");
        }
    }
    __syncthreads();
}

constexpr int NWAVES = 8;
constexpr int RING_BYTES = 131072, LDSCTL_OFF = RING_BYTES, MISC_OFF = LDSCTL_OFF + 320, LDS_BYTES = 147456;
struct Args { const float* in[30]; float* out; unsigned char* ws; int ph_lo, ph_hi, use_bar, pad; };
typedef const __attribute__((address_space(4))) Args CArgs;
struct Frame {
    LAS unsigned char* lds; int tid, lane, wave, G, vcu, bx, dry;
    float* out; unsigned char* ws; float* xm;
};
#define FIN(i) (A.in[i])

__constant__ unsigned char c_bucket[257] = {
15,15,15,15,15,15,15,15,15,15,15,15,15,15,15,15,15,15,15,15,15,15,15,15,15,15,15,15,15,15,15,15,15,15,15,15,15,15,14,14,14,14,14,14,14,14,14,14,14,14,14,14,14,14,14,14,14,14,14,14,14,14,14,14,14,13,13,13,13,13,13,13,13,13,13,13,13,13,13,13,13,13,13,12,12,12,12,12,12,12,12,12,12,12,12,12,12,11,11,11,11,11,11,11,11,11,10,10,10,10,10,10,10,9,9,9,9,8,8,8,8,7,6,5,4,3,2,1,0,17,18,19,20,21,22,23,24,24,24,24,25,25,25,25,26,26,26,26,26,26,26,27,27,27,27,27,27,27,27,27,28,28,28,28,28,28,28,28,28,28,28,28,28,28,29,29,29,29,29,29,29,29,29,29,29,29,29,29,29,29,29,29,30,30,30,30,30,30,30,30,30,30,30,30,30,30,30,30,30,30,30,30,30,30,30,30,30,30,30,31,31,31,31,31,31,31,31,31,31,31,31,31,31,31,31,31,31,31,31,31,31,31,31,31,31,31,31,31,31,31,31,31,31,31,31,31,31};

__device__ __forceinline__ void p0_transpose_item(const float* W, int K, int N, bf16_t* WT, int row_off, LAS float* scr, int item, int lane) {
    const int nblk = N / 32, kb = item / nblk, nb = item % nblk, k0 = 64 * kb, n0 = 32 * nb;
    f32x4 v[8];
#pragma unroll
    for (int i = 0; i < 8; ++i) v[i] = *(const f32x4*)(W + (size_t)(k0 + 8 * i + (lane >> 3)) * N + n0 + 4 * (lane & 7));
#pragma unroll
    for (int i = 0; i < 8; ++i) { LAS float* d = scr + (8 * i + (lane >> 3)) * 33 + 4 * (lane & 7); d[0] = v[i].x; d[1] = v[i].y; d[2] = v[i].z; d[3] = v[i].w; }
    LDS_WAIT(); asm volatile("" ::: "memory");
    const int c = lane & 7;
#pragma unroll
    for (int j = 0; j < 4; ++j) { const int n = (lane >> 3) + 8 * j; const LAS float* s = scr + (8 * c) * 33 + n;
        u32x4 o; o.x = pk2(s[0 * 33], s[1 * 33]); o.y = pk2(s[2 * 33], s[3 * 33]); o.z = pk2(s[4 * 33], s[5 * 33]); o.w = pk2(s[6 * 33], s[7 * 33]);
        *(u32x4*)(WT + (size_t)(row_off + n0 + n) * K + k0 + 8 * c) = o; }
    LDS_WAIT(); asm volatile("" ::: "memory");
}
__device__ __forceinline__ void rms_row(const f32x4 (&v)[4], const float* g, bf16_t* orow, int lane) {
    float s = 0.f;
#pragma unroll
    for (int j = 0; j < 4; ++j) s += (v[j].x * v[j].x + v[j].y * v[j].y) + (v[j].z * v[j].z + v[j].w * v[j].w);
    const float rstd = 1.0f / sqrtf(wave_sum(s, lane) * (1.f / DM) + EPS);
    unsigned long long* o8 = (unsigned long long*)orow + lane;
#pragma unroll
    for (int j = 0; j < 4; ++j) { const f32x4 gg = *((const f32x4*)g + lane + 64 * j);
        o8[64 * j] = (unsigned long long)pk2(v[j].x * rstd * gg.x, v[j].y * rstd * gg.y) | ((unsigned long long)pk2(v[j].z * rstd * gg.z, v[j].w * rstd * gg.w) << 32); }
}
constexpr size_t WS_H2F_P = 2 * MiB, WS_H2F_S = WS_END;
constexpr int NCH_P = (LP + 31) / 32, NCH_S = (LS + 31) / 32;
static_assert(WS_H2F_S + (size_t)NCH_S * 32 * 128 <= 512 * MiB && WS_H2F_P + (size_t)NCH_P * 32 * 128 <= WS_W, "h2 scratch");
__device__ __forceinline__ void filt_h2_compute(const CArgs& A, const Frame& F, int layer, int L, int tc, LAS float* h1t, int lane, float (&acc)[32]) {
    const float* w1 = FIN(11) + (size_t)layer * 33 * 64; const float* b1 = FIN(12) + layer * 64;
    const float* w2 = FIN(13) + (size_t)layer * 64 * 64; const float* b2 = FIN(14) + layer * 64; const float* fq_ = FIN(16) + layer * 64;
    const int pos = lane & 31, half = lane >> 5, jb = 32 * half;
    const float tt = (float)tc / (float)(L - 1);
    { f32x4 bv[8], wv[8];
#pragma unroll
      for (int i = 0; i < 8; ++i) { bv[i] = *(const f32x4*)(b1 + jb + 4 * i); wv[i] = *(const f32x4*)(w1 + jb + 4 * i); }
#pragma unroll
      for (int i = 0; i < 8; ++i)
#pragma unroll
          for (int e = 0; e < 4; ++e) acc[4 * i + e] = bv[i][e] + tt * wv[i][e]; }
#pragma unroll 2
    for (int k = 0; k < 16; ++k) {
        const float f = 1e-4f + (float)k * ((15.0f - 1e-4f) / 15.0f);
        const float rev = f * (float)tc * (1.0f / (float)L);
        const float sn = __builtin_amdgcn_sinf(rev), cs = __builtin_amdgcn_cosf(rev);
        f32x4 wc_[8], ws_[8];
#pragma unroll
        for (int i = 0; i < 8; ++i) { wc_[i] = *(const f32x4*)(w1 + (size_t)(1 + k) * 64 + jb + 4 * i); ws_[i] = *(const f32x4*)(w1 + (size_t)(17 + k) * 64 + jb + 4 * i); }
#pragma unroll
        for (int i = 0; i < 8; ++i)
#pragma unroll
            for (int e = 0; e < 4; ++e) acc[4 * i + e] += cs * wc_[i][e] - sn * ws_[i][e];
    }
    { f32x4 fv[8];
#pragma unroll
      for (int i = 0; i < 8; ++i) fv[i] = *(const f32x4*)(fq_ + jb + 4 * i);
#pragma unroll
      for (int i = 0; i < 8; ++i)
#pragma unroll
          for (int e = 0; e < 4; ++e) h1t[(jb + 4 * i + e) * 32 + pos] = __builtin_amdgcn_sinf(fv[i][e] * acc[4 * i + e] * 0.15915494309189535f); }
    LDS_WAIT();
    { f32x4 bv[8];
#pragma unroll
      for (int i = 0; i < 8; ++i) bv[i] = *(const f32x4*)(b2 + jb + 4 * i);
#pragma unroll
      for (int i = 0; i < 8; ++i)
#pragma unroll
          for (int e = 0; e < 4; ++e) acc[4 * i + e] = bv[i][e]; }
#pragma unroll 4
    for (int i2 = 0; i2 < 64; ++i2) { const float h = h1t[i2 * 32 + pos]; f32x4 wv[8];
#pragma unroll
        for (int i = 0; i < 8; ++i) wv[i] = *(const f32x4*)(w2 + (size_t)i2 * 64 + jb + 4 * i);
#pragma unroll
        for (int i = 0; i < 8; ++i)
#pragma unroll
            for (int e = 0; e < 4; ++e) acc[4 * i + e] += h * wv[i][e]; }
}
__device__ __forceinline__ void filt_h2_item(const CArgs& A, const Frame& F, int layer, int item, LAS float* h1t, int lane) {
    const int cls = item >= NCH_P ? 1 : 0, ch = cls ? item - NCH_P : item, L = cls ? LS : LP;
    const int pos = lane & 31, half = lane >> 5, jb = 32 * half;
    const int t = ch * 32 + pos, tc = t < L ? t : L - 1;
    const float* fq_ = FIN(16) + layer * 64;
    float acc[32];
    filt_h2_compute(A, F, layer, L, tc, h1t, lane, acc);
    { f32x4 fv[8]; unsigned hw[16];
#pragma unroll
      for (int i = 0; i < 8; ++i) fv[i] = *(const f32x4*)(fq_ + jb + 4 * i);
#pragma unroll
      for (int i = 0; i < 8; ++i)
#pragma unroll
          for (int e = 0; e < 4; e += 2) { const float a0 = __builtin_amdgcn_sinf(fv[i][e] * acc[4 * i + e] * 0.15915494309189535f), a1 = __builtin_amdgcn_sinf(fv[i][e + 1] * acc[4 * i + e + 1] * 0.15915494309189535f);
              typedef _Float16 h2_t __attribute__((ext_vector_type(2))); const h2_t hv = {(_Float16)a0, (_Float16)a1}; hw[2 * i + (e >> 1)] = __builtin_bit_cast(unsigned, hv); }
      u32x4* dst = (u32x4*)(F.ws + (cls ? WS_H2F_S : WS_H2F_P) + (size_t)t * 128 + half * 64);
#pragma unroll
      for (int i = 0; i < 4; ++i) dst[i] = (u32x4){hw[4 * i], hw[4 * i + 1], hw[4 * i + 2], hw[4 * i + 3]}; }
    LDS_WAIT();
}
constexpr int NI8_P = LP / 8, NI8 = NI8_P + LS / 8;
static_assert(LP % 8 == 0 && LS % 8 == 0, "filter items");
__device__ __forceinline__ void filt_h2_item8(const CArgs& A, const Frame& F, int layer, int item, LAS float* h1t, int lane) {
    const int cls = item >= NI8_P ? 1 : 0, ch = cls ? item - NI8_P : item, L = cls ? LS : LP;
    const float* w1 = FIN(11) + (size_t)layer * 33 * 64; const float* b1 = FIN(12) + layer * 64;
    const float* w2 = FIN(13) + (size_t)layer * 64 * 64; const float* b2 = FIN(14) + layer * 64; const float* fq_ = FIN(16) + layer * 64;
    const int pos = lane & 7, jb = (lane >> 3) * 8, t = ch * 8 + pos;
    const float tt = (float)t / (float)(L - 1);
    float acc[8];
    { const f32x4 ba = *(const f32x4*)(b1 + jb), bb = *(const f32x4*)(b1 + jb + 4), wa = *(const f32x4*)(w1 + jb), wb = *(const f32x4*)(w1 + jb + 4);
#pragma unroll
      for (int e = 0; e < 4; ++e) { acc[e] = ba[e] + tt * wa[e]; acc[4 + e] = bb[e] + tt * wb[e]; } }
#pragma unroll
    for (int k0 = 0; k0 < 16; k0 += 4) { f32x4 ca[4], cb[4], sa[4], sb[4];
#pragma unroll
        for (int q = 0; q < 4; ++q) { const int k = k0 + q; ca[q] = *(const f32x4*)(w1 + (size_t)(1 + k) * 64 + jb); cb[q] = *(const f32x4*)(w1 + (size_t)(1 + k) * 64 + jb + 4);
            sa[q] = *(const f32x4*)(w1 + (size_t)(17 + k) * 64 + jb); sb[q] = *(const f32x4*)(w1 + (size_t)(17 + k) * 64 + jb + 4); }
        asm volatile("" ::: "memory");
#pragma unroll
        for (int q = 0; q < 4; ++q) { const int k = k0 + q;
            const float f = 1e-4f + (float)k * ((15.0f - 1e-4f) / 15.0f);
            const float rev = f * (float)t * (1.0f / (float)L);
            const float sn = __builtin_amdgcn_sinf(rev), cs = __builtin_amdgcn_cosf(rev);
#pragma unroll
            for (int e = 0; e < 4; ++e) { acc[e] += cs * ca[q][e] - sn * sa[q][e]; acc[4 + e] += cs * cb[q][e] - sn * sb[q][e]; } }
        asm volatile("" ::: "memory");
    }
    const f32x4 fa = *(const f32x4*)(fq_ + jb), fb = *(const f32x4*)(fq_ + jb + 4);
#pragma unroll
    for (int e = 0; e < 4; ++e) { h1t[(jb + e) * 8 + pos] = __builtin_amdgcn_sinf(fa[e] * acc[e] * 0.15915494309189535f); h1t[(jb + 4 + e) * 8 + pos] = __builtin_amdgcn_sinf(fb[e] * acc[4 + e] * 0.15915494309189535f); }
    LDS_WAIT();
    { const f32x4 ba = *(const f32x4*)(b2 + jb), bb = *(const f32x4*)(b2 + jb + 4);
#pragma unroll
      for (int e = 0; e < 4; ++e) { acc[e] = ba[e]; acc[4 + e] = bb[e]; } }
#pragma unroll
    for (int i0 = 0; i0 < 64; i0 += 8) { f32x4 wa[8], wb[8];
#pragma unroll
        for (int q = 0; q < 8; ++q) { wa[q] = *(const f32x4*)(w2 + (size_t)(i0 + q) * 64 + jb); wb[q] = *(const f32x4*)(w2 + (size_t)(i0 + q) * 64 + jb + 4); }
        asm volatile("" ::: "memory");
#pragma unroll
        for (int q = 0; q < 8; ++q) { const float h = h1t[(i0 + q) * 8 + pos];
#pragma unroll
            for (int e = 0; e < 4; ++e) { acc[e] += h * wa[q][e]; acc[4 + e] += h * wb[q][e]; } }
        asm volatile("" ::: "memory");
    }
    unsigned hw[4];
#pragma unroll
    for (int e = 0; e < 4; e += 2) { typedef _Float16 h2_t __attribute__((ext_vector_type(2)));
        const h2_t ha = {(_Float16)__builtin_amdgcn_sinf(fa[e] * acc[e] * 0.15915494309189535f), (_Float16)__builtin_amdgcn_sinf(fa[e + 1] * acc[e + 1] * 0.15915494309189535f)};
        const h2_t hb = {(_Float16)__builtin_amdgcn_sinf(fb[e] * acc[4 + e] * 0.15915494309189535f), (_Float16)__builtin_amdgcn_sinf(fb[e + 1] * acc[4 + e + 1] * 0.15915494309189535f)};
        hw[e >> 1] = __builtin_bit_cast(unsigned, ha); hw[2 + (e >> 1)] = __builtin_bit_cast(unsigned, hb); }
    *(u32x4*)(F.ws + (cls ? WS_H2F_S : WS_H2F_P) + (size_t)t * 128 + jb * 2) = (u32x4){hw[0], hw[1], hw[2], hw[3]};
    LDS_WAIT();
}
constexpr int NCHF_P = (LP - 1 + 31) / 32 + 1, NCHB_P = (LP + 31) / 32, NCHF_S = (LS - 1 + 31) / 32 + 1, NCHB_S = (LS + 31) / 32;
constexpr int NFI_P = NCHF_P + NCHB_P, NFI = NFI_P + NCHF_S + NCHB_S;
__device__ __forceinline__ void filt_tile_item(const CArgs& A, const Frame& F, int layer, int item, int lane) {
    const int ct = item & 15; int cls = 0, it = item >> 4; if (it >= NFI_P) { cls = 1; it -= NFI_P; }
    const int nchf = cls ? NCHF_S : NCHF_P, L = cls ? LS : LP;
    bool bwd; int ch; if (it < nchf) { bwd = false; ch = it - 1; } else { bwd = true; ch = it - nchf; }
    const int tsh = bwd ? 0 : 1;
    const float* w3 = FIN(15) + (size_t)layer * 64 * 1024;
    const int pos = lane & 31, half = lane >> 5;
    const int t = ch * 32 + pos + tsh, tc = t < 0 ? 0 : (t < L ? t : L - 1);
    float acc[32];
#if FT_RECOMPUTE
    if (FT_RECOMPUTE == 1 || FT_RECOMPUTE == 9 || (FT_RECOMPUTE == 2 && cls == 0) || (FT_RECOMPUTE == 3 && cls == 1)) { LAS float* h1t = (LAS float*)(F.lds + F.wave * 16384); filt_h2_compute(A, F, layer, L, tc, h1t, lane, acc); const float* fq_ = FIN(16) + layer * 64;
#pragma unroll
      for (int k = 0; k < 32; ++k) acc[k] = __builtin_amdgcn_sinf(fq_[32 * half + k] * acc[k] * 0.15915494309189535f); LDS_WAIT(); }
    else
#endif
    { const u32x4* src = (const u32x4*)(F.ws + (cls ? WS_H2F_S : WS_H2F_P) + (size_t)tc * 128 + half * 64);
      u32x4 hv[4];
#pragma unroll
      for (int i = 0; i < 4; ++i) hv[i] = src[i];
#pragma unroll
      for (int i = 0; i < 4; ++i)
#pragma unroll
          for (int e = 0; e < 4; ++e) { typedef _Float16 h2_t __attribute__((ext_vector_type(2))); const unsigned wv_ = hv[i][e];
              const h2_t p = __builtin_bit_cast(h2_t, wv_); acc[8 * i + 2 * e] = (float)p[0]; acc[8 * i + 2 * e + 1] = (float)p[1]; } }
#if FT_RECOMPUTE == 9
    float bad = 0.f;
    { const u32x4* src = (const u32x4*)(F.ws + (cls ? WS_H2F_S : WS_H2F_P) + (size_t)tc * 128 + half * 64);
#pragma unroll
      for (int i = 0; i < 4; ++i) { const u32x4 hvv = src[i];
#pragma unroll
          for (int e = 0; e < 4; ++e) { typedef _Float16 h2_t __attribute__((ext_vector_type(2))); const h2_t p = __builtin_bit_cast(h2_t, hvv[e]);
              if (fabsf((float)p[0] - acc[8 * i + 2 * e]) > 2e-3f || fabsf((float)p[1] - acc[8 * i + 2 * e + 1]) > 2e-3f) bad = 1e4f; } } }
#else
    const float bad = 0.f;
#endif
    bf16_t* RK = (bf16_t*)(F.ws + (cls ? WS_RKS : WS_RKP)); const int rklen = cls ? RKLEN_S : RKLEN_P;
    float* sums = (float*)(F.ws + WS_CTL) + CW_SUMS + (layer * 2 + cls) * 512;
    const float da = -15.350567286626973f, db = -3.0701134573253945f;
    {
        const int col0 = (bwd ? 512 : 0) + ct * 32;
        float bw[32];
#pragma unroll
        for (int ks = 0; ks < 32; ++ks) bw[ks] = w3[(size_t)(32 * half + ks) * 1024 + col0 + pos];
        f32x16 d = {};
#pragma unroll
        for (int ks = 0; ks < 32; ++ks) d = __builtin_amdgcn_mfma_f32_32x32x2f32(acc[ks], bw[ks], d, 0, 0, 0);
        const int c = (col0 + pos) & 511;
        const float delta = fabsf(da + (db - da) * ((float)c / 511.0f));
        bf16_t* rk = RK + (size_t)c * rklen + RK_PAD + L;
        float asum = 0.f;
#pragma unroll
        for (int g = 0; g < 4; ++g) { const int t0 = ch * 32 + 8 * g + 4 * half + tsh; float v[4];
#pragma unroll
            for (int e = 0; e < 4; ++e) { const int tp = t0 + e; const bool ok = tp >= 0 && tp < L && !(bwd && tp == 0);
                const float tq = (float)tp / (float)(L - 1); v[e] = ok ? d[4 * g + e] * __expf(-tq * delta) + bad : 0.f; asum += fabsf(v[e]); }
            if (bwd) { if (t0 >= 4 && t0 + 3 < L) { u32x2 w; w.x = pk2(v[0], v[1]); w.y = pk2(v[2], v[3]); *(u32x2*)(rk + t0) = w; }
                       else {
#pragma unroll
                           for (int e = 0; e < 4; ++e) if (t0 + e >= 1 && t0 + e < L) rk[t0 + e] = (bf16_t)f2bf(v[e]); } }
            else { if (t0 >= 0 && t0 + 3 < L) { u32x2 w; w.x = pk2(v[3], v[2]); w.y = pk2(v[1], v[0]); *(u32x2*)(rk - t0 - 3) = w; }
                   else {
#pragma unroll
                       for (int e = 0; e < 4; ++e) if (t0 + e >= 0 && t0 + e < L) rk[-(t0 + e)] = (bf16_t)f2bf(v[e]); } } }
        asum += shx(asum, 32, lane);
        if (half == 0 && !F.dry) atomicAdd(sums + c, asum);
    }
}
__device__ __forceinline__ void p_filt_tiles(const CArgs& A, const Frame& F, int layer) {
    const int gw = F.vcu * NWAVES + F.wave, NGW = F.G * NWAVES;
    for (int it = gw; it < 16 * NFI; it += NGW) filt_tile_item(A, F, layer, it, F.lane);
}
__device__ __forceinline__ void p_prep(const CArgs& A, const Frame& F, int layer) {
    const int gw = F.vcu * NWAVES + F.wave, NGW = F.G * NWAVES, lane = F.lane;
    const bool filt_first = false;
    if (filt_first && DSEL(8)) { LAS float* scr = (LAS float*)(F.lds + F.wave * 16384); for (int it = gw; it < NI8; it += NGW) filt_h2_item8(A, F, layer, it, scr, lane); }
    if (DSEL(1)) {
        const float* g = FIN(4) + layer * DM; bf16_t* XN = (bf16_t*)(F.ws + WS_XNR);
        for (int r0 = gw; r0 < MP; r0 += 2 * NGW) {
            f32x4 v[2][4]; const int rr[2] = {r0, r0 + NGW};
#pragma unroll
            for (int q = 0; q < 2; ++q) { const int r = rr[q];
                if (r >= MP) continue;
                if (r >= MROWS) {
#pragma unroll
                    for (int j = 0; j < 4; ++j) v[q][j] = (f32x4){0.f, 0.f, 0.f, 0.f};
                } else if (layer == 0) {
                    const int s = seq_of_row(r), p = r - seq_base(s);
                    const float* src = p < NMETA ? FIN(2) + (size_t)p * DM : (s < 8 ? FIN(0) + ((size_t)s * 2048 + (p - NMETA)) * DM : FIN(1) + (size_t)(p - NMETA) * DM);
                    const f32x4* sr = (const f32x4*)src + lane;
#pragma unroll
                    for (int j = 0; j < 4; ++j) v[q][j] = sr[64 * j];
                } else {
                    const f32x4* xr = (const f32x4*)xrow(F.out, F.xm, r) + lane;
#pragma unroll
                    for (int j = 0; j < 4; ++j) v[q][j] = xr[64 * j];
                } }
#pragma unroll
            for (int q = 0; q < 2; ++q) { const int r = rr[q];
                if (r >= MP) continue;
                if (layer == 0) { f32x4* xr = (f32x4*)xrow(F.out, F.xm, r) + lane;
#pragma unroll
                    for (int j = 0; j < 4; ++j) xr[64 * j] = v[q][j]; }
                rms_row(v[q], g, XN + (size_t)r * DM, lane); }
        }
    }
    {
        LAS float* scr = (LAS float*)(F.lds + F.wave * 16384);
        unsigned char* W = F.ws + WS_W;
        constexpr int I_IN = (DM / 64) * (INW / 32), I_G = (DM / 64) * (DFF / 32), I_D = (DFF / 64) * (DM / 32), I_O = (DM / 64) * (DM / 32), I_M = (512 / 64) * (DM / 32);
        constexpr int NIT = I_IN + 2 * I_G + I_D + I_O + 2 * I_M;
        if (DSEL(2)) for (int it = gw; it < NIT; it += NGW) {
            int r = it;
            if (r < I_IN) { p0_transpose_item(FIN(5) + (size_t)layer * DM * INW, DM, INW, (bf16_t*)(W + W_IN), 0, scr, r, lane); continue; } r -= I_IN;
            if (r < I_G) { p0_transpose_item(FIN(25) + (size_t)layer * DM * DFF, DM, DFF, (bf16_t*)(W + W_G), 0, scr, r, lane); continue; } r -= I_G;
            if (r < I_G) { p0_transpose_item(FIN(26) + (size_t)layer * DM * DFF, DM, DFF, (bf16_t*)(W + W_U), 0, scr, r, lane); continue; } r -= I_G;
            if (r < I_D) { p0_transpose_item(FIN(29) + (size_t)layer * DFF * DM, DFF, DM, (bf16_t*)(W + W_D), 0, scr, r, lane); continue; } r -= I_D;
            if (r < I_O) { p0_transpose_item(FIN(23) + (size_t)layer * DM * DM, DM, DM, (bf16_t*)(W + W_OUT), 0, scr, r, lane); continue; } r -= I_O;
            if (r < I_M) { p0_transpose_item(FIN(20) + (size_t)layer * 512 * DM, 512, DM, (bf16_t*)(W + W_MRG), 0, scr, r, lane); continue; } r -= I_M;
            p0_transpose_item(FIN(21) + (size_t)layer * 512 * DM, 512, DM, (bf16_t*)(W + W_MRG), DM, scr, r, lane);
        }
        const float* pw = FIN(18) + (size_t)layer * 4 * 128 * 128; const float* psc = FIN(19) + layer * 512; const float* wpo = FIN(22) + (size_t)layer * 512 * DM;
        bf16_t* WT = (bf16_t*)(W + W_MRG) + (size_t)2 * DM * 512;
        const int gt = (F.vcu * NWAVES + F.wave) * 64 + lane, NGT = NGW * 64;
        if (DSEL(4)) for (int st = NGW - 1 - gw; st < (512 / 8) * (DM / 64); st += NGW) {
            const int c0 = (st >> 4) * 8, j = (st & 15) * 64 + lane, g = c0 >> 7;
            { const int cr = lane >> 3, d0 = (lane & 7) * 16; const float* pr = pw + ((size_t)c0 + cr) * 128 + d0; const float* ps = psc + g * 128 + d0;
#pragma unroll
              for (int q = 0; q < 4; ++q) { const f32x4 a = *(const f32x4*)(pr + 4 * q), b = *(const f32x4*)(ps + 4 * q); *(LAS f32x4*)(scr + cr * 128 + d0 + 4 * q) = a * b; } }
            LDS_WAIT(); asm volatile("" ::: "memory");
            const float* wp = wpo + (size_t)(g * 128) * DM + j;
            float a[8];
#pragma unroll
            for (int c = 0; c < 8; ++c) a[c] = 0.f;
#pragma unroll 1
            for (int d0 = 0; d0 < 128; d0 += 16) { float w[16];
#pragma unroll
                for (int q = 0; q < 16; ++q) w[q] = wp[(size_t)(d0 + q) * DM];
                asm volatile("" ::: "memory");
#pragma unroll
                for (int c = 0; c < 8; ++c)
#pragma unroll
                    for (int q4 = 0; q4 < 4; ++q4) { const f32x4 cf = *(const LAS f32x4*)(scr + c * 128 + d0 + 4 * q4);
#pragma unroll
                        for (int e = 0; e < 4; ++e) a[c] += cf[e] * w[4 * q4 + e]; }
                asm volatile("" ::: "memory");
            }
            u32x4 o; o.x = pk2(a[0], a[1]); o.y = pk2(a[2], a[3]); o.z = pk2(a[4], a[5]); o.w = pk2(a[6], a[7]);
            *(u32x4*)(WT + (size_t)j * 512 + c0) = o;
            LDS_WAIT(); asm volatile("" ::: "memory");
        }
        for (int idx = gt; idx < 2 * 512 * 513; idx += NGT) { const int k = idx % 513, cc = (idx / 513) & 511, cls = idx / (513 * 512);
            const int L = cls ? LS : LP, rklen = cls ? RKLEN_S : RKLEN_P; bf16_t* RK = (bf16_t*)(F.ws + (cls ? WS_RKS : WS_RKP)) + (size_t)cc * rklen;
            RK[k <= 256 ? k : 256 + 2 * L + (k - 257)] = 0; }
        if (!filt_first && DSEL(8)) for (int it = gw; it < NI8; it += NGW) filt_h2_item8(A, F, layer, it, scr, lane);
    }
}

__device__ __forceinline__ void p_attn_ref(const CArgs& A, const Frame& F, int layer) {
    bf16_t* P = (bf16_t*)(F.ws + WS_PROJ);
    const float* qg = FIN(6) + layer * HD; const float* kg = FIN(7) + layer * HD; const float* sink = FIN(8) + layer * NHEAD; const float* rb = FIN(3);
    const int gt = (F.vcu * NWAVES + F.wave) * 64 + F.lane, NGT = F.G * NWAVES * 64;
    for (int idx = gt; idx < MROWS * NHEAD; idx += NGT) {
        const int r = idx >> 3, h = idx & 7, hk = h >> 2;
        const int s = seq_of_row(r), base = seq_base(s), L = seq_len(s), p = r - base;
        unsigned qs[32]; float o[64];
        { const u32x4* qp = (const u32x4*)(P + (size_t)r * INW + C_Q + 64 * h); float ss = 0.f;
#pragma unroll
          for (int c = 0; c < 8; ++c) { const u32x4 w = qp[c]; qs[4 * c] = w.x; qs[4 * c + 1] = w.y; qs[4 * c + 2] = w.z; qs[4 * c + 3] = w.w; }
#pragma unroll
          for (int d = 0; d < 32; ++d) { const float a = bflo(qs[d]), b = bfhi(qs[d]); ss += a * a + b * b; }
          const float rs = 1.0f / sqrtf(ss * (1.f / 64) + EPS) * 0.125f;
#pragma unroll
          for (int d = 0; d < 32; ++d) { qs[d] = pk2(bflo(qs[d]) * rs * qg[2 * d], bfhi(qs[d]) * rs * qg[2 * d + 1]); o[2 * d] = 0.f; o[2 * d + 1] = 0.f; } }
        float m = sink[h], l = 1.f;
        const int lo = p - 128 < 0 ? 0 : p - 128, hi = p + 128 > L - 1 ? L - 1 : p + 128;
        for (int pk = lo; pk <= hi; ++pk) {
            const bf16_t* kr = P + (size_t)(base + pk) * INW;
            const u32x4* kp = (const u32x4*)(kr + C_K + 64 * hk); const u32x4* vp = (const u32x4*)(kr + C_V + 64 * hk);
            float ss = 0.f, dt = 0.f;
#pragma unroll
            for (int c = 0; c < 8; ++c) { float kk[8]; unpack8(kp[c], kk);
#pragma unroll
                for (int e = 0; e < 8; ++e) { ss += kk[e] * kk[e]; const unsigned qw = qs[4 * c + (e >> 1)]; dt += kk[e] * kg[8 * c + e] * ((e & 1) ? bfhi(qw) : bflo(qw)); }
                asm volatile("" ::: "memory"); }
            const float sc = dt / sqrtf(ss * (1.f / 64) + EPS) + rb[c_bucket[pk - p + 128] * NHEAD + h];
            const float mn = fmaxf(m, sc), f = __expf(m - mn), pe = __expf(sc - mn);
            l = l * f + pe; m = mn;
#pragma unroll
            for (int c = 0; c < 8; ++c) { float vv[8]; unpack8(vp[c], vv);
#pragma unroll
                for (int e = 0; e < 8; ++e) o[8 * c + e] = o[8 * c + e] * f + pe * vv[e];
                asm volatile("" ::: "memory"); }
        }
        const float il = (DBG & 4) ? 0.f : 1.f / l; u32x4* op = (u32x4*)(P + (size_t)r * INW + C_Q + 64 * h);
#pragma unroll
        for (int c = 0; c < 8; ++c) { u32x4 w; w.x = pk2(o[8 * c] * il, o[8 * c + 1] * il); w.y = pk2(o[8 * c + 2] * il, o[8 * c + 3] * il); w.z = pk2(o[8 * c + 4] * il, o[8 * c + 5] * il); w.w = pk2(o[8 * c + 6] * il, o[8 * c + 7] * il); op[c] = w; }
    }
}

constexpr int AT_K = 0, AT_V = 49152, AT_VSTR = 776, AT_B = AT_V + 64 * AT_VSTR, AT_BSTR = 324;
constexpr float AT_LOG2E = 1.4426950408889634f;
__device__ __forceinline__ void p_attn(const CArgs& A, const Frame& F, int layer) {
    bf16_t* P = (bf16_t*)(F.ws + WS_PROJ);
    const float* qg = FIN(6) + layer * HD; const float* kg = FIN(7) + layer * HD; const float* sink = FIN(8) + layer * NHEAD; const float* rb = FIN(3);
    const int lane = F.lane, wave = F.wave, tid = F.tid, r32 = lane & 31, hi = lane >> 5;
    LAS unsigned char* lds = F.lds;
    for (int unit = F.vcu; unit < 265 * 4; unit += F.G) {
        const int gb = unit >> 2, hk = (unit >> 1) & 1, gh = unit & 1;
        const int s = gb < 136 ? gb / 17 : 8, nb = gb < 136 ? gb - 17 * s : gb - 136;
        const int base = seq_base(s), L = seq_len(s);
        const int pk0 = 128 * nb - 240;
        u32x4 kws[6], vws[6];
#pragma unroll
        for (int it = 0; it < 6; ++it) { const int idx = tid + it * 512, key = idx >> 3, ch = idx & 7, pk = pk0 + key; const bool ok = pk >= 0 && pk < L;
            const bf16_t* rowp = P + (size_t)(base + (ok ? pk : 0)) * INW + 64 * hk + 8 * ch;
            kws[it] = *(const u32x4*)(rowp + C_K); vws[it] = *(const u32x4*)(rowp + C_V); }
#pragma unroll
        for (int it = 0; it < 6; ++it) { const int idx = tid + it * 512, key = idx >> 3, ch = idx & 7, pk = pk0 + key; const bool ok = pk >= 0 && pk < L;
            u32x4 kw = kws[it], vw = vws[it];
            float kf[8]; unpack8(kw, kf); float ss = 0.f;
#pragma unroll
            for (int e = 0; e < 8; ++e) ss += kf[e] * kf[e];
            ss += shx(ss, 1, lane); ss += shx(ss, 2, lane); ss += shx(ss, 4, lane);
            const float rs = ok ? 1.0f / sqrtf(ss * (1.f / 64) + EPS) : 0.f;
            u32x4 ko; ko.x = pk2(kf[0] * rs * kg[8 * ch], kf[1] * rs * kg[8 * ch + 1]); ko.y = pk2(kf[2] * rs * kg[8 * ch + 2], kf[3] * rs * kg[8 * ch + 3]);
            ko.z = pk2(kf[4] * rs * kg[8 * ch + 4], kf[5] * rs * kg[8 * ch + 5]); ko.w = pk2(kf[6] * rs * kg[8 * ch + 6], kf[7] * rs * kg[8 * ch + 7]);
            *(LAS u32x4*)(lds + AT_K + key * 128 + ((ch ^ (key & 7)) << 4)) = ko;
            if (!ok) vw = (u32x4){0u, 0u, 0u, 0u};
            LAS bf16_t* vt = (LAS bf16_t*)(lds + AT_V + (8 * ch) * AT_VSTR) + key;
            vt[0] = (bf16_t)(vw.x & 0xffffu); *(LAS bf16_t*)((LAS unsigned char*)vt + AT_VSTR) = (bf16_t)(vw.x >> 16);
            *(LAS bf16_t*)((LAS unsigned char*)vt + 2 * AT_VSTR) = (bf16_t)(vw.y & 0xffffu); *(LAS bf16_t*)((LAS unsigned char*)vt + 3 * AT_VSTR) = (bf16_t)(vw.y >> 16);
            *(LAS bf16_t*)((LAS unsigned char*)vt + 4 * AT_VSTR) = (bf16_t)(vw.z & 0xffffu); *(LAS bf16_t*)((LAS unsigned char*)vt + 5 * AT_VSTR) = (bf16_t)(vw.z >> 16);
            *(LAS bf16_t*)((LAS unsigned char*)vt + 6 * AT_VSTR) = (bf16_t)(vw.w & 0xffffu); *(LAS bf16_t*)((LAS unsigned char*)vt + 7 * AT_VSTR) = (bf16_t)(vw.w >> 16); }
        for (int i = tid; i < 2 * 257; i += 512) { const int hh = i >= 257 ? 1 : 0, rr = i - 257 * hh; ((LAS float*)(lds + AT_B))[hh * AT_BSTR + 32 + rr] = AT_LOG2E * rb[c_bucket[rr] * NHEAD + 4 * hk + 2 * gh + hh]; }
        __syncthreads();
        const int hh = wave >> 2, head = 4 * hk + 2 * gh + hh, qt = wave & 3, qi = 32 * qt + r32, pq = 128 * nb - 112 + qi; const bool qok = pq >= 0;
        const LAS float* bias = (const LAS float*)(lds + AT_B) + hh * AT_BSTR + 32;
        const bool edge = pk0 < 0 || pk0 + 384 > L;
        bf16x8 qf[4];
        { const bf16_t* qp = P + (size_t)(base + (qok ? pq : 0)) * INW + C_Q + 64 * head + 8 * hi; u32x4 qw[4]; float ss = 0.f;
#pragma unroll
          for (int ds = 0; ds < 4; ++ds) { qw[ds] = *(const u32x4*)(qp + 16 * ds); float f[8]; unpack8(qw[ds], f);
#pragma unroll
              for (int e = 0; e < 8; ++e) ss += f[e] * f[e]; }
          ss += shx(ss, 32, lane);
          const float rs = (0.125f * AT_LOG2E) / sqrtf(ss * (1.f / 64) + EPS);
#pragma unroll
          for (int ds = 0; ds < 4; ++ds) { float f[8]; unpack8(qw[ds], f); const float* g = qg + 16 * ds + 8 * hi; u32x4 o;
              o.x = pk2(f[0] * rs * g[0], f[1] * rs * g[1]); o.y = pk2(f[2] * rs * g[2], f[3] * rs * g[3]); o.z = pk2(f[4] * rs * g[4], f[5] * rs * g[5]); o.w = pk2(f[6] * rs * g[6], f[7] * rs * g[7]);
              qf[ds] = __builtin_bit_cast(bf16x8, o); } }
        float m = AT_LOG2E * sink[head], lp = hi == 0 ? 1.f : 0.f;
        f32x16 o0 = {}, o1 = {};
#define ATT_TILE(MODE, KT) do { const int kt = (KT); \
            f32x16 st = {}; \
            _Pragma("unroll") for (int ds = 0; ds < 4; ++ds) { const int key = 32 * kt + r32, chn = 2 * ds + hi; \
                const bf16x8 kfr = *(const LAS bf16x8*)(lds + AT_K + key * 128 + ((chn ^ (key & 7)) << 4)); \
                st = __builtin_amdgcn_mfma_f32_32x32x16_bf16(kfr, qf[ds], st, 0, 0, 0); } \
            const LAS float* bj = bias + 32 * (kt - qt) - r32 + 4 * hi; float bv[16]; \
            _Pragma("unroll") for (int i = 0; i < 16; ++i) bv[i] = bj[(i & 3) + 8 * (i >> 2)]; \
            float tmax = -1e30f; \
            _Pragma("unroll") for (int i = 0; i < 16; ++i) { const int ci = (i & 3) + 8 * (i >> 2); bool ok = true; \
                if (MODE == 0) ok = ci >= thr; else if (MODE == 2) ok = ci <= thr; \
                else if (MODE == 3) { const int kj = 32 * kt + ci + 4 * hi, rel = kj - 128 - qi, pk = pk0 + kj; ok = rel >= -128 && rel <= 128 && pk >= 0 && pk < L; } \
                const float v = ok ? st[i] + bv[i] : -1e30f; st[i] = v; tmax = fmaxf(tmax, v); } \
            tmax = fmaxf(tmax, shx(tmax, 32, lane)); \
            const float mn = fmaxf(m, tmax), f = __builtin_amdgcn_exp2f(m - mn); m = mn; \
            float ps = 0.f; \
            _Pragma("unroll") for (int i = 0; i < 16; ++i) { st[i] = __builtin_amdgcn_exp2f(st[i] - mn); ps += st[i]; } \
            lp = lp * f + ps; \
            _Pragma("unroll") for (int i = 0; i < 16; ++i) { o0[i] *= f; o1[i] *= f; } \
            _Pragma("unroll") for (int s2 = 0; s2 < 2; ++s2) { \
                u32x4 pw; pw.x = pk2(st[8 * s2], st[8 * s2 + 1]); pw.y = pk2(st[8 * s2 + 2], st[8 * s2 + 3]); pw.z = pk2(st[8 * s2 + 4], st[8 * s2 + 5]); pw.w = pk2(st[8 * s2 + 6], st[8 * s2 + 7]); \
                const bf16x8 pf = __builtin_bit_cast(bf16x8, pw); \
                _Pragma("unroll") for (int dt = 0; dt < 2; ++dt) { const LAS unsigned char* vp = lds + AT_V + (32 * dt + r32) * AT_VSTR + (32 * kt + 16 * s2 + 4 * hi) * 2; \
                    const u32x2 a0 = *(const LAS u32x2*)vp, a1 = *(const LAS u32x2*)(vp + 16); \
                    const bf16x8 vf = __builtin_bit_cast(bf16x8, (u32x4){a0.x, a0.y, a1.x, a1.y}); \
                    if (dt == 0) o0 = __builtin_amdgcn_mfma_f32_32x32x16_bf16(vf, pf, o0, 0, 0, 0); else o1 = __builtin_amdgcn_mfma_f32_32x32x16_bf16(vf, pf, o1, 0, 0, 0); } } } while (0)
        const int thr = r32 - 4 * hi;
        if (edge) { for (int j = 0; j <= 8; ++j) ATT_TILE(3, qt + j); }
        else { ATT_TILE(0, qt); for (int j = 1; j < 8; ++j) ATT_TILE(1, qt + j); ATT_TILE(2, qt + 8); }
#undef ATT_TILE
        const float il = (DBG & 4) ? 0.f : 1.f / (lp + shx(lp, 32, lane));
        if (qok && !F.dry) { bf16_t* op = P + (size_t)(base + pq) * INW + C_Q + 64 * head + 4 * hi;
#pragma unroll
            for (int g = 0; g < 4; ++g) { u32x2 w0, w1; w0.x = pk2(o0[4 * g] * il, o0[4 * g + 1] * il); w0.y = pk2(o0[4 * g + 2] * il, o0[4 * g + 3] * il);
                w1.x = pk2(o1[4 * g] * il, o1[4 * g + 1] * il); w1.y = pk2(o1[4 * g + 2] * il, o1[4 * g + 3] * il);
                *(u32x2*)(op + 8 * g) = w0; *(u32x2*)(op + 32 + 8 * g) = w1; } }
        __syncthreads();
    }
}
__device__ __forceinline__ void dwconv8(const bf16_t* P, int r, int col, const float* cw, const float* cb, int ucol, float* out) {
    const int s = seq_of_row(r), p = r - seq_base(s); const bool hasp = p > 0, hasn = p < seq_len(s) - 1;
    const bf16_t* gp = P + (size_t)r * INW + col;
    const u32x4 gm = *(const u32x4*)(gp - (hasp ? INW : 0)), g0 = *(const u32x4*)gp, gn = *(const u32x4*)(gp + (hasn ? INW : 0));
    float fm[8], f0[8], fn[8]; unpack8(gm, fm); unpack8(g0, f0); unpack8(gn, fn);
    const float mp_ = hasp ? 1.f : 0.f, mn_ = hasn ? 1.f : 0.f;
#pragma unroll
    for (int e = 0; e < 8; ++e) { fm[e] *= mp_; fn[e] *= mn_; }
#pragma unroll
    for (int e = 0; e < 8; ++e) out[e] = cw[ucol + e] * fm[e] + cw[1536 + ucol + e] * f0[e] + cw[2 * 1536 + ucol + e] * fn[e] + cb[ucol + e];
}
struct DwRows { u32x4 gm, g0, gn; float mp_, mn_; };
struct DwTaps { f32x4 a[2], b[2], c[2], d[2]; };
__device__ __forceinline__ void dw_load(const bf16_t* P, int r, int col, DwRows& d) {
    const int s = seq_of_row(r), p = r - seq_base(s); const bool hasp = p > 0, hasn = p < seq_len(s) - 1;
    const bf16_t* gp = P + (size_t)r * INW + col;
    d.gm = *(const u32x4*)(gp - (hasp ? INW : 0)); d.g0 = *(const u32x4*)gp; d.gn = *(const u32x4*)(gp + (hasn ? INW : 0));
    d.mp_ = hasp ? 1.f : 0.f; d.mn_ = hasn ? 1.f : 0.f;
}
__device__ __forceinline__ void dw_taps(const float* cw, const float* cb, int ucol, DwTaps& w) {
#pragma unroll
    for (int h = 0; h < 2; ++h) { w.a[h] = *(const f32x4*)(cw + ucol + 4 * h); w.b[h] = *(const f32x4*)(cw + 1536 + ucol + 4 * h); w.c[h] = *(const f32x4*)(cw + 2 * 1536 + ucol + 4 * h); w.d[h] = *(const f32x4*)(cb + ucol + 4 * h); }
}
__device__ __forceinline__ void dw_apply(const DwRows& d, const DwTaps& w, float* out) {
    float fm[8], f0[8], fn[8]; unpack8(d.gm, fm); unpack8(d.g0, f0); unpack8(d.gn, fn);
#pragma unroll
    for (int e = 0; e < 8; ++e) out[e] = w.a[e >> 2][e & 3] * (fm[e] * d.mp_) + w.b[e >> 2][e & 3] * f0[e] + w.c[e >> 2][e & 3] * (fn[e] * d.mn_) + w.d[e >> 2][e & 3];
}
__device__ __forceinline__ void p_h1(const CArgs& A, const Frame& F, int layer) {
    const bf16_t* P = (const bf16_t*)(F.ws + WS_PROJ); bf16_t* ZT = (bf16_t*)(F.ws + WS_XNR);
    const float* cw = FIN(9) + (size_t)layer * 3 * 1536; const float* cb = FIN(10) + layer * 1536;
    LAS bf16_t* scr = (LAS bf16_t*)(F.lds + F.wave * 16384);
    const int gw = F.vcu * NWAVES + F.wave, NGW = F.G * NWAVES, lane = F.lane, rs = lane >> 3, ck = lane & 7;
    for (int it = gw; it < (MP / 64) * 8; it += NGW) {
        const int rt = it >> 3, cc = it & 7, c0 = cc * 64 + ck * 8;
        DwTaps wa, wb; dw_taps(cw, cb, 512 + c0, wa); dw_taps(cw, cb, 1024 + c0, wb);
#pragma unroll
        for (int hb = 0; hb < 2; ++hb) { DwRows da[4], db[4];
#pragma unroll
            for (int q = 0; q < 4; ++q) { const int r = rt * 64 + (hb * 4 + q) * 8 + rs, rc = r < MROWS ? r : MROWS - 1; dw_load(P, rc, C_X1 + c0, da[q]); dw_load(P, rc, C_VV + c0, db[q]); }
            asm volatile("" ::: "memory");
#pragma unroll
            for (int q = 0; q < 4; ++q) { const int lr = (hb * 4 + q) * 8 + rs, r = rt * 64 + lr; float a[8], b[8]; dw_apply(da[q], wa, a); dw_apply(db[q], wb, b);
                const float ok = r < MROWS ? 1.f : 0.f;
#pragma unroll
                for (int e = 0; e < 8; ++e) scr[(ck * 8 + e) * 72 + lr] = (bf16_t)f2bf(a[e] * b[e] * ok); }
            asm volatile("" ::: "memory"); }
        LDS_WAIT();
#pragma unroll
        for (int j = 0; j < 8; ++j) { const int chn = (lane >> 3) + 8 * j, pc = lane & 7;
            const u32x4 w = *(const LAS u32x4*)(scr + chn * 72 + pc * 8);
            *(u32x4*)(ZT + (size_t)(cc * 64 + chn) * MP + rt * 64 + pc * 8) = w; }
        LDS_WAIT();
    }
}

__device__ __forceinline__ void p_h2_ref(const CArgs& A, const Frame& F) {
    const bf16_t* ZT = (const bf16_t*)(F.ws + WS_XNR); bf16_t* CT = (bf16_t*)(F.ws + WS_XNR + (size_t)512 * MP * 2);
    const int gt = (F.vcu * NWAVES + F.wave) * 64 + F.lane, NGT = F.G * NWAVES * 64;
    for (long idx = gt; idx < (long)512 * MP; idx += NGT) {
        const int c = (int)(idx / MP), r = (int)(idx - (long)c * MP);
        float acc = 0.f;
        if (r < MROWS) {
            const int s = seq_of_row(r), base = seq_base(s), L = seq_len(s), p = r - base, cls = s < 8 ? 0 : 1;
            const bf16_t* rk = (const bf16_t*)(F.ws + (cls ? WS_RKS : WS_RKP)) + (size_t)c * (cls ? RKLEN_S : RKLEN_P) + RK_PAD + L - p;
            const bf16_t* z = ZT + (size_t)c * MP + base;
            for (int s8 = 0; s8 < L; s8 += 8) { const u32x4 zw = *(const u32x4*)(z + s8); float zf[8]; unpack8(zw, zf);
#pragma unroll
                for (int e = 0; e < 8; ++e) acc += zf[e] * __uint_as_float((unsigned)rk[s8 + e] << 16); }
        }
        CT[idx] = (bf16_t)f2bf(acc);
    }
}
constexpr int H2_ZOFF_S = ((RKLEN_S * 2 + 1023) >> 10) << 10, H2_ZOFF_P = ((RKLEN_P * 2 + 1023) >> 10) << 10;
constexpr int H2_ZPADL_S = 4096, H2_ZSLOTS_S = 24704, H2_ZPADL_P = 512, H2_ZSLOTS_P = 3072, H2_SZP = 6976;
static_assert(H2_ZOFF_S + (H2_ZSLOTS_S + (H2_ZSLOTS_S >> 7) * 16) * 2 <= RING_BYTES_C && H2_ZOFF_P + 8 * H2_SZP <= RING_BYTES_C, "H2 LDS");
__device__ __forceinline__ void p_h2(const Frame& F) {
    const bf16_t* ZT = (const bf16_t*)(F.ws + WS_XNR); bf16_t* CT = (bf16_t*)(F.ws + WS_XNR + (size_t)512 * MP * 2);
    const int lane = F.lane, wave = F.wave, tid = F.tid;
    LAS float* red = (LAS float*)(F.lds + LDSCTL_OFF_C + 1024);
    for (int item = F.vcu; item < 1024; item += F.G) {
        const int cls = item < 512 ? 1 : 0, c = item & 511;
        const int L = cls ? LS : LP, rklen = cls ? RKLEN_S : RKLEN_P, ZPADL = cls ? H2_ZPADL_S : H2_ZPADL_P, zs8 = (cls ? H2_ZSLOTS_S : H2_ZSLOTS_P) / 8;
        LAS unsigned char* rkl = F.lds; LAS unsigned char* zl = F.lds + (cls ? H2_ZOFF_S : H2_ZOFF_P);
        {
          const char* rkg = (const char*)((const bf16_t*)(F.ws + (cls ? WS_RKS : WS_RKP)) + (size_t)c * rklen);
          const int npc = (rklen * 2 + 1023) >> 10;
          for (int pc = wave; pc < npc; pc += NWAVES)
              __builtin_amdgcn_global_load_lds((const unsigned*)(rkg + (size_t)pc * 1024 + lane * 16), (LAS unsigned*)(rkl + pc * 1024), 16, 0, 0);
          const int nsl = (cls ? 1 : 8) * zs8; u32x4 zv[7];
#pragma unroll
          for (int j = 0; j < 7; ++j) { const int i = tid + j * (NWAVES * 64); const int sq = i / zs8, i8 = i - sq * zs8, sp = i8 * 8 - ZPADL;
              zv[j] = (u32x4){0u, 0u, 0u, 0u};
              if (i < nsl && sp >= 0 && sp < L) zv[j] = *(const u32x4*)(ZT + (size_t)c * MP + (cls ? ROWS_P : sq * LP) + sp); }
#pragma unroll
          for (int j = 0; j < 7; ++j) { const int i = tid + j * (NWAVES * 64); const int sq = i / zs8, i8 = i - sq * zs8; const int pos = i8 * 8, el = pos + ((pos >> 7) << 4);
              if (i < nsl) *(LAS u32x4*)(zl + sq * H2_SZP + el * 2) = zv[j]; }
          asm volatile("s_waitcnt vmcnt(0)" ::: "memory"); }
        __syncthreads();
        const int n = lane & 15, h = lane >> 4, cg = wave & 3, us = wave >> 2;
        int T0a, zb, T0min, T0max, rowbase;
        const int T0g = cls ? 128 * 16 : 256; const int zg1 = (T0g + (T0g >> 7) * 16) * 2;
        if (cls) { T0min = 16 + 128 * 32 * cg; T0max = T0min + 128 * 31; T0a = T0min + 128 * n; zb = 0; rowbase = ROWS_P; }
        else { const int sq = n >> 1; T0min = 16 + 512 * cg; T0max = T0min + 384; T0a = T0min + 128 * (n & 1); zb = sq * H2_SZP; rowbase = sq * LP; }
        const int u_lo = -(((T0max + 7 + 31) >> 5) << 5), u_hi = ((L - 32 - T0min + 31) >> 5) << 5;
        const int nst = (u_hi - u_lo) / 32 + 1, nh = (nst + 1) >> 1;
        const int u_a = us ? u_lo + 32 * nh : u_lo, u_b = us ? u_hi : u_lo + 32 * (nh - 1);
        const int abase = RK_PAD + L - 8 * n + 8 * h;
        f32x4 acc[2][8];
#pragma unroll
        for (int g = 0; g < 2; ++g)
#pragma unroll
            for (int t = 0; t < 8; ++t) acc[g][t] = (f32x4){0.f, 0.f, 0.f, 0.f};
#define H2_STEP(V0, V1) do { \
            const LAS unsigned char* ap = rkl + (abase + u) * 2; \
            const u32x4 Lo = *(const LAS u32x4*)(ap - 16), Hi = *(const LAS u32x4*)ap; \
            bf16x8 Bz[2]; \
            { const int i0 = T0a + u + 8 * h + ZPADL, e0 = i0 + ((i0 >> 7) << 4); const LAS unsigned char* zp = zl + zb + e0 * 2; \
              if (V0) Bz[0] = *(const LAS bf16x8*)zp; if (V1) Bz[1] = *(const LAS bf16x8*)(zp + zg1); } \
            unsigned W[8] = {Lo.x, Lo.y, Lo.z, Lo.w, Hi.x, Hi.y, Hi.z, Hi.w}, Od[7]; \
            _Pragma("unroll") for (int k = 0; k < 7; ++k) Od[k] = __builtin_amdgcn_alignbit(W[k + 1], W[k], 16); \
            _Pragma("unroll") for (int t = 0; t < 8; ++t) { const int i = 4 - ((t + 1) >> 1); \
                const u32x4 fw = (t & 1) ? (u32x4){Od[i], Od[i + 1], Od[i + 2], Od[i + 3]} : (u32x4){W[i], W[i + 1], W[i + 2], W[i + 3]}; \
                const bf16x8 Af = __builtin_bit_cast(bf16x8, fw); \
                if (V0) acc[0][t] = __builtin_amdgcn_mfma_f32_16x16x32_bf16(Af, Bz[0], acc[0][t], 0, 0, 0); \
                if (V1) acc[1][t] = __builtin_amdgcn_mfma_f32_16x16x32_bf16(Af, Bz[1], acc[1][t], 0, 0, 0); } } while (0)
        { const int gspan = cls ? 128 * 15 : 128;
          int u0s = -(T0min + gspan + 39); u0s = u0s >= 0 ? ((u0s + 31) >> 5) << 5 : -((-u0s) >> 5 << 5);
          int u1e = L - (T0min + T0g); u1e = u1e >= 0 ? ((u1e + 31) >> 5) << 5 : -((-u1e) >> 5 << 5);
          const int ua2 = u0s > u_a ? (u0s < u_b + 32 ? u0s : u_b + 32) : u_a;
          const int ub2 = u1e < u_b + 32 ? (u1e > ua2 ? u1e : ua2) : u_b + 32;
          int u = u_a;
          for (; u < ua2; u += 32) H2_STEP(false, true);
          for (; u < ub2; u += 32) H2_STEP(true, true);
          for (; u <= u_b; u += 32) H2_STEP(true, false); }
#undef H2_STEP
        { float m[16];
#pragma unroll
          for (int t = 0; t < 16; ++t) m[t] = 0.f;
          const int nchunk = L / 8, cstep = cls ? NWAVES * 64 : 64; const int zb2 = cls ? 0 : wave * H2_SZP;
          for (int ck = cls ? tid : lane; ck < nchunk; ck += cstep) { const int s0 = ck * 8, i0 = s0 + ZPADL, e0 = i0 + ((i0 >> 7) << 4);
              const u32x4 zw = *(const LAS u32x4*)(zl + zb2 + e0 * 2);
              const LAS unsigned char* rp = rkl + (RK_PAD + L + s0 - 16) * 2;
              const u32x4 r0 = *(const LAS u32x4*)rp, r1 = *(const LAS u32x4*)(rp + 16), r2 = *(const LAS u32x4*)(rp + 32);
              float zf[8], rf[24]; unpack8(zw, zf); unpack8(r0, rf); unpack8(r1, rf + 8); unpack8(r2, rf + 16);
#pragma unroll
              for (int t = 0; t < 16; ++t)
#pragma unroll
                  for (int e = 0; e < 8; ++e) m[t] += zf[e] * rf[16 + e - t]; }
#pragma unroll
          for (int t = 0; t < 16; ++t) m[t] = wave_sum(m[t], lane);
          float mine = 0.f;
#pragma unroll
          for (int t = 0; t < 16; ++t) mine = (lane == t) ? m[t] : mine;
          if (cls) { if (lane < 16) red[wave * 16 + lane] = mine; }
          else if (lane < 16) CT[(size_t)c * MP + wave * LP + lane] = (bf16_t)f2bf(mine); }
        __syncthreads();
        if (us == 1) {
#pragma unroll
            for (int g = 0; g < 2; ++g)
#pragma unroll
                for (int t = 0; t < 8; ++t) *(LAS f32x4*)(F.lds + cg * 16384 + (g * 8 + t) * 1024 + lane * 16) = acc[g][t]; }
        if (cls && tid < 16) { float a = 0.f;
#pragma unroll
            for (int w = 0; w < 8; ++w) a += red[w * 16 + tid];
            CT[(size_t)c * MP + ROWS_P + tid] = (bf16_t)f2bf(a); }
        __syncthreads();
        if (us == 0) {
#pragma unroll
            for (int g = 0; g < 2; ++g) {
#pragma unroll
                for (int t = 0; t < 8; ++t) acc[g][t] += *(const LAS f32x4*)(F.lds + cg * 16384 + (g * 8 + t) * 1024 + lane * 16);
                bf16_t* op = CT + (size_t)c * MP + rowbase + T0a + g * T0g + 32 * h;
#pragma unroll
                for (int i = 0; i < 4; ++i) { u32x4 w; w.x = pk2(acc[g][0][i], acc[g][1][i]); w.y = pk2(acc[g][2][i], acc[g][3][i]); w.z = pk2(acc[g][4][i], acc[g][5][i]); w.w = pk2(acc[g][6][i], acc[g][7][i]);
                    *(u32x4*)(op + 8 * i) = w; } } }
        __syncthreads();
    }
}
__device__ __forceinline__ void p_pool(const CArgs& A, const Frame& F) {
    bf16_t* P = (bf16_t*)(F.ws + WS_PROJ);
    const int gw = F.vcu * NWAVES + F.wave, NGW = F.G * NWAVES, lane = F.lane, c0 = lane * 8, hw = 1 << (lane >> 4);
    for (int run = gw; run < MROWS / 16; run += NGW) {
        const int r0 = run * 16, s = seq_of_row(r0), base = seq_base(s), L = seq_len(s), p0 = r0 - base;
        const bf16_t* ub = P + (size_t)base * INW + C_PU + c0;
        float S[8];
#pragma unroll
        for (int e = 0; e < 8; ++e) S[e] = 0.f;
#pragma unroll
        for (int i = 0; i < 16; ++i) { const int pp = p0 - hw + i; const bool ok = i < 2 * hw && pp >= 0 && pp < L;
            const u32x4 w = *(const u32x4*)(ub + (size_t)(ok ? pp : p0) * INW); float f[8]; unpack8(w, f); const float mk = ok ? 1.f : 0.f;
#pragma unroll
            for (int e = 0; e < 8; ++e) S[e] += mk * f[e]; }
#pragma unroll 4
        for (int k = 0; k < 16; ++k) { const int p = p0 + k, pn = p + hw, po = p - hw; const bool okn = pn < L, oko = po >= 0;
            const u32x4 ws_ = *(const u32x4*)(ub + (size_t)p * INW), wn = *(const u32x4*)(ub + (size_t)(okn ? pn : p) * INW), wo = *(const u32x4*)(ub + (size_t)(oko ? po : p) * INW);
            float fs[8], fn[8], fo[8]; unpack8(ws_, fs); unpack8(wn, fn); unpack8(wo, fo);
            const int lo = po < 0 ? 0 : po, hi = pn > L ? L : pn; const float ic = 1.f / (float)(hi - lo);
            float a[8];
#pragma unroll
            for (int e = 0; e < 8; ++e) a[e] = (DBG & 16) ? 0.f : S[e] * ic - fs[e];
            u32x4 w; w.x = pk2(a[0], a[1]); w.y = pk2(a[2], a[3]); w.z = pk2(a[4], a[5]); w.w = pk2(a[6], a[7]);
            *(u32x4*)(P + (size_t)(r0 + k) * INW + C_X1 + c0) = w;
            const float mn = okn ? 1.f : 0.f, mo = oko ? 1.f : 0.f;
#pragma unroll
            for (int e = 0; e < 8; ++e) S[e] += mn * fn[e] - mo * fo[e]; }
    }
}
__device__ __forceinline__ void p_final(const CArgs& A, const Frame& F, int layer) {
    bf16_t* P = (bf16_t*)(F.ws + WS_PROJ); const bf16_t* ZT = (const bf16_t*)(F.ws + WS_XNR); const bf16_t* CT = ZT + (size_t)512 * MP;
    const float* cw = FIN(9) + (size_t)layer * 3 * 1536; const float* cb = FIN(10) + layer * 1536; const float* skip = FIN(17) + layer * 512;
    LAS bf16_t* sz = (LAS bf16_t*)(F.lds + F.wave * 16384); LAS bf16_t* sc = sz + 64 * 64;
    const int gw = F.vcu * NWAVES + F.wave, NGW = F.G * NWAVES, lane = F.lane, rs = lane >> 3, ck = lane & 7;
    for (int it = gw; it < (MP / 64) * 8; it += NGW) {
        const int rt = it >> 3, cc = it & 7, c0 = cc * 64 + ck * 8; const int cls = rt * 64 < ROWS_P ? 0 : 1;
        const float* sums = (const float*)(F.ws + WS_CTL) + CW_SUMS + (layer * 2 + cls) * 512;
#pragma unroll
        for (int j = 0; j < 8; ++j) { const int chn = (lane >> 3) + 8 * j, pc = lane & 7; const size_t off = (size_t)(cc * 64 + chn) * MP + rt * 64 + pc * 8;
            *(LAS u32x4*)(sz + chn * 64 + pc * 8) = *(const u32x4*)(ZT + off); *(LAS u32x4*)(sc + chn * 64 + pc * 8) = *(const u32x4*)(CT + off); }
        LDS_WAIT();
        DwTaps wt; dw_taps(cw, cb, c0, wt); float isum[8], sk[8];
        { const f32x4 s0 = *(const f32x4*)(sums + c0), s1 = *(const f32x4*)(sums + c0 + 4), k0 = *(const f32x4*)(skip + c0), k1 = *(const f32x4*)(skip + c0 + 4);
#pragma unroll
          for (int e = 0; e < 4; ++e) { isum[e] = 1.f / s0[e]; isum[4 + e] = 1.f / s1[e]; sk[e] = k0[e]; sk[4 + e] = k1[e]; } }
#pragma unroll
        for (int hb = 0; hb < 2; ++hb) { DwRows dr[4];
#pragma unroll
            for (int q = 0; q < 4; ++q) { const int r = rt * 64 + (hb * 4 + q) * 8 + rs; dw_load(P, r < MROWS ? r : MROWS - 1, C_X0 + c0, dr[q]); }
            asm volatile("" ::: "memory");
#pragma unroll
            for (int q = 0; q < 4; ++q) { const int lr = (hb * 4 + q) * 8 + rs, r = rt * 64 + lr; float x0[8], o[8]; dw_apply(dr[q], wt, x0);
#pragma unroll
                for (int e = 0; e < 8; ++e) { const float z = __uint_as_float((unsigned)sz[(ck * 8 + e) * 64 + lr] << 16), cv = __uint_as_float((unsigned)sc[(ck * 8 + e) * 64 + lr] << 16);
                    o[e] = (DBG & 8) ? 0.f : (((DBG & 64) ? 0.f : cv * isum[e]) + ((DBG & 128) ? 0.f : z * sk[e])) * x0[e]; }
                u32x4 w; w.x = pk2(o[0], o[1]); w.y = pk2(o[2], o[3]); w.z = pk2(o[4], o[5]); w.w = pk2(o[6], o[7]);
                if (r < MROWS) *(u32x4*)(P + (size_t)r * INW + C_VV + c0) = w; }
            asm volatile("" ::: "memory"); }
        LDS_WAIT();
    }
}
__device__ __forceinline__ void p_norm2(const CArgs& A, const Frame& F, int layer) {
    const int gw = F.vcu * NWAVES + F.wave, NGW = F.G * NWAVES, lane = F.lane;
    const float* g = FIN(24) + layer * DM; bf16_t* XN = (bf16_t*)(F.ws + WS_XNR);
    for (int r0 = gw; r0 < MP; r0 += 2 * NGW) { f32x4 v[2][4]; const int r1 = r0 + NGW;
        { const f32x4* xr = (const f32x4*)xrow(F.out, F.xm, r0) + lane;
#pragma unroll
          for (int j = 0; j < 4; ++j) v[0][j] = xr[64 * j]; }
        if (r1 < MP) { const f32x4* xr = (const f32x4*)xrow(F.out, F.xm, r1) + lane;
#pragma unroll
          for (int j = 0; j < 4; ++j) v[1][j] = xr[64 * j]; }
        rms_row(v[0], g, XN + (size_t)r0 * DM, lane);
        if (r1 < MP) rms_row(v[1], g, XN + (size_t)r1 * DM, lane); }
}

constexpr int TAIL_ROW0 = 32768, TAIL_ITEMS = ((MROWS - TAIL_ROW0) / 16) * 16;
static_assert(MROWS - TAIL_ROW0 == 144 && TAIL_ROW0 % 256 == 0, "tail rows");
template <int NS>
__device__ __forceinline__ void tail_partial(f32x4 (&acc)[4], const bf16_t* ap, const bf16_t* bp, size_t bstride16) {
#pragma unroll
    for (int s0 = 0; s0 < NS; s0 += 4) {
        bf16x8 a[4], b[4][4];
#pragma unroll
        for (int s = 0; s < 4; ++s) if (s0 + s < NS) { a[s] = *(const bf16x8*)(ap + (s0 + s) * 32);
#pragma unroll
            for (int j = 0; j < 4; ++j) b[s][j] = *(const bf16x8*)(bp + j * bstride16 + (s0 + s) * 32); }
#pragma unroll
        for (int s = 0; s < 4; ++s) if (s0 + s < NS) {
#pragma unroll
            for (int j = 0; j < 4; ++j) acc[j] = __builtin_amdgcn_mfma_f32_16x16x32_bf16(b[s][j], a[s], acc[j], 0, 0, 0); }
        asm volatile("" ::: "memory");
    }
}
template <int K>
__device__ __forceinline__ void tail_res(const Frame& F, const bf16_t* A, const bf16_t* Bt) {
    constexpr int KW = K / 8, NS = KW / 32; static_assert(K % 256 == 0, "K split");
    const int lane = F.lane, fr = lane & 15, fq = lane >> 4, tid = F.tid;
    for (int item = F.bx; item < TAIL_ITEMS; item += F.G) {
        const int row0 = TAIL_ROW0 + (item >> 4) * 16, col0 = (item & 15) * 64;
        f32x4 acc[4];
#pragma unroll
        for (int j = 0; j < 4; ++j) acc[j] = (f32x4){0.f, 0.f, 0.f, 0.f};
        tail_partial<NS>(acc, A + (size_t)(row0 + fr) * K + F.wave * KW + fq * 8, Bt + (size_t)(col0 + fr) * K + F.wave * KW + fq * 8, (size_t)16 * K);
#pragma unroll
        for (int j = 0; j < 4; ++j) *(LAS f32x4*)(F.lds + F.wave * 4096 + j * 1024 + lane * 16) = acc[j];
        __syncthreads();
        f32x2 s = {0.f, 0.f};
#pragma unroll
        for (int w = 0; w < 8; ++w) s += *(const LAS f32x2*)(F.lds + w * 4096 + tid * 8);
        const int j = tid >> 7, l = (tid & 127) >> 1, r = (tid & 1) * 2;
        float* p = xrow(F.out, F.xm, row0 + (l & 15)) + col0 + j * 16 + 4 * (l >> 4) + r;
        f32x2 v = *(f32x2*)p; v += s; if (!F.dry) *(f32x2*)p = v;
        __syncthreads();
    }
}
__device__ __forceinline__ void tail_merge(const Frame& F, const bf16_t* P, const bf16_t* WM, bf16_t* O) {
    const int lane = F.lane, fr = lane & 15, fq = lane >> 4, tid = F.tid;
    for (int item = F.bx; item < TAIL_ITEMS; item += F.G) {
        const int row0 = TAIL_ROW0 + (item >> 4) * 16, col0 = (item & 15) * 64;
#pragma unroll
        for (int s = 0; s < 3; ++s) { const int col = s == 0 ? C_Q : (s == 1 ? C_VV : C_X1);
            f32x4 acc[4];
#pragma unroll
            for (int j = 0; j < 4; ++j) acc[j] = (f32x4){0.f, 0.f, 0.f, 0.f};
            tail_partial<2>(acc, P + (size_t)(row0 + fr) * INW + col + F.wave * 64 + fq * 8, WM + ((size_t)s * DM + col0 + fr) * 512 + F.wave * 64 + fq * 8, (size_t)16 * 512);
#pragma unroll
            for (int j = 0; j < 4; ++j) *(LAS f32x4*)(F.lds + s * 32768 + F.wave * 4096 + j * 1024 + lane * 16) = acc[j]; }
        __syncthreads();
        const int j = tid >> 7, l = (tid & 127) >> 1, r = (tid & 1) * 2, row = row0 + (l & 15), colo = col0 + j * 16 + 4 * (l >> 4) + r;
        const unsigned char* gp = (const unsigned char*)(P + (size_t)row * INW) + C_G * 2 + colo;
        f32x2 o = {0.f, 0.f};
#pragma unroll
        for (int s = 0; s < 3; ++s) { f32x2 t = {0.f, 0.f};
#pragma unroll
            for (int w = 0; w < 8; ++w) t += *(const LAS f32x2*)(F.lds + s * 32768 + w * 4096 + tid * 8);
            const unsigned g2 = *(const unsigned short*)(gp + s * DM);
            o.x += t.x * ((float)(g2 & 255u) * (1.f / 255.f)); o.y += t.y * ((float)(g2 >> 8) * (1.f / 255.f)); }
        *(unsigned*)(O + (size_t)row * DM + colo) = pg8::cvt_pk_bf16(o.x, o.y);
        __syncthreads();
    }
}

constexpr int PH_PER_LAYER = 11, N_PHASES = 2 * PH_PER_LAYER;
__global__ void __launch_bounds__(NWAVES * 64, 2) fwd_kernel(Args args0) {
    extern __shared__ __attribute__((aligned(16))) unsigned char lds_raw[];
    const int wave0 = __builtin_amdgcn_readfirstlane(threadIdx.x >> 6);
    {
        for (int u = threadIdx.x; u < (LDS_BYTES - LDSCTL_OFF) / 4; u += NWAVES * 64) ((LAS unsigned*)((LAS unsigned char*)lds_raw + LDSCTL_OFF))[u] = 0u;
        __syncthreads();
    }
    XcdBarrier bar; bar.bar = (unsigned*)(args0.ws + WS_CTL) + CW_BAR; bar.x = 0; bar.st = nullptr;
    if (args0.use_bar) bar = xcd_barrier_post((unsigned*)(args0.ws + WS_CTL) + CW_BAR, (volatile LAS unsigned*)((LAS unsigned char*)lds_raw + MISC_OFF) + 8);
    for (int ph2 = 2 * args0.ph_lo; ph2 < 2 * args0.ph_hi; ++ph2) {
        const int ph = ph2 >> 1, rep = ph2 & 1;
        const int layer = ph / PH_PER_LAYER, k = ph % PH_PER_LAYER;
        if (rep == 1 && !(DUP_PHASE >= 0 && k == DUP_PHASE && args0.pad == 0)) continue;
        const __attribute__((address_space(4))) Args* ap = (const __attribute__((address_space(4))) Args*)__builtin_amdgcn_kernarg_segment_ptr();
        asm volatile("" : "+s"(ap));
        const __attribute__((address_space(4))) Args& args = *ap;
        Frame F;
        { int w_ = wave0; asm volatile("" : "+s"(w_)); int z_ = 0; asm volatile("" : "+v"(z_)); const int l_ = __builtin_amdgcn_mbcnt_hi(-1, __builtin_amdgcn_mbcnt_lo(-1, z_));
          F.lane = l_; F.wave = w_; F.tid = w_ * 64 + l_;
          int bx = blockIdx.x, G_ = gridDim.x; asm volatile("" : "+s"(bx), "+s"(G_)); F.G = G_; F.vcu = (G_ % 8 == 0) ? (bx % 8) * (G_ / 8) + bx / 8 : bx; F.bx = bx;
          F.dry = rep; F.lds = (LAS unsigned char*)lds_raw; F.ws = args.ws; F.out = args.out; F.xm = (float*)(args.ws + WS_XM); }
        unsigned char* W = F.ws + WS_W;
        bf16_t* XNR = (bf16_t*)(F.ws + WS_XNR); bf16_t* PROJ = (bf16_t*)(F.ws + WS_PROJ);
        bf16_t* GB = PROJ; bf16_t* ACT = PROJ + (size_t)MP * DFF;
#ifndef ONLY_PHASE
#define ONLY_PHASE -1
#endif
#define PHS(x) ((ONLY_PHASE < 0 || ONLY_PHASE == (x)) && k == (x) && !((DBG & 1) && (x) >= 1 && (x) <= 6) && !((DBG & 2) && (x) >= 7) && !((DBG & 32) && layer > 0))
        if (PHS(0)) p_prep(args, F, layer);
        else if (PHS(1)) { OpsPlain O{XNR, (const bf16_t*)(W + W_IN), DM, DM}; pg8::StaticOrder S; S.init(MP, INW, F.G, F.bx, 1); EpiStore E{PROJ, INW, C_G / 256};
            pg8::gemm_phase<EpiStore, OpsPlain, true>(F.lds, O, S, E, F.tid); }
        else if (PHS(2)) { if (DBG & 512) p_attn_ref(args, F, layer); else if (DSEL(64)) p_attn(args, F, layer); if (DSEL(128)) p_h1(args, F, layer); if (DSEL(256)) p_filt_tiles(args, F, layer); }
        else if (PHS(3)) { if (DBG & 256) p_h2_ref(args, F); else if (DSEL(16)) p_h2(F); if (DSEL(32)) p_pool(args, F); }
        else if (PHS(4)) p_final(args, F, layer);
        else if (PHS(5)) { OpsMerge O{PROJ, (const bf16_t*)(W + W_MRG), 512, INW}; pg8::StaticOrder S; S.init(TAIL_ROW0, DM, F.G, F.bx, 3); EpiMerge E{PROJ, XNR};
            pg8::gemm_phase<EpiMerge, OpsMerge, true>(F.lds, O, S, E, F.tid); tail_merge(F, PROJ, (const bf16_t*)(W + W_MRG), XNR); }
        else if (PHS(6)) { OpsPlain O{XNR, (const bf16_t*)(W + W_OUT), DM, DM}; pg8::StaticOrder S; S.init(TAIL_ROW0, DM, F.G, F.bx, 1); EpiRes E{F.out, F.xm, F.dry};
            pg8::gemm_phase<EpiRes, OpsPlain, true>(F.lds, O, S, E, F.tid); tail_res<DM>(F, XNR, (const bf16_t*)(W + W_OUT)); }
        else if (PHS(7)) p_norm2(args, F, layer);
        else if (PHS(8)) { OpsPlain O{XNR, (const bf16_t*)(W + W_G), DM, DM}; pg8::StaticOrder S; S.init(MP, DFF, F.G, F.bx, 1); EpiStore E{GB, DFF, 1 << 20};
            pg8::gemm_phase<EpiStore, OpsPlain, true>(F.lds, O, S, E, F.tid); }
        else if (PHS(9)) { OpsPlain O{XNR, (const bf16_t*)(W + W_U), DM, DM}; pg8::StaticOrder S; S.init(MP, DFF, F.G, F.bx, 1);
            EpiGeluMul E{GB, args.in[27] + (size_t)layer * 3 * DFF, args.in[28] + layer * DFF, ACT, F.dry ? DRYVAR : 0};
            pg8::gemm_phase<EpiGeluMul, OpsPlain, true>(F.lds, O, S, E, F.tid); }
        else if (PHS(10)) { OpsPlain O{ACT, (const bf16_t*)(W + W_D), DFF, DFF}; pg8::StaticOrder S; S.init(TAIL_ROW0, DM, F.G, F.bx, 1); EpiRes E{F.out, F.xm, F.dry};
            pg8::gemm_phase<EpiRes, OpsPlain, true>(F.lds, O, S, E, F.tid); tail_res<DFF>(F, ACT, (const bf16_t*)(W + W_D)); }
        if (ph2 + 1 < 2 * args0.ph_hi) { { int z2_ = 0; asm volatile("" : "+v"(z2_)); const int tid2 = wave0 * 64 + __builtin_amdgcn_mbcnt_hi(-1, __builtin_amdgcn_mbcnt_lo(-1, z2_));
              if (args0.use_bar) xcd_barrier(bar, tid2); else __syncthreads(); } }
    }
}

__global__ void fill_k(float* o, size_t n, float v) { size_t i = (size_t)blockIdx.x * blockDim.x + threadIdx.x; for (; i < n; i += (size_t)gridDim.x * blockDim.x) o[i] = v; }
extern "C" void kernel_launch(void* const* d_in, const int* in_sizes, int n_in, void* d_out, int out_size, void* d_ws, size_t ws_size, hipStream_t stream) {
    static int grid = 0;
    if (grid == 0) {
        int dev = 0, cus = 0;
        if (n_in != 30 || out_size != 32768 * DM || ws_size < WS_END || hipGetDevice(&dev) != hipSuccess || hipDeviceGetAttribute(&cus, hipDeviceAttributeMultiprocessorCount, dev) != hipSuccess ||
            hipFuncSetAttribute((const void*)fwd_kernel, hipFuncAttributeMaxDynamicSharedMemorySize, LDS_BYTES) != hipSuccess) { fprintf(stderr, "kernel_launch: bad shapes / workspace / device\n"); grid = -1; }
        else { int per_cu = 0; (void)hipOccupancyMaxActiveBlocksPerMultiprocessor(&per_cu, (const void*)fwd_kernel, NWAVES * 64, LDS_BYTES); (void)hipGetLastError();
            grid = cus * (per_cu >= 1 ? 1 : 0); if (grid <= 0) grid = -1; }
    }
    if (grid < 0) { fill_k<<<1024, 256, 0, stream>>>((float*)d_out, (size_t)out_size, 1e6f); return; }
    (void)hipMemsetAsync((char*)d_ws + WS_CTL, 0, CTL_ZERO_BYTES, stream);
    Args a{};
    for (int i = 0; i < 30; ++i) a.in[i] = (const float*)d_in[i];
    a.out = (float*)d_out; a.ws = (unsigned char*)d_ws;
#if MK_N_LAUNCHES == 1
    a.ph_lo = 0; a.ph_hi = N_PHASES; a.use_bar = 1;
    void* kargs[] = {&a};
    hipError_t e = hipLaunchCooperativeKernel((const void*)fwd_kernel, dim3(grid), dim3(NWAVES * 64), kargs, LDS_BYTES, stream);
    if (e != hipSuccess) fprintf(stderr, "cooperative launch failed: %s\n", hipGetErrorString(e));
#else
    for (int ph = 0; ph < N_PHASES; ++ph) { a.ph_lo = ph; a.ph_hi = ph + 1; a.use_bar = 0;
        hipLaunchKernelGGL(fwd_kernel, dim3(grid), dim3(NWAVES * 64), LDS_BYTES, stream, a); }
#endif
}
```

```cpp
#include <hip/hip_runtime.h>
#include <cstdio>
#include <cstdint>
#include <cmath>

#ifndef DBG
#define DBG 0
#endif
#ifndef DUP_PHASE
#define DUP_PHASE -1
#endif
#ifndef FT_RECOMPUTE
#define FT_RECOMPUTE 0
#endif
#ifndef DRYVAR
#define DRYVAR 0
#endif
#ifndef DUPMASK
#define DUPMASK 65535
#endif
#define DSEL(b) (!F.dry || (DUPMASK & (b)))
#ifndef MK_N_LAUNCHES
#define MK_N_LAUNCHES 1
#endif

#define LAS __attribute__((address_space(3)))
#define GAS __attribute__((address_space(1)))
typedef unsigned short bf16_t;
typedef short bf16x8 __attribute__((ext_vector_type(8)));
typedef float f32x4 __attribute__((ext_vector_type(4)));
typedef float f32x2 __attribute__((ext_vector_type(2)));
typedef float f32x16 __attribute__((ext_vector_type(16)));
typedef unsigned u32x4 __attribute__((ext_vector_type(4)));
typedef unsigned u32x2 __attribute__((ext_vector_type(2)));

constexpr int DM = 1024, INW = 5888, DFF = 2816, NHEAD = 8, HD = 64;
constexpr int LP = 2064, LS = 16400, NMETA = 16;
constexpr int ROWS_P = 8 * LP;
constexpr int MROWS = ROWS_P + LS;
constexpr int MP = 33024;
constexpr int C_Q = 0, C_K = 512, C_V = 640, C_X0 = 768, C_X1 = 1280, C_VV = 1792, C_PU = 2304, C_G = 2816;
constexpr float EPS = 1e-6f;
constexpr int RK_PAD = 256;
constexpr int RKLEN_P = 2 * LP + 512, RKLEN_S = 2 * LS + 512;

constexpr size_t MiB = 1u << 20;
constexpr size_t WS_CTL = 0, CTL_ZERO_BYTES = 1 * MiB;
constexpr size_t WS_XM = 1 * MiB;
constexpr size_t WS_W = 3 * MiB;
constexpr size_t W_IN = 0, W_G = W_IN + (size_t)INW * DM * 2, W_U = W_G + (size_t)DFF * DM * 2, W_D = W_U + (size_t)DFF * DM * 2,
                 W_OUT = W_D + (size_t)DM * DFF * 2, W_MRG = W_OUT + (size_t)DM * DM * 2, W_END = W_MRG + (size_t)3 * DM * 512 * 2;
static_assert(WS_W + W_END <= 36 * MiB, "weights");
constexpr size_t WS_RKP = 36 * MiB;
constexpr size_t WS_RKS = WS_RKP + (size_t)512 * RKLEN_P * 2;
static_assert(WS_RKS + (size_t)512 * RKLEN_S * 2 <= 74 * MiB, "filters");
constexpr size_t WS_XNR = 74 * MiB;
constexpr size_t XNR_BYTES = (size_t)MP * DM * 2;
constexpr size_t WS_PROJ = 139 * MiB;
constexpr size_t WS_END = WS_PROJ + (size_t)MP * INW * 2;
static_assert(WS_XNR + XNR_BYTES <= WS_PROJ && WS_END <= 512 * MiB, "d_ws map");
constexpr int CW_BAR = 4096;
constexpr int CW_SUMS = 16384;

namespace pg8 {
constexpr int BM = 256, BK = 64, HALF = 128, HTB = HALF * BK * 2, STAGE_BYTES = 8 * HTB, NXCD = 8, WGM = 8;
__host__ __device__ __forceinline__ int lds_byte(int r, int c) { const int st = (r >> 4) * 2 + (c >> 5), rr = r & 15, cc = c & 31, ob = rr * 64 + cc * 2; return st * 1024 + (ob ^ (((ob >> 9) & 1) << 5)); }
__host__ __device__ __forceinline__ void stage_rc(int b, int& R, int& C) { const int st = b / 1024, sb = b % 1024, swz = sb ^ (((sb >> 9) & 1) << 5); R = (st >> 1) * 16 + swz / 64; C = (st & 1) * 32 + (swz % 64) / 2; }
__host__ __device__ __forceinline__ int perm32(int rho) { const int n = rho >> 4, i = rho & 15; return 8 * (i >> 2) + 4 * n + (i & 3); }

struct Unit { int pm, pn, sub; };
struct StaticOrder {
    int nM, nN, nwg, G, c, nsub;
    __device__ void init(int M, int N, int G_, int c_, int nsub_) { nM = M / BM; nN = N / BM; nwg = nM * nN; G = G_; c = c_; nsub = nsub_; }
    __device__ bool next(int i, Unit& u) const {
        const int tile = i / nsub; u.sub = i - tile * nsub;
        const long L = (long)tile * G + c; if (L >= nwg) return false;
        int wgid = (int)L; { const int q = nwg / NXCD, r = nwg % NXCD, xcd = wgid % NXCD, off = wgid / NXCD; wgid = (xcd < r ? xcd * (q + 1) : r * (q + 1) + (xcd - r) * q) + off; }
        const int nig = WGM * nN, gid = wgid / nig, fm = gid * WGM, gsz = (nM - fm) < WGM ? (nM - fm) : WGM;
        u.pm = fm + ((wgid % nig) % gsz); u.pn = (wgid % nig) / gsz; return true;
    }
};
__device__ __forceinline__ unsigned cvt_pk_bf16(float lo, float hi) { unsigned r; asm volatile("v_cvt_pk_bf16_f32 %0, %1, %2" : "=v"(r) : "v"(lo), "v"(hi)); return r; }
__device__ __forceinline__ f32x2 gelu_pk(f32x2 v) {
    const f32x2 av = __builtin_elementwise_abs(v), d = av * 0.2316418882f + 1.0f;
    f32x2 t; t.x = __builtin_amdgcn_rcpf(d.x); t.y = __builtin_amdgcn_rcpf(d.y);
    f32x2 q = t * 0.5307027145f + (-0.7265760135f); q = q * t + 0.7107068705f; q = q * t + (-0.142248368f); q = q * t + 0.127414796f; q = q * t;
    const f32x2 s = (v * v) * (-0.72134752044f);
    f32x2 e; e.x = __builtin_amdgcn_exp2f(s.x); e.y = __builtin_amdgcn_exp2f(s.y);
    const f32x2 m = v * (q * e), r = v - m;
    f32x2 o; o.x = v.x < 0.f ? m.x : r.x; o.y = v.y < 0.f ? m.y : r.y; return o;
}

template <class Epi, class Ops, bool ALIGN_EPI>
__device__ __forceinline__ void gemm_phase(LAS unsigned char* lds, const Ops& O, const StaticOrder& S, const Epi& E, int tid) {
    const int wid = __builtin_amdgcn_readfirstlane(tid >> 6), lane = tid & 63, wr = wid >> 2, wc = wid & 3, fr = lane & 15, fq = lane >> 4;
    const int K = O.K, nt = K / BK, lda = O.lda;
    unsigned voffA[2], voffB[2];
#pragma unroll
    for (int i = 0; i < 2; ++i) { int R, C; stage_rc(tid * 16 + i * 8192, R, C); const int Rb = (R & ~31) + perm32(R & 31);
        voffA[i] = (unsigned)(R * lda + C) * 2u; voffB[i] = (unsigned)(Rb * K + C) * 2u; }
    const size_t kstep = (size_t)(BK * 2);
    const size_t hstepA = (size_t)HALF * lda * 2, hstepB = (size_t)HALF * K * 2;
    const unsigned ldsw = (unsigned)wid * 1024u;
    const int aoff = lds_byte(wr * 64 + fr, fq * 8), boff = lds_byte(wc * 32 + fr, fq * 8);
#define PG8_SA(b, h) (((b) * 2 + (h)) * HTB)
#define PG8_SB(b, h) ((4 + (b) * 2 + (h)) * HTB)
#define PG8_STAGE(bufoff, gbase, voff) do { _Pragma("unroll") for (int _i = 0; _i < 2; ++_i) \
        __builtin_amdgcn_global_load_lds((const unsigned*)((const char*)(gbase) + (voff)[_i]), (LAS unsigned*)(lds + (bufoff) + ldsw + _i * 8192), 16, 0, 0); } while (0)
#define PG8_LDA(dst, b, h) do { _Pragma("unroll") for (int m = 0; m < 4; ++m) _Pragma("unroll") for (int k = 0; k < 2; ++k) dst[m][k] = *(const LAS bf16x8*)(lds + PG8_SA(b, h) + aoff + m * 2048 + k * 1024); } while (0)
#define PG8_LDB(dst, b, h) do { _Pragma("unroll") for (int n = 0; n < 2; ++n) _Pragma("unroll") for (int k = 0; k < 2; ++k) dst[n][k] = *(const LAS bf16x8*)(lds + PG8_SB(b, h) + boff + n * 2048 + k * 1024); } while (0)
#define PG8_MMA(ai, bj, At, Bt) do { __builtin_amdgcn_s_setprio(1); _Pragma("unroll") for (int m = 0; m < 4; ++m) _Pragma("unroll") for (int n = 0; n < 2; ++n) _Pragma("unroll") for (int k = 0; k < 2; ++k) \
        acc[ai][bj][m][n] = __builtin_amdgcn_mfma_f32_16x16x32_bf16(Bt[n][k], At[m][k], acc[ai][bj][m][n], 0, 0, 0); __builtin_amdgcn_s_setprio(0); } while (0)
#define PG8_WAIT_V(n) asm volatile("s_waitcnt vmcnt(" #n ")" ::: "memory")
#define PG8_WAIT_L(n) asm volatile("s_waitcnt lgkmcnt(" #n ")" ::: "memory")
#define PG8_BAR __builtin_amdgcn_s_barrier()
#define PG8_SCHED __builtin_amdgcn_sched_barrier(0)
    Unit cur, nxt; int ui = 0;
    if (!S.next(0, cur)) return;
    f32x4 acc[2][2][4][2];
#pragma unroll
    for (int a = 0; a < 2; ++a)
#pragma unroll
        for (int b = 0; b < 2; ++b)
#pragma unroll
            for (int m = 0; m < 4; ++m)
#pragma unroll
                for (int n = 0; n < 2; ++n) acc[a][b][m][n] = (f32x4){0.f, 0.f, 0.f, 0.f};
    bf16x8 At[4][2], B0[2][2], B1[2][2];
    const char* cA; const char* cB; O.ptrs(cur, cA, cB);
    PG8_STAGE(PG8_SB(0, 0), cB, voffB); PG8_STAGE(PG8_SB(0, 1), cB + hstepB, voffB); PG8_STAGE(PG8_SA(0, 0), cA, voffA); PG8_STAGE(PG8_SA(0, 1), cA + hstepA, voffA);
    if (wr == 1) PG8_BAR;
    PG8_WAIT_V(2); PG8_BAR;
    PG8_STAGE(PG8_SB(1, 0), cB + kstep, voffB); PG8_STAGE(PG8_SA(1, 0), cA + kstep, voffA); PG8_STAGE(PG8_SB(1, 1), cB + hstepB + kstep, voffB);
    PG8_WAIT_V(6); PG8_BAR;
    for (;;) {
        const bool has_next = S.next(ui + 1, nxt);
        const char* nA = cA; const char* nB = cB; if (has_next) O.ptrs(nxt, nA, nB);
        for (int t = 0; t < nt; t += 2) {
            const bool last = (t == nt - 2);
            const char* a1 = cA + (size_t)(t + 1) * kstep;
            const char* a2 = last ? nA : cA + (size_t)(t + 2) * kstep; const char* b2 = last ? nB : cB + (size_t)(t + 2) * kstep;
            const char* a3 = a2 + kstep; const char* b3 = b2 + kstep;
            PG8_LDB(B0, 0, 0); PG8_LDB(B1, 0, 1); PG8_SCHED; PG8_LDA(At, 0, 0); PG8_STAGE(PG8_SA(1, 1), a1 + hstepA, voffA);
            PG8_WAIT_V(8); PG8_WAIT_L(0); PG8_BAR; PG8_MMA(0, 0, At, B0); PG8_MMA(0, 1, At, B1); PG8_BAR; PG8_SCHED;
            PG8_LDA(At, 0, 1); PG8_STAGE(PG8_SB(0, 0), b2, voffB); PG8_STAGE(PG8_SB(0, 1), b2 + hstepB, voffB); PG8_STAGE(PG8_SA(0, 0), a2, voffA);
            PG8_WAIT_V(8); PG8_WAIT_L(0); PG8_BAR; PG8_MMA(1, 0, At, B0); PG8_MMA(1, 1, At, B1); PG8_BAR; PG8_SCHED;
            PG8_LDB(B0, 1, 0); PG8_LDB(B1, 1, 1); PG8_SCHED; PG8_LDA(At, 1, 0); PG8_STAGE(PG8_SA(0, 1), a2 + hstepA, voffA);
            PG8_WAIT_V(8); PG8_WAIT_L(0); PG8_BAR; PG8_MMA(0, 0, At, B0); PG8_MMA(0, 1, At, B1); PG8_BAR; PG8_SCHED;
            PG8_LDA(At, 1, 1); PG8_STAGE(PG8_SB(1, 0), b3, voffB); PG8_STAGE(PG8_SB(1, 1), b3 + hstepB, voffB); PG8_STAGE(PG8_SA(1, 0), a3, voffA);
            PG8_WAIT_V(8); PG8_WAIT_L(0); PG8_BAR; PG8_MMA(1, 0, At, B0); PG8_MMA(1, 1, At, B1); PG8_BAR; PG8_SCHED;
        }
        if constexpr (ALIGN_EPI) { if (wr == 0) PG8_BAR; }
        { int z_ = 0; asm volatile("" : "+v"(z_)); const int l2 = __builtin_amdgcn_mbcnt_hi(-1, __builtin_amdgcn_mbcnt_lo(-1, z_));
          E(acc, cur, wr, wc, l2 & 15, l2 >> 4); }
        if (!E.keep(cur)) {
#pragma unroll
            for (int a = 0; a < 2; ++a)
#pragma unroll
                for (int b = 0; b < 2; ++b)
#pragma unroll
                    for (int m = 0; m < 4; ++m)
#pragma unroll
                        for (int n = 0; n < 2; ++n) acc[a][b][m][n] = (f32x4){0.f, 0.f, 0.f, 0.f};
        }
        if (!has_next) break;
        cur = nxt; cA = nA; cB = nB; ++ui;
        if constexpr (ALIGN_EPI) { if (wr == 1) PG8_BAR; }
    }
    PG8_WAIT_V(0);
    if constexpr (!ALIGN_EPI) { if (wr == 0) PG8_BAR; }
    PG8_BAR;
#undef PG8_SA
#undef PG8_SB
#undef PG8_STAGE
#undef PG8_LDA
#undef PG8_LDB
#undef PG8_MMA
#undef PG8_WAIT_V
#undef PG8_WAIT_L
#undef PG8_BAR
#undef PG8_SCHED
}
}

constexpr int RING_BYTES_C = 131072, LDSCTL_OFF_C = 131072;
__device__ __forceinline__ int seq_of_row(int r) { return r < ROWS_P ? r / LP : 8; }
__device__ __forceinline__ int seq_base(int s) { return s < 8 ? s * LP : ROWS_P; }
__device__ __forceinline__ int seq_len(int s) { return s < 8 ? LP : LS; }
__device__ __forceinline__ float* xrow(float* xreal, float* xm, int r) {
    if (r >= MROWS) return xm + (size_t)(144 + r - MROWS) * DM;
    const int s = seq_of_row(r), p = r - seq_base(s);
    if (p < NMETA) return xm + (size_t)(s * 16 + p) * DM;
    return xreal + (size_t)(r - 16 * (s + 1)) * DM;
}
__device__ __forceinline__ float bflo(unsigned u) { return __uint_as_float(u << 16); }
__device__ __forceinline__ float bfhi(unsigned u) { return __uint_as_float(u & 0xffff0000u); }
__device__ __forceinline__ unsigned pk2(float lo, float hi) { unsigned r; asm("v_cvt_pk_bf16_f32 %0, %1, %2" : "=v"(r) : "v"(lo), "v"(hi)); return r; }
__device__ __forceinline__ unsigned f2bf(float f) { return pk2(f, f); }
__device__ __forceinline__ void unpack8(const u32x4 w, float* f) { f[0] = bflo(w.x); f[1] = bfhi(w.x); f[2] = bflo(w.y); f[3] = bfhi(w.y); f[4] = bflo(w.z); f[5] = bfhi(w.z); f[6] = bflo(w.w); f[7] = bfhi(w.w); }
__device__ __forceinline__ float shx(float v, int o, int lane) { return __int_as_float(__builtin_amdgcn_ds_bpermute((lane ^ o) << 2, __float_as_int(v))); }
__device__ __forceinline__ float wave_sum(float v, int lane) {
#pragma unroll
    for (int o = 1; o < 64; o <<= 1) v += shx(v, o, lane);
    return v;
}
#define LDS_WAIT() asm volatile("s_waitcnt lgkmcnt(0)" ::: "memory")

struct OpsPlain {
    const bf16_t* A; const bf16_t* Bt; int K, lda;
    __device__ __forceinline__ void ptrs(const pg8::Unit& u, const char*& a, const char*& b) const {
        a = (const char*)A + (size_t)u.pm * 256 * lda * 2; b = (const char*)Bt + (size_t)u.pn * 256 * K * 2; }
};
struct OpsMerge {
    const bf16_t* P; const bf16_t* WM; int K, lda;
    __device__ __forceinline__ void ptrs(const pg8::Unit& u, const char*& a, const char*& b) const {
        const int col = u.sub == 0 ? C_Q : (u.sub == 1 ? C_VV : C_X1);
        a = (const char*)P + ((size_t)u.pm * 256 * lda + col) * 2; b = (const char*)WM + ((size_t)u.sub * DM + (size_t)u.pn * 256) * 512 * 2; }
};
typedef f32x4 acc_t[2][2][4][2];
struct EpiStore {
    bf16_t* O; int ldc; int sig_pn;
    __device__ __forceinline__ bool keep(const pg8::Unit&) const { return false; }
    __device__ __forceinline__ void operator()(acc_t& acc, const pg8::Unit& u, int wr, int wc, int fr, int fq) const {
        const int row0 = u.pm * 256 + wr * 64 + fr, col0 = u.pn * 256 + wc * 32 + 8 * fq; const bool sig = u.pn >= sig_pn;
#pragma unroll
        for (int ai = 0; ai < 2; ++ai)
#pragma unroll
            for (int m = 0; m < 4; ++m) { bf16_t* rowp = O + (size_t)(row0 + ai * 128 + m * 16) * ldc + col0;
#pragma unroll
                for (int bj = 0; bj < 2; ++bj) { f32x4 v0 = acc[ai][bj][m][0], v1 = acc[ai][bj][m][1];
                    if (sig) { unsigned q[8];
#pragma unroll
                        for (int e = 0; e < 4; ++e) { q[e] = (unsigned)fminf(fmaxf(__builtin_rintf(255.f * __builtin_amdgcn_rcpf(1.f + __expf(-v0[e]))), 1.f), 255.f);
                                                      q[4 + e] = (unsigned)fminf(fmaxf(__builtin_rintf(255.f * __builtin_amdgcn_rcpf(1.f + __expf(-v1[e]))), 1.f), 255.f); }
                        u32x2 w8; w8.x = q[0] | (q[1] << 8) | (q[2] << 16) | (q[3] << 24); w8.y = q[4] | (q[5] << 8) | (q[6] << 16) | (q[7] << 24);
                        *(u32x2*)((unsigned char*)(O + (size_t)(row0 + ai * 128 + m * 16) * ldc) + C_G * 2 + (col0 + bj * 128 - C_G)) = w8; continue; }
                    u32x4 w; w.x = pg8::cvt_pk_bf16(v0[0], v0[1]); w.y = pg8::cvt_pk_bf16(v0[2], v0[3]); w.z = pg8::cvt_pk_bf16(v1[0], v1[1]); w.w = pg8::cvt_pk_bf16(v1[2], v1[3]);
                    *(u32x4*)(rowp + bj * 128) = w; } }
    }
};
struct EpiRes {
    float* xreal; float* xm; int dry;
    __device__ __forceinline__ bool keep(const pg8::Unit&) const { return false; }
    __device__ __forceinline__ void operator()(acc_t& acc, const pg8::Unit& u, int wr, int wc, int fr, int fq) const {
        const int row0 = u.pm * 256 + wr * 64 + fr, col0 = u.pn * 256 + wc * 32 + 8 * fq;
#pragma unroll
        for (int ai = 0; ai < 2; ++ai)
#pragma unroll
            for (int m = 0; m < 4; ++m) { float* p = xrow(xreal, xm, row0 + ai * 128 + m * 16) + col0;
#pragma unroll
                for (int bj = 0; bj < 2; ++bj) { f32x4 a = *(f32x4*)(p + bj * 128), b = *(f32x4*)(p + bj * 128 + 4);
                    a += acc[ai][bj][m][0]; b += acc[ai][bj][m][1]; if (!dry) { *(f32x4*)(p + bj * 128) = a; *(f32x4*)(p + bj * 128 + 4) = b; } } }
    }
};
struct EpiGeluMul {
    const bf16_t* G; const float* cw; const float* cb; bf16_t* O; int dv;
    __device__ __forceinline__ bool keep(const pg8::Unit&) const { return false; }
    __device__ __forceinline__ void operator()(acc_t& acc, const pg8::Unit& u, int wr, int wc, int fr, int fq) const {
        if (dv == 1) return;
        const int row0 = u.pm * 256 + wr * 64 + fr, col0 = u.pn * 256 + wc * 32 + 8 * fq;
#pragma unroll
        for (int ai = 0; ai < 2; ++ai)
#pragma unroll
            for (int m = 0; m < 4; ++m) { const int r = row0 + ai * 128 + m * 16;
                const int s = seq_of_row(r), p = r - seq_base(s); const bool inb = r < MROWS;
                const bool hasp = inb && p > 0, hasn = inb && p < seq_len(s) - 1;
                const float mp_ = hasp ? 1.f : 0.f, mn_ = hasn ? 1.f : 0.f;
#pragma unroll
                for (int bj = 0; bj < 2; ++bj) { const int col = col0 + bj * 128;
                    const bf16_t* gp = G + (size_t)r * DFF + col;
                    const u32x4 gm = *(const u32x4*)(gp - (hasp ? DFF : 0)), g0 = *(const u32x4*)gp, gn = *(const u32x4*)(gp + (hasn ? DFF : 0));
                    float fm[8], f0[8], fn[8]; unpack8(gm, fm); unpack8(g0, f0); unpack8(gn, fn);
                    float o[8];
#pragma unroll
                    for (int h = 0; h < 2; ++h) { const f32x4 a = *(const f32x4*)(cw + col + 4 * h), b = *(const f32x4*)(cw + DFF + col + 4 * h), c = *(const f32x4*)(cw + 2 * DFF + col + 4 * h), d = *(const f32x4*)(cb + col + 4 * h);
#pragma unroll
                        for (int e = 0; e < 4; e += 2) { f32x2 x; x.x = a[e] * mp_ * fm[4 * h + e] + b[e] * f0[4 * h + e] + c[e] * mn_ * fn[4 * h + e] + d[e];
                            x.y = a[e + 1] * mp_ * fm[4 * h + e + 1] + b[e + 1] * f0[4 * h + e + 1] + c[e + 1] * mn_ * fn[4 * h + e + 1] + d[e + 1];
                            const f32x2 g = pg8::gelu_pk(x); o[4 * h + e] = g.x; o[4 * h + e + 1] = g.y; } }
                    const f32x4 v0 = acc[ai][bj][m][0], v1 = acc[ai][bj][m][1];
                    u32x4 w; w.x = pg8::cvt_pk_bf16(o[0] * v0[0], o[1] * v0[1]); w.y = pg8::cvt_pk_bf16(o[2] * v0[2], o[3] * v0[3]);
                    w.z = pg8::cvt_pk_bf16(o[4] * v1[0], o[5] * v1[1]); w.w = pg8::cvt_pk_bf16(o[6] * v1[2], o[7] * v1[3]);
                    if (dv != 2) *(u32x4*)(O + (size_t)r * DFF + col) = w; else asm volatile("" :: "v"(w.x), "v"(w.y), "v"(w.z), "v"(w.w)); }
                if (m & 1) asm volatile("" ::: "memory"); }
    }
};
__device__ __forceinline__ void unpack8u(const u32x2 w, float* f) {
#pragma unroll
    for (int e = 0; e < 4; ++e) { f[e] = (float)((w.x >> (8 * e)) & 255u) * (1.f / 255.f); f[4 + e] = (float)((w.y >> (8 * e)) & 255u) * (1.f / 255.f); }
}
struct EpiMerge {
    const bf16_t* P; bf16_t* O;
    __device__ __forceinline__ bool keep(const pg8::Unit& u) const { return u.sub < 2; }
    __device__ __forceinline__ void operator()(acc_t& acc, const pg8::Unit& u, int wr, int wc, int fr, int fq) const {
        const int row0 = u.pm * 256 + wr * 64 + fr, col0 = u.pn * 256 + wc * 32 + 8 * fq; const int sub = u.sub;
#pragma unroll
        for (int ai = 0; ai < 2; ++ai)
#pragma unroll
            for (int m = 0; m < 4; ++m) { const int r = row0 + ai * 128 + m * 16;
#pragma unroll
                for (int bj = 0; bj < 2; ++bj) { const int col = col0 + bj * 128;
                    const unsigned char* gp = (const unsigned char*)(P + (size_t)r * INW) + C_G * 2 + col;
                    float mu[8];
                    if (sub < 2) { const u32x2 ga = *(const u32x2*)(gp + sub * DM), gb = *(const u32x2*)(gp + (sub + 1) * DM); float fa[8], fb[8]; unpack8u(ga, fa); unpack8u(gb, fb);
#pragma unroll
                        for (int e = 0; e < 8; ++e) mu[e] = fa[e] * __builtin_amdgcn_rcpf(fb[e]); }
                    else { const u32x2 ga = *(const u32x2*)(gp + 2 * DM); unpack8u(ga, mu); }
                    f32x4 v0 = acc[ai][bj][m][0], v1 = acc[ai][bj][m][1];
#pragma unroll
                    for (int e = 0; e < 4; ++e) { v0[e] *= mu[e]; v1[e] *= mu[4 + e]; }
                    if (sub < 2) { acc[ai][bj][m][0] = v0; acc[ai][bj][m][1] = v1; }
                    else { u32x4 w; w.x = pg8::cvt_pk_bf16(v0[0], v0[1]); w.y = pg8::cvt_pk_bf16(v0[2], v0[3]); w.z = pg8::cvt_pk_bf16(v1[0], v1[1]); w.w = pg8::cvt_pk_bf16(v1[2], v1[3]);
                        *(u32x4*)(O + (size_t)r * DM + col) = w; } } }
    }
};

#define XB_TMO      128
#define XB_XCNT(j)  (256  + 64 * (j))
#define XB_XSUB(j)  (1280 + 64 * (j))
#define XB_XGEN(j)  (2304 + 64 * (j))
#define XB_TOP      3328
#define XB_TOPGEN   3392
#define XCD_BAR_WORDS 3456
#define XB_SPIN_CAP (1u << 20)
__device__ __forceinline__ unsigned xb_ld(unsigned* p)              { return __hip_atomic_load(p, __ATOMIC_RELAXED, __HIP_MEMORY_SCOPE_AGENT); }
__device__ __forceinline__ unsigned xb_add(unsigned* p, unsigned v) { return __hip_atomic_fetch_add(p, v, __ATOMIC_RELAXED, __HIP_MEMORY_SCOPE_AGENT); }
__device__ __forceinline__ unsigned xb_xcc_id() { return (unsigned)__builtin_amdgcn_s_getreg((3 << 11) | 20) & 0xFu; }
#define XB_SPIN(cond, bar) do { unsigned _sp = 0; while (cond) { __builtin_amdgcn_s_sleep(1); \
    if ((++_sp & 255u) == 0u) { if (xb_ld(&(bar)[XB_TMO])) break; if (_sp > XB_SPIN_CAP) { atomicAdd(&(bar)[XB_TMO], 1u); break; } } } } while (0)
struct XcdBarrier { unsigned* bar; unsigned x; volatile LAS unsigned* st; };
__device__ __forceinline__ XcdBarrier xcd_barrier_post(unsigned* bar, volatile LAS unsigned* st) {
    XcdBarrier b; b.bar = bar; b.x = xb_xcc_id(); b.st = st;
    if (threadIdx.x == 0) (void)xb_add(&bar[XB_XCNT(b.x)], 1u);
    return b;
}
__device__ __forceinline__ void xcd_barrier_complete(unsigned* bar, unsigned x, unsigned& nloc, unsigned& nx) {
    const unsigned G = gridDim.x * gridDim.y * gridDim.z;
    unsigned sum, cnt, mine, sp = 0u;
    for (;;) {
        sum = 0u; cnt = 0u; mine = 0u;
#pragma unroll
        for (unsigned j = 0; j < 16; ++j) { const unsigned c = xb_ld(&bar[XB_XCNT(j)]); sum += c; cnt += (c > 0u) ? 1u : 0u; mine = (j == x) ? c : mine; }
        if (sum == G) break;
        __builtin_amdgcn_s_sleep(1);
        if ((++sp & 255u) == 0u) { if (xb_ld(&bar[XB_TMO])) break; if (sp > XB_SPIN_CAP) { atomicAdd(&bar[XB_TMO], 1u); break; } }
    }
    nloc = mine > 0u ? mine : 1u; nx = cnt > 0u ? cnt : 1u;
}
__device__ __forceinline__ void xcd_barrier(const XcdBarrier& b, int tid) {
    asm volatile("s_waitcnt vmcnt(0)" ::: "memory");
    __syncthreads();
    if (tid == 0) {
        unsigned* bar = b.bar;
        __builtin_amdgcn_s_waitcnt(0);
        unsigned nloc = b.st[0], nx = b.st[1];
        if (nloc == 0u) { xcd_barrier_complete(bar, b.x, nloc, nx); b.st[0] = nloc; b.st[1] = nx; }
        const unsigned old = xb_add(&bar[XB_XSUB(b.x)], 1u);
        const unsigned gen = old / nloc;
        if (old + 1u == (gen + 1u) * nloc) {
            __builtin_amdgcn_fence(__ATOMIC_RELEASE, "agent");
            asm volatile("s_waitcnt vmcnt(0)" ::: "memory");
            const unsigned og = xb_add(&bar[XB_TOP], 1u);
            const unsigned tg = og / nx;
            if (og + 1u == (tg + 1u) * nx) xb_add(&bar[XB_TOPGEN], 1u);
            else XB_SPIN(xb_ld(&bar[XB_TOPGEN]) == tg, bar);
            __builtin_amdgcn_fence(__ATOMIC_ACQUIRE, "agent");
            xb_add(&bar[XB_XGEN(b.x)], 1u);
            asm volatile("s_waitcnt vmcnt(0)" ::: "memory");
        } else {
            XB_SPIN(xb_ld(&bar[XB_XGEN(b.x)]) == gen, bar);
            __builtin_amdgcn_fence(__ATOMIC_ACQUIRE, "agent");
            asm volatile("s_waitcnt vmcnt(0)" ::: "memory");
        }
    }
    __syncthreads();
}

constexpr int NWAVES = 8;
constexpr int RING_BYTES = 131072, LDSCTL_OFF = RING_BYTES, MISC_OFF = LDSCTL_OFF + 320, LDS_BYTES = 147456;
struct Args { const float* in[30]; float* out; unsigned char* ws; int ph_lo, ph_hi, use_bar, pad; };
typedef const __attribute__((address_space(4))) Args CArgs;
struct Frame {
    LAS unsigned char* lds; int tid, lane, wave, G, vcu, bx, dry;
    float* out; unsigned char* ws; float* xm;
};
#define FIN(i) (A.in[i])

__constant__ unsigned char c_bucket[257] = {
15,15,15,15,15,15,15,15,15,15,15,15,15,15,15,15,15,15,15,15,15,15,15,15,15,15,15,15,15,15,15,15,15,15,15,15,15,15,14,14,14,14,14,14,14,14,14,14,14,14,14,14,14,14,14,14,14,14,14,14,14,14,14,14,14,13,13,13,13,13,13,13,13,13,13,13,13,13,13,13,13,13,13,12,12,12,12,12,12,12,12,12,12,12,12,12,12,11,11,11,11,11,11,11,11,11,10,10,10,10,10,10,10,9,9,9,9,8,8,8,8,7,6,5,4,3,2,1,0,17,18,19,20,21,22,23,24,24,24,24,25,25,25,25,26,26,26,26,26,26,26,27,27,27,27,27,27,27,27,27,28,28,28,28,28,28,28,28,28,28,28,28,28,28,29,29,29,29,29,29,29,29,29,29,29,29,29,29,29,29,29,29,30,30,30,30,30,30,30,30,30,30,30,30,30,30,30,30,30,30,30,30,30,30,30,30,30,30,30,31,31,31,31,31,31,31,31,31,31,31,31,31,31,31,31,31,31,31,31,31,31,31,31,31,31,31,31,31,31,31,31,31,31,31,31,31,31};

__device__ __forceinline__ void p0_transpose_item(const float* W, int K, int N, bf16_t* WT, int row_off, LAS float* scr, int item, int lane) {
    const int nblk = N / 32, kb = item / nblk, nb = item % nblk, k0 = 64 * kb, n0 = 32 * nb;
    f32x4 v[8];
#pragma unroll
    for (int i = 0; i < 8; ++i) v[i] = *(const f32x4*)(W + (size_t)(k0 + 8 * i + (lane >> 3)) * N + n0 + 4 * (lane & 7));
#pragma unroll
    for (int i = 0; i < 8; ++i) { LAS float* d = scr + (8 * i + (lane >> 3)) * 33 + 4 * (lane & 7); d[0] = v[i].x; d[1] = v[i].y; d[2] = v[i].z; d[3] = v[i].w; }
    LDS_WAIT(); asm volatile("" ::: "memory");
    const int c = lane & 7;
#pragma unroll
    for (int j = 0; j < 4; ++j) { const int n = (lane >> 3) + 8 * j; const LAS float* s = scr + (8 * c) * 33 + n;
        u32x4 o; o.x = pk2(s[0 * 33], s[1 * 33]); o.y = pk2(s[2 * 33], s[3 * 33]); o.z = pk2(s[4 * 33], s[5 * 33]); o.w = pk2(s[6 * 33], s[7 * 33]);
        *(u32x4*)(WT + (size_t)(row_off + n0 + n) * K + k0 + 8 * c) = o; }
    LDS_WAIT(); asm volatile("" ::: "memory");
}
__device__ __forceinline__ void rms_row(const f32x4 (&v)[4], const float* g, bf16_t* orow, int lane) {
    float s = 0.f;
#pragma unroll
    for (int j = 0; j < 4; ++j) s += (v[j].x * v[j].x + v[j].y * v[j].y) + (v[j].z * v[j].z + v[j].w * v[j].w);
    const float rstd = 1.0f / sqrtf(wave_sum(s, lane) * (1.f / DM) + EPS);
    unsigned long long* o8 = (unsigned long long*)orow + lane;
#pragma unroll
    for (int j = 0; j < 4; ++j) { const f32x4 gg = *((const f32x4*)g + lane + 64 * j);
        o8[64 * j] = (unsigned long long)pk2(v[j].x * rstd * gg.x, v[j].y * rstd * gg.y) | ((unsigned long long)pk2(v[j].z * rstd * gg.z, v[j].w * rstd * gg.w) << 32); }
}
constexpr size_t WS_H2F_P = 2 * MiB, WS_H2F_S = WS_END;
constexpr int NCH_P = (LP + 31) / 32, NCH_S = (LS + 31) / 32;
static_assert(WS_H2F_S + (size_t)NCH_S * 32 * 128 <= 512 * MiB && WS_H2F_P + (size_t)NCH_P * 32 * 128 <= WS_W, "h2 scratch");
__device__ __forceinline__ void filt_h2_compute(const CArgs& A, const Frame& F, int layer, int L, int tc, LAS float* h1t, int lane, float (&acc)[32]) {
    const float* w1 = FIN(11) + (size_t)layer * 33 * 64; const float* b1 = FIN(12) + layer * 64;
    const float* w2 = FIN(13) + (size_t)layer * 64 * 64; const float* b2 = FIN(14) + layer * 64; const float* fq_ = FIN(16) + layer * 64;
    const int pos = lane & 31, half = lane >> 5, jb = 32 * half;
    const float tt = (float)tc / (float)(L - 1);
    { f32x4 bv[8], wv[8];
#pragma unroll
      for (int i = 0; i < 8; ++i) { bv[i] = *(const f32x4*)(b1 + jb + 4 * i); wv[i] = *(const f32x4*)(w1 + jb + 4 * i); }
#pragma unroll
      for (int i = 0; i < 8; ++i)
#pragma unroll
          for (int e = 0; e < 4; ++e) acc[4 * i + e] = bv[i][e] + tt * wv[i][e]; }
#pragma unroll 2
    for (int k = 0; k < 16; ++k) {
        const float f = 1e-4f + (float)k * ((15.0f - 1e-4f) / 15.0f);
        const float rev = f * (float)tc * (1.0f / (float)L);
        const float sn = __builtin_amdgcn_sinf(rev), cs = __builtin_amdgcn_cosf(rev);
        f32x4 wc_[8], ws_[8];
#pragma unroll
        for (int i = 0; i < 8; ++i) { wc_[i] = *(const f32x4*)(w1 + (size_t)(1 + k) * 64 + jb + 4 * i); ws_[i] = *(const f32x4*)(w1 + (size_t)(17 + k) * 64 + jb + 4 * i); }
#pragma unroll
        for (int i = 0; i < 8; ++i)
#pragma unroll
            for (int e = 0; e < 4; ++e) acc[4 * i + e] += cs * wc_[i][e] - sn * ws_[i][e];
    }
    { f32x4 fv[8];
#pragma unroll
      for (int i = 0; i < 8; ++i) fv[i] = *(const f32x4*)(fq_ + jb + 4 * i);
#pragma unroll
      for (int i = 0; i < 8; ++i)
#pragma unroll
          for (int e = 0; e < 4; ++e) h1t[(jb + 4 * i + e) * 32 + pos] = __builtin_amdgcn_sinf(fv[i][e] * acc[4 * i + e] * 0.15915494309189535f); }
    LDS_WAIT();
    { f32x4 bv[8];
#pragma unroll
      for (int i = 0; i < 8; ++i) bv[i] = *(const f32x4*)(b2 + jb + 4 * i);
#pragma unroll
      for (int i = 0; i < 8; ++i)
#pragma unroll
          for (int e = 0; e < 4; ++e) acc[4 * i + e] = bv[i][e]; }
#pragma unroll 4
    for (int i2 = 0; i2 < 64; ++i2) { const float h = h1t[i2 * 32 + pos]; f32x4 wv[8];
#pragma unroll
        for (int i = 0; i < 8; ++i) wv[i] = *(const f32x4*)(w2 + (size_t)i2 * 64 + jb + 4 * i);
#pragma unroll
        for (int i = 0; i < 8; ++i)
#pragma unroll
            for (int e = 0; e < 4; ++e) acc[4 * i + e] += h * wv[i][e]; }
}
__device__ __forceinline__ void filt_h2_item(const CArgs& A, const Frame& F, int layer, int item, LAS float* h1t, int lane) {
    const int cls = item >= NCH_P ? 1 : 0, ch = cls ? item - NCH_P : item, L = cls ? LS : LP;
    const int pos = lane & 31, half = lane >> 5, jb = 32 * half;
    const int t = ch * 32 + pos, tc = t < L ? t : L - 1;
    const float* fq_ = FIN(16) + layer * 64;
    float acc[32];
    filt_h2_compute(A, F, layer, L, tc, h1t, lane, acc);
    { f32x4 fv[8]; unsigned hw[16];
#pragma unroll
      for (int i = 0; i < 8; ++i) fv[i] = *(const f32x4*)(fq_ + jb + 4 * i);
#pragma unroll
      for (int i = 0; i < 8; ++i)
#pragma unroll
          for (int e = 0; e < 4; e += 2) { const float a0 = __builtin_amdgcn_sinf(fv[i][e] * acc[4 * i + e] * 0.15915494309189535f), a1 = __builtin_amdgcn_sinf(fv[i][e + 1] * acc[4 * i + e + 1] * 0.15915494309189535f);
              typedef _Float16 h2_t __attribute__((ext_vector_type(2))); const h2_t hv = {(_Float16)a0, (_Float16)a1}; hw[2 * i + (e >> 1)] = __builtin_bit_cast(unsigned, hv); }
      u32x4* dst = (u32x4*)(F.ws + (cls ? WS_H2F_S : WS_H2F_P) + (size_t)t * 128 + half * 64);
#pragma unroll
      for (int i = 0; i < 4; ++i) dst[i] = (u32x4){hw[4 * i], hw[4 * i + 1], hw[4 * i + 2], hw[4 * i + 3]}; }
    LDS_WAIT();
}
constexpr int NI8_P = LP / 8, NI8 = NI8_P + LS / 8;
static_assert(LP % 8 == 0 && LS % 8 == 0, "filter items");
__device__ __forceinline__ void filt_h2_item8(const CArgs& A, const Frame& F, int layer, int item, LAS float* h1t, int lane) {
    const int cls = item >= NI8_P ? 1 : 0, ch = cls ? item - NI8_P : item, L = cls ? LS : LP;
    const float* w1 = FIN(11) + (size_t)layer * 33 * 64; const float* b1 = FIN(12) + layer * 64;
    const float* w2 = FIN(13) + (size_t)layer * 64 * 64; const float* b2 = FIN(14) + layer * 64; const float* fq_ = FIN(16) + layer * 64;
    const int pos = lane & 7, jb = (lane >> 3) * 8, t = ch * 8 + pos;
    const float tt = (float)t / (float)(L - 1);
    float acc[8];
    { const f32x4 ba = *(const f32x4*)(b1 + jb), bb = *(const f32x4*)(b1 + jb + 4), wa = *(const f32x4*)(w1 + jb), wb = *(const f32x4*)(w1 + jb + 4);
#pragma unroll
      for (int e = 0; e < 4; ++e) { acc[e] = ba[e] + tt * wa[e]; acc[4 + e] = bb[e] + tt * wb[e]; } }
#pragma unroll
    for (int k0 = 0; k0 < 16; k0 += 4) { f32x4 ca[4], cb[4], sa[4], sb[4];
#pragma unroll
        for (int q = 0; q < 4; ++q) { const int k = k0 + q; ca[q] = *(const f32x4*)(w1 + (size_t)(1 + k) * 64 + jb); cb[q] = *(const f32x4*)(w1 + (size_t)(1 + k) * 64 + jb + 4);
            sa[q] = *(const f32x4*)(w1 + (size_t)(17 + k) * 64 + jb); sb[q] = *(const f32x4*)(w1 + (size_t)(17 + k) * 64 + jb + 4); }
        asm volatile("" ::: "memory");
#pragma unroll
        for (int q = 0; q < 4; ++q) { const int k = k0 + q;
            const float f = 1e-4f + (float)k * ((15.0f - 1e-4f) / 15.0f);
            const float rev = f * (float)t * (1.0f / (float)L);
            const float sn = __builtin_amdgcn_sinf(rev), cs = __builtin_amdgcn_cosf(rev);
#pragma unroll
            for (int e = 0; e < 4; ++e) { acc[e] += cs * ca[q][e] - sn * sa[q][e]; acc[4 + e] += cs * cb[q][e] - sn * sb[q][e]; } }
        asm volatile("" ::: "memory");
    }
    const f32x4 fa = *(const f32x4*)(fq_ + jb), fb = *(const f32x4*)(fq_ + jb + 4);
#pragma unroll
    for (int e = 0; e < 4; ++e) { h1t[(jb + e) * 8 + pos] = __builtin_amdgcn_sinf(fa[e] * acc[e] * 0.15915494309189535f); h1t[(jb + 4 + e) * 8 + pos] = __builtin_amdgcn_sinf(fb[e] * acc[4 + e] * 0.15915494309189535f); }
    LDS_WAIT();
    { const f32x4 ba = *(const f32x4*)(b2 + jb), bb = *(const f32x4*)(b2 + jb + 4);
#pragma unroll
      for (int e = 0; e < 4; ++e) { acc[e] = ba[e]; acc[4 + e] = bb[e]; } }
#pragma unroll
    for (int i0 = 0; i0 < 64; i0 += 8) { f32x4 wa[8], wb[8];
#pragma unroll
        for (int q = 0; q < 8; ++q) { wa[q] = *(const f32x4*)(w2 + (size_t)(i0 + q) * 64 + jb); wb[q] = *(const f32x4*)(w2 + (size_t)(i0 + q) * 64 + jb + 4); }
        asm volatile("" ::: "memory");
#pragma unroll
        for (int q = 0; q < 8; ++q) { const float h = h1t[(i0 + q) * 8 + pos];
#pragma unroll
            for (int e = 0; e < 4; ++e) { acc[e] += h * wa[q][e]; acc[4 + e] += h * wb[q][e]; } }
        asm volatile("" ::: "memory");
    }
    unsigned hw[4];
#pragma unroll
    for (int e = 0; e < 4; e += 2) { typedef _Float16 h2_t __attribute__((ext_vector_type(2)));
        const h2_t ha = {(_Float16)__builtin_amdgcn_sinf(fa[e] * acc[e] * 0.15915494309189535f), (_Float16)__builtin_amdgcn_sinf(fa[e + 1] * acc[e + 1] * 0.15915494309189535f)};
        const h2_t hb = {(_Float16)__builtin_amdgcn_sinf(fb[e] * acc[4 + e] * 0.15915494309189535f), (_Float16)__builtin_amdgcn_sinf(fb[e + 1] * acc[4 + e + 1] * 0.15915494309189535f)};
        hw[e >> 1] = __builtin_bit_cast(unsigned, ha); hw[2 + (e >> 1)] = __builtin_bit_cast(unsigned, hb); }
    *(u32x4*)(F.ws + (cls ? WS_H2F_S : WS_H2F_P) + (size_t)t * 128 + jb * 2) = (u32x4){hw[0], hw[1], hw[2], hw[3]};
    LDS_WAIT();
}
constexpr int NCHF_P = (LP - 1 + 31) / 32 + 1, NCHB_P = (LP + 31) / 32, NCHF_S = (LS - 1 + 31) / 32 + 1, NCHB_S = (LS + 31) / 32;
constexpr int NFI_P = NCHF_P + NCHB_P, NFI = NFI_P + NCHF_S + NCHB_S;
__device__ __forceinline__ void filt_tile_item(const CArgs& A, const Frame& F, int layer, int item, int lane) {
    const int ct = item & 15; int cls = 0, it = item >> 4; if (it >= NFI_P) { cls = 1; it -= NFI_P; }
    const int nchf = cls ? NCHF_S : NCHF_P, L = cls ? LS : LP;
    bool bwd; int ch; if (it < nchf) { bwd = false; ch = it - 1; } else { bwd = true; ch = it - nchf; }
    const int tsh = bwd ? 0 : 1;
    const float* w3 = FIN(15) + (size_t)layer * 64 * 1024;
    const int pos = lane & 31, half = lane >> 5;
    const int t = ch * 32 + pos + tsh, tc = t < 0 ? 0 : (t < L ? t : L - 1);
    float acc[32];
#if FT_RECOMPUTE
    if (FT_RECOMPUTE == 1 || FT_RECOMPUTE == 9 || (FT_RECOMPUTE == 2 && cls == 0) || (FT_RECOMPUTE == 3 && cls == 1)) { LAS float* h1t = (LAS float*)(F.lds + F.wave * 16384); filt_h2_compute(A, F, layer, L, tc, h1t, lane, acc); const float* fq_ = FIN(16) + layer * 64;
#pragma unroll
      for (int k = 0; k < 32; ++k) acc[k] = __builtin_amdgcn_sinf(fq_[32 * half + k] * acc[k] * 0.15915494309189535f); LDS_WAIT(); }
    else
#endif
    { const u32x4* src = (const u32x4*)(F.ws + (cls ? WS_H2F_S : WS_H2F_P) + (size_t)tc * 128 + half * 64);
      u32x4 hv[4];
#pragma unroll
      for (int i = 0; i < 4; ++i) hv[i] = src[i];
#pragma unroll
      for (int i = 0; i < 4; ++i)
#pragma unroll
          for (int e = 0; e < 4; ++e) { typedef _Float16 h2_t __attribute__((ext_vector_type(2))); const unsigned wv_ = hv[i][e];
              const h2_t p = __builtin_bit_cast(h2_t, wv_); acc[8 * i + 2 * e] = (float)p[0]; acc[8 * i + 2 * e + 1] = (float)p[1]; } }
#if FT_RECOMPUTE == 9
    float bad = 0.f;
    { const u32x4* src = (const u32x4*)(F.ws + (cls ? WS_H2F_S : WS_H2F_P) + (size_t)tc * 128 + half * 64);
#pragma unroll
      for (int i = 0; i < 4; ++i) { const u32x4 hvv = src[i];
#pragma unroll
          for (int e = 0; e < 4; ++e) { typedef _Float16 h2_t __attribute__((ext_vector_type(2))); const h2_t p = __builtin_bit_cast(h2_t, hvv[e]);
              if (fabsf((float)p[0] - acc[8 * i + 2 * e]) > 2e-3f || fabsf((float)p[1] - acc[8 * i + 2 * e + 1]) > 2e-3f) bad = 1e4f; } } }
#else
    const float bad = 0.f;
#endif
    bf16_t* RK = (bf16_t*)(F.ws + (cls ? WS_RKS : WS_RKP)); const int rklen = cls ? RKLEN_S : RKLEN_P;
    float* sums = (float*)(F.ws + WS_CTL) + CW_SUMS + (layer * 2 + cls) * 512;
    const float da = -15.350567286626973f, db = -3.0701134573253945f;
    {
        const int col0 = (bwd ? 512 : 0) + ct * 32;
        float bw[32];
#pragma unroll
        for (int ks = 0; ks < 32; ++ks) bw[ks] = w3[(size_t)(32 * half + ks) * 1024 + col0 + pos];
        f32x16 d = {};
#pragma unroll
        for (int ks = 0; ks < 32; ++ks) d = __builtin_amdgcn_mfma_f32_32x32x2f32(acc[ks], bw[ks], d, 0, 0, 0);
        const int c = (col0 + pos) & 511;
        const float delta = fabsf(da + (db - da) * ((float)c / 511.0f));
        bf16_t* rk = RK + (size_t)c * rklen + RK_PAD + L;
        float asum = 0.f;
#pragma unroll
        for (int g = 0; g < 4; ++g) { const int t0 = ch * 32 + 8 * g + 4 * half + tsh; float v[4];
#pragma unroll
            for (int e = 0; e < 4; ++e) { const int tp = t0 + e; const bool ok = tp >= 0 && tp < L && !(bwd && tp == 0);
                const float tq = (float)tp / (float)(L - 1); v[e] = ok ? d[4 * g + e] * __expf(-tq * delta) + bad : 0.f; asum += fabsf(v[e]); }
            if (bwd) { if (t0 >= 4 && t0 + 3 < L) { u32x2 w; w.x = pk2(v[0], v[1]); w.y = pk2(v[2], v[3]); *(u32x2*)(rk + t0) = w; }
                       else {
#pragma unroll
                           for (int e = 0; e < 4; ++e) if (t0 + e >= 1 && t0 + e < L) rk[t0 + e] = (bf16_t)f2bf(v[e]); } }
            else { if (t0 >= 0 && t0 + 3 < L) { u32x2 w; w.x = pk2(v[3], v[2]); w.y = pk2(v[1], v[0]); *(u32x2*)(rk - t0 - 3) = w; }
                   else {
#pragma unroll
                       for (int e = 0; e < 4; ++e) if (t0 + e >= 0 && t0 + e < L) rk[-(t0 + e)] = (bf16_t)f2bf(v[e]); } } }
        asum += shx(asum, 32, lane);
        if (half == 0 && !F.dry) atomicAdd(sums + c, asum);
    }
}
constexpr int FT_RUN = 10;
constexpr int FT_RF_P = (NCHF_P + FT_RUN - 1) / FT_RUN, FT_RB_P = (NCHB_P + FT_RUN - 1) / FT_RUN, FT_RF_S = (NCHF_S + FT_RUN - 1) / FT_RUN, FT_RB_S = (NCHB_S + FT_RUN - 1) / FT_RUN;
constexpr int FT_UNITS = 16 * (FT_RF_P + FT_RB_P + FT_RF_S + FT_RB_S);
typedef _Float16 f16x8 __attribute__((ext_vector_type(8)));
__device__ __forceinline__ void filt_tile_run(const CArgs& A, const Frame& F, int layer, int unit, int lane) {
    const int ct = unit & 15; int rr = unit >> 4, cls, bwd, nch;
    if (rr < FT_RF_P) { cls = 0; bwd = 0; nch = NCHF_P; }
    else if (rr < FT_RF_P + FT_RB_P) { rr -= FT_RF_P; cls = 0; bwd = 1; nch = NCHB_P; }
    else if (rr < FT_RF_P + FT_RB_P + FT_RF_S) { rr -= FT_RF_P + FT_RB_P; cls = 1; bwd = 0; nch = NCHF_S; }
    else { rr -= FT_RF_P + FT_RB_P + FT_RF_S; cls = 1; bwd = 1; nch = NCHB_S; }
    const int L = cls ? LS : LP, it0 = rr * FT_RUN, it1 = it0 + FT_RUN < nch ? it0 + FT_RUN : nch, toff = bwd ? 0 : -31;
    const float* w3 = FIN(15) + (size_t)layer * 64 * 1024;
    const int pos = lane & 31, half = lane >> 5, col0 = (bwd ? 512 : 0) + ct * 32, c = (col0 + pos) & 511;
    f16x8 bw[4];
    { float wf[32];
#pragma unroll
      for (int q = 0; q < 32; ++q) wf[q] = w3[(size_t)(16 * (q >> 3) + 8 * half + (q & 7)) * 1024 + col0 + pos];
#pragma unroll
      for (int q = 0; q < 32; ++q) bw[q >> 3][q & 7] = (_Float16)wf[q]; }
    const float da = -15.350567286626973f, db = -3.0701134573253945f;
    const float e2 = fabsf(da + (db - da) * ((float)c / 511.0f)) * (1.4426950408889634f / (float)(L - 1));
    bf16_t* rk = (bf16_t*)(F.ws + (cls ? WS_RKS : WS_RKP)) + (size_t)c * (cls ? RKLEN_S : RKLEN_P) + RK_PAD + L;
    const unsigned char* hbase = F.ws + (cls ? WS_H2F_S : WS_H2F_P) + half * 16;
    float asum = 0.f;
    u32x4 hv[4];
    { const int t = 32 * it0 + toff + pos, tc = t < 0 ? 0 : (t < L ? t : L - 1);
#pragma unroll
      for (int kb = 0; kb < 4; ++kb) hv[kb] = *(const u32x4*)(hbase + (size_t)tc * 128 + kb * 32); }
    for (int it = it0; it < it1; ++it) {
        u32x4 hn[4];
        { const int itn = it + 1 < it1 ? it + 1 : it, t = 32 * itn + toff + pos, tc = t < 0 ? 0 : (t < L ? t : L - 1);
#pragma unroll
          for (int kb = 0; kb < 4; ++kb) hn[kb] = *(const u32x4*)(hbase + (size_t)tc * 128 + kb * 32); }
        f32x16 d = {};
#pragma unroll
        for (int kb = 0; kb < 4; ++kb) d = __builtin_amdgcn_mfma_f32_32x32x16_f16(__builtin_bit_cast(f16x8, hv[kb]), bw[kb], d, 0, 0, 0);
        const int tb = 32 * it + toff;
        float v[16];
#pragma unroll
        for (int i = 0; i < 16; ++i) { const int tp = tb + 8 * (i >> 2) + 4 * half + (i & 3); const bool ok = tp >= bwd && tp < L;
            v[i] = ok ? d[i] * __builtin_amdgcn_exp2f(-(float)tp * e2) : 0.f; asum += fabsf(v[i]); }
        if (tb >= bwd && tb + 31 < L) {
            unsigned g[4][2];
#pragma unroll
            for (int q = 0; q < 4; ++q) { if (bwd) { g[q][0] = pk2(v[4 * q], v[4 * q + 1]); g[q][1] = pk2(v[4 * q + 2], v[4 * q + 3]); }
                                          else { g[q][0] = pk2(v[4 * q + 3], v[4 * q + 2]); g[q][1] = pk2(v[4 * q + 1], v[4 * q]); } }
            unsigned pc[4][2];
#pragma unroll
            for (int w = 0; w < 2; ++w) { const u32x2 s0 = __builtin_amdgcn_permlane32_swap(g[0][w], g[2][w], false, false), s1 = __builtin_amdgcn_permlane32_swap(g[1][w], g[3][w], false, false);
                pc[0][w] = s0[0]; pc[1][w] = s0[1]; pc[2][w] = s1[0]; pc[3][w] = s1[1]; }
            const int p0 = tb + 16 * half;
            if (bwd) { u32x4* dst = (u32x4*)(rk + p0); dst[0] = (u32x4){pc[0][0], pc[0][1], pc[1][0], pc[1][1]}; dst[1] = (u32x4){pc[2][0], pc[2][1], pc[3][0], pc[3][1]}; }
            else { u32x4* dst = (u32x4*)(rk - p0 - 15); dst[0] = (u32x4){pc[3][0], pc[3][1], pc[2][0], pc[2][1]}; dst[1] = (u32x4){pc[1][0], pc[1][1], pc[0][0], pc[0][1]}; }
        } else {
#pragma unroll
            for (int i = 0; i < 16; ++i) { const int tp = tb + 8 * (i >> 2) + 4 * half + (i & 3); if (tp >= bwd && tp < L) rk[bwd ? tp : -tp] = (bf16_t)f2bf(v[i]); }
        }
#pragma unroll
        for (int kb = 0; kb < 4; ++kb) hv[kb] = hn[kb];
    }
    asum += shx(asum, 32, lane);
    if (half == 0 && !F.dry) atomicAdd((float*)(F.ws + WS_CTL) + CW_SUMS + (layer * 2 + cls) * 512 + c, asum);
}
__device__ __forceinline__ void p_filt_tiles(const CArgs& A, const Frame& F, int layer) {
    const int gw = F.vcu * NWAVES + F.wave, NGW = F.G * NWAVES;
#if FT_RECOMPUTE
    for (int it = gw; it < 16 * NFI; it += NGW) filt_tile_item(A, F, layer, it, F.lane);
#else
    for (int u = NGW - 1 - gw; u < FT_UNITS; u += NGW) filt_tile_run(A, F, layer, u, F.lane);
#endif
}
__device__ __forceinline__ void p_prep(const CArgs& A, const Frame& F, int layer) {
    const int gw = F.vcu * NWAVES + F.wave, NGW = F.G * NWAVES, lane = F.lane;
    const bool filt_first = false;
    if (filt_first && DSEL(8)) { LAS float* scr = (LAS float*)(F.lds + F.wave * 16384); for (int it = gw; it < NI8; it += NGW) filt_h2_item8(A, F, layer, it, scr, lane); }
    if (DSEL(1)) {
        const float* g = FIN(4) + layer * DM; bf16_t* XN = (bf16_t*)(F.ws + WS_XNR);
        for (int r0 = gw; r0 < MP; r0 += 2 * NGW) {
            f32x4 v[2][4]; const int rr[2] = {r0, r0 + NGW};
#pragma unroll
            for (int q = 0; q < 2; ++q) { const int r = rr[q];
                if (r >= MP) continue;
                if (r >= MROWS) {
#pragma unroll
                    for (int j = 0; j < 4; ++j) v[q][j] = (f32x4){0.f, 0.f, 0.f, 0.f};
                } else if (layer == 0) {
                    const int s = seq_of_row(r), p = r - seq_base(s);
                    const float* src = p < NMETA ? FIN(2) + (size_t)p * DM : (s < 8 ? FIN(0) + ((size_t)s * 2048 + (p - NMETA)) * DM : FIN(1) + (size_t)(p - NMETA) * DM);
                    const f32x4* sr = (const f32x4*)src + lane;
#pragma unroll
                    for (int j = 0; j < 4; ++j) v[q][j] = sr[64 * j];
                } else {
                    const f32x4* xr = (const f32x4*)xrow(F.out, F.xm, r) + lane;
#pragma unroll
                    for (int j = 0; j < 4; ++j) v[q][j] = xr[64 * j];
                } }
#pragma unroll
            for (int q = 0; q < 2; ++q) { const int r = rr[q];
                if (r >= MP) continue;
                if (layer == 0) { f32x4* xr = (f32x4*)xrow(F.out, F.xm, r) + lane;
#pragma unroll
                    for (int j = 0; j < 4; ++j) xr[64 * j] = v[q][j]; }
                rms_row(v[q], g, XN + (size_t)r * DM, lane); }
        }
    }
    {
        LAS float* scr = (LAS float*)(F.lds + F.wave * 16384);
        unsigned char* W = F.ws + WS_W;
        constexpr int I_IN = (DM / 64) * (INW / 32), I_G = (DM / 64) * (DFF / 32), I_D = (DFF / 64) * (DM / 32), I_O = (DM / 64) * (DM / 32), I_M = (512 / 64) * (DM / 32);
        constexpr int NIT = I_IN + 2 * I_G + I_D + I_O + 2 * I_M;
        if (DSEL(2)) for (int it = gw; it < NIT; it += NGW) {
            int r = it;
            if (r < I_IN) { p0_transpose_item(FIN(5) + (size_t)layer * DM * INW, DM, INW, (bf16_t*)(W + W_IN), 0, scr, r, lane); continue; } r -= I_IN;
            if (r < I_G) { p0_transpose_item(FIN(25) + (size_t)layer * DM * DFF, DM, DFF, (bf16_t*)(W + W_G), 0, scr, r, lane); continue; } r -= I_G;
            if (r < I_G) { p0_transpose_item(FIN(26) + (size_t)layer * DM * DFF, DM, DFF, (bf16_t*)(W + W_U), 0, scr, r, lane); continue; } r -= I_G;
            if (r < I_D) { p0_transpose_item(FIN(29) + (size_t)layer * DFF * DM, DFF, DM, (bf16_t*)(W + W_D), 0, scr, r, lane); continue; } r -= I_D;
            if (r < I_O) { p0_transpose_item(FIN(23) + (size_t)layer * DM * DM, DM, DM, (bf16_t*)(W + W_OUT), 0, scr, r, lane); continue; } r -= I_O;
            if (r < I_M) { p0_transpose_item(FIN(20) + (size_t)layer * 512 * DM, 512, DM, (bf16_t*)(W + W_MRG), 0, scr, r, lane); continue; } r -= I_M;
            p0_transpose_item(FIN(21) + (size_t)layer * 512 * DM, 512, DM, (bf16_t*)(W + W_MRG), DM, scr, r, lane);
        }
        const float* pw = FIN(18) + (size_t)layer * 4 * 128 * 128; const float* psc = FIN(19) + layer * 512; const float* wpo = FIN(22) + (size_t)layer * 512 * DM;
        bf16_t* WT = (bf16_t*)(W + W_MRG) + (size_t)2 * DM * 512;
        const int gt = (F.vcu * NWAVES + F.wave) * 64 + lane, NGT = NGW * 64;
        if (DSEL(4)) for (int st = NGW - 1 - gw; st < (512 / 8) * (DM / 64); st += NGW) {
            const int c0 = (st >> 4) * 8, j = (st & 15) * 64 + lane, g = c0 >> 7;
            { const int cr = lane >> 3, d0 = (lane & 7) * 16; const float* pr = pw + ((size_t)c0 + cr) * 128 + d0; const float* ps = psc + g * 128 + d0;
#pragma unroll
              for (int q = 0; q < 4; ++q) { const f32x4 a = *(const f32x4*)(pr + 4 * q), b = *(const f32x4*)(ps + 4 * q); *(LAS f32x4*)(scr + cr * 128 + d0 + 4 * q) = a * b; } }
            LDS_WAIT(); asm volatile("" ::: "memory");
            const float* wp = wpo + (size_t)(g * 128) * DM + j;
            float a[8];
#pragma unroll
            for (int c = 0; c < 8; ++c) a[c] = 0.f;
#pragma unroll 1
            for (int d0 = 0; d0 < 128; d0 += 16) { float w[16];
#pragma unroll
                for (int q = 0; q < 16; ++q) w[q] = wp[(size_t)(d0 + q) * DM];
                asm volatile("" ::: "memory");
#pragma unroll
                for (int c = 0; c < 8; ++c)
#pragma unroll
                    for (int q4 = 0; q4 < 4; ++q4) { const f32x4 cf = *(const LAS f32x4*)(scr + c * 128 + d0 + 4 * q4);
#pragma unroll
                        for (int e = 0; e < 4; ++e) a[c] += cf[e] * w[4 * q4 + e]; }
                asm volatile("" ::: "memory");
            }
            u32x4 o; o.x = pk2(a[0], a[1]); o.y = pk2(a[2], a[3]); o.z = pk2(a[4], a[5]); o.w = pk2(a[6], a[7]);
            *(u32x4*)(WT + (size_t)j * 512 + c0) = o;
            LDS_WAIT(); asm volatile("" ::: "memory");
        }
        for (int idx = gt; idx < 2 * 512 * 513; idx += NGT) { const int k = idx % 513, cc = (idx / 513) & 511, cls = idx / (513 * 512);
            const int L = cls ? LS : LP, rklen = cls ? RKLEN_S : RKLEN_P; bf16_t* RK = (bf16_t*)(F.ws + (cls ? WS_RKS : WS_RKP)) + (size_t)cc * rklen;
            RK[k <= 256 ? k : 256 + 2 * L + (k - 257)] = 0; }
        if (!filt_first && DSEL(8)) for (int it = gw; it < NI8; it += NGW) filt_h2_item8(A, F, layer, it, scr, lane);
    }
}

__device__ __forceinline__ void p_attn_ref(const CArgs& A, const Frame& F, int layer) {
    bf16_t* P = (bf16_t*)(F.ws + WS_PROJ);
    const float* qg = FIN(6) + layer * HD; const float* kg = FIN(7) + layer * HD; const float* sink = FIN(8) + layer * NHEAD; const float* rb = FIN(3);
    const int gt = (F.vcu * NWAVES + F.wave) * 64 + F.lane, NGT = F.G * NWAVES * 64;
    for (int idx = gt; idx < MROWS * NHEAD; idx += NGT) {
        const int r = idx >> 3, h = idx & 7, hk = h >> 2;
        const int s = seq_of_row(r), base = seq_base(s), L = seq_len(s), p = r - base;
        unsigned qs[32]; float o[64];
        { const u32x4* qp = (const u32x4*)(P + (size_t)r * INW + C_Q + 64 * h); float ss = 0.f;
#pragma unroll
          for (int c = 0; c < 8; ++c) { const u32x4 w = qp[c]; qs[4 * c] = w.x; qs[4 * c + 1] = w.y; qs[4 * c + 2] = w.z; qs[4 * c + 3] = w.w; }
#pragma unroll
          for (int d = 0; d < 32; ++d) { const float a = bflo(qs[d]), b = bfhi(qs[d]); ss += a * a + b * b; }
          const float rs = 1.0f / sqrtf(ss * (1.f / 64) + EPS) * 0.125f;
#pragma unroll
          for (int d = 0; d < 32; ++d) { qs[d] = pk2(bflo(qs[d]) * rs * qg[2 * d], bfhi(qs[d]) * rs * qg[2 * d + 1]); o[2 * d] = 0.f; o[2 * d + 1] = 0.f; } }
        float m = sink[h], l = 1.f;
        const int lo = p - 128 < 0 ? 0 : p - 128, hi = p + 128 > L - 1 ? L - 1 : p + 128;
        for (int pk = lo; pk <= hi; ++pk) {
            const bf16_t* kr = P + (size_t)(base + pk) * INW;
            const u32x4* kp = (const u32x4*)(kr + C_K + 64 * hk); const u32x4* vp = (const u32x4*)(kr + C_V + 64 * hk);
            float ss = 0.f, dt = 0.f;
#pragma unroll
            for (int c = 0; c < 8; ++c) { float kk[8]; unpack8(kp[c], kk);
#pragma unroll
                for (int e = 0; e < 8; ++e) { ss += kk[e] * kk[e]; const unsigned qw = qs[4 * c + (e >> 1)]; dt += kk[e] * kg[8 * c + e] * ((e & 1) ? bfhi(qw) : bflo(qw)); }
                asm volatile("" ::: "memory"); }
            const float sc = dt / sqrtf(ss * (1.f / 64) + EPS) + rb[c_bucket[pk - p + 128] * NHEAD + h];
            const float mn = fmaxf(m, sc), f = __expf(m - mn), pe = __expf(sc - mn);
            l = l * f + pe; m = mn;
#pragma unroll
            for (int c = 0; c < 8; ++c) { float vv[8]; unpack8(vp[c], vv);
#pragma unroll
                for (int e = 0; e < 8; ++e) o[8 * c + e] = o[8 * c + e] * f + pe * vv[e];
                asm volatile("" ::: "memory"); }
        }
        const float il = (DBG & 4) ? 0.f : 1.f / l; u32x4* op = (u32x4*)(P + (size_t)r * INW + C_Q + 64 * h);
#pragma unroll
        for (int c = 0; c < 8; ++c) { u32x4 w; w.x = pk2(o[8 * c] * il, o[8 * c + 1] * il); w.y = pk2(o[8 * c + 2] * il, o[8 * c + 3] * il); w.z = pk2(o[8 * c + 4] * il, o[8 * c + 5] * il); w.w = pk2(o[8 * c + 6] * il, o[8 * c + 7] * il); op[c] = w; }
    }
}

constexpr int AT_K = 0, AT_V = 49152, AT_VSTR = 776, AT_B = AT_V + 64 * AT_VSTR, AT_BSTR = 324;
constexpr float AT_LOG2E = 1.4426950408889634f;
__device__ __forceinline__ void p_attn(const CArgs& A, const Frame& F, int layer) {
    bf16_t* P = (bf16_t*)(F.ws + WS_PROJ);
    const float* qg = FIN(6) + layer * HD; const float* kg = FIN(7) + layer * HD; const float* sink = FIN(8) + layer * NHEAD; const float* rb = FIN(3);
    const int lane = F.lane, wave = F.wave, tid = F.tid, r32 = lane & 31, hi = lane >> 5;
    LAS unsigned char* lds = F.lds;
    for (int unit = F.vcu; unit < 265 * 4; unit += F.G) {
        const int gb = unit >> 2, hk = (unit >> 1) & 1, gh = unit & 1;
        const int s = gb < 136 ? gb / 17 : 8, nb = gb < 136 ? gb - 17 * s : gb - 136;
        const int base = seq_base(s), L = seq_len(s);
        const int pk0 = 128 * nb - 240;
        u32x4 kws[6], vws[6];
#pragma unroll
        for (int it = 0; it < 6; ++it) { const int idx = tid + it * 512, key = idx >> 3, ch = idx & 7, pk = pk0 + key; const bool ok = pk >= 0 && pk < L;
            const bf16_t* rowp = P + (size_t)(base + (ok ? pk : 0)) * INW + 64 * hk + 8 * ch;
            kws[it] = *(const u32x4*)(rowp + C_K); vws[it] = *(const u32x4*)(rowp + C_V); }
#pragma unroll
        for (int it = 0; it < 6; ++it) { const int idx = tid + it * 512, key = idx >> 3, ch = idx & 7, pk = pk0 + key; const bool ok = pk >= 0 && pk < L;
            u32x4 kw = kws[it], vw = vws[it];
            float kf[8]; unpack8(kw, kf); float ss = 0.f;
#pragma unroll
            for (int e = 0; e < 8; ++e) ss += kf[e] * kf[e];
            ss += shx(ss, 1, lane); ss += shx(ss, 2, lane); ss += shx(ss, 4, lane);
            const float rs = ok ? 1.0f / sqrtf(ss * (1.f / 64) + EPS) : 0.f;
            u32x4 ko; ko.x = pk2(kf[0] * rs * kg[8 * ch], kf[1] * rs * kg[8 * ch + 1]); ko.y = pk2(kf[2] * rs * kg[8 * ch + 2], kf[3] * rs * kg[8 * ch + 3]);
            ko.z = pk2(kf[4] * rs * kg[8 * ch + 4], kf[5] * rs * kg[8 * ch + 5]); ko.w = pk2(kf[6] * rs * kg[8 * ch + 6], kf[7] * rs * kg[8 * ch + 7]);
            *(LAS u32x4*)(lds + AT_K + key * 128 + ((ch ^ (key & 7)) << 4)) = ko;
            if (!ok) vw = (u32x4){0u, 0u, 0u, 0u};
            LAS bf16_t* vt = (LAS bf16_t*)(lds + AT_V + (8 * ch) * AT_VSTR) + key;
            vt[0] = (bf16_t)(vw.x & 0xffffu); *(LAS bf16_t*)((LAS unsigned char*)vt + AT_VSTR) = (bf16_t)(vw.x >> 16);
            *(LAS bf16_t*)((LAS unsigned char*)vt + 2 * AT_VSTR) = (bf16_t)(vw.y & 0xffffu); *(LAS bf16_t*)((LAS unsigned char*)vt + 3 * AT_VSTR) = (bf16_t)(vw.y >> 16);
            *(LAS bf16_t*)((LAS unsigned char*)vt + 4 * AT_VSTR) = (bf16_t)(vw.z & 0xffffu); *(LAS bf16_t*)((LAS unsigned char*)vt + 5 * AT_VSTR) = (bf16_t)(vw.z >> 16);
            *(LAS bf16_t*)((LAS unsigned char*)vt + 6 * AT_VSTR) = (bf16_t)(vw.w & 0xffffu); *(LAS bf16_t*)((LAS unsigned char*)vt + 7 * AT_VSTR) = (bf16_t)(vw.w >> 16); }
        for (int i = tid; i < 2 * 257; i += 512) { const int hh = i >= 257 ? 1 : 0, rr = i - 257 * hh; ((LAS float*)(lds + AT_B))[hh * AT_BSTR + 32 + rr] = AT_LOG2E * rb[c_bucket[rr] * NHEAD + 4 * hk + 2 * gh + hh]; }
        __syncthreads();
        const int hh = wave >> 2, head = 4 * hk + 2 * gh + hh, qt = wave & 3, qi = 32 * qt + r32, pq = 128 * nb - 112 + qi; const bool qok = pq >= 0;
        const LAS float* bias = (const LAS float*)(lds + AT_B) + hh * AT_BSTR + 32;
        const bool edge = pk0 < 0 || pk0 + 384 > L;
        bf16x8 qf[4];
        { const bf16_t* qp = P + (size_t)(base + (qok ? pq : 0)) * INW + C_Q + 64 * head + 8 * hi; u32x4 qw[4]; float ss = 0.f;
#pragma unroll
          for (int ds = 0; ds < 4; ++ds) { qw[ds] = *(const u32x4*)(qp + 16 * ds); float f[8]; unpack8(qw[ds], f);
#pragma unroll
              for (int e = 0; e < 8; ++e) ss += f[e] * f[e]; }
          ss += shx(ss, 32, lane);
          const float rs = (0.125f * AT_LOG2E) / sqrtf(ss * (1.f / 64) + EPS);
#pragma unroll
          for (int ds = 0; ds < 4; ++ds) { float f[8]; unpack8(qw[ds], f); const float* g = qg + 16 * ds + 8 * hi; u32x4 o;
              o.x = pk2(f[0] * rs * g[0], f[1] * rs * g[1]); o.y = pk2(f[2] * rs * g[2], f[3] * rs * g[3]); o.z = pk2(f[4] * rs * g[4], f[5] * rs * g[5]); o.w = pk2(f[6] * rs * g[6], f[7] * rs * g[7]);
              qf[ds] = __builtin_bit_cast(bf16x8, o); } }
        float m = AT_LOG2E * sink[head], lp = hi == 0 ? 1.f : 0.f;
        f32x16 o0 = {}, o1 = {};
#define ATT_TILE(MODE, KT) do { const int kt = (KT); \
            f32x16 st = {}; \
            _Pragma("unroll") for (int ds = 0; ds < 4; ++ds) { const int key = 32 * kt + r32, chn = 2 * ds + hi; \
                const bf16x8 kfr = *(const LAS bf16x8*)(lds + AT_K + key * 128 + ((chn ^ (key & 7)) << 4)); \
                st = __builtin_amdgcn_mfma_f32_32x32x16_bf16(kfr, qf[ds], st, 0, 0, 0); } \
            const LAS float* bj = bias + 32 * (kt - qt) - r32 + 4 * hi; float bv[16]; \
            _Pragma("unroll") for (int i = 0; i < 16; ++i) bv[i] = bj[(i & 3) + 8 * (i >> 2)]; \
            float tmax = -1e30f; \
            _Pragma("unroll") for (int i = 0; i < 16; ++i) { const int ci = (i & 3) + 8 * (i >> 2); bool ok = true; \
                if (MODE == 0) ok = ci >= thr; else if (MODE == 2) ok = ci <= thr; \
                else if (MODE == 3) { const int kj = 32 * kt + ci + 4 * hi, rel = kj - 128 - qi, pk = pk0 + kj; ok = rel >= -128 && rel <= 128 && pk >= 0 && pk < L; } \
                const float v = ok ? st[i] + bv[i] : -1e30f; st[i] = v; tmax = fmaxf(tmax, v); } \
            tmax = fmaxf(tmax, shx(tmax, 32, lane)); \
            const float mn = fmaxf(m, tmax), f = __builtin_amdgcn_exp2f(m - mn); m = mn; \
            float ps = 0.f; \
            _Pragma("unroll") for (int i = 0; i < 16; ++i) { st[i] = __builtin_amdgcn_exp2f(st[i] - mn); ps += st[i]; } \
            lp = lp * f + ps; \
            _Pragma("unroll") for (int i = 0; i < 16; ++i) { o0[i] *= f; o1[i] *= f; } \
            _Pragma("unroll") for (int s2 = 0; s2 < 2; ++s2) { \
                u32x4 pw; pw.x = pk2(st[8 * s2], st[8 * s2 + 1]); pw.y = pk2(st[8 * s2 + 2], st[8 * s2 + 3]); pw.z = pk2(st[8 * s2 + 4], st[8 * s2 + 5]); pw.w = pk2(st[8 * s2 + 6], st[8 * s2 + 7]); \
                const bf16x8 pf = __builtin_bit_cast(bf16x8, pw); \
                _Pragma("unroll") for (int dt = 0; dt < 2; ++dt) { const LAS unsigned char* vp = lds + AT_V + (32 * dt + r32) * AT_VSTR + (32 * kt + 16 * s2 + 4 * hi) * 2; \
                    const u32x2 a0 = *(const LAS u32x2*)vp, a1 = *(const LAS u32x2*)(vp + 16); \
                    const bf16x8 vf = __builtin_bit_cast(bf16x8, (u32x4){a0.x, a0.y, a1.x, a1.y}); \
                    if (dt == 0) o0 = __builtin_amdgcn_mfma_f32_32x32x16_bf16(vf, pf, o0, 0, 0, 0); else o1 = __builtin_amdgcn_mfma_f32_32x32x16_bf16(vf, pf, o1, 0, 0, 0); } } } while (0)
        const int thr = r32 - 4 * hi;
        if (edge) { for (int j = 0; j <= 8; ++j) ATT_TILE(3, qt + j); }
        else { ATT_TILE(0, qt); for (int j = 1; j < 8; ++j) ATT_TILE(1, qt + j); ATT_TILE(2, qt + 8); }
#undef ATT_TILE
        const float il = (DBG & 4) ? 0.f : 1.f / (lp + shx(lp, 32, lane));
        if (qok && !F.dry) { bf16_t* op = P + (size_t)(base + pq) * INW + C_Q + 64 * head + 4 * hi;
#pragma unroll
            for (int g = 0; g < 4; ++g) { u32x2 w0, w1; w0.x = pk2(o0[4 * g] * il, o0[4 * g + 1] * il); w0.y = pk2(o0[4 * g + 2] * il, o0[4 * g + 3] * il);
                w1.x = pk2(o1[4 * g] * il, o1[4 * g + 1] * il); w1.y = pk2(o1[4 * g + 2] * il, o1[4 * g + 3] * il);
                *(u32x2*)(op + 8 * g) = w0; *(u32x2*)(op + 32 + 8 * g) = w1; } }
        __syncthreads();
    }
}
__device__ __forceinline__ void dwconv8(const bf16_t* P, int r, int col, const float* cw, const float* cb, int ucol, float* out) {
    const int s = seq_of_row(r), p = r - seq_base(s); const bool hasp = p > 0, hasn = p < seq_len(s) - 1;
    const bf16_t* gp = P + (size_t)r * INW + col;
    const u32x4 gm = *(const u32x4*)(gp - (hasp ? INW : 0)), g0 = *(const u32x4*)gp, gn = *(const u32x4*)(gp + (hasn ? INW : 0));
    float fm[8], f0[8], fn[8]; unpack8(gm, fm); unpack8(g0, f0); unpack8(gn, fn);
    const float mp_ = hasp ? 1.f : 0.f, mn_ = hasn ? 1.f : 0.f;
#pragma unroll
    for (int e = 0; e < 8; ++e) { fm[e] *= mp_; fn[e] *= mn_; }
#pragma unroll
    for (int e = 0; e < 8; ++e) out[e] = cw[ucol + e] * fm[e] + cw[1536 + ucol + e] * f0[e] + cw[2 * 1536 + ucol + e] * fn[e] + cb[ucol + e];
}
struct DwRows { u32x4 gm, g0, gn; float mp_, mn_; };
struct DwTaps { f32x4 a[2], b[2], c[2], d[2]; };
__device__ __forceinline__ void dw_load(const bf16_t* P, int r, int col, DwRows& d) {
    const int s = seq_of_row(r), p = r - seq_base(s); const bool hasp = p > 0, hasn = p < seq_len(s) - 1;
    const bf16_t* gp = P + (size_t)r * INW + col;
    d.gm = *(const u32x4*)(gp - (hasp ? INW : 0)); d.g0 = *(const u32x4*)gp; d.gn = *(const u32x4*)(gp + (hasn ? INW : 0));
    d.mp_ = hasp ? 1.f : 0.f; d.mn_ = hasn ? 1.f : 0.f;
}
__device__ __forceinline__ void dw_taps(const float* cw, const float* cb, int ucol, DwTaps& w) {
#pragma unroll
    for (int h = 0; h < 2; ++h) { w.a[h] = *(const f32x4*)(cw + ucol + 4 * h); w.b[h] = *(const f32x4*)(cw + 1536 + ucol + 4 * h); w.c[h] = *(const f32x4*)(cw + 2 * 1536 + ucol + 4 * h); w.d[h] = *(const f32x4*)(cb + ucol + 4 * h); }
}
__device__ __forceinline__ void dw_apply(const DwRows& d, const DwTaps& w, float* out) {
    float fm[8], f0[8], fn[8]; unpack8(d.gm, fm); unpack8(d.g0, f0); unpack8(d.gn, fn);
#pragma unroll
    for (int e = 0; e < 8; ++e) out[e] = w.a[e >> 2][e & 3] * (fm[e] * d.mp_) + w.b[e >> 2][e & 3] * f0[e] + w.c[e >> 2][e & 3] * (fn[e] * d.mn_) + w.d[e >> 2][e & 3];
}
__device__ __forceinline__ void p_h1(const CArgs& A, const Frame& F, int layer) {
    const bf16_t* P = (const bf16_t*)(F.ws + WS_PROJ); bf16_t* ZT = (bf16_t*)(F.ws + WS_XNR);
    const float* cw = FIN(9) + (size_t)layer * 3 * 1536; const float* cb = FIN(10) + layer * 1536;
    LAS bf16_t* scr = (LAS bf16_t*)(F.lds + F.wave * 16384);
    const int gw = F.vcu * NWAVES + F.wave, NGW = F.G * NWAVES, lane = F.lane, rs = lane >> 3, ck = lane & 7;
    for (int it = gw; it < (MP / 64) * 8; it += NGW) {
        const int rt = it >> 3, cc = it & 7, c0 = cc * 64 + ck * 8;
        DwTaps wa, wb; dw_taps(cw, cb, 512 + c0, wa); dw_taps(cw, cb, 1024 + c0, wb);
#pragma unroll
        for (int hb = 0; hb < 2; ++hb) { DwRows da[4], db[4];
#pragma unroll
            for (int q = 0; q < 4; ++q) { const int r = rt * 64 + (hb * 4 + q) * 8 + rs, rc = r < MROWS ? r : MROWS - 1; dw_load(P, rc, C_X1 + c0, da[q]); dw_load(P, rc, C_VV + c0, db[q]); }
            asm volatile("" ::: "memory");
#pragma unroll
            for (int q = 0; q < 4; ++q) { const int lr = (hb * 4 + q) * 8 + rs, r = rt * 64 + lr; float a[8], b[8]; dw_apply(da[q], wa, a); dw_apply(db[q], wb, b);
                const float ok = r < MROWS ? 1.f : 0.f;
#pragma unroll
                for (int e = 0; e < 8; ++e) scr[(ck * 8 + e) * 72 + lr] = (bf16_t)f2bf(a[e] * b[e] * ok); }
            asm volatile("" ::: "memory"); }
        LDS_WAIT();
#pragma unroll
        for (int j = 0; j < 8; ++j) { const int chn = (lane >> 3) + 8 * j, pc = lane & 7;
            const u32x4 w = *(const LAS u32x4*)(scr + chn * 72 + pc * 8);
            *(u32x4*)(ZT + (size_t)(cc * 64 + chn) * MP + rt * 64 + pc * 8) = w; }
        LDS_WAIT();
    }
}

__device__ __forceinline__ void p_h2_ref(const CArgs& A, const Frame& F) {
    const bf16_t* ZT = (const bf16_t*)(F.ws + WS_XNR); bf16_t* CT = (bf16_t*)(F.ws + WS_XNR + (size_t)512 * MP * 2);
    const int gt = (F.vcu * NWAVES + F.wave) * 64 + F.lane, NGT = F.G * NWAVES * 64;
    for (long idx = gt; idx < (long)512 * MP; idx += NGT) {
        const int c = (int)(idx / MP), r = (int)(idx - (long)c * MP);
        float acc = 0.f;
        if (r < MROWS) {
            const int s = seq_of_row(r), base = seq_base(s), L = seq_len(s), p = r - base, cls = s < 8 ? 0 : 1;
            const bf16_t* rk = (const bf16_t*)(F.ws + (cls ? WS_RKS : WS_RKP)) + (size_t)c * (cls ? RKLEN_S : RKLEN_P) + RK_PAD + L - p;
            const bf16_t* z = ZT + (size_t)c * MP + base;
            for (int s8 = 0; s8 < L; s8 += 8) { const u32x4 zw = *(const u32x4*)(z + s8); float zf[8]; unpack8(zw, zf);
#pragma unroll
                for (int e = 0; e < 8; ++e) acc += zf[e] * __uint_as_float((unsigned)rk[s8 + e] << 16); }
        }
        CT[idx] = (bf16_t)f2bf(acc);
    }
}
constexpr int H2_ZOFF_S = ((RKLEN_S * 2 + 1023) >> 10) << 10, H2_ZOFF_P = ((RKLEN_P * 2 + 1023) >> 10) << 10;
constexpr int H2_ZPADL_S = 4096, H2_ZSLOTS_S = 24704, H2_ZPADL_P = 512, H2_ZSLOTS_P = 3072, H2_SZP = 6976;
static_assert(H2_ZOFF_S + (H2_ZSLOTS_S + (H2_ZSLOTS_S >> 7) * 16) * 2 <= RING_BYTES_C && H2_ZOFF_P + 8 * H2_SZP <= RING_BYTES_C, "H2 LDS");
__device__ __forceinline__ void p_h2(const Frame& F) {
    const bf16_t* ZT = (const bf16_t*)(F.ws + WS_XNR); bf16_t* CT = (bf16_t*)(F.ws + WS_XNR + (size_t)512 * MP * 2);
    const int lane = F.lane, wave = F.wave, tid = F.tid;
    LAS float* red = (LAS float*)(F.lds + LDSCTL_OFF_C + 1024);
    for (int item = F.vcu; item < 1024; item += F.G) {
        const int cls = item < 512 ? 1 : 0, c = item & 511;
        const int L = cls ? LS : LP, rklen = cls ? RKLEN_S : RKLEN_P, ZPADL = cls ? H2_ZPADL_S : H2_ZPADL_P, zs8 = (cls ? H2_ZSLOTS_S : H2_ZSLOTS_P) / 8;
        LAS unsigned char* rkl = F.lds; LAS unsigned char* zl = F.lds + (cls ? H2_ZOFF_S : H2_ZOFF_P);
        {
          const char* rkg = (const char*)((const bf16_t*)(F.ws + (cls ? WS_RKS : WS_RKP)) + (size_t)c * rklen);
          const int npc = (rklen * 2 + 1023) >> 10;
          for (int pc = wave; pc < npc; pc += NWAVES)
              __builtin_amdgcn_global_load_lds((const unsigned*)(rkg + (size_t)pc * 1024 + lane * 16), (LAS unsigned*)(rkl + pc * 1024), 16, 0, 0);
          const int nsl = (cls ? 1 : 8) * zs8; u32x4 zv[7];
#pragma unroll
          for (int j = 0; j < 7; ++j) { const int i = tid + j * (NWAVES * 64); const int sq = i / zs8, i8 = i - sq * zs8, sp = i8 * 8 - ZPADL;
              zv[j] = (u32x4){0u, 0u, 0u, 0u};
              if (i < nsl && sp >= 0 && sp < L) zv[j] = *(const u32x4*)(ZT + (size_t)c * MP + (cls ? ROWS_P : sq * LP) + sp); }
#pragma unroll
          for (int j = 0; j < 7; ++j) { const int i = tid + j * (NWAVES * 64); const int sq = i / zs8, i8 = i - sq * zs8; const int pos = i8 * 8, el = pos + ((pos >> 7) << 4);
              if (i < nsl) *(LAS u32x4*)(zl + sq * H2_SZP + el * 2) = zv[j]; }
          asm volatile("s_waitcnt vmcnt(0)" ::: "memory"); }
        __syncthreads();
        const int n = lane & 15, h = lane >> 4, cg = wave & 3, us = wave >> 2;
        int T0a, zb, T0min, T0max, rowbase;
        const int T0g = cls ? 128 * 16 : 256; const int zg1 = (T0g + (T0g >> 7) * 16) * 2;
        if (cls) { T0min = 16 + 128 * 32 * cg; T0max = T0min + 128 * 31; T0a = T0min + 128 * n; zb = 0; rowbase = ROWS_P; }
        else { const int sq = n >> 1; T0min = 16 + 512 * cg; T0max = T0min + 384; T0a = T0min + 128 * (n & 1); zb = sq * H2_SZP; rowbase = sq * LP; }
        const int u_lo = -(((T0max + 7 + 31) >> 5) << 5), u_hi = ((L - 32 - T0min + 31) >> 5) << 5;
        const int nst = (u_hi - u_lo) / 32 + 1, nh = (nst + 1) >> 1;
        const int u_a = us ? u_lo + 32 * nh : u_lo, u_b = us ? u_hi : u_lo + 32 * (nh - 1);
        const int abase = RK_PAD + L - 8 * n + 8 * h;
        f32x4 acc[2][8];
#pragma unroll
        for (int g = 0; g < 2; ++g)
#pragma unroll
            for (int t = 0; t < 8; ++t) acc[g][t] = (f32x4){0.f, 0.f, 0.f, 0.f};
#define H2_STEP(V0, V1) do { \
            const LAS unsigned char* ap = rkl + (abase + u) * 2; \
            const u32x4 Lo = *(const LAS u32x4*)(ap - 16), Hi = *(const LAS u32x4*)ap; \
            bf16x8 Bz[2]; \
            { const int i0 = T0a + u + 8 * h + ZPADL, e0 = i0 + ((i0 >> 7) << 4); const LAS unsigned char* zp = zl + zb + e0 * 2; \
              if (V0) Bz[0] = *(const LAS bf16x8*)zp; if (V1) Bz[1] = *(const LAS bf16x8*)(zp + zg1); } \
            unsigned W[8] = {Lo.x, Lo.y, Lo.z, Lo.w, Hi.x, Hi.y, Hi.z, Hi.w}, Od[7]; \
            _Pragma("unroll") for (int k = 0; k < 7; ++k) Od[k] = __builtin_amdgcn_alignbit(W[k + 1], W[k], 16); \
            _Pragma("unroll") for (int t = 0; t < 8; ++t) { const int i = 4 - ((t + 1) >> 1); \
                const u32x4 fw = (t & 1) ? (u32x4){Od[i], Od[i + 1], Od[i + 2], Od[i + 3]} : (u32x4){W[i], W[i + 1], W[i + 2], W[i + 3]}; \
                const bf16x8 Af = __builtin_bit_cast(bf16x8, fw); \
                if (V0) acc[0][t] = __builtin_amdgcn_mfma_f32_16x16x32_bf16(Af, Bz[0], acc[0][t], 0, 0, 0); \
                if (V1) acc[1][t] = __builtin_amdgcn_mfma_f32_16x16x32_bf16(Af, Bz[1], acc[1][t], 0, 0, 0); } } while (0)
        { const int gspan = cls ? 128 * 15 : 128;
          int u0s = -(T0min + gspan + 39); u0s = u0s >= 0 ? ((u0s + 31) >> 5) << 5 : -((-u0s) >> 5 << 5);
          int u1e = L - (T0min + T0g); u1e = u1e >= 0 ? ((u1e + 31) >> 5) << 5 : -((-u1e) >> 5 << 5);
          const int ua2 = u0s > u_a ? (u0s < u_b + 32 ? u0s : u_b + 32) : u_a;
          const int ub2 = u1e < u_b + 32 ? (u1e > ua2 ? u1e : ua2) : u_b + 32;
          int u = u_a;
          for (; u < ua2; u += 32) H2_STEP(false, true);
          for (; u < ub2; u += 32) H2_STEP(true, true);
          for (; u <= u_b; u += 32) H2_STEP(true, false); }
#undef H2_STEP
        { float m[16];
#pragma unroll
          for (int t = 0; t < 16; ++t) m[t] = 0.f;
          const int nchunk = L / 8, cstep = cls ? NWAVES * 64 : 64; const int zb2 = cls ? 0 : wave * H2_SZP;
          for (int ck = cls ? tid : lane; ck < nchunk; ck += cstep) { const int s0 = ck * 8, i0 = s0 + ZPADL, e0 = i0 + ((i0 >> 7) << 4);
              const u32x4 zw = *(const LAS u32x4*)(zl + zb2 + e0 * 2);
              const LAS unsigned char* rp = rkl + (RK_PAD + L + s0 - 16) * 2;
              const u32x4 r0 = *(const LAS u32x4*)rp, r1 = *(const LAS u32x4*)(rp + 16), r2 = *(const LAS u32x4*)(rp + 32);
              float zf[8], rf[24]; unpack8(zw, zf); unpack8(r0, rf); unpack8(r1, rf + 8); unpack8(r2, rf + 16);
#pragma unroll
              for (int t = 0; t < 16; ++t)
#pragma unroll
                  for (int e = 0; e < 8; ++e) m[t] += zf[e] * rf[16 + e - t]; }
#pragma unroll
          for (int t = 0; t < 16; ++t) m[t] = wave_sum(m[t], lane);
          float mine = 0.f;
#pragma unroll
          for (int t = 0; t < 16; ++t) mine = (lane == t) ? m[t] : mine;
          if (cls) { if (lane < 16) red[wave * 16 + lane] = mine; }
          else if (lane < 16) CT[(size_t)c * MP + wave * LP + lane] = (bf16_t)f2bf(mine); }
        __syncthreads();
        if (us == 1) {
#pragma unroll
            for (int g = 0; g < 2; ++g)
#pragma unroll
                for (int t = 0; t < 8; ++t) *(LAS f32x4*)(F.lds + cg * 16384 + (g * 8 + t) * 1024 + lane * 16) = acc[g][t]; }
        if (cls && tid < 16) { float a = 0.f;
#pragma unroll
            for (int w = 0; w < 8; ++w) a += red[w * 16 + tid];
            CT[(size_t)c * MP + ROWS_P + tid] = (bf16_t)f2bf(a); }
        __syncthreads();
        if (us == 0) {
#pragma unroll
            for (int g = 0; g < 2; ++g) {
#pragma unroll
                for (int t = 0; t < 8; ++t) acc[g][t] += *(const LAS f32x4*)(F.lds + cg * 16384 + (g * 8 + t) * 1024 + lane * 16);
                bf16_t* op = CT + (size_t)c * MP + rowbase + T0a + g * T0g + 32 * h;
#pragma unroll
                for (int i = 0; i < 4; ++i) { u32x4 w; w.x = pk2(acc[g][0][i], acc[g][1][i]); w.y = pk2(acc[g][2][i], acc[g][3][i]); w.z = pk2(acc[g][4][i], acc[g][5][i]); w.w = pk2(acc[g][6][i], acc[g][7][i]);
                    *(u32x4*)(op + 8 * i) = w; } } }
        __syncthreads();
    }
}
__device__ __forceinline__ void p_pool(const CArgs& A, const Frame& F) {
    bf16_t* P = (bf16_t*)(F.ws + WS_PROJ);
    const int gw = F.vcu * NWAVES + F.wave, NGW = F.G * NWAVES, lane = F.lane, c0 = lane * 8, hw = 1 << (lane >> 4);
    for (int run = gw; run < MROWS / 16; run += NGW) {
        const int r0 = run * 16, s = seq_of_row(r0), base = seq_base(s), L = seq_len(s), p0 = r0 - base;
        const bf16_t* ub = P + (size_t)base * INW + C_PU + c0;
        float S[8];
#pragma unroll
        for (int e = 0; e < 8; ++e) S[e] = 0.f;
#pragma unroll
        for (int i = 0; i < 16; ++i) { const int pp = p0 - hw + i; const bool ok = i < 2 * hw && pp >= 0 && pp < L;
            const u32x4 w = *(const u32x4*)(ub + (size_t)(ok ? pp : p0) * INW); float f[8]; unpack8(w, f); const float mk = ok ? 1.f : 0.f;
#pragma unroll
            for (int e = 0; e < 8; ++e) S[e] += mk * f[e]; }
#pragma unroll 4
        for (int k = 0; k < 16; ++k) { const int p = p0 + k, pn = p + hw, po = p - hw; const bool okn = pn < L, oko = po >= 0;
            const u32x4 ws_ = *(const u32x4*)(ub + (size_t)p * INW), wn = *(const u32x4*)(ub + (size_t)(okn ? pn : p) * INW), wo = *(const u32x4*)(ub + (size_t)(oko ? po : p) * INW);
            float fs[8], fn[8], fo[8]; unpack8(ws_, fs); unpack8(wn, fn); unpack8(wo, fo);
            const int lo = po < 0 ? 0 : po, hi = pn > L ? L : pn; const float ic = 1.f / (float)(hi - lo);
            float a[8];
#pragma unroll
            for (int e = 0; e < 8; ++e) a[e] = (DBG & 16) ? 0.f : S[e] * ic - fs[e];
            u32x4 w; w.x = pk2(a[0], a[1]); w.y = pk2(a[2], a[3]); w.z = pk2(a[4], a[5]); w.w = pk2(a[6], a[7]);
            *(u32x4*)(P + (size_t)(r0 + k) * INW + C_X1 + c0) = w;
            const float mn = okn ? 1.f : 0.f, mo = oko ? 1.f : 0.f;
#pragma unroll
            for (int e = 0; e < 8; ++e) S[e] += mn * fn[e] - mo * fo[e]; }
    }
}
__device__ __forceinline__ void p_final(const CArgs& A, const Frame& F, int layer) {
    bf16_t* P = (bf16_t*)(F.ws + WS_PROJ); const bf16_t* ZT = (const bf16_t*)(F.ws + WS_XNR); const bf16_t* CT = ZT + (size_t)512 * MP;
    const float* cw = FIN(9) + (size_t)layer * 3 * 1536; const float* cb = FIN(10) + layer * 1536; const float* skip = FIN(17) + layer * 512;
    LAS bf16_t* sz = (LAS bf16_t*)(F.lds + F.wave * 16384); LAS bf16_t* sc = sz + 64 * 64;
    const int gw = F.vcu * NWAVES + F.wave, NGW = F.G * NWAVES, lane = F.lane, rs = lane >> 3, ck = lane & 7;
    for (int it = gw; it < (MP / 64) * 8; it += NGW) {
        const int rt = it >> 3, cc = it & 7, c0 = cc * 64 + ck * 8; const int cls = rt * 64 < ROWS_P ? 0 : 1;
        const float* sums = (const float*)(F.ws + WS_CTL) + CW_SUMS + (layer * 2 + cls) * 512;
#pragma unroll
        for (int j = 0; j < 8; ++j) { const int chn = (lane >> 3) + 8 * j, pc = lane & 7; const size_t off = (size_t)(cc * 64 + chn) * MP + rt * 64 + pc * 8;
            *(LAS u32x4*)(sz + chn * 64 + pc * 8) = *(const u32x4*)(ZT + off); *(LAS u32x4*)(sc + chn * 64 + pc * 8) = *(const u32x4*)(CT + off); }
        LDS_WAIT();
        DwTaps wt; dw_taps(cw, cb, c0, wt); float isum[8], sk[8];
        { const f32x4 s0 = *(const f32x4*)(sums + c0), s1 = *(const f32x4*)(sums + c0 + 4), k0 = *(const f32x4*)(skip + c0), k1 = *(const f32x4*)(skip + c0 + 4);
#pragma unroll
          for (int e = 0; e < 4; ++e) { isum[e] = 1.f / s0[e]; isum[4 + e] = 1.f / s1[e]; sk[e] = k0[e]; sk[4 + e] = k1[e]; } }
#pragma unroll
        for (int hb = 0; hb < 2; ++hb) { DwRows dr[4];
#pragma unroll
            for (int q = 0; q < 4; ++q) { const int r = rt * 64 + (hb * 4 + q) * 8 + rs; dw_load(P, r < MROWS ? r : MROWS - 1, C_X0 + c0, dr[q]); }
            asm volatile("" ::: "memory");
#pragma unroll
            for (int q = 0; q < 4; ++q) { const int lr = (hb * 4 + q) * 8 + rs, r = rt * 64 + lr; float x0[8], o[8]; dw_apply(dr[q], wt, x0);
#pragma unroll
                for (int e = 0; e < 8; ++e) { const float z = __uint_as_float((unsigned)sz[(ck * 8 + e) * 64 + lr] << 16), cv = __uint_as_float((unsigned)sc[(ck * 8 + e) * 64 + lr] << 16);
                    o[e] = (DBG & 8) ? 0.f : (((DBG & 64) ? 0.f : cv * isum[e]) + ((DBG & 128) ? 0.f : z * sk[e])) * x0[e]; }
                u32x4 w; w.x = pk2(o[0], o[1]); w.y = pk2(o[2], o[3]); w.z = pk2(o[4], o[5]); w.w = pk2(o[6], o[7]);
                if (r < MROWS) *(u32x4*)(P + (size_t)r * INW + C_VV + c0) = w; }
            asm volatile("" ::: "memory"); }
        LDS_WAIT();
    }
}
__device__ __forceinline__ void p_norm2(const CArgs& A, const Frame& F, int layer) {
    const int gw = F.vcu * NWAVES + F.wave, NGW = F.G * NWAVES, lane = F.lane;
    const float* g = FIN(24) + layer * DM; bf16_t* XN = (bf16_t*)(F.ws + WS_XNR);
    for (int r0 = gw; r0 < MP; r0 += 2 * NGW) { f32x4 v[2][4]; const int r1 = r0 + NGW;
        { const f32x4* xr = (const f32x4*)xrow(F.out, F.xm, r0) + lane;
#pragma unroll
          for (int j = 0; j < 4; ++j) v[0][j] = xr[64 * j]; }
        if (r1 < MP) { const f32x4* xr = (const f32x4*)xrow(F.out, F.xm, r1) + lane;
#pragma unroll
          for (int j = 0; j < 4; ++j) v[1][j] = xr[64 * j]; }
        rms_row(v[0], g, XN + (size_t)r0 * DM, lane);
        if (r1 < MP) rms_row(v[1], g, XN + (size_t)r1 * DM, lane); }
}

constexpr int TAIL_ROW0 = 32768, TAIL_ITEMS = ((MROWS - TAIL_ROW0) / 16) * 16;
static_assert(MROWS - TAIL_ROW0 == 144 && TAIL_ROW0 % 256 == 0, "tail rows");
template <int NS>
__device__ __forceinline__ void tail_partial(f32x4 (&acc)[4], const bf16_t* ap, const bf16_t* bp, size_t bstride16) {
#pragma unroll
    for (int s0 = 0; s0 < NS; s0 += 4) {
        bf16x8 a[4], b[4][4];
#pragma unroll
        for (int s = 0; s < 4; ++s) if (s0 + s < NS) { a[s] = *(const bf16x8*)(ap + (s0 + s) * 32);
#pragma unroll
            for (int j = 0; j < 4; ++j) b[s][j] = *(const bf16x8*)(bp + j * bstride16 + (s0 + s) * 32); }
#pragma unroll
        for (int s = 0; s < 4; ++s) if (s0 + s < NS) {
#pragma unroll
            for (int j = 0; j < 4; ++j) acc[j] = __builtin_amdgcn_mfma_f32_16x16x32_bf16(b[s][j], a[s], acc[j], 0, 0, 0); }
        asm volatile("" ::: "memory");
    }
}
template <int K>
__device__ __forceinline__ void tail_res(const Frame& F, const bf16_t* A, const bf16_t* Bt) {
    constexpr int KW = K / 8, NS = KW / 32; static_assert(K % 256 == 0, "K split");
    const int lane = F.lane, fr = lane & 15, fq = lane >> 4, tid = F.tid;
    for (int item = F.bx; item < TAIL_ITEMS; item += F.G) {
        const int row0 = TAIL_ROW0 + (item >> 4) * 16, col0 = (item & 15) * 64;
        f32x4 acc[4];
#pragma unroll
        for (int j = 0; j < 4; ++j) acc[j] = (f32x4){0.f, 0.f, 0.f, 0.f};
        tail_partial<NS>(acc, A + (size_t)(row0 + fr) * K + F.wave * KW + fq * 8, Bt + (size_t)(col0 + fr) * K + F.wave * KW + fq * 8, (size_t)16 * K);
#pragma unroll
        for (int j = 0; j < 4; ++j) *(LAS f32x4*)(F.lds + F.wave * 4096 + j * 1024 + lane * 16) = acc[j];
        __syncthreads();
        f32x2 s = {0.f, 0.f};
#pragma unroll
        for (int w = 0; w < 8; ++w) s += *(const LAS f32x2*)(F.lds + w * 4096 + tid * 8);
        const int j = tid >> 7, l = (tid & 127) >> 1, r = (tid & 1) * 2;
        float* p = xrow(F.out, F.xm, row0 + (l & 15)) + col0 + j * 16 + 4 * (l >> 4) + r;
        f32x2 v = *(f32x2*)p; v += s; if (!F.dry) *(f32x2*)p = v;
        __syncthreads();
    }
}
__device__ __forceinline__ void tail_merge(const Frame& F, const bf16_t* P, const bf16_t* WM, bf16_t* O) {
    const int lane = F.lane, fr = lane & 15, fq = lane >> 4, tid = F.tid;
    for (int item = F.bx; item < TAIL_ITEMS; item += F.G) {
        const int row0 = TAIL_ROW0 + (item >> 4) * 16, col0 = (item & 15) * 64;
#pragma unroll
        for (int s = 0; s < 3; ++s) { const int col = s == 0 ? C_Q : (s == 1 ? C_VV : C_X1);
            f32x4 acc[4];
#pragma unroll
            for (int j = 0; j < 4; ++j) acc[j] = (f32x4){0.f, 0.f, 0.f, 0.f};
            tail_partial<2>(acc, P + (size_t)(row0 + fr) * INW + col + F.wave * 64 + fq * 8, WM + ((size_t)s * DM + col0 + fr) * 512 + F.wave * 64 + fq * 8, (size_t)16 * 512);
#pragma unroll
            for (int j = 0; j < 4; ++j) *(LAS f32x4*)(F.lds + s * 32768 + F.wave * 4096 + j * 1024 + lane * 16) = acc[j]; }
        __syncthreads();
        const int j = tid >> 7, l = (tid & 127) >> 1, r = (tid & 1) * 2, row = row0 + (l & 15), colo = col0 + j * 16 + 4 * (l >> 4) + r;
        const unsigned char* gp = (const unsigned char*)(P + (size_t)row * INW) + C_G * 2 + colo;
        f32x2 o = {0.f, 0.f};
#pragma unroll
        for (int s = 0; s < 3; ++s) { f32x2 t = {0.f, 0.f};
#pragma unroll
            for (int w = 0; w < 8; ++w) t += *(const LAS f32x2*)(F.lds + s * 32768 + w * 4096 + tid * 8);
            const unsigned g2 = *(const unsigned short*)(gp + s * DM);
            o.x += t.x * ((float)(g2 & 255u) * (1.f / 255.f)); o.y += t.y * ((float)(g2 >> 8) * (1.f / 255.f)); }
        *(unsigned*)(O + (size_t)row * DM + colo) = pg8::cvt_pk_bf16(o.x, o.y);
        __syncthreads();
    }
}

constexpr int PH_PER_LAYER = 11, N_PHASES = 2 * PH_PER_LAYER;
__global__ void __launch_bounds__(NWAVES * 64, 2) fwd_kernel(Args args0) {
    extern __shared__ __attribute__((aligned(16))) unsigned char lds_raw[];
    const int wave0 = __builtin_amdgcn_readfirstlane(threadIdx.x >> 6);
    {
        for (int u = threadIdx.x; u < (LDS_BYTES - LDSCTL_OFF) / 4; u += NWAVES * 64) ((LAS unsigned*)((LAS unsigned char*)lds_raw + LDSCTL_OFF))[u] = 0u;
        __syncthreads();
    }
    XcdBarrier bar; bar.bar = (unsigned*)(args0.ws + WS_CTL) + CW_BAR; bar.x = 0; bar.st = nullptr;
    if (args0.use_bar) bar = xcd_barrier_post((unsigned*)(args0.ws + WS_CTL) + CW_BAR, (volatile LAS unsigned*)((LAS unsigned char*)lds_raw + MISC_OFF) + 8);
    for (int ph2 = 2 * args0.ph_lo; ph2 < 2 * args0.ph_hi; ++ph2) {
        const int ph = ph2 >> 1, rep = ph2 & 1;
        const int layer = ph / PH_PER_LAYER, k = ph % PH_PER_LAYER;
        if (rep == 1 && !(DUP_PHASE >= 0 && k == DUP_PHASE && args0.pad == 0)) continue;
        const __attribute__((address_space(4))) Args* ap = (const __attribute__((address_space(4))) Args*)__builtin_amdgcn_kernarg_segment_ptr();
        asm volatile("" : "+s"(ap));
        const __attribute__((address_space(4))) Args& args = *ap;
        Frame F;
        { int w_ = wave0; asm volatile("" : "+s"(w_)); int z_ = 0; asm volatile("" : "+v"(z_)); const int l_ = __builtin_amdgcn_mbcnt_hi(-1, __builtin_amdgcn_mbcnt_lo(-1, z_));
          F.lane = l_; F.wave = w_; F.tid = w_ * 64 + l_;
          int bx = blockIdx.x, G_ = gridDim.x; asm volatile("" : "+s"(bx), "+s"(G_)); F.G = G_; F.vcu = (G_ % 8 == 0) ? (bx % 8) * (G_ / 8) + bx / 8 : bx; F.bx = bx;
          F.dry = rep; F.lds = (LAS unsigned char*)lds_raw; F.ws = args.ws; F.out = args.out; F.xm = (float*)(args.ws + WS_XM); }
        unsigned char* W = F.ws + WS_W;
        bf16_t* XNR = (bf16_t*)(F.ws + WS_XNR); bf16_t* PROJ = (bf16_t*)(F.ws + WS_PROJ);
        bf16_t* GB = PROJ; bf16_t* ACT = PROJ + (size_t)MP * DFF;
#ifndef ONLY_PHASE
#define ONLY_PHASE -1
#endif
#define PHS(x) ((ONLY_PHASE < 0 || ONLY_PHASE == (x)) && k == (x) && !((DBG & 1) && (x) >= 1 && (x) <= 6) && !((DBG & 2) && (x) >= 7) && !((DBG & 32) && layer > 0))
        if (PHS(0)) p_prep(args, F, layer);
        else if (PHS(1)) { OpsPlain O{XNR, (const bf16_t*)(W + W_IN), DM, DM}; pg8::StaticOrder S; S.init(MP, INW, F.G, F.bx, 1); EpiStore E{PROJ, INW, C_G / 256};
            pg8::gemm_phase<EpiStore, OpsPlain, true>(F.lds, O, S, E, F.tid); }
        else if (PHS(2)) { if (DBG & 512) p_attn_ref(args, F, layer); else if (DSEL(64)) p_attn(args, F, layer); if (DSEL(128)) p_h1(args, F, layer); if (DSEL(256)) p_filt_tiles(args, F, layer); }
        else if (PHS(3)) { if (DBG & 256) p_h2_ref(args, F); else if (DSEL(16)) p_h2(F); if (DSEL(32)) p_pool(args, F); }
        else if (PHS(4)) p_final(args, F, layer);
        else if (PHS(5)) { OpsMerge O{PROJ, (const bf16_t*)(W + W_MRG), 512, INW}; pg8::StaticOrder S; S.init(TAIL_ROW0, DM, F.G, F.bx, 3); EpiMerge E{PROJ, XNR};
            pg8::gemm_phase<EpiMerge, OpsMerge, true>(F.lds, O, S, E, F.tid); tail_merge(F, PROJ, (const bf16_t*)(W + W_MRG), XNR); }
        else if (PHS(6)) { OpsPlain O{XNR, (const bf16_t*)(W + W_OUT), DM, DM}; pg8::StaticOrder S; S.init(TAIL_ROW0, DM, F.G, F.bx, 1); EpiRes E{F.out, F.xm, F.dry};
            pg8::gemm_phase<EpiRes, OpsPlain, true>(F.lds, O, S, E, F.tid); tail_res<DM>(F, XNR, (const bf16_t*)(W + W_OUT)); }
        else if (PHS(7)) p_norm2(args, F, layer);
        else if (PHS(8)) { OpsPlain O{XNR, (const bf16_t*)(W + W_G), DM, DM}; pg8::StaticOrder S; S.init(MP, DFF, F.G, F.bx, 1); EpiStore E{GB, DFF, 1 << 20};
            pg8::gemm_phase<EpiStore, OpsPlain, true>(F.lds, O, S, E, F.tid); }
        else if (PHS(9)) { OpsPlain O{XNR, (const bf16_t*)(W + W_U), DM, DM}; pg8::StaticOrder S; S.init(MP, DFF, F.G, F.bx, 1);
            EpiGeluMul E{GB, args.in[27] + (size_t)layer * 3 * DFF, args.in[28] + layer * DFF, ACT, F.dry ? DRYVAR : 0};
            pg8::gemm_phase<EpiGeluMul, OpsPlain, true>(F.lds, O, S, E, F.tid); }
        else if (PHS(10)) { OpsPlain O{ACT, (const bf16_t*)(W + W_D), DFF, DFF}; pg8::StaticOrder S; S.init(TAIL_ROW0, DM, F.G, F.bx, 1); EpiRes E{F.out, F.xm, F.dry};
            pg8::gemm_phase<EpiRes, OpsPlain, true>(F.lds, O, S, E, F.tid); tail_res<DFF>(F, ACT, (const bf16_t*)(W + W_D)); }
        if (ph2 + 1 < 2 * args0.ph_hi) { { int z2_ = 0; asm volatile("" : "+v"(z2_)); const int tid2 = wave0 * 64 + __builtin_amdgcn_mbcnt_hi(-1, __builtin_amdgcn_mbcnt_lo(-1, z2_));
              if (args0.use_bar) xcd_barrier(bar, tid2); else __syncthreads(); } }
    }
}

__global__ void fill_k(float* o, size_t n, float v) { size_t i = (size_t)blockIdx.x * blockDim.x + threadIdx.x; for (; i < n; i += (size_t)gridDim.x * blockDim.x) o[i] = v; }
extern "C" void kernel_launch(void* const* d_in, const int* in_sizes, int n_in, void* d_out, int out_size, void* d_ws, size_t ws_size, hipStream_t stream) {
    static int grid = 0;
    if (grid == 0) {
        int dev = 0, cus = 0;
        if (n_in != 30 || out_size != 32768 * DM || ws_size < WS_END || hipGetDevice(&dev) != hipSuccess || hipDeviceGetAttribute(&cus, hipDeviceAttributeMultiprocessorCount, dev) != hipSuccess ||
            hipFuncSetAttribute((const void*)fwd_kernel, hipFuncAttributeMaxDynamicSharedMemorySize, LDS_BYTES) != hipSuccess) { fprintf(stderr, "kernel_launch: bad shapes / workspace / device\n"); grid = -1; }
        else { int per_cu = 0; (void)hipOccupancyMaxActiveBlocksPerMultiprocessor(&per_cu, (const void*)fwd_kernel, NWAVES * 64, LDS_BYTES); (void)hipGetLastError();
            grid = cus * (per_cu >= 1 ? 1 : 0); if (grid <= 0) grid = -1; }
    }
    if (grid < 0) { fill_k<<<1024, 256, 0, stream>>>((float*)d_out, (size_t)out_size, 1e6f); return; }
    (void)hipMemsetAsync((char*)d_ws + WS_CTL, 0, CTL_ZERO_BYTES, stream);
    Args a{};
    for (int i = 0; i < 30; ++i) a.in[i] = (const float*)d_in[i];
    a.out = (float*)d_out; a.ws = (unsigned char*)d_ws;
#if MK_N_LAUNCHES == 1
    a.ph_lo = 0; a.ph_hi = N_PHASES; a.use_bar = 1;
    void* kargs[] = {&a};
    hipError_t e = hipLaunchCooperativeKernel((const void*)fwd_kernel, dim3(grid), dim3(NWAVES * 64), kargs, LDS_BYTES, stream);
    if (e != hipSuccess) fprintf(stderr, "cooperative launch failed: %s\n", hipGetErrorString(e));
#else
    for (int ph = 0; ph < N_PHASES; ++ph) { a.ph_lo = ph; a.ph_hi = ph + 1; a.use_bar = 0;
        hipLaunchKernelGGL(fwd_kernel, dim3(grid), dim3(NWAVES * 64), LDS_BYTES, stream, a); }
#endif
}
```

```cpp
#include <hip/hip_runtime.h>
#include <cstdio>
#include <cstdint>
#include <cmath>

#ifndef DBG
#define DBG 0
#endif
#ifndef DUP_PHASE
#define DUP_PHASE -1
#endif
#ifndef FT_RECOMPUTE
#define FT_RECOMPUTE 0
#endif
#ifndef DRYVAR
#define DRYVAR 0
#endif
#ifndef DUPMASK
#define DUPMASK 65535
#endif
#define DSEL(b) (!F.dry || (DUPMASK & (b)))
#ifndef MK_N_LAUNCHES
#define MK_N_LAUNCHES 1
#endif

#define LAS __attribute__((address_space(3)))
#define GAS __attribute__((address_space(1)))
typedef unsigned short bf16_t;
typedef short bf16x8 __attribute__((ext_vector_type(8)));
typedef float f32x4 __attribute__((ext_vector_type(4)));
typedef float f32x2 __attribute__((ext_vector_type(2)));
typedef float f32x16 __attribute__((ext_vector_type(16)));
typedef unsigned u32x4 __attribute__((ext_vector_type(4)));
typedef unsigned u32x2 __attribute__((ext_vector_type(2)));

constexpr int DM = 1024, INW = 5888, DFF = 2816, NHEAD = 8, HD = 64;
constexpr int LP = 2064, LS = 16400, NMETA = 16;
constexpr int ROWS_P = 8 * LP;
constexpr int MROWS = ROWS_P + LS;
constexpr int MP = 33024;
constexpr int C_Q = 0, C_K = 512, C_V = 640, C_X0 = 768, C_X1 = 1280, C_VV = 1792, C_PU = 2304, C_G = 2816;
constexpr float EPS = 1e-6f;
constexpr int RK_PAD = 256;
constexpr int RKLEN_P = 2 * LP + 512, RKLEN_S = 2 * LS + 512;

constexpr size_t MiB = 1u << 20;
constexpr size_t WS_CTL = 0, CTL_ZERO_BYTES = 1 * MiB;
constexpr size_t WS_XM = 1 * MiB;
constexpr size_t WS_W = 3 * MiB;
constexpr size_t W_IN = 0, W_G = W_IN + (size_t)INW * DM * 2, W_U = W_G + (size_t)DFF * DM * 2, W_D = W_U + (size_t)DFF * DM * 2,
                 W_OUT = W_D + (size_t)DM * DFF * 2, W_MRG = W_OUT + (size_t)DM * DM * 2, W_END = W_MRG + (size_t)3 * DM * 512 * 2;
static_assert(WS_W + W_END <= 36 * MiB, "weights");
constexpr size_t WS_RKP = 36 * MiB;
constexpr size_t WS_RKS = WS_RKP + (size_t)512 * RKLEN_P * 2;
static_assert(WS_RKS + (size_t)512 * RKLEN_S * 2 <= 74 * MiB, "filters");
constexpr size_t WS_XNR = 74 * MiB;
constexpr size_t XNR_BYTES = (size_t)MP * DM * 2;
constexpr size_t WS_PROJ = 139 * MiB;
constexpr size_t WS_END = WS_PROJ + (size_t)MP * INW * 2;
static_assert(WS_XNR + XNR_BYTES <= WS_PROJ && WS_END <= 512 * MiB, "d_ws map");
constexpr int CW_BAR = 4096;
constexpr int CW_SUMS = 16384;
constexpr int CW_SS = 32768;
static_assert((size_t)(CW_SS + 4 * MP) * 4 <= CTL_ZERO_BYTES, "row sums");

namespace pg8 {
constexpr int BM = 256, BK = 64, HALF = 128, HTB = HALF * BK * 2, STAGE_BYTES = 8 * HTB, NXCD = 8, WGM = 8;
__host__ __device__ __forceinline__ int lds_byte(int r, int c) { const int st = (r >> 4) * 2 + (c >> 5), rr = r & 15, cc = c & 31, ob = rr * 64 + cc * 2; return st * 1024 + (ob ^ (((ob >> 9) & 1) << 5)); }
__host__ __device__ __forceinline__ void stage_rc(int b, int& R, int& C) { const int st = b / 1024, sb = b % 1024, swz = sb ^ (((sb >> 9) & 1) << 5); R = (st >> 1) * 16 + swz / 64; C = (st & 1) * 32 + (swz % 64) / 2; }
__host__ __device__ __forceinline__ int perm32(int rho) { const int n = rho >> 4, i = rho & 15; return 8 * (i >> 2) + 4 * n + (i & 3); }

struct Unit { int pm, pn, sub; };
struct StaticOrder {
    int nM, nN, nwg, G, c, nsub;
    __device__ void init(int M, int N, int G_, int c_, int nsub_) { nM = M / BM; nN = N / BM; nwg = nM * nN; G = G_; c = c_; nsub = nsub_; }
    __device__ bool next(int i, Unit& u) const {
        const int tile = i / nsub; u.sub = i - tile * nsub;
        const long L = (long)tile * G + c; if (L >= nwg) return false;
        int wgid = (int)L; { const int q = nwg / NXCD, r = nwg % NXCD, xcd = wgid % NXCD, off = wgid / NXCD; wgid = (xcd < r ? xcd * (q + 1) : r * (q + 1) + (xcd - r) * q) + off; }
        const int nig = WGM * nN, gid = wgid / nig, fm = gid * WGM, gsz = (nM - fm) < WGM ? (nM - fm) : WGM;
        u.pm = fm + ((wgid % nig) % gsz); u.pn = (wgid % nig) / gsz; return true;
    }
};
__device__ __forceinline__ unsigned cvt_pk_bf16(float lo, float hi) { unsigned r; asm volatile("v_cvt_pk_bf16_f32 %0, %1, %2" : "=v"(r) : "v"(lo), "v"(hi)); return r; }
__device__ __forceinline__ f32x2 gelu_pk(f32x2 v) {
    const f32x2 av = __builtin_elementwise_abs(v), d = av * 0.2316418882f + 1.0f;
    f32x2 t; t.x = __builtin_amdgcn_rcpf(d.x); t.y = __builtin_amdgcn_rcpf(d.y);
    f32x2 q = t * 0.5307027145f + (-0.7265760135f); q = q * t + 0.7107068705f; q = q * t + (-0.142248368f); q = q * t + 0.127414796f; q = q * t;
    const f32x2 s = (v * v) * (-0.72134752044f);
    f32x2 e; e.x = __builtin_amdgcn_exp2f(s.x); e.y = __builtin_amdgcn_exp2f(s.y);
    const f32x2 m = v * (q * e), r = v - m;
    f32x2 o; o.x = v.x < 0.f ? m.x : r.x; o.y = v.y < 0.f ? m.y : r.y; return o;
}

template <class Epi, class Ops, bool ALIGN_EPI>
__device__ __forceinline__ void gemm_phase(LAS unsigned char* lds, const Ops& O, const StaticOrder& S, const Epi& E, int tid) {
    const int wid = __builtin_amdgcn_readfirstlane(tid >> 6), lane = tid & 63, wr = wid >> 2, wc = wid & 3, fr = lane & 15, fq = lane >> 4;
    const int K = O.K, nt = K / BK, lda = O.lda;
    unsigned voffA[2], voffB[2];
#pragma unroll
    for (int i = 0; i < 2; ++i) { int R, C; stage_rc(tid * 16 + i * 8192, R, C); const int Rb = (R & ~31) + perm32(R & 31);
        voffA[i] = (unsigned)(R * lda + C) * 2u; voffB[i] = (unsigned)(Rb * K + C) * 2u; }
    const size_t kstep = (size_t)(BK * 2);
    const size_t hstepA = (size_t)HALF * lda * 2, hstepB = (size_t)HALF * K * 2;
    const unsigned ldsw = (unsigned)wid * 1024u;
    const int aoff = lds_byte(wr * 64 + fr, fq * 8), boff = lds_byte(wc * 32 + fr, fq * 8);
#define PG8_SA(b, h) (((b) * 2 + (h)) * HTB)
#define PG8_SB(b, h) ((4 + (b) * 2 + (h)) * HTB)
#define PG8_STAGE(bufoff, gbase, voff) do { _Pragma("unroll") for (int _i = 0; _i < 2; ++_i) \
        __builtin_amdgcn_global_load_lds((const unsigned*)((const char*)(gbase) + (voff)[_i]), (LAS unsigned*)(lds + (bufoff) + ldsw + _i * 8192), 16, 0, 0); } while (0)
#define PG8_LDA(dst, b, h) do { _Pragma("unroll") for (int m = 0; m < 4; ++m) _Pragma("unroll") for (int k = 0; k < 2; ++k) dst[m][k] = *(const LAS bf16x8*)(lds + PG8_SA(b, h) + aoff + m * 2048 + k * 1024); } while (0)
#define PG8_LDB(dst, b, h) do { _Pragma("unroll") for (int n = 0; n < 2; ++n) _Pragma("unroll") for (int k = 0; k < 2; ++k) dst[n][k] = *(const LAS bf16x8*)(lds + PG8_SB(b, h) + boff + n * 2048 + k * 1024); } while (0)
#define PG8_MMA(ai, bj, At, Bt) do { __builtin_amdgcn_s_setprio(1); _Pragma("unroll") for (int m = 0; m < 4; ++m) _Pragma("unroll") for (int n = 0; n < 2; ++n) _Pragma("unroll") for (int k = 0; k < 2; ++k) \
        acc[ai][bj][m][n] = __builtin_amdgcn_mfma_f32_16x16x32_bf16(Bt[n][k], At[m][k], acc[ai][bj][m][n], 0, 0, 0); __builtin_amdgcn_s_setprio(0); } while (0)
#define PG8_WAIT_V(n) asm volatile("s_waitcnt vmcnt(" #n ")" ::: "memory")
#define PG8_WAIT_L(n) asm volatile("s_waitcnt lgkmcnt(" #n ")" ::: "memory")
#define PG8_BAR __builtin_amdgcn_s_barrier()
#define PG8_SCHED __builtin_amdgcn_sched_barrier(0)
    Unit cur, nxt; int ui = 0;
    if (!S.next(0, cur)) return;
    f32x4 acc[2][2][4][2];
#pragma unroll
    for (int a = 0; a < 2; ++a)
#pragma unroll
        for (int b = 0; b < 2; ++b)
#pragma unroll
            for (int m = 0; m < 4; ++m)
#pragma unroll
                for (int n = 0; n < 2; ++n) acc[a][b][m][n] = (f32x4){0.f, 0.f, 0.f, 0.f};
    bf16x8 At[4][2], B0[2][2], B1[2][2];
    const char* cA; const char* cB; O.ptrs(cur, cA, cB);
    PG8_STAGE(PG8_SB(0, 0), cB, voffB); PG8_STAGE(PG8_SB(0, 1), cB + hstepB, voffB); PG8_STAGE(PG8_SA(0, 0), cA, voffA); PG8_STAGE(PG8_SA(0, 1), cA + hstepA, voffA);
    if (wr == 1) PG8_BAR;
    PG8_WAIT_V(2); PG8_BAR;
    PG8_STAGE(PG8_SB(1, 0), cB + kstep, voffB); PG8_STAGE(PG8_SA(1, 0), cA + kstep, voffA); PG8_STAGE(PG8_SB(1, 1), cB + hstepB + kstep, voffB);
    PG8_WAIT_V(6); PG8_BAR;
    for (;;) {
        const bool has_next = S.next(ui + 1, nxt);
        const char* nA = cA; const char* nB = cB; if (has_next) O.ptrs(nxt, nA, nB);
        for (int t = 0; t < nt; t += 2) {
            const bool last = (t == nt - 2);
            const char* a1 = cA + (size_t)(t + 1) * kstep;
            const char* a2 = last ? nA : cA + (size_t)(t + 2) * kstep; const char* b2 = last ? nB : cB + (size_t)(t + 2) * kstep;
            const char* a3 = a2 + kstep; const char* b3 = b2 + kstep;
            PG8_LDB(B0, 0, 0); PG8_LDB(B1, 0, 1); PG8_SCHED; PG8_LDA(At, 0, 0); PG8_STAGE(PG8_SA(1, 1), a1 + hstepA, voffA);
            PG8_WAIT_V(8); PG8_WAIT_L(0); PG8_BAR; PG8_MMA(0, 0, At, B0); PG8_MMA(0, 1, At, B1); PG8_BAR; PG8_SCHED;
            PG8_LDA(At, 0, 1); PG8_STAGE(PG8_SB(0, 0), b2, voffB); PG8_STAGE(PG8_SB(0, 1), b2 + hstepB, voffB); PG8_STAGE(PG8_SA(0, 0), a2, voffA);
            PG8_WAIT_V(8); PG8_WAIT_L(0); PG8_BAR; PG8_MMA(1, 0, At, B0); PG8_MMA(1, 1, At, B1); PG8_BAR; PG8_SCHED;
            PG8_LDB(B0, 1, 0); PG8_LDB(B1, 1, 1); PG8_SCHED; PG8_LDA(At, 1, 0); PG8_STAGE(PG8_SA(0, 1), a2 + hstepA, voffA);
            PG8_WAIT_V(8); PG8_WAIT_L(0); PG8_BAR; PG8_MMA(0, 0, At, B0); PG8_MMA(0, 1, At, B1); PG8_BAR; PG8_SCHED;
            PG8_LDA(At, 1, 1); PG8_STAGE(PG8_SB(1, 0), b3, voffB); PG8_STAGE(PG8_SB(1, 1), b3 + hstepB, voffB); PG8_STAGE(PG8_SA(1, 0), a3, voffA);
            PG8_WAIT_V(8); PG8_WAIT_L(0); PG8_BAR; PG8_MMA(1, 0, At, B0); PG8_MMA(1, 1, At, B1); PG8_BAR; PG8_SCHED;
        }
        if constexpr (ALIGN_EPI) { if (wr == 0) PG8_BAR; }
        { int z_ = 0; asm volatile("" : "+v"(z_)); const int l2 = __builtin_amdgcn_mbcnt_hi(-1, __builtin_amdgcn_mbcnt_lo(-1, z_));
          E(acc, cur, wr, wc, l2 & 15, l2 >> 4); }
        if (!E.keep(cur)) {
#pragma unroll
            for (int a = 0; a < 2; ++a)
#pragma unroll
                for (int b = 0; b < 2; ++b)
#pragma unroll
                    for (int m = 0; m < 4; ++m)
#pragma unroll
                        for (int n = 0; n < 2; ++n) acc[a][b][m][n] = (f32x4){0.f, 0.f, 0.f, 0.f};
        }
        if (!has_next) break;
        cur = nxt; cA = nA; cB = nB; ++ui;
        if constexpr (ALIGN_EPI) { if (wr == 1) PG8_BAR; }
    }
    PG8_WAIT_V(0);
    if constexpr (!ALIGN_EPI) { if (wr == 0) PG8_BAR; }
    PG8_BAR;
#undef PG8_SA
#undef PG8_SB
#undef PG8_STAGE
#undef PG8_LDA
#undef PG8_LDB
#undef PG8_MMA
#undef PG8_WAIT_V
#undef PG8_WAIT_L
#undef PG8_BAR
#undef PG8_SCHED
}
}

constexpr int RING_BYTES_C = 131072, LDSCTL_OFF_C = 131072;
__device__ __forceinline__ int seq_of_row(int r) { return r < ROWS_P ? r / LP : 8; }
__device__ __forceinline__ int seq_base(int s) { return s < 8 ? s * LP : ROWS_P; }
__device__ __forceinline__ int seq_len(int s) { return s < 8 ? LP : LS; }
__device__ __forceinline__ float* xrow(float* xreal, float* xm, int r) {
    if (r >= MROWS) return xm + (size_t)(144 + r - MROWS) * DM;
    const int s = seq_of_row(r), p = r - seq_base(s);
    if (p < NMETA) return xm + (size_t)(s * 16 + p) * DM;
    return xreal + (size_t)(r - 16 * (s + 1)) * DM;
}
__device__ __forceinline__ float bflo(unsigned u) { return __uint_as_float(u << 16); }
__device__ __forceinline__ float bfhi(unsigned u) { return __uint_as_float(u & 0xffff0000u); }
__device__ __forceinline__ unsigned pk2(float lo, float hi) { unsigned r; asm("v_cvt_pk_bf16_f32 %0, %1, %2" : "=v"(r) : "v"(lo), "v"(hi)); return r; }
__device__ __forceinline__ unsigned f2bf(float f) { return pk2(f, f); }
__device__ __forceinline__ void unpack8(const u32x4 w, float* f) { f[0] = bflo(w.x); f[1] = bfhi(w.x); f[2] = bflo(w.y); f[3] = bfhi(w.y); f[4] = bflo(w.z); f[5] = bfhi(w.z); f[6] = bflo(w.w); f[7] = bfhi(w.w); }
__device__ __forceinline__ float shx(float v, int o, int lane) { return __int_as_float(__builtin_amdgcn_ds_bpermute((lane ^ o) << 2, __float_as_int(v))); }
__device__ __forceinline__ float wave_sum(float v, int lane) {
#pragma unroll
    for (int o = 1; o < 64; o <<= 1) v += shx(v, o, lane);
    return v;
}
#define LDS_WAIT() asm volatile("s_waitcnt lgkmcnt(0)" ::: "memory")

struct OpsPlain {
    const bf16_t* A; const bf16_t* Bt; int K, lda;
    __device__ __forceinline__ void ptrs(const pg8::Unit& u, const char*& a, const char*& b) const {
        a = (const char*)A + (size_t)u.pm * 256 * lda * 2; b = (const char*)Bt + (size_t)u.pn * 256 * K * 2; }
};
struct OpsMerge {
    const bf16_t* P; const bf16_t* WM; int K, lda;
    __device__ __forceinline__ void ptrs(const pg8::Unit& u, const char*& a, const char*& b) const {
        const int col = u.sub == 0 ? C_Q : (u.sub == 1 ? C_VV : C_X1);
        a = (const char*)P + ((size_t)u.pm * 256 * lda + col) * 2; b = (const char*)WM + ((size_t)u.sub * DM + (size_t)u.pn * 256) * 512 * 2; }
};
typedef f32x4 acc_t[2][2][4][2];
struct EpiStore {
    bf16_t* O; int ldc; int sig_pn; const float* ss;
    __device__ __forceinline__ bool keep(const pg8::Unit&) const { return false; }
    __device__ __forceinline__ void operator()(acc_t& acc, const pg8::Unit& u, int wr, int wc, int fr, int fq) const {
        const int row0 = u.pm * 256 + wr * 64 + fr, col0 = u.pn * 256 + wc * 32 + 8 * fq; const bool sig = u.pn >= sig_pn;
#pragma unroll
        for (int ai = 0; ai < 2; ++ai)
#pragma unroll
            for (int m = 0; m < 4; ++m) { bf16_t* rowp = O + (size_t)(row0 + ai * 128 + m * 16) * ldc + col0;
                const float rs = __builtin_amdgcn_rsqf(ss[row0 + ai * 128 + m * 16] * (1.f / DM) + EPS);
#pragma unroll
                for (int bj = 0; bj < 2; ++bj) { f32x4 v0 = acc[ai][bj][m][0] * rs, v1 = acc[ai][bj][m][1] * rs;
                    if (sig) { unsigned q[8];
#pragma unroll
                        for (int e = 0; e < 4; ++e) { q[e] = (unsigned)fminf(fmaxf(__builtin_rintf(255.f * __builtin_amdgcn_rcpf(1.f + __expf(-v0[e]))), 1.f), 255.f);
                                                      q[4 + e] = (unsigned)fminf(fmaxf(__builtin_rintf(255.f * __builtin_amdgcn_rcpf(1.f + __expf(-v1[e]))), 1.f), 255.f); }
                        u32x2 w8; w8.x = q[0] | (q[1] << 8) | (q[2] << 16) | (q[3] << 24); w8.y = q[4] | (q[5] << 8) | (q[6] << 16) | (q[7] << 24);
                        *(u32x2*)((unsigned char*)(O + (size_t)(row0 + ai * 128 + m * 16) * ldc) + C_G * 2 + (col0 + bj * 128 - C_G)) = w8; continue; }
                    u32x4 w; w.x = pg8::cvt_pk_bf16(v0[0], v0[1]); w.y = pg8::cvt_pk_bf16(v0[2], v0[3]); w.z = pg8::cvt_pk_bf16(v1[0], v1[1]); w.w = pg8::cvt_pk_bf16(v1[2], v1[3]);
                    *(u32x4*)(rowp + bj * 128) = w; } }
    }
};
__device__ __forceinline__ float* out_row(float* out, int r) {
    if (r >= MROWS) return nullptr;
    const int sq = seq_of_row(r), p = r - seq_base(sq);
    return p < NMETA ? nullptr : out + (size_t)(r - 16 * (sq + 1)) * DM;
}
struct EpiRes {
    bf16_t* X; float* ss; float* outf; int dry;
    __device__ __forceinline__ bool keep(const pg8::Unit&) const { return false; }
    __device__ __forceinline__ void operator()(acc_t& acc, const pg8::Unit& u, int wr, int wc, int fr, int fq) const {
        const int row0 = u.pm * 256 + wr * 64 + fr, col0 = u.pn * 256 + wc * 32 + 8 * fq, lane = fr + 16 * fq;
#pragma unroll
        for (int ai = 0; ai < 2; ++ai) { u32x4 xv[4][2];
#pragma unroll
            for (int m = 0; m < 4; ++m)
#pragma unroll
                for (int bj = 0; bj < 2; ++bj) xv[m][bj] = *(const u32x4*)(X + (size_t)(row0 + ai * 128 + m * 16) * DM + col0 + bj * 128);
            asm volatile("" ::: "memory");
#pragma unroll
            for (int m = 0; m < 4; ++m) { const int r = row0 + ai * 128 + m * 16; float sq = 0.f;
                float* po = outf ? out_row(outf, r) : nullptr;
#pragma unroll
                for (int bj = 0; bj < 2; ++bj) { float f[8]; unpack8(xv[m][bj], f);
                    const f32x4 a = (f32x4){f[0], f[1], f[2], f[3]} + acc[ai][bj][m][0], b = (f32x4){f[4], f[5], f[6], f[7]} + acc[ai][bj][m][1];
                    if (outf) { if (po && !dry) { *(f32x4*)(po + col0 + bj * 128) = a; *(f32x4*)(po + col0 + bj * 128 + 4) = b; } }
                    else { u32x4 w; w.x = pk2(a[0], a[1]); w.y = pk2(a[2], a[3]); w.z = pk2(b[0], b[1]); w.w = pk2(b[2], b[3]);
                        if (!dry) *(u32x4*)(X + (size_t)r * DM + col0 + bj * 128) = w;
                        sq += (a[0] * a[0] + a[1] * a[1]) + (a[2] * a[2] + a[3] * a[3]) + (b[0] * b[0] + b[1] * b[1]) + (b[2] * b[2] + b[3] * b[3]); } }
                if (ss) { sq += shx(sq, 16, lane); sq += shx(sq, 32, lane); if (fq == 0 && !dry) atomicAdd(ss + r, sq); } }
            asm volatile("" ::: "memory"); }
    }
};
struct EpiGeluMul {
    const bf16_t* G; const float* cw; const float* cb; bf16_t* O; int dv; const float* ss;
    __device__ __forceinline__ bool keep(const pg8::Unit&) const { return false; }
    __device__ __forceinline__ void operator()(acc_t& acc, const pg8::Unit& u, int wr, int wc, int fr, int fq) const {
        if (dv == 1) return;
        const int row0 = u.pm * 256 + wr * 64 + fr, col0 = u.pn * 256 + wc * 32 + 8 * fq;
#pragma unroll
        for (int ai = 0; ai < 2; ++ai)
#pragma unroll
            for (int m = 0; m < 4; ++m) { const int r = row0 + ai * 128 + m * 16;
                const int s = seq_of_row(r), p = r - seq_base(s); const bool inb = r < MROWS;
                const bool hasp = inb && p > 0, hasn = inb && p < seq_len(s) - 1;
                const float mp_ = hasp ? 1.f : 0.f, mn_ = hasn ? 1.f : 0.f;
#pragma unroll
                for (int bj = 0; bj < 2; ++bj) { const int col = col0 + bj * 128;
                    const bf16_t* gp = G + (size_t)r * DFF + col;
                    const u32x4 gm = *(const u32x4*)(gp - (hasp ? DFF : 0)), g0 = *(const u32x4*)gp, gn = *(const u32x4*)(gp + (hasn ? DFF : 0));
                    float fm[8], f0[8], fn[8]; unpack8(gm, fm); unpack8(g0, f0); unpack8(gn, fn);
                    float o[8];
#pragma unroll
                    for (int h = 0; h < 2; ++h) { const f32x4 a = *(const f32x4*)(cw + col + 4 * h), b = *(const f32x4*)(cw + DFF + col + 4 * h), c = *(const f32x4*)(cw + 2 * DFF + col + 4 * h), d = *(const f32x4*)(cb + col + 4 * h);
#pragma unroll
                        for (int e = 0; e < 4; e += 2) { f32x2 x; x.x = a[e] * mp_ * fm[4 * h + e] + b[e] * f0[4 * h + e] + c[e] * mn_ * fn[4 * h + e] + d[e];
                            x.y = a[e + 1] * mp_ * fm[4 * h + e + 1] + b[e + 1] * f0[4 * h + e + 1] + c[e + 1] * mn_ * fn[4 * h + e + 1] + d[e + 1];
                            const f32x2 g = pg8::gelu_pk(x); o[4 * h + e] = g.x; o[4 * h + e + 1] = g.y; } }
                    const float rs = __builtin_amdgcn_rsqf(ss[r] * (1.f / DM) + EPS);
                    const f32x4 v0 = acc[ai][bj][m][0] * rs, v1 = acc[ai][bj][m][1] * rs;
                    u32x4 w; w.x = pg8::cvt_pk_bf16(o[0] * v0[0], o[1] * v0[1]); w.y = pg8::cvt_pk_bf16(o[2] * v0[2], o[3] * v0[3]);
                    w.z = pg8::cvt_pk_bf16(o[4] * v1[0], o[5] * v1[1]); w.w = pg8::cvt_pk_bf16(o[6] * v1[2], o[7] * v1[3]);
                    if (dv != 2) *(u32x4*)(O + (size_t)r * DFF + col) = w; else asm volatile("" :: "v"(w.x), "v"(w.y), "v"(w.z), "v"(w.w)); }
                if (m & 1) asm volatile("" ::: "memory"); }
    }
};
__device__ __forceinline__ void unpack8u(const u32x2 w, float* f) {
#pragma unroll
    for (int e = 0; e < 4; ++e) { f[e] = (float)((w.x >> (8 * e)) & 255u) * (1.f / 255.f); f[4 + e] = (float)((w.y >> (8 * e)) & 255u) * (1.f / 255.f); }
}
struct EpiMerge {
    const bf16_t* P; bf16_t* O;
    __device__ __forceinline__ bool keep(const pg8::Unit& u) const { return u.sub < 2; }
    __device__ __forceinline__ void operator()(acc_t& acc, const pg8::Unit& u, int wr, int wc, int fr, int fq) const {
        const int row0 = u.pm * 256 + wr * 64 + fr, col0 = u.pn * 256 + wc * 32 + 8 * fq; const int sub = u.sub;
#pragma unroll
        for (int ai = 0; ai < 2; ++ai)
#pragma unroll
            for (int m = 0; m < 4; ++m) { const int r = row0 + ai * 128 + m * 16;
#pragma unroll
                for (int bj = 0; bj < 2; ++bj) { const int col = col0 + bj * 128;
                    const unsigned char* gp = (const unsigned char*)(P + (size_t)r * INW) + C_G * 2 + col;
                    float mu[8];
                    if (sub < 2) { const u32x2 ga = *(const u32x2*)(gp + sub * DM), gb = *(const u32x2*)(gp + (sub + 1) * DM); float fa[8], fb[8]; unpack8u(ga, fa); unpack8u(gb, fb);
#pragma unroll
                        for (int e = 0; e < 8; ++e) mu[e] = fa[e] * __builtin_amdgcn_rcpf(fb[e]); }
                    else { const u32x2 ga = *(const u32x2*)(gp + 2 * DM); unpack8u(ga, mu); }
                    f32x4 v0 = acc[ai][bj][m][0], v1 = acc[ai][bj][m][1];
#pragma unroll
                    for (int e = 0; e < 4; ++e) { v0[e] *= mu[e]; v1[e] *= mu[4 + e]; }
                    if (sub < 2) { acc[ai][bj][m][0] = v0; acc[ai][bj][m][1] = v1; }
                    else { u32x4 w; w.x = pg8::cvt_pk_bf16(v0[0], v0[1]); w.y = pg8::cvt_pk_bf16(v0[2], v0[3]); w.z = pg8::cvt_pk_bf16(v1[0], v1[1]); w.w = pg8::cvt_pk_bf16(v1[2], v1[3]);
                        *(u32x4*)(O + (size_t)r * DM + col) = w; } } }
    }
};

#define XB_TMO      128
#define XB_XCNT(j)  (256  + 64 * (j))
#define XB_XSUB(j)  (1280 + 64 * (j))
#define XB_XGEN(j)  (2304 + 64 * (j))
#define XB_TOP      3328
#define XB_TOPGEN   3392
#define XCD_BAR_WORDS 3456
#define XB_SPIN_CAP (1u << 20)
__device__ __forceinline__ unsigned xb_ld(unsigned* p)              { return __hip_atomic_load(p, __ATOMIC_RELAXED, __HIP_MEMORY_SCOPE_AGENT); }
__device__ __forceinline__ unsigned xb_add(unsigned* p, unsigned v) { return __hip_atomic_fetch_add(p, v, __ATOMIC_RELAXED, __HIP_MEMORY_SCOPE_AGENT); }
__device__ __forceinline__ unsigned xb_xcc_id() { return (unsigned)__builtin_amdgcn_s_getreg((3 << 11) | 20) & 0xFu; }
#define XB_SPIN(cond, bar) do { unsigned _sp = 0; while (cond) { __builtin_amdgcn_s_sleep(1); \
    if ((++_sp & 255u) == 0u) { if (xb_ld(&(bar)[XB_TMO])) break; if (_sp > XB_SPIN_CAP) { atomicAdd(&(bar)[XB_TMO], 1u); break; } } } } while (0)
struct XcdBarrier { unsigned* bar; unsigned x; volatile LAS unsigned* st; };
__device__ __forceinline__ XcdBarrier xcd_barrier_post(unsigned* bar, volatile LAS unsigned* st) {
    XcdBarrier b; b.bar = bar; b.x = xb_xcc_id(); b.st = st;
    if (threadIdx.x == 0) (void)xb_add(&bar[XB_XCNT(b.x)], 1u);
    return b;
}
__device__ __forceinline__ void xcd_barrier_complete(unsigned* bar, unsigned x, unsigned& nloc, unsigned& nx) {
    const unsigned G = gridDim.x * gridDim.y * gridDim.z;
    unsigned sum, cnt, mine, sp = 0u;
    for (;;) {
        sum = 0u; cnt = 0u; mine = 0u;
#pragma unroll
        for (unsigned j = 0; j < 16; ++j) { const unsigned c = xb_ld(&bar[XB_XCNT(j)]); sum += c; cnt += (c > 0u) ? 1u : 0u; mine = (j == x) ? c : mine; }
        if (sum == G) break;
        __builtin_amdgcn_s_sleep(1);
        if ((++sp & 255u) == 0u) { if (xb_ld(&bar[XB_TMO])) break; if (sp > XB_SPIN_CAP) { atomicAdd(&bar[XB_TMO], 1u); break; } }
    }
    nloc = mine > 0u ? mine : 1u; nx = cnt > 0u ? cnt : 1u;
}
__device__ __forceinline__ void xcd_barrier(const XcdBarrier& b, int tid) {
    asm volatile("s_waitcnt vmcnt(0)" ::: "memory");
    __syncthreads();
    if (tid == 0) {
        unsigned* bar = b.bar;
        __builtin_amdgcn_s_waitcnt(0);
        unsigned nloc = b.st[0], nx = b.st[1];
        if (nloc == 0u) { xcd_barrier_complete(bar, b.x, nloc, nx); b.st[0] = nloc; b.st[1] = nx; }
        const unsigned old = xb_add(&bar[XB_XSUB(b.x)], 1u);
        const unsigned gen = old / nloc;
        if (old + 1u == (gen + 1u) * nloc) {
            __builtin_amdgcn_fence(__ATOMIC_RELEASE, "agent");
            asm volatile("s_waitcnt vmcnt(0)" ::: "memory");
            const unsigned og = xb_add(&bar[XB_TOP], 1u);
            const unsigned tg = og / nx;
            if (og + 1u == (tg + 1u) * nx) xb_add(&bar[XB_TOPGEN], 1u);
            else XB_SPIN(xb_ld(&bar[XB_TOPGEN]) == tg, bar);
            __builtin_amdgcn_fence(__ATOMIC_ACQUIRE, "agent");
            xb_add(&bar[XB_XGEN(b.x)], 1u);
            asm volatile("s_waitcnt vmcnt(0)" ::: "memory");
        } else {
            XB_SPIN(xb_ld(&bar[XB_XGEN(b.x)]) == gen, bar);
            __builtin_amdgcn_fence(__ATOMIC_ACQUIRE, "agent");
            asm volatile("s_waitcnt vmcnt(0)" ::: "memory");
        }
    }
    __syncthreads();
}

constexpr int NWAVES = 8;
constexpr int RING_BYTES = 131072, LDSCTL_OFF = RING_BYTES, MISC_OFF = LDSCTL_OFF + 320, LDS_BYTES = 147456;
struct Args { const float* in[30]; float* out; unsigned char* ws; int ph_lo, ph_hi, use_bar, pad; };
typedef const __attribute__((address_space(4))) Args CArgs;
struct Frame {
    LAS unsigned char* lds; int tid, lane, wave, G, vcu, bx, dry;
    float* out; unsigned char* ws; float* xm;
};
#define FIN(i) (A.in[i])

__constant__ unsigned char c_bucket[257] = {
15,15,15,15,15,15,15,15,15,15,15,15,15,15,15,15,15,15,15,15,15,15,15,15,15,15,15,15,15,15,15,15,15,15,15,15,15,15,14,14,14,14,14,14,14,14,14,14,14,14,14,14,14,14,14,14,14,14,14,14,14,14,14,14,14,13,13,13,13,13,13,13,13,13,13,13,13,13,13,13,13,13,13,12,12,12,12,12,12,12,12,12,12,12,12,12,12,11,11,11,11,11,11,11,11,11,10,10,10,10,10,10,10,9,9,9,9,8,8,8,8,7,6,5,4,3,2,1,0,17,18,19,20,21,22,23,24,24,24,24,25,25,25,25,26,26,26,26,26,26,26,27,27,27,27,27,27,27,27,27,28,28,28,28,28,28,28,28,28,28,28,28,28,28,29,29,29,29,29,29,29,29,29,29,29,29,29,29,29,29,29,29,30,30,30,30,30,30,30,30,30,30,30,30,30,30,30,30,30,30,30,30,30,30,30,30,30,30,30,31,31,31,31,31,31,31,31,31,31,31,31,31,31,31,31,31,31,31,31,31,31,31,31,31,31,31,31,31,31,31,31,31,31,31,31,31,31};

__device__ __forceinline__ void p0_transpose_item(const float* W, int K, int N, bf16_t* WT, int row_off, LAS float* scr, int item, int lane, const float* gk = nullptr) {
    const int nblk = N / 32, kb = item / nblk, nb = item % nblk, k0 = 64 * kb, n0 = 32 * nb;
    f32x4 v[8];
#pragma unroll
    for (int i = 0; i < 8; ++i) v[i] = *(const f32x4*)(W + (size_t)(k0 + 8 * i + (lane >> 3)) * N + n0 + 4 * (lane & 7));
    if (gk) {
#pragma unroll
        for (int i = 0; i < 8; ++i) v[i] = v[i] * gk[k0 + 8 * i + (lane >> 3)]; }
#pragma unroll
    for (int i = 0; i < 8; ++i) { LAS float* d = scr + (8 * i + (lane >> 3)) * 33 + 4 * (lane & 7); d[0] = v[i].x; d[1] = v[i].y; d[2] = v[i].z; d[3] = v[i].w; }
    LDS_WAIT(); asm volatile("" ::: "memory");
    const int c = lane & 7;
#pragma unroll
    for (int j = 0; j < 4; ++j) { const int n = (lane >> 3) + 8 * j; const LAS float* s = scr + (8 * c) * 33 + n;
        u32x4 o; o.x = pk2(s[0 * 33], s[1 * 33]); o.y = pk2(s[2 * 33], s[3 * 33]); o.z = pk2(s[4 * 33], s[5 * 33]); o.w = pk2(s[6 * 33], s[7 * 33]);
        *(u32x4*)(WT + (size_t)(row_off + n0 + n) * K + k0 + 8 * c) = o; }
    LDS_WAIT(); asm volatile("" ::: "memory");
}
__device__ __forceinline__ void rms_row(const f32x4 (&v)[4], const float* g, bf16_t* orow, int lane) {
    float s = 0.f;
#pragma unroll
    for (int j = 0; j < 4; ++j) s += (v[j].x * v[j].x + v[j].y * v[j].y) + (v[j].z * v[j].z + v[j].w * v[j].w);
    const float rstd = 1.0f / sqrtf(wave_sum(s, lane) * (1.f / DM) + EPS);
    unsigned long long* o8 = (unsigned long long*)orow + lane;
#pragma unroll
    for (int j = 0; j < 4; ++j) { const f32x4 gg = *((const f32x4*)g + lane + 64 * j);
        o8[64 * j] = (unsigned long long)pk2(v[j].x * rstd * gg.x, v[j].y * rstd * gg.y) | ((unsigned long long)pk2(v[j].z * rstd * gg.z, v[j].w * rstd * gg.w) << 32); }
}
constexpr size_t WS_H2F_P = 2 * MiB, WS_H2F_S = WS_END;
constexpr int NCH_P = (LP + 31) / 32, NCH_S = (LS + 31) / 32;
static_assert(WS_H2F_S + (size_t)NCH_S * 32 * 128 <= 512 * MiB && WS_H2F_P + (size_t)NCH_P * 32 * 128 <= WS_W, "h2 scratch");
__device__ __forceinline__ void filt_h2_compute(const CArgs& A, const Frame& F, int layer, int L, int tc, LAS float* h1t, int lane, float (&acc)[32]) {
    const float* w1 = FIN(11) + (size_t)layer * 33 * 64; const float* b1 = FIN(12) + layer * 64;
    const float* w2 = FIN(13) + (size_t)layer * 64 * 64; const float* b2 = FIN(14) + layer * 64; const float* fq_ = FIN(16) + layer * 64;
    const int pos = lane & 31, half = lane >> 5, jb = 32 * half;
    const float tt = (float)tc / (float)(L - 1);
    { f32x4 bv[8], wv[8];
#pragma unroll
      for (int i = 0; i < 8; ++i) { bv[i] = *(const f32x4*)(b1 + jb + 4 * i); wv[i] = *(const f32x4*)(w1 + jb + 4 * i); }
#pragma unroll
      for (int i = 0; i < 8; ++i)
#pragma unroll
          for (int e = 0; e < 4; ++e) acc[4 * i + e] = bv[i][e] + tt * wv[i][e]; }
#pragma unroll 2
    for (int k = 0; k < 16; ++k) {
        const float f = 1e-4f + (float)k * ((15.0f - 1e-4f) / 15.0f);
        const float rev = f * (float)tc * (1.0f / (float)L);
        const float sn = __builtin_amdgcn_sinf(rev), cs = __builtin_amdgcn_cosf(rev);
        f32x4 wc_[8], ws_[8];
#pragma unroll
        for (int i = 0; i < 8; ++i) { wc_[i] = *(const f32x4*)(w1 + (size_t)(1 + k) * 64 + jb + 4 * i); ws_[i] = *(const f32x4*)(w1 + (size_t)(17 + k) * 64 + jb + 4 * i); }
#pragma unroll
        for (int i = 0; i < 8; ++i)
#pragma unroll
            for (int e = 0; e < 4; ++e) acc[4 * i + e] += cs * wc_[i][e] - sn * ws_[i][e];
    }
    { f32x4 fv[8];
#pragma unroll
      for (int i = 0; i < 8; ++i) fv[i] = *(const f32x4*)(fq_ + jb + 4 * i);
#pragma unroll
      for (int i = 0; i < 8; ++i)
#pragma unroll
          for (int e = 0; e < 4; ++e) h1t[(jb + 4 * i + e) * 32 + pos] = __builtin_amdgcn_sinf(fv[i][e] * acc[4 * i + e] * 0.15915494309189535f); }
    LDS_WAIT();
    { f32x4 bv[8];
#pragma unroll
      for (int i = 0; i < 8; ++i) bv[i] = *(const f32x4*)(b2 + jb + 4 * i);
#pragma unroll
      for (int i = 0; i < 8; ++i)
#pragma unroll
          for (int e = 0; e < 4; ++e) acc[4 * i + e] = bv[i][e]; }
#pragma unroll 4
    for (int i2 = 0; i2 < 64; ++i2) { const float h = h1t[i2 * 32 + pos]; f32x4 wv[8];
#pragma unroll
        for (int i = 0; i < 8; ++i) wv[i] = *(const f32x4*)(w2 + (size_t)i2 * 64 + jb + 4 * i);
#pragma unroll
        for (int i = 0; i < 8; ++i)
#pragma unroll
            for (int e = 0; e < 4; ++e) acc[4 * i + e] += h * wv[i][e]; }
}
__device__ __forceinline__ void filt_h2_item(const CArgs& A, const Frame& F, int layer, int item, LAS float* h1t, int lane) {
    const int cls = item >= NCH_P ? 1 : 0, ch = cls ? item - NCH_P : item, L = cls ? LS : LP;
    const int pos = lane & 31, half = lane >> 5, jb = 32 * half;
    const int t = ch * 32 + pos, tc = t < L ? t : L - 1;
    const float* fq_ = FIN(16) + layer * 64;
    float acc[32];
    filt_h2_compute(A, F, layer, L, tc, h1t, lane, acc);
    { f32x4 fv[8]; unsigned hw[16];
#pragma unroll
      for (int i = 0; i < 8; ++i) fv[i] = *(const f32x4*)(fq_ + jb + 4 * i);
#pragma unroll
      for (int i = 0; i < 8; ++i)
#pragma unroll
          for (int e = 0; e < 4; e += 2) { const float a0 = __builtin_amdgcn_sinf(fv[i][e] * acc[4 * i + e] * 0.15915494309189535f), a1 = __builtin_amdgcn_sinf(fv[i][e + 1] * acc[4 * i + e + 1] * 0.15915494309189535f);
              typedef _Float16 h2_t __attribute__((ext_vector_type(2))); const h2_t hv = {(_Float16)a0, (_Float16)a1}; hw[2 * i + (e >> 1)] = __builtin_bit_cast(unsigned, hv); }
      u32x4* dst = (u32x4*)(F.ws + (cls ? WS_H2F_S : WS_H2F_P) + (size_t)t * 128 + half * 64);
#pragma unroll
      for (int i = 0; i < 4; ++i) dst[i] = (u32x4){hw[4 * i], hw[4 * i + 1], hw[4 * i + 2], hw[4 * i + 3]}; }
    LDS_WAIT();
}
constexpr int NI8_P = LP / 8, NI8 = NI8_P + LS / 8;
static_assert(LP % 8 == 0 && LS % 8 == 0, "filter items");
__device__ __forceinline__ void filt_h2_item8(const CArgs& A, const Frame& F, int layer, int item, LAS float* h1t, int lane) {
    const int cls = item >= NI8_P ? 1 : 0, ch = cls ? item - NI8_P : item, L = cls ? LS : LP;
    const float* w1 = FIN(11) + (size_t)layer * 33 * 64; const float* b1 = FIN(12) + layer * 64;
    const float* w2 = FIN(13) + (size_t)layer * 64 * 64; const float* b2 = FIN(14) + layer * 64; const float* fq_ = FIN(16) + layer * 64;
    const int pos = lane & 7, jb = (lane >> 3) * 8, t = ch * 8 + pos;
    const float tt = (float)t / (float)(L - 1);
    float acc[8];
    { const f32x4 ba = *(const f32x4*)(b1 + jb), bb = *(const f32x4*)(b1 + jb + 4), wa = *(const f32x4*)(w1 + jb), wb = *(const f32x4*)(w1 + jb + 4);
#pragma unroll
      for (int e = 0; e < 4; ++e) { acc[e] = ba[e] + tt * wa[e]; acc[4 + e] = bb[e] + tt * wb[e]; } }
#pragma unroll
    for (int k0 = 0; k0 < 16; k0 += 4) { f32x4 ca[4], cb[4], sa[4], sb[4];
#pragma unroll
        for (int q = 0; q < 4; ++q) { const int k = k0 + q; ca[q] = *(const f32x4*)(w1 + (size_t)(1 + k) * 64 + jb); cb[q] = *(const f32x4*)(w1 + (size_t)(1 + k) * 64 + jb + 4);
            sa[q] = *(const f32x4*)(w1 + (size_t)(17 + k) * 64 + jb); sb[q] = *(const f32x4*)(w1 + (size_t)(17 + k) * 64 + jb + 4); }
        asm volatile("" ::: "memory");
#pragma unroll
        for (int q = 0; q < 4; ++q) { const int k = k0 + q;
            const float f = 1e-4f + (float)k * ((15.0f - 1e-4f) / 15.0f);
            const float rev = f * (float)t * (1.0f / (float)L);
            const float sn = __builtin_amdgcn_sinf(rev), cs = __builtin_amdgcn_cosf(rev);
#pragma unroll
            for (int e = 0; e < 4; ++e) { acc[e] += cs * ca[q][e] - sn * sa[q][e]; acc[4 + e] += cs * cb[q][e] - sn * sb[q][e]; } }
        asm volatile("" ::: "memory");
    }
    const f32x4 fa = *(const f32x4*)(fq_ + jb), fb = *(const f32x4*)(fq_ + jb + 4);
#pragma unroll
    for (int e = 0; e < 4; ++e) { h1t[(jb + e) * 8 + pos] = __builtin_amdgcn_sinf(fa[e] * acc[e] * 0.15915494309189535f); h1t[(jb + 4 + e) * 8 + pos] = __builtin_amdgcn_sinf(fb[e] * acc[4 + e] * 0.15915494309189535f); }
    LDS_WAIT();
    { const f32x4 ba = *(const f32x4*)(b2 + jb), bb = *(const f32x4*)(b2 + jb + 4);
#pragma unroll
      for (int e = 0; e < 4; ++e) { acc[e] = ba[e]; acc[4 + e] = bb[e]; } }
#pragma unroll
    for (int i0 = 0; i0 < 64; i0 += 8) { f32x4 wa[8], wb[8];
#pragma unroll
        for (int q = 0; q < 8; ++q) { wa[q] = *(const f32x4*)(w2 + (size_t)(i0 + q) * 64 + jb); wb[q] = *(const f32x4*)(w2 + (size_t)(i0 + q) * 64 + jb + 4); }
        asm volatile("" ::: "memory");
#pragma unroll
        for (int q = 0; q < 8; ++q) { const float h = h1t[(i0 + q) * 8 + pos];
#pragma unroll
            for (int e = 0; e < 4; ++e) { acc[e] += h * wa[q][e]; acc[4 + e] += h * wb[q][e]; } }
        asm volatile("" ::: "memory");
    }
    unsigned hw[4];
#pragma unroll
    for (int e = 0; e < 4; e += 2) { typedef _Float16 h2_t __attribute__((ext_vector_type(2)));
        const h2_t ha = {(_Float16)__builtin_amdgcn_sinf(fa[e] * acc[e] * 0.15915494309189535f), (_Float16)__builtin_amdgcn_sinf(fa[e + 1] * acc[e + 1] * 0.15915494309189535f)};
        const h2_t hb = {(_Float16)__builtin_amdgcn_sinf(fb[e] * acc[4 + e] * 0.15915494309189535f), (_Float16)__builtin_amdgcn_sinf(fb[e + 1] * acc[4 + e + 1] * 0.15915494309189535f)};
        hw[e >> 1] = __builtin_bit_cast(unsigned, ha); hw[2 + (e >> 1)] = __builtin_bit_cast(unsigned, hb); }
    *(u32x4*)(F.ws + (cls ? WS_H2F_S : WS_H2F_P) + (size_t)t * 128 + jb * 2) = (u32x4){hw[0], hw[1], hw[2], hw[3]};
    LDS_WAIT();
}
constexpr int NCHF_P = (LP - 1 + 31) / 32 + 1, NCHB_P = (LP + 31) / 32, NCHF_S = (LS - 1 + 31) / 32 + 1, NCHB_S = (LS + 31) / 32;
constexpr int NFI_P = NCHF_P + NCHB_P, NFI = NFI_P + NCHF_S + NCHB_S;
__device__ __forceinline__ void filt_tile_item(const CArgs& A, const Frame& F, int layer, int item, int lane) {
    const int ct = item & 15; int cls = 0, it = item >> 4; if (it >= NFI_P) { cls = 1; it -= NFI_P; }
    const int nchf = cls ? NCHF_S : NCHF_P, L = cls ? LS : LP;
    bool bwd; int ch; if (it < nchf) { bwd = false; ch = it - 1; } else { bwd = true; ch = it - nchf; }
    const int tsh = bwd ? 0 : 1;
    const float* w3 = FIN(15) + (size_t)layer * 64 * 1024;
    const int pos = lane & 31, half = lane >> 5;
    const int t = ch * 32 + pos + tsh, tc = t < 0 ? 0 : (t < L ? t : L - 1);
    float acc[32];
#if FT_RECOMPUTE
    if (FT_RECOMPUTE == 1 || FT_RECOMPUTE == 9 || (FT_RECOMPUTE == 2 && cls == 0) || (FT_RECOMPUTE == 3 && cls == 1)) { LAS float* h1t = (LAS float*)(F.lds + F.wave * 16384); filt_h2_compute(A, F, layer, L, tc, h1t, lane, acc); const float* fq_ = FIN(16) + layer * 64;
#pragma unroll
      for (int k = 0; k < 32; ++k) acc[k] = __builtin_amdgcn_sinf(fq_[32 * half + k] * acc[k] * 0.15915494309189535f); LDS_WAIT(); }
    else
#endif
    { const u32x4* src = (const u32x4*)(F.ws + (cls ? WS_H2F_S : WS_H2F_P) + (size_t)tc * 128 + half * 64);
      u32x4 hv[4];
#pragma unroll
      for (int i = 0; i < 4; ++i) hv[i] = src[i];
#pragma unroll
      for (int i = 0; i < 4; ++i)
#pragma unroll
          for (int e = 0; e < 4; ++e) { typedef _Float16 h2_t __attribute__((ext_vector_type(2))); const unsigned wv_ = hv[i][e];
              const h2_t p = __builtin_bit_cast(h2_t, wv_); acc[8 * i + 2 * e] = (float)p[0]; acc[8 * i + 2 * e + 1] = (float)p[1]; } }
#if FT_RECOMPUTE == 9
    float bad = 0.f;
    { const u32x4* src = (const u32x4*)(F.ws + (cls ? WS_H2F_S : WS_H2F_P) + (size_t)tc * 128 + half * 64);
#pragma unroll
      for (int i = 0; i < 4; ++i) { const u32x4 hvv = src[i];
#pragma unroll
          for (int e = 0; e < 4; ++e) { typedef _Float16 h2_t __attribute__((ext_vector_type(2))); const h2_t p = __builtin_bit_cast(h2_t, hvv[e]);
              if (fabsf((float)p[0] - acc[8 * i + 2 * e]) > 2e-3f || fabsf((float)p[1] - acc[8 * i + 2 * e + 1]) > 2e-3f) bad = 1e4f; } } }
#else
    const float bad = 0.f;
#endif
    bf16_t* RK = (bf16_t*)(F.ws + (cls ? WS_RKS : WS_RKP)); const int rklen = cls ? RKLEN_S : RKLEN_P;
    float* sums = (float*)(F.ws + WS_CTL) + CW_SUMS + (layer * 2 + cls) * 512;
    const float da = -15.350567286626973f, db = -3.0701134573253945f;
    {
        const int col0 = (bwd ? 512 : 0) + ct * 32;
        float bw[32];
#pragma unroll
        for (int ks = 0; ks < 32; ++ks) bw[ks] = w3[(size_t)(32 * half + ks) * 1024 + col0 + pos];
        f32x16 d = {};
#pragma unroll
        for (int ks = 0; ks < 32; ++ks) d = __builtin_amdgcn_mfma_f32_32x32x2f32(acc[ks], bw[ks], d, 0, 0, 0);
        const int c = (col0 + pos) & 511;
        const float delta = fabsf(da + (db - da) * ((float)c / 511.0f));
        bf16_t* rk = RK + (size_t)c * rklen + RK_PAD + L;
        float asum = 0.f;
#pragma unroll
        for (int g = 0; g < 4; ++g) { const int t0 = ch * 32 + 8 * g + 4 * half + tsh; float v[4];
#pragma unroll
            for (int e = 0; e < 4; ++e) { const int tp = t0 + e; const bool ok = tp >= 0 && tp < L && !(bwd && tp == 0);
                const float tq = (float)tp / (float)(L - 1); v[e] = ok ? d[4 * g + e] * __expf(-tq * delta) + bad : 0.f; asum += fabsf(v[e]); }
            if (bwd) { if (t0 >= 4 && t0 + 3 < L) { u32x2 w; w.x = pk2(v[0], v[1]); w.y = pk2(v[2], v[3]); *(u32x2*)(rk + t0) = w; }
                       else {
#pragma unroll
                           for (int e = 0; e < 4; ++e) if (t0 + e >= 1 && t0 + e < L) rk[t0 + e] = (bf16_t)f2bf(v[e]); } }
            else { if (t0 >= 0 && t0 + 3 < L) { u32x2 w; w.x = pk2(v[3], v[2]); w.y = pk2(v[1], v[0]); *(u32x2*)(rk - t0 - 3) = w; }
                   else {
#pragma unroll
                       for (int e = 0; e < 4; ++e) if (t0 + e >= 0 && t0 + e < L) rk[-(t0 + e)] = (bf16_t)f2bf(v[e]); } } }
        asum += shx(asum, 32, lane);
        if (half == 0 && !F.dry) atomicAdd(sums + c, asum);
    }
}
constexpr int FT_RUN = 10;
constexpr int FT_RF_P = (NCHF_P + FT_RUN - 1) / FT_RUN, FT_RB_P = (NCHB_P + FT_RUN - 1) / FT_RUN, FT_RF_S = (NCHF_S + FT_RUN - 1) / FT_RUN, FT_RB_S = (NCHB_S + FT_RUN - 1) / FT_RUN;
constexpr int FT_UNITS = 16 * (FT_RF_P + FT_RB_P + FT_RF_S + FT_RB_S);
typedef _Float16 f16x8 __attribute__((ext_vector_type(8)));
__device__ __forceinline__ void filt_tile_run(const CArgs& A, const Frame& F, int layer, int unit, int lane) {
    const int ct = unit & 15; int rr = unit >> 4, cls, bwd, nch;
    if (rr < FT_RF_P) { cls = 0; bwd = 0; nch = NCHF_P; }
    else if (rr < FT_RF_P + FT_RB_P) { rr -= FT_RF_P; cls = 0; bwd = 1; nch = NCHB_P; }
    else if (rr < FT_RF_P + FT_RB_P + FT_RF_S) { rr -= FT_RF_P + FT_RB_P; cls = 1; bwd = 0; nch = NCHF_S; }
    else { rr -= FT_RF_P + FT_RB_P + FT_RF_S; cls = 1; bwd = 1; nch = NCHB_S; }
    const int L = cls ? LS : LP, it0 = rr * FT_RUN, it1 = it0 + FT_RUN < nch ? it0 + FT_RUN : nch, toff = bwd ? 0 : -31;
    const float* w3 = FIN(15) + (size_t)layer * 64 * 1024;
    const int pos = lane & 31, half = lane >> 5, col0 = (bwd ? 512 : 0) + ct * 32, c = (col0 + pos) & 511;
    f16x8 bw[4];
    { float wf[32];
#pragma unroll
      for (int q = 0; q < 32; ++q) wf[q] = w3[(size_t)(16 * (q >> 3) + 8 * half + (q & 7)) * 1024 + col0 + pos];
#pragma unroll
      for (int q = 0; q < 32; ++q) bw[q >> 3][q & 7] = (_Float16)wf[q]; }
    const float da = -15.350567286626973f, db = -3.0701134573253945f;
    const float e2 = fabsf(da + (db - da) * ((float)c / 511.0f)) * (1.4426950408889634f / (float)(L - 1));
    bf16_t* rk = (bf16_t*)(F.ws + (cls ? WS_RKS : WS_RKP)) + (size_t)c * (cls ? RKLEN_S : RKLEN_P) + RK_PAD + L;
    const unsigned char* hbase = F.ws + (cls ? WS_H2F_S : WS_H2F_P) + half * 16;
    float asum = 0.f;
    u32x4 hv[4];
    { const int t = 32 * it0 + toff + pos, tc = t < 0 ? 0 : (t < L ? t : L - 1);
#pragma unroll
      for (int kb = 0; kb < 4; ++kb) hv[kb] = *(const u32x4*)(hbase + (size_t)tc * 128 + kb * 32); }
    for (int it = it0; it < it1; ++it) {
        u32x4 hn[4];
        { const int itn = it + 1 < it1 ? it + 1 : it, t = 32 * itn + toff + pos, tc = t < 0 ? 0 : (t < L ? t : L - 1);
#pragma unroll
          for (int kb = 0; kb < 4; ++kb) hn[kb] = *(const u32x4*)(hbase + (size_t)tc * 128 + kb * 32); }
        f32x16 d = {};
#pragma unroll
        for (int kb = 0; kb < 4; ++kb) d = __builtin_amdgcn_mfma_f32_32x32x16_f16(__builtin_bit_cast(f16x8, hv[kb]), bw[kb], d, 0, 0, 0);
        const int tb = 32 * it + toff;
        float v[16];
#pragma unroll
        for (int i = 0; i < 16; ++i) { const int tp = tb + 8 * (i >> 2) + 4 * half + (i & 3); const bool ok = tp >= bwd && tp < L;
            v[i] = ok ? d[i] * __builtin_amdgcn_exp2f(-(float)tp * e2) : 0.f; asum += fabsf(v[i]); }
        if (tb >= bwd && tb + 31 < L) {
            unsigned g[4][2];
#pragma unroll
            for (int q = 0; q < 4; ++q) { if (bwd) { g[q][0] = pk2(v[4 * q], v[4 * q + 1]); g[q][1] = pk2(v[4 * q + 2], v[4 * q + 3]); }
                                          else { g[q][0] = pk2(v[4 * q + 3], v[4 * q + 2]); g[q][1] = pk2(v[4 * q + 1], v[4 * q]); } }
            unsigned pc[4][2];
#pragma unroll
            for (int w = 0; w < 2; ++w) { const u32x2 s0 = __builtin_amdgcn_permlane32_swap(g[0][w], g[2][w], false, false), s1 = __builtin_amdgcn_permlane32_swap(g[1][w], g[3][w], false, false);
                pc[0][w] = s0[0]; pc[1][w] = s0[1]; pc[2][w] = s1[0]; pc[3][w] = s1[1]; }
            const int p0 = tb + 16 * half;
            if (bwd) { u32x4* dst = (u32x4*)(rk + p0); dst[0] = (u32x4){pc[0][0], pc[0][1], pc[1][0], pc[1][1]}; dst[1] = (u32x4){pc[2][0], pc[2][1], pc[3][0], pc[3][1]}; }
            else { u32x4* dst = (u32x4*)(rk - p0 - 15); dst[0] = (u32x4){pc[3][0], pc[3][1], pc[2][0], pc[2][1]}; dst[1] = (u32x4){pc[1][0], pc[1][1], pc[0][0], pc[0][1]}; }
        } else {
#pragma unroll
            for (int i = 0; i < 16; ++i) { const int tp = tb + 8 * (i >> 2) + 4 * half + (i & 3); if (tp >= bwd && tp < L) rk[bwd ? tp : -tp] = (bf16_t)f2bf(v[i]); }
        }
#pragma unroll
        for (int kb = 0; kb < 4; ++kb) hv[kb] = hn[kb];
    }
    asum += shx(asum, 32, lane);
    if (half == 0 && !F.dry) atomicAdd((float*)(F.ws + WS_CTL) + CW_SUMS + (layer * 2 + cls) * 512 + c, asum);
}
__device__ __forceinline__ void p_filt_tiles(const CArgs& A, const Frame& F, int layer) {
    const int gw = F.vcu * NWAVES + F.wave, NGW = F.G * NWAVES;
#if FT_RECOMPUTE
    for (int it = gw; it < 16 * NFI; it += NGW) filt_tile_item(A, F, layer, it, F.lane);
#else
    for (int u = NGW - 1 - gw; u < FT_UNITS; u += NGW) filt_tile_run(A, F, layer, u, F.lane);
#endif
}
__device__ __forceinline__ void p_prep(const CArgs& A, const Frame& F, int layer) {
    const int gw = F.vcu * NWAVES + F.wave, NGW = F.G * NWAVES, lane = F.lane;
    const bool filt_first = false;
    if (filt_first && DSEL(8)) { LAS float* scr = (LAS float*)(F.lds + F.wave * 16384); for (int it = gw; it < NI8; it += NGW) filt_h2_item8(A, F, layer, it, scr, lane); }
    if (layer == 0 && DSEL(1)) {
        bf16_t* XB = (bf16_t*)(F.ws + WS_XNR); float* ss = (float*)(F.ws + WS_CTL) + CW_SS;
        for (int r0 = gw; r0 < MP; r0 += 2 * NGW) {
            f32x4 v[2][4]; const int rr[2] = {r0, r0 + NGW};
#pragma unroll
            for (int q = 0; q < 2; ++q) { const int r = rr[q];
                if (r >= MP) continue;
                if (r >= MROWS) {
#pragma unroll
                    for (int j = 0; j < 4; ++j) v[q][j] = (f32x4){0.f, 0.f, 0.f, 0.f};
                } else {
                    const int sq = seq_of_row(r), p = r - seq_base(sq);
                    const float* src = p < NMETA ? FIN(2) + (size_t)p * DM : (sq < 8 ? FIN(0) + ((size_t)sq * 2048 + (p - NMETA)) * DM : FIN(1) + (size_t)(p - NMETA) * DM);
                    const f32x4* sr = (const f32x4*)src + lane;
#pragma unroll
                    for (int j = 0; j < 4; ++j) v[q][j] = sr[64 * j];
                } }
#pragma unroll
            for (int q = 0; q < 2; ++q) { const int r = rr[q];
                if (r >= MP) continue;
                float a = 0.f;
#pragma unroll
                for (int j = 0; j < 4; ++j) a += (v[q][j].x * v[q][j].x + v[q][j].y * v[q][j].y) + (v[q][j].z * v[q][j].z + v[q][j].w * v[q][j].w);
                a = wave_sum(a, lane); if (lane == 0) ss[r] = a;
                unsigned long long* o8 = (unsigned long long*)(XB + (size_t)r * DM) + lane;
#pragma unroll
                for (int j = 0; j < 4; ++j) o8[64 * j] = (unsigned long long)pk2(v[q][j].x, v[q][j].y) | ((unsigned long long)pk2(v[q][j].z, v[q][j].w) << 32); }
        }
    }
    {
        LAS float* scr = (LAS float*)(F.lds + F.wave * 16384);
        unsigned char* W = F.ws + WS_W;
        constexpr int I_IN = (DM / 64) * (INW / 32), I_G = (DM / 64) * (DFF / 32), I_D = (DFF / 64) * (DM / 32), I_O = (DM / 64) * (DM / 32), I_M = (512 / 64) * (DM / 32);
        constexpr int NIT = I_IN + 2 * I_G + I_D + I_O + 2 * I_M;
        if (DSEL(2)) for (int it = gw; it < NIT; it += NGW) {
            int r = it;
            if (r < I_IN) { p0_transpose_item(FIN(5) + (size_t)layer * DM * INW, DM, INW, (bf16_t*)(W + W_IN), 0, scr, r, lane, FIN(4) + layer * DM); continue; } r -= I_IN;
            if (r < I_G) { p0_transpose_item(FIN(25) + (size_t)layer * DM * DFF, DM, DFF, (bf16_t*)(W + W_G), 0, scr, r, lane, FIN(24) + layer * DM); continue; } r -= I_G;
            if (r < I_G) { p0_transpose_item(FIN(26) + (size_t)layer * DM * DFF, DM, DFF, (bf16_t*)(W + W_U), 0, scr, r, lane, FIN(24) + layer * DM); continue; } r -= I_G;
            if (r < I_D) { p0_transpose_item(FIN(29) + (size_t)layer * DFF * DM, DFF, DM, (bf16_t*)(W + W_D), 0, scr, r, lane); continue; } r -= I_D;
            if (r < I_O) { p0_transpose_item(FIN(23) + (size_t)layer * DM * DM, DM, DM, (bf16_t*)(W + W_OUT), 0, scr, r, lane); continue; } r -= I_O;
            if (r < I_M) { p0_transpose_item(FIN(20) + (size_t)layer * 512 * DM, 512, DM, (bf16_t*)(W + W_MRG), 0, scr, r, lane); continue; } r -= I_M;
            p0_transpose_item(FIN(21) + (size_t)layer * 512 * DM, 512, DM, (bf16_t*)(W + W_MRG), DM, scr, r, lane);
        }
        const float* pw = FIN(18) + (size_t)layer * 4 * 128 * 128; const float* psc = FIN(19) + layer * 512; const float* wpo = FIN(22) + (size_t)layer * 512 * DM;
        bf16_t* WT = (bf16_t*)(W + W_MRG) + (size_t)2 * DM * 512;
        const int gt = (F.vcu * NWAVES + F.wave) * 64 + lane, NGT = NGW * 64;
        if (DSEL(4)) for (int st = NGW - 1 - gw; st < (512 / 8) * (DM / 64); st += NGW) {
            const int c0 = (st >> 4) * 8, j = (st & 15) * 64 + lane, g = c0 >> 7;
            { const int cr = lane >> 3, d0 = (lane & 7) * 16; const float* pr = pw + ((size_t)c0 + cr) * 128 + d0; const float* ps = psc + g * 128 + d0;
#pragma unroll
              for (int q = 0; q < 4; ++q) { const f32x4 a = *(const f32x4*)(pr + 4 * q), b = *(const f32x4*)(ps + 4 * q); *(LAS f32x4*)(scr + cr * 128 + d0 + 4 * q) = a * b; } }
            LDS_WAIT(); asm volatile("" ::: "memory");
            const float* wp = wpo + (size_t)(g * 128) * DM + j;
            float a[8];
#pragma unroll
            for (int c = 0; c < 8; ++c) a[c] = 0.f;
#pragma unroll 1
            for (int d0 = 0; d0 < 128; d0 += 16) { float w[16];
#pragma unroll
                for (int q = 0; q < 16; ++q) w[q] = wp[(size_t)(d0 + q) * DM];
                asm volatile("" ::: "memory");
#pragma unroll
                for (int c = 0; c < 8; ++c)
#pragma unroll
                    for (int q4 = 0; q4 < 4; ++q4) { const f32x4 cf = *(const LAS f32x4*)(scr + c * 128 + d0 + 4 * q4);
#pragma unroll
                        for (int e = 0; e < 4; ++e) a[c] += cf[e] * w[4 * q4 + e]; }
                asm volatile("" ::: "memory");
            }
            u32x4 o; o.x = pk2(a[0], a[1]); o.y = pk2(a[2], a[3]); o.z = pk2(a[4], a[5]); o.w = pk2(a[6], a[7]);
            *(u32x4*)(WT + (size_t)j * 512 + c0) = o;
            LDS_WAIT(); asm volatile("" ::: "memory");
        }
        for (int idx = gt; idx < 2 * 512 * 513; idx += NGT) { const int k = idx % 513, cc = (idx / 513) & 511, cls = idx / (513 * 512);
            const int L = cls ? LS : LP, rklen = cls ? RKLEN_S : RKLEN_P; bf16_t* RK = (bf16_t*)(F.ws + (cls ? WS_RKS : WS_RKP)) + (size_t)cc * rklen;
            RK[k <= 256 ? k : 256 + 2 * L + (k - 257)] = 0; }
        if (!filt_first && DSEL(8)) for (int it = gw; it < NI8; it += NGW) filt_h2_item8(A, F, layer, it, scr, lane);
    }
}

__device__ __forceinline__ void p_attn_ref(const CArgs& A, const Frame& F, int layer) {
    bf16_t* P = (bf16_t*)(F.ws + WS_PROJ);
    const float* qg = FIN(6) + layer * HD; const float* kg = FIN(7) + layer * HD; const float* sink = FIN(8) + layer * NHEAD; const float* rb = FIN(3);
    const int gt = (F.vcu * NWAVES + F.wave) * 64 + F.lane, NGT = F.G * NWAVES * 64;
    for (int idx = gt; idx < MROWS * NHEAD; idx += NGT) {
        const int r = idx >> 3, h = idx & 7, hk = h >> 2;
        const int s = seq_of_row(r), base = seq_base(s), L = seq_len(s), p = r - base;
        unsigned qs[32]; float o[64];
        { const u32x4* qp = (const u32x4*)(P + (size_t)r * INW + C_Q + 64 * h); float ss = 0.f;
#pragma unroll
          for (int c = 0; c < 8; ++c) { const u32x4 w = qp[c]; qs[4 * c] = w.x; qs[4 * c + 1] = w.y; qs[4 * c + 2] = w.z; qs[4 * c + 3] = w.w; }
#pragma unroll
          for (int d = 0; d < 32; ++d) { const float a = bflo(qs[d]), b = bfhi(qs[d]); ss += a * a + b * b; }
          const float rs = 1.0f / sqrtf(ss * (1.f / 64) + EPS) * 0.125f;
#pragma unroll
          for (int d = 0; d < 32; ++d) { qs[d] = pk2(bflo(qs[d]) * rs * qg[2 * d], bfhi(qs[d]) * rs * qg[2 * d + 1]); o[2 * d] = 0.f; o[2 * d + 1] = 0.f; } }
        float m = sink[h], l = 1.f;
        const int lo = p - 128 < 0 ? 0 : p - 128, hi = p + 128 > L - 1 ? L - 1 : p + 128;
        for (int pk = lo; pk <= hi; ++pk) {
            const bf16_t* kr = P + (size_t)(base + pk) * INW;
            const u32x4* kp = (const u32x4*)(kr + C_K + 64 * hk); const u32x4* vp = (const u32x4*)(kr + C_V + 64 * hk);
            float ss = 0.f, dt = 0.f;
#pragma unroll
            for (int c = 0; c < 8; ++c) { float kk[8]; unpack8(kp[c], kk);
#pragma unroll
                for (int e = 0; e < 8; ++e) { ss += kk[e] * kk[e]; const unsigned qw = qs[4 * c + (e >> 1)]; dt += kk[e] * kg[8 * c + e] * ((e & 1) ? bfhi(qw) : bflo(qw)); }
                asm volatile("" ::: "memory"); }
            const float sc = dt / sqrtf(ss * (1.f / 64) + EPS) + rb[c_bucket[pk - p + 128] * NHEAD + h];
            const float mn = fmaxf(m, sc), f = __expf(m - mn), pe = __expf(sc - mn);
            l = l * f + pe; m = mn;
#pragma unroll
            for (int c = 0; c < 8; ++c) { float vv[8]; unpack8(vp[c], vv);
#pragma unroll
                for (int e = 0; e < 8; ++e) o[8 * c + e] = o[8 * c + e] * f + pe * vv[e];
                asm volatile("" ::: "memory"); }
        }
        const float il = (DBG & 4) ? 0.f : 1.f / l; u32x4* op = (u32x4*)(P + (size_t)r * INW + C_Q + 64 * h);
#pragma unroll
        for (int c = 0; c < 8; ++c) { u32x4 w; w.x = pk2(o[8 * c] * il, o[8 * c + 1] * il); w.y = pk2(o[8 * c + 2] * il, o[8 * c + 3] * il); w.z = pk2(o[8 * c + 4] * il, o[8 * c + 5] * il); w.w = pk2(o[8 * c + 6] * il, o[8 * c + 7] * il); op[c] = w; }
    }
}

constexpr int AT_K = 0, AT_V = 49152, AT_VSTR = 776, AT_B = AT_V + 64 * AT_VSTR, AT_BSTR = 324;
constexpr float AT_LOG2E = 1.4426950408889634f;
__device__ __forceinline__ void p_attn(const CArgs& A, const Frame& F, int layer) {
    bf16_t* P = (bf16_t*)(F.ws + WS_PROJ);
    const float* qg = FIN(6) + layer * HD; const float* kg = FIN(7) + layer * HD; const float* sink = FIN(8) + layer * NHEAD; const float* rb = FIN(3);
    const int lane = F.lane, wave = F.wave, tid = F.tid, r32 = lane & 31, hi = lane >> 5;
    LAS unsigned char* lds = F.lds;
    for (int unit = F.vcu; unit < 265 * 4; unit += F.G) {
        const int gb = unit >> 2, hk = (unit >> 1) & 1, gh = unit & 1;
        const int s = gb < 136 ? gb / 17 : 8, nb = gb < 136 ? gb - 17 * s : gb - 136;
        const int base = seq_base(s), L = seq_len(s);
        const int pk0 = 128 * nb - 240;
        u32x4 kws[6], vws[6];
#pragma unroll
        for (int it = 0; it < 6; ++it) { const int idx = tid + it * 512, key = idx >> 3, ch = idx & 7, pk = pk0 + key; const bool ok = pk >= 0 && pk < L;
            const bf16_t* rowp = P + (size_t)(base + (ok ? pk : 0)) * INW + 64 * hk + 8 * ch;
            kws[it] = *(const u32x4*)(rowp + C_K); vws[it] = *(const u32x4*)(rowp + C_V); }
#pragma unroll
        for (int it = 0; it < 6; ++it) { const int idx = tid + it * 512, key = idx >> 3, ch = idx & 7, pk = pk0 + key; const bool ok = pk >= 0 && pk < L;
            u32x4 kw = kws[it], vw = vws[it];
            float kf[8]; unpack8(kw, kf); float ss = 0.f;
#pragma unroll
            for (int e = 0; e < 8; ++e) ss += kf[e] * kf[e];
            ss += shx(ss, 1, lane); ss += shx(ss, 2, lane); ss += shx(ss, 4, lane);
            const float rs = ok ? 1.0f / sqrtf(ss * (1.f / 64) + EPS) : 0.f;
            u32x4 ko; ko.x = pk2(kf[0] * rs * kg[8 * ch], kf[1] * rs * kg[8 * ch + 1]); ko.y = pk2(kf[2] * rs * kg[8 * ch + 2], kf[3] * rs * kg[8 * ch + 3]);
            ko.z = pk2(kf[4] * rs * kg[8 * ch + 4], kf[5] * rs * kg[8 * ch + 5]); ko.w = pk2(kf[6] * rs * kg[8 * ch + 6], kf[7] * rs * kg[8 * ch + 7]);
            *(LAS u32x4*)(lds + AT_K + key * 128 + ((ch ^ (key & 7)) << 4)) = ko;
            if (!ok) vw = (u32x4){0u, 0u, 0u, 0u};
            LAS bf16_t* vt = (LAS bf16_t*)(lds + AT_V + (8 * ch) * AT_VSTR) + key;
            vt[0] = (bf16_t)(vw.x & 0xffffu); *(LAS bf16_t*)((LAS unsigned char*)vt + AT_VSTR) = (bf16_t)(vw.x >> 16);
            *(LAS bf16_t*)((LAS unsigned char*)vt + 2 * AT_VSTR) = (bf16_t)(vw.y & 0xffffu); *(LAS bf16_t*)((LAS unsigned char*)vt + 3 * AT_VSTR) = (bf16_t)(vw.y >> 16);
            *(LAS bf16_t*)((LAS unsigned char*)vt + 4 * AT_VSTR) = (bf16_t)(vw.z & 0xffffu); *(LAS bf16_t*)((LAS unsigned char*)vt + 5 * AT_VSTR) = (bf16_t)(vw.z >> 16);
            *(LAS bf16_t*)((LAS unsigned char*)vt + 6 * AT_VSTR) = (bf16_t)(vw.w & 0xffffu); *(LAS bf16_t*)((LAS unsigned char*)vt + 7 * AT_VSTR) = (bf16_t)(vw.w >> 16); }
        for (int i = tid; i < 2 * 257; i += 512) { const int hh = i >= 257 ? 1 : 0, rr = i - 257 * hh; ((LAS float*)(lds + AT_B))[hh * AT_BSTR + 32 + rr] = AT_LOG2E * rb[c_bucket[rr] * NHEAD + 4 * hk + 2 * gh + hh]; }
        __syncthreads();
        const int hh = wave >> 2, head = 4 * hk + 2 * gh + hh, qt = wave & 3, qi = 32 * qt + r32, pq = 128 * nb - 112 + qi; const bool qok = pq >= 0;
        const LAS float* bias = (const LAS float*)(lds + AT_B) + hh * AT_BSTR + 32;
        const bool edge = pk0 < 0 || pk0 + 384 > L;
        bf16x8 qf[4];
        { const bf16_t* qp = P + (size_t)(base + (qok ? pq : 0)) * INW + C_Q + 64 * head + 8 * hi; u32x4 qw[4]; float ss = 0.f;
#pragma unroll
          for (int ds = 0; ds < 4; ++ds) { qw[ds] = *(const u32x4*)(qp + 16 * ds); float f[8]; unpack8(qw[ds], f);
#pragma unroll
              for (int e = 0; e < 8; ++e) ss += f[e] * f[e]; }
          ss += shx(ss, 32, lane);
          const float rs = (0.125f * AT_LOG2E) / sqrtf(ss * (1.f / 64) + EPS);
#pragma unroll
          for (int ds = 0; ds < 4; ++ds) { float f[8]; unpack8(qw[ds], f); const float* g = qg + 16 * ds + 8 * hi; u32x4 o;
              o.x = pk2(f[0] * rs * g[0], f[1] * rs * g[1]); o.y = pk2(f[2] * rs * g[2], f[3] * rs * g[3]); o.z = pk2(f[4] * rs * g[4], f[5] * rs * g[5]); o.w = pk2(f[6] * rs * g[6], f[7] * rs * g[7]);
              qf[ds] = __builtin_bit_cast(bf16x8, o); } }
        float m = AT_LOG2E * sink[head], lp = hi == 0 ? 1.f : 0.f;
        f32x16 o0 = {}, o1 = {};
#define ATT_TILE(MODE, KT) do { const int kt = (KT); \
            f32x16 st = {}; \
            _Pragma("unroll") for (int ds = 0; ds < 4; ++ds) { const int key = 32 * kt + r32, chn = 2 * ds + hi; \
                const bf16x8 kfr = *(const LAS bf16x8*)(lds + AT_K + key * 128 + ((chn ^ (key & 7)) << 4)); \
                st = __builtin_amdgcn_mfma_f32_32x32x16_bf16(kfr, qf[ds], st, 0, 0, 0); } \
            const LAS float* bj = bias + 32 * (kt - qt) - r32 + 4 * hi; float bv[16]; \
            _Pragma("unroll") for (int i = 0; i < 16; ++i) bv[i] = bj[(i & 3) + 8 * (i >> 2)]; \
            float tmax = -1e30f; \
            _Pragma("unroll") for (int i = 0; i < 16; ++i) { const int ci = (i & 3) + 8 * (i >> 2); bool ok = true; \
                if (MODE == 0) ok = ci >= thr; else if (MODE == 2) ok = ci <= thr; \
                else if (MODE == 3) { const int kj = 32 * kt + ci + 4 * hi, rel = kj - 128 - qi, pk = pk0 + kj; ok = rel >= -128 && rel <= 128 && pk >= 0 && pk < L; } \
                const float v = ok ? st[i] + bv[i] : -1e30f; st[i] = v; tmax = fmaxf(tmax, v); } \
            tmax = fmaxf(tmax, shx(tmax, 32, lane)); \
            const float mn = fmaxf(m, tmax), f = __builtin_amdgcn_exp2f(m - mn); m = mn; \
            float ps = 0.f; \
            _Pragma("unroll") for (int i = 0; i < 16; ++i) { st[i] = __builtin_amdgcn_exp2f(st[i] - mn); ps += st[i]; } \
            lp = lp * f + ps; \
            _Pragma("unroll") for (int i = 0; i < 16; ++i) { o0[i] *= f; o1[i] *= f; } \
            _Pragma("unroll") for (int s2 = 0; s2 < 2; ++s2) { \
                u32x4 pw; pw.x = pk2(st[8 * s2], st[8 * s2 + 1]); pw.y = pk2(st[8 * s2 + 2], st[8 * s2 + 3]); pw.z = pk2(st[8 * s2 + 4], st[8 * s2 + 5]); pw.w = pk2(st[8 * s2 + 6], st[8 * s2 + 7]); \
                const bf16x8 pf = __builtin_bit_cast(bf16x8, pw); \
                _Pragma("unroll") for (int dt = 0; dt < 2; ++dt) { const LAS unsigned char* vp = lds + AT_V + (32 * dt + r32) * AT_VSTR + (32 * kt + 16 * s2 + 4 * hi) * 2; \
                    const u32x2 a0 = *(const LAS u32x2*)vp, a1 = *(const LAS u32x2*)(vp + 16); \
                    const bf16x8 vf = __builtin_bit_cast(bf16x8, (u32x4){a0.x, a0.y, a1.x, a1.y}); \
                    if (dt == 0) o0 = __builtin_amdgcn_mfma_f32_32x32x16_bf16(vf, pf, o0, 0, 0, 0); else o1 = __builtin_amdgcn_mfma_f32_32x32x16_bf16(vf, pf, o1, 0, 0, 0); } } } while (0)
        const int thr = r32 - 4 * hi;
        if (edge) { for (int j = 0; j <= 8; ++j) ATT_TILE(3, qt + j); }
        else { ATT_TILE(0, qt); for (int j = 1; j < 8; ++j) ATT_TILE(1, qt + j); ATT_TILE(2, qt + 8); }
#undef ATT_TILE
        const float il = (DBG & 4) ? 0.f : 1.f / (lp + shx(lp, 32, lane));
        if (qok && !F.dry) { bf16_t* op = P + (size_t)(base + pq) * INW + C_Q + 64 * head + 4 * hi;
#pragma unroll
            for (int g = 0; g < 4; ++g) { u32x2 w0, w1; w0.x = pk2(o0[4 * g] * il, o0[4 * g + 1] * il); w0.y = pk2(o0[4 * g + 2] * il, o0[4 * g + 3] * il);
                w1.x = pk2(o1[4 * g] * il, o1[4 * g + 1] * il); w1.y = pk2(o1[4 * g + 2] * il, o1[4 * g + 3] * il);
                *(u32x2*)(op + 8 * g) = w0; *(u32x2*)(op + 32 + 8 * g) = w1; } }
        __syncthreads();
    }
}
__device__ __forceinline__ void dwconv8(const bf16_t* P, int r, int col, const float* cw, const float* cb, int ucol, float* out) {
    const int s = seq_of_row(r), p = r - seq_base(s); const bool hasp = p > 0, hasn = p < seq_len(s) - 1;
    const bf16_t* gp = P + (size_t)r * INW + col;
    const u32x4 gm = *(const u32x4*)(gp - (hasp ? INW : 0)), g0 = *(const u32x4*)gp, gn = *(const u32x4*)(gp + (hasn ? INW : 0));
    float fm[8], f0[8], fn[8]; unpack8(gm, fm); unpack8(g0, f0); unpack8(gn, fn);
    const float mp_ = hasp ? 1.f : 0.f, mn_ = hasn ? 1.f : 0.f;
#pragma unroll
    for (int e = 0; e < 8; ++e) { fm[e] *= mp_; fn[e] *= mn_; }
#pragma unroll
    for (int e = 0; e < 8; ++e) out[e] = cw[ucol + e] * fm[e] + cw[1536 + ucol + e] * f0[e] + cw[2 * 1536 + ucol + e] * fn[e] + cb[ucol + e];
}
struct DwRows { u32x4 gm, g0, gn; float mp_, mn_; };
struct DwTaps { f32x4 a[2], b[2], c[2], d[2]; };
__device__ __forceinline__ void dw_load(const bf16_t* P, int r, int col, DwRows& d) {
    const int s = seq_of_row(r), p = r - seq_base(s); const bool hasp = p > 0, hasn = p < seq_len(s) - 1;
    const bf16_t* gp = P + (size_t)r * INW + col;
    d.gm = *(const u32x4*)(gp - (hasp ? INW : 0)); d.g0 = *(const u32x4*)gp; d.gn = *(const u32x4*)(gp + (hasn ? INW : 0));
    d.mp_ = hasp ? 1.f : 0.f; d.mn_ = hasn ? 1.f : 0.f;
}
__device__ __forceinline__ void dw_taps(const float* cw, const float* cb, int ucol, DwTaps& w) {
#pragma unroll
    for (int h = 0; h < 2; ++h) { w.a[h] = *(const f32x4*)(cw + ucol + 4 * h); w.b[h] = *(const f32x4*)(cw + 1536 + ucol + 4 * h); w.c[h] = *(const f32x4*)(cw + 2 * 1536 + ucol + 4 * h); w.d[h] = *(const f32x4*)(cb + ucol + 4 * h); }
}
__device__ __forceinline__ void dw_apply(const DwRows& d, const DwTaps& w, float* out) {
    float fm[8], f0[8], fn[8]; unpack8(d.gm, fm); unpack8(d.g0, f0); unpack8(d.gn, fn);
#pragma unroll
    for (int e = 0; e < 8; ++e) out[e] = w.a[e >> 2][e & 3] * (fm[e] * d.mp_) + w.b[e >> 2][e & 3] * f0[e] + w.c[e >> 2][e & 3] * (fn[e] * d.mn_) + w.d[e >> 2][e & 3];
}
__device__ __forceinline__ void p_h1(const CArgs& A, const Frame& F, int layer) {
    const bf16_t* P = (const bf16_t*)(F.ws + WS_PROJ); bf16_t* ZT = (bf16_t*)F.out;
    const float* cw = FIN(9) + (size_t)layer * 3 * 1536; const float* cb = FIN(10) + layer * 1536;
    LAS bf16_t* scr = (LAS bf16_t*)(F.lds + F.wave * 16384);
    const int gw = F.vcu * NWAVES + F.wave, NGW = F.G * NWAVES, lane = F.lane, rs = lane >> 3, ck = lane & 7;
    for (int it = gw; it < (MP / 64) * 8; it += NGW) {
        const int rt = it >> 3, cc = it & 7, c0 = cc * 64 + ck * 8;
        DwTaps wa, wb; dw_taps(cw, cb, 512 + c0, wa); dw_taps(cw, cb, 1024 + c0, wb);
#pragma unroll
        for (int hb = 0; hb < 2; ++hb) { DwRows da[4], db[4];
#pragma unroll
            for (int q = 0; q < 4; ++q) { const int r = rt * 64 + (hb * 4 + q) * 8 + rs, rc = r < MROWS ? r : MROWS - 1; dw_load(P, rc, C_X1 + c0, da[q]); dw_load(P, rc, C_VV + c0, db[q]); }
            asm volatile("" ::: "memory");
#pragma unroll
            for (int q = 0; q < 4; ++q) { const int lr = (hb * 4 + q) * 8 + rs, r = rt * 64 + lr; float a[8], b[8]; dw_apply(da[q], wa, a); dw_apply(db[q], wb, b);
                const float ok = r < MROWS ? 1.f : 0.f;
#pragma unroll
                for (int e = 0; e < 8; ++e) scr[(ck * 8 + e) * 72 + lr] = (bf16_t)f2bf(a[e] * b[e] * ok); }
            asm volatile("" ::: "memory"); }
        LDS_WAIT();
#pragma unroll
        for (int j = 0; j < 8; ++j) { const int chn = (lane >> 3) + 8 * j, pc = lane & 7;
            const u32x4 w = *(const LAS u32x4*)(scr + chn * 72 + pc * 8);
            *(u32x4*)(ZT + (size_t)(cc * 64 + chn) * MP + rt * 64 + pc * 8) = w; }
        LDS_WAIT();
    }
}

__device__ __forceinline__ void p_h2_ref(const CArgs& A, const Frame& F) {
    const bf16_t* ZT = (const bf16_t*)F.out; bf16_t* CT = (bf16_t*)F.out + (size_t)512 * MP;
    const int gt = (F.vcu * NWAVES + F.wave) * 64 + F.lane, NGT = F.G * NWAVES * 64;
    for (long idx = gt; idx < (long)512 * MP; idx += NGT) {
        const int c = (int)(idx / MP), r = (int)(idx - (long)c * MP);
        float acc = 0.f;
        if (r < MROWS) {
            const int s = seq_of_row(r), base = seq_base(s), L = seq_len(s), p = r - base, cls = s < 8 ? 0 : 1;
            const bf16_t* rk = (const bf16_t*)(F.ws + (cls ? WS_RKS : WS_RKP)) + (size_t)c * (cls ? RKLEN_S : RKLEN_P) + RK_PAD + L - p;
            const bf16_t* z = ZT + (size_t)c * MP + base;
            for (int s8 = 0; s8 < L; s8 += 8) { const u32x4 zw = *(const u32x4*)(z + s8); float zf[8]; unpack8(zw, zf);
#pragma unroll
                for (int e = 0; e < 8; ++e) acc += zf[e] * __uint_as_float((unsigned)rk[s8 + e] << 16); }
        }
        CT[idx] = (bf16_t)f2bf(acc);
    }
}
constexpr int H2_ZOFF_S = ((RKLEN_S * 2 + 1023) >> 10) << 10, H2_ZOFF_P = ((RKLEN_P * 2 + 1023) >> 10) << 10;
constexpr int H2_ZPADL_S = 4096, H2_ZSLOTS_S = 24704, H2_ZPADL_P = 512, H2_ZSLOTS_P = 3072, H2_SZP = 6976;
static_assert(H2_ZOFF_S + (H2_ZSLOTS_S + (H2_ZSLOTS_S >> 7) * 16) * 2 <= RING_BYTES_C && H2_ZOFF_P + 8 * H2_SZP <= RING_BYTES_C, "H2 LDS");
__device__ __forceinline__ void p_h2(const Frame& F) {
    const bf16_t* ZT = (const bf16_t*)F.out; bf16_t* CT = (bf16_t*)F.out + (size_t)512 * MP;
    const int lane = F.lane, wave = F.wave, tid = F.tid;
    LAS float* red = (LAS float*)(F.lds + LDSCTL_OFF_C + 1024);
    for (int item = F.vcu; item < 1024; item += F.G) {
        const int cls = item < 512 ? 1 : 0, c = item & 511;
        const int L = cls ? LS : LP, rklen = cls ? RKLEN_S : RKLEN_P, ZPADL = cls ? H2_ZPADL_S : H2_ZPADL_P, zs8 = (cls ? H2_ZSLOTS_S : H2_ZSLOTS_P) / 8;
        LAS unsigned char* rkl = F.lds; LAS unsigned char* zl = F.lds + (cls ? H2_ZOFF_S : H2_ZOFF_P);
        {
          const char* rkg = (const char*)((const bf16_t*)(F.ws + (cls ? WS_RKS : WS_RKP)) + (size_t)c * rklen);
          const int npc = (rklen * 2 + 1023) >> 10;
          for (int pc = wave; pc < npc; pc += NWAVES)
              __builtin_amdgcn_global_load_lds((const unsigned*)(rkg + (size_t)pc * 1024 + lane * 16), (LAS unsigned*)(rkl + pc * 1024), 16, 0, 0);
          const int nsl = (cls ? 1 : 8) * zs8; u32x4 zv[7];
#pragma unroll
          for (int j = 0; j < 7; ++j) { const int i = tid + j * (NWAVES * 64); const int sq = i / zs8, i8 = i - sq * zs8, sp = i8 * 8 - ZPADL;
              zv[j] = (u32x4){0u, 0u, 0u, 0u};
              if (i < nsl && sp >= 0 && sp < L) zv[j] = *(const u32x4*)(ZT + (size_t)c * MP + (cls ? ROWS_P : sq * LP) + sp); }
#pragma unroll
          for (int j = 0; j < 7; ++j) { const int i = tid + j * (NWAVES * 64); const int sq = i / zs8, i8 = i - sq * zs8; const int pos = i8 * 8, el = pos + ((pos >> 7) << 4);
              if (i < nsl) *(LAS u32x4*)(zl + sq * H2_SZP + el * 2) = zv[j]; }
          asm volatile("s_waitcnt vmcnt(0)" ::: "memory"); }
        __syncthreads();
        const int n = lane & 15, h = lane >> 4, cg = wave & 3, us = wave >> 2;
        int T0a, zb, T0min, T0max, rowbase;
        const int T0g = cls ? 128 * 16 : 256; const int zg1 = (T0g + (T0g >> 7) * 16) * 2;
        if (cls) { T0min = 16 + 128 * 32 * cg; T0max = T0min + 128 * 31; T0a = T0min + 128 * n; zb = 0; rowbase = ROWS_P; }
        else { const int sq = n >> 1; T0min = 16 + 512 * cg; T0max = T0min + 384; T0a = T0min + 128 * (n & 1); zb = sq * H2_SZP; rowbase = sq * LP; }
        const int u_lo = -(((T0max + 7 + 31) >> 5) << 5), u_hi = ((L - 32 - T0min + 31) >> 5) << 5;
        const int nst = (u_hi - u_lo) / 32 + 1, nh = (nst + 1) >> 1;
        const int u_a = us ? u_lo + 32 * nh : u_lo, u_b = us ? u_hi : u_lo + 32 * (nh - 1);
        const int abase = RK_PAD + L - 8 * n + 8 * h;
        f32x4 acc[2][8];
#pragma unroll
        for (int g = 0; g < 2; ++g)
#pragma unroll
            for (int t = 0; t < 8; ++t) acc[g][t] = (f32x4){0.f, 0.f, 0.f, 0.f};
#define H2_STEP(V0, V1) do { \
            const LAS unsigned char* ap = rkl + (abase + u) * 2; \
            const u32x4 Lo = *(const LAS u32x4*)(ap - 16), Hi = *(const LAS u32x4*)ap; \
            bf16x8 Bz[2]; \
            { const int i0 = T0a + u + 8 * h + ZPADL, e0 = i0 + ((i0 >> 7) << 4); const LAS unsigned char* zp = zl + zb + e0 * 2; \
              if (V0) Bz[0] = *(const LAS bf16x8*)zp; if (V1) Bz[1] = *(const LAS bf16x8*)(zp + zg1); } \
            unsigned W[8] = {Lo.x, Lo.y, Lo.z, Lo.w, Hi.x, Hi.y, Hi.z, Hi.w}, Od[7]; \
            _Pragma("unroll") for (int k = 0; k < 7; ++k) Od[k] = __builtin_amdgcn_alignbit(W[k + 1], W[k], 16); \
            _Pragma("unroll") for (int t = 0; t < 8; ++t) { const int i = 4 - ((t + 1) >> 1); \
                const u32x4 fw = (t & 1) ? (u32x4){Od[i], Od[i + 1], Od[i + 2], Od[i + 3]} : (u32x4){W[i], W[i + 1], W[i + 2], W[i + 3]}; \
                const bf16x8 Af = __builtin_bit_cast(bf16x8, fw); \
                if (V0) acc[0][t] = __builtin_amdgcn_mfma_f32_16x16x32_bf16(Af, Bz[0], acc[0][t], 0, 0, 0); \
                if (V1) acc[1][t] = __builtin_amdgcn_mfma_f32_16x16x32_bf16(Af, Bz[1], acc[1][t], 0, 0, 0); } } while (0)
        { const int gspan = cls ? 128 * 15 : 128;
          int u0s = -(T0min + gspan + 39); u0s = u0s >= 0 ? ((u0s + 31) >> 5) << 5 : -((-u0s) >> 5 << 5);
          int u1e = L - (T0min + T0g); u1e = u1e >= 0 ? ((u1e + 31) >> 5) << 5 : -((-u1e) >> 5 << 5);
          const int ua2 = u0s > u_a ? (u0s < u_b + 32 ? u0s : u_b + 32) : u_a;
          const int ub2 = u1e < u_b + 32 ? (u1e > ua2 ? u1e : ua2) : u_b + 32;
          int u = u_a;
          for (; u < ua2; u += 32) H2_STEP(false, true);
          for (; u < ub2; u += 32) H2_STEP(true, true);
          for (; u <= u_b; u += 32) H2_STEP(true, false); }
#undef H2_STEP
        { float m[16];
#pragma unroll
          for (int t = 0; t < 16; ++t) m[t] = 0.f;
          const int nchunk = L / 8, cstep = cls ? NWAVES * 64 : 64; const int zb2 = cls ? 0 : wave * H2_SZP;
          for (int ck = cls ? tid : lane; ck < nchunk; ck += cstep) { const int s0 = ck * 8, i0 = s0 + ZPADL, e0 = i0 + ((i0 >> 7) << 4);
              const u32x4 zw = *(const LAS u32x4*)(zl + zb2 + e0 * 2);
              const LAS unsigned char* rp = rkl + (RK_PAD + L + s0 - 16) * 2;
              const u32x4 r0 = *(const LAS u32x4*)rp, r1 = *(const LAS u32x4*)(rp + 16), r2 = *(const LAS u32x4*)(rp + 32);
              float zf[8], rf[24]; unpack8(zw, zf); unpack8(r0, rf); unpack8(r1, rf + 8); unpack8(r2, rf + 16);
#pragma unroll
              for (int t = 0; t < 16; ++t)
#pragma unroll
                  for (int e = 0; e < 8; ++e) m[t] += zf[e] * rf[16 + e - t]; }
#pragma unroll
          for (int t = 0; t < 16; ++t) m[t] = wave_sum(m[t], lane);
          float mine = 0.f;
#pragma unroll
          for (int t = 0; t < 16; ++t) mine = (lane == t) ? m[t] : mine;
          if (cls) { if (lane < 16) red[wave * 16 + lane] = mine; }
          else if (lane < 16) CT[(size_t)c * MP + wave * LP + lane] = (bf16_t)f2bf(mine); }
        __syncthreads();
        if (us == 1) {
#pragma unroll
            for (int g = 0; g < 2; ++g)
#pragma unroll
                for (int t = 0; t < 8; ++t) *(LAS f32x4*)(F.lds + cg * 16384 + (g * 8 + t) * 1024 + lane * 16) = acc[g][t]; }
        if (cls && tid < 16) { float a = 0.f;
#pragma unroll
            for (int w = 0; w < 8; ++w) a += red[w * 16 + tid];
            CT[(size_t)c * MP + ROWS_P + tid] = (bf16_t)f2bf(a); }
        __syncthreads();
        if (us == 0) {
#pragma unroll
            for (int g = 0; g < 2; ++g) {
#pragma unroll
                for (int t = 0; t < 8; ++t) acc[g][t] += *(const LAS f32x4*)(F.lds + cg * 16384 + (g * 8 + t) * 1024 + lane * 16);
                bf16_t* op = CT + (size_t)c * MP + rowbase + T0a + g * T0g + 32 * h;
#pragma unroll
                for (int i = 0; i < 4; ++i) { u32x4 w; w.x = pk2(acc[g][0][i], acc[g][1][i]); w.y = pk2(acc[g][2][i], acc[g][3][i]); w.z = pk2(acc[g][4][i], acc[g][5][i]); w.w = pk2(acc[g][6][i], acc[g][7][i]);
                    *(u32x4*)(op + 8 * i) = w; } } }
        __syncthreads();
    }
}
__device__ __forceinline__ void p_pool(const CArgs& A, const Frame& F) {
    bf16_t* P = (bf16_t*)(F.ws + WS_PROJ);
    const int gw = F.vcu * NWAVES + F.wave, NGW = F.G * NWAVES, lane = F.lane, c0 = lane * 8, hw = 1 << (lane >> 4);
    for (int run = gw; run < MROWS / 16; run += NGW) {
        const int r0 = run * 16, s = seq_of_row(r0), base = seq_base(s), L = seq_len(s), p0 = r0 - base;
        const bf16_t* ub = P + (size_t)base * INW + C_PU + c0;
        float S[8];
#pragma unroll
        for (int e = 0; e < 8; ++e) S[e] = 0.f;
#pragma unroll
        for (int i = 0; i < 16; ++i) { const int pp = p0 - hw + i; const bool ok = i < 2 * hw && pp >= 0 && pp < L;
            const u32x4 w = *(const u32x4*)(ub + (size_t)(ok ? pp : p0) * INW); float f[8]; unpack8(w, f); const float mk = ok ? 1.f : 0.f;
#pragma unroll
            for (int e = 0; e < 8; ++e) S[e] += mk * f[e]; }
#pragma unroll 4
        for (int k = 0; k < 16; ++k) { const int p = p0 + k, pn = p + hw, po = p - hw; const bool okn = pn < L, oko = po >= 0;
            const u32x4 ws_ = *(const u32x4*)(ub + (size_t)p * INW), wn = *(const u32x4*)(ub + (size_t)(okn ? pn : p) * INW), wo = *(const u32x4*)(ub + (size_t)(oko ? po : p) * INW);
            float fs[8], fn[8], fo[8]; unpack8(ws_, fs); unpack8(wn, fn); unpack8(wo, fo);
            const int lo = po < 0 ? 0 : po, hi = pn > L ? L : pn; const float ic = 1.f / (float)(hi - lo);
            float a[8];
#pragma unroll
            for (int e = 0; e < 8; ++e) a[e] = (DBG & 16) ? 0.f : S[e] * ic - fs[e];
            u32x4 w; w.x = pk2(a[0], a[1]); w.y = pk2(a[2], a[3]); w.z = pk2(a[4], a[5]); w.w = pk2(a[6], a[7]);
            *(u32x4*)(P + (size_t)(r0 + k) * INW + C_X1 + c0) = w;
            const float mn = okn ? 1.f : 0.f, mo = oko ? 1.f : 0.f;
#pragma unroll
            for (int e = 0; e < 8; ++e) S[e] += mn * fn[e] - mo * fo[e]; }
    }
}
__device__ __forceinline__ void p_final(const CArgs& A, const Frame& F, int layer) {
    bf16_t* P = (bf16_t*)(F.ws + WS_PROJ); const bf16_t* ZT = (const bf16_t*)F.out; const bf16_t* CT = ZT + (size_t)512 * MP;
    const float* cw = FIN(9) + (size_t)layer * 3 * 1536; const float* cb = FIN(10) + layer * 1536; const float* skip = FIN(17) + layer * 512;
    LAS bf16_t* sz = (LAS bf16_t*)(F.lds + F.wave * 16384); LAS bf16_t* sc = sz + 64 * 64;
    const int gw = F.vcu * NWAVES + F.wave, NGW = F.G * NWAVES, lane = F.lane, rs = lane >> 3, ck = lane & 7;
    for (int it = gw; it < (MP / 64) * 8; it += NGW) {
        const int rt = it >> 3, cc = it & 7, c0 = cc * 64 + ck * 8; const int cls = rt * 64 < ROWS_P ? 0 : 1;
        const float* sums = (const float*)(F.ws + WS_CTL) + CW_SUMS + (layer * 2 + cls) * 512;
#pragma unroll
        for (int j = 0; j < 8; ++j) { const int chn = (lane >> 3) + 8 * j, pc = lane & 7; const size_t off = (size_t)(cc * 64 + chn) * MP + rt * 64 + pc * 8;
            *(LAS u32x4*)(sz + chn * 64 + pc * 8) = *(const u32x4*)(ZT + off); *(LAS u32x4*)(sc + chn * 64 + pc * 8) = *(const u32x4*)(CT + off); }
        LDS_WAIT();
        DwTaps wt; dw_taps(cw, cb, c0, wt); float isum[8], sk[8];
        { const f32x4 s0 = *(const f32x4*)(sums + c0), s1 = *(const f32x4*)(sums + c0 + 4), k0 = *(const f32x4*)(skip + c0), k1 = *(const f32x4*)(skip + c0 + 4);
#pragma unroll
          for (int e = 0; e < 4; ++e) { isum[e] = 1.f / s0[e]; isum[4 + e] = 1.f / s1[e]; sk[e] = k0[e]; sk[4 + e] = k1[e]; } }
#pragma unroll
        for (int hb = 0; hb < 2; ++hb) { DwRows dr[4];
#pragma unroll
            for (int q = 0; q < 4; ++q) { const int r = rt * 64 + (hb * 4 + q) * 8 + rs; dw_load(P, r < MROWS ? r : MROWS - 1, C_X0 + c0, dr[q]); }
            asm volatile("" ::: "memory");
#pragma unroll
            for (int q = 0; q < 4; ++q) { const int lr = (hb * 4 + q) * 8 + rs, r = rt * 64 + lr; float x0[8], o[8]; dw_apply(dr[q], wt, x0);
#pragma unroll
                for (int e = 0; e < 8; ++e) { const float z = __uint_as_float((unsigned)sz[(ck * 8 + e) * 64 + lr] << 16), cv = __uint_as_float((unsigned)sc[(ck * 8 + e) * 64 + lr] << 16);
                    o[e] = (DBG & 8) ? 0.f : (((DBG & 64) ? 0.f : cv * isum[e]) + ((DBG & 128) ? 0.f : z * sk[e])) * x0[e]; }
                u32x4 w; w.x = pk2(o[0], o[1]); w.y = pk2(o[2], o[3]); w.z = pk2(o[4], o[5]); w.w = pk2(o[6], o[7]);
                if (r < MROWS) *(u32x4*)(P + (size_t)r * INW + C_VV + c0) = w; }
            asm volatile("" ::: "memory"); }
        LDS_WAIT();
    }
}
constexpr int TAIL_ROW0 = 32768, TAIL_ITEMS = ((MROWS - TAIL_ROW0) / 16) * 16;
static_assert(MROWS - TAIL_ROW0 == 144 && TAIL_ROW0 % 256 == 0, "tail rows");
template <int NS>
__device__ __forceinline__ void tail_partial(f32x4 (&acc)[4], const bf16_t* ap, const bf16_t* bp, size_t bstride16) {
#pragma unroll
    for (int s0 = 0; s0 < NS; s0 += 4) {
        bf16x8 a[4], b[4][4];
#pragma unroll
        for (int s = 0; s < 4; ++s) if (s0 + s < NS) { a[s] = *(const bf16x8*)(ap + (s0 + s) * 32);
#pragma unroll
            for (int j = 0; j < 4; ++j) b[s][j] = *(const bf16x8*)(bp + j * bstride16 + (s0 + s) * 32); }
#pragma unroll
        for (int s = 0; s < 4; ++s) if (s0 + s < NS) {
#pragma unroll
            for (int j = 0; j < 4; ++j) acc[j] = __builtin_amdgcn_mfma_f32_16x16x32_bf16(b[s][j], a[s], acc[j], 0, 0, 0); }
        asm volatile("" ::: "memory");
    }
}
template <int K>
__device__ __forceinline__ void tail_res(const Frame& F, const bf16_t* A, const bf16_t* Bt, bf16_t* X, float* ss, float* outf) {
    constexpr int KW = K / 8, NS = KW / 32; static_assert(K % 256 == 0, "K split");
    const int lane = F.lane, fr = lane & 15, fq = lane >> 4, tid = F.tid;
    for (int item = F.bx; item < TAIL_ITEMS; item += F.G) {
        const int row0 = TAIL_ROW0 + (item >> 4) * 16, col0 = (item & 15) * 64;
        f32x4 acc[4];
#pragma unroll
        for (int j = 0; j < 4; ++j) acc[j] = (f32x4){0.f, 0.f, 0.f, 0.f};
        tail_partial<NS>(acc, A + (size_t)(row0 + fr) * K + F.wave * KW + fq * 8, Bt + (size_t)(col0 + fr) * K + F.wave * KW + fq * 8, (size_t)16 * K);
#pragma unroll
        for (int j = 0; j < 4; ++j) *(LAS f32x4*)(F.lds + F.wave * 4096 + j * 1024 + lane * 16) = acc[j];
        __syncthreads();
        f32x2 sm = {0.f, 0.f};
#pragma unroll
        for (int w = 0; w < 8; ++w) sm += *(const LAS f32x2*)(F.lds + w * 4096 + tid * 8);
        const int j = tid >> 7, l = (tid & 127) >> 1, r2 = (tid & 1) * 2, row = row0 + (l & 15), col = col0 + j * 16 + 4 * (l >> 4) + r2;
        unsigned* xp = (unsigned*)(X + (size_t)row * DM + col); const unsigned xw = *xp;
        const float a = bflo(xw) + sm.x, b = bfhi(xw) + sm.y;
        if (outf) { float* po = out_row(outf, row); if (po && !F.dry) *(f32x2*)(po + col) = (f32x2){a, b}; }
        else { if (!F.dry) *xp = pk2(a, b);
            if (ss) { float sq = a * a + b * b; sq += shx(sq, 1, lane); sq += shx(sq, 32, lane);
                if ((lane & 33) == 0 && !F.dry) atomicAdd(ss + row, sq); } }
        __syncthreads();
    }
}
__device__ __forceinline__ void tail_merge(const Frame& F, const bf16_t* P, const bf16_t* WM, bf16_t* O) {
    const int lane = F.lane, fr = lane & 15, fq = lane >> 4, tid = F.tid;
    for (int item = F.bx; item < TAIL_ITEMS; item += F.G) {
        const int row0 = TAIL_ROW0 + (item >> 4) * 16, col0 = (item & 15) * 64;
#pragma unroll
        for (int s = 0; s < 3; ++s) { const int col = s == 0 ? C_Q : (s == 1 ? C_VV : C_X1);
            f32x4 acc[4];
#pragma unroll
            for (int j = 0; j < 4; ++j) acc[j] = (f32x4){0.f, 0.f, 0.f, 0.f};
            tail_partial<2>(acc, P + (size_t)(row0 + fr) * INW + col + F.wave * 64 + fq * 8, WM + ((size_t)s * DM + col0 + fr) * 512 + F.wave * 64 + fq * 8, (size_t)16 * 512);
#pragma unroll
            for (int j = 0; j < 4; ++j) *(LAS f32x4*)(F.lds + s * 32768 + F.wave * 4096 + j * 1024 + lane * 16) = acc[j]; }
        __syncthreads();
        const int j = tid >> 7, l = (tid & 127) >> 1, r = (tid & 1) * 2, row = row0 + (l & 15), colo = col0 + j * 16 + 4 * (l >> 4) + r;
        const unsigned char* gp = (const unsigned char*)(P + (size_t)row * INW) + C_G * 2 + colo;
        f32x2 o = {0.f, 0.f};
#pragma unroll
        for (int s = 0; s < 3; ++s) { f32x2 t = {0.f, 0.f};
#pragma unroll
            for (int w = 0; w < 8; ++w) t += *(const LAS f32x2*)(F.lds + s * 32768 + w * 4096 + tid * 8);
            const unsigned g2 = *(const unsigned short*)(gp + s * DM);
            o.x += t.x * ((float)(g2 & 255u) * (1.f / 255.f)); o.y += t.y * ((float)(g2 >> 8) * (1.f / 255.f)); }
        *(unsigned*)(O + (size_t)row * DM + colo) = pg8::cvt_pk_bf16(o.x, o.y);
        __syncthreads();
    }
}

constexpr int PH_PER_LAYER = 10, N_PHASES = 2 * PH_PER_LAYER;
__global__ void __launch_bounds__(NWAVES * 64, 2) fwd_kernel(Args args0) {
    extern __shared__ __attribute__((aligned(16))) unsigned char lds_raw[];
    const int wave0 = __builtin_amdgcn_readfirstlane(threadIdx.x >> 6);
    {
        for (int u = threadIdx.x; u < (LDS_BYTES - LDSCTL_OFF) / 4; u += NWAVES * 64) ((LAS unsigned*)((LAS unsigned char*)lds_raw + LDSCTL_OFF))[u] = 0u;
        __syncthreads();
    }
    XcdBarrier bar; bar.bar = (unsigned*)(args0.ws + WS_CTL) + CW_BAR; bar.x = 0; bar.st = nullptr;
    if (args0.use_bar) bar = xcd_barrier_post((unsigned*)(args0.ws + WS_CTL) + CW_BAR, (volatile LAS unsigned*)((LAS unsigned char*)lds_raw + MISC_OFF) + 8);
    for (int ph2 = 2 * args0.ph_lo; ph2 < 2 * args0.ph_hi; ++ph2) {
        const int ph = ph2 >> 1, rep = ph2 & 1;
        const int layer = ph / PH_PER_LAYER, k = ph % PH_PER_LAYER;
        if (rep == 1 && !(DUP_PHASE >= 0 && k == DUP_PHASE && args0.pad == 0)) continue;
        const __attribute__((address_space(4))) Args* ap = (const __attribute__((address_space(4))) Args*)__builtin_amdgcn_kernarg_segment_ptr();
        asm volatile("" : "+s"(ap));
        const __attribute__((address_space(4))) Args& args = *ap;
        Frame F;
        { int w_ = wave0; asm volatile("" : "+s"(w_)); int z_ = 0; asm volatile("" : "+v"(z_)); const int l_ = __builtin_amdgcn_mbcnt_hi(-1, __builtin_amdgcn_mbcnt_lo(-1, z_));
          F.lane = l_; F.wave = w_; F.tid = w_ * 64 + l_;
          int bx = blockIdx.x, G_ = gridDim.x; asm volatile("" : "+s"(bx), "+s"(G_)); F.G = G_; F.vcu = (G_ % 8 == 0) ? (bx % 8) * (G_ / 8) + bx / 8 : bx; F.bx = bx;
          F.dry = rep; F.lds = (LAS unsigned char*)lds_raw; F.ws = args.ws; F.out = args.out; F.xm = (float*)(args.ws + WS_XM); }
        unsigned char* W = F.ws + WS_W;
        bf16_t* XNR = (bf16_t*)(F.ws + WS_XNR); bf16_t* PROJ = (bf16_t*)(F.ws + WS_PROJ);
        bf16_t* GB = PROJ; bf16_t* ACT = PROJ + (size_t)MP * DFF;
#ifndef ONLY_PHASE
#define ONLY_PHASE -1
#endif
#define PHS(x) ((ONLY_PHASE < 0 || ONLY_PHASE == (x)) && k == (x))
        float* SS = (float*)(F.ws + WS_CTL) + CW_SS; bf16_t* OV = (bf16_t*)F.out;
        const bool last = layer == 1;
        if (PHS(0)) p_prep(args, F, layer);
        else if (PHS(1)) { OpsPlain O{XNR, (const bf16_t*)(W + W_IN), DM, DM}; pg8::StaticOrder S; S.init(MP, INW, F.G, F.bx, 1); EpiStore E{PROJ, INW, C_G / 256, SS + (size_t)(2 * layer) * MP};
            pg8::gemm_phase<EpiStore, OpsPlain, true>(F.lds, O, S, E, F.tid); }
        else if (PHS(2)) { if (DBG & 512) p_attn_ref(args, F, layer); else if (DSEL(64)) p_attn(args, F, layer); if (DSEL(128)) p_h1(args, F, layer); if (DSEL(256)) p_filt_tiles(args, F, layer); }
        else if (PHS(3)) { if (DBG & 256) p_h2_ref(args, F); else if (DSEL(16)) p_h2(F); if (DSEL(32)) p_pool(args, F); }
        else if (PHS(4)) p_final(args, F, layer);
        else if (PHS(5)) { OpsMerge O{PROJ, (const bf16_t*)(W + W_MRG), 512, INW}; pg8::StaticOrder S; S.init(TAIL_ROW0, DM, F.G, F.bx, 3); EpiMerge E{PROJ, OV};
            pg8::gemm_phase<EpiMerge, OpsMerge, true>(F.lds, O, S, E, F.tid); tail_merge(F, PROJ, (const bf16_t*)(W + W_MRG), OV); }
        else if (PHS(6)) { OpsPlain O{OV, (const bf16_t*)(W + W_OUT), DM, DM}; pg8::StaticOrder S; S.init(TAIL_ROW0, DM, F.G, F.bx, 1); EpiRes E{XNR, SS + (size_t)(2 * layer + 1) * MP, nullptr, F.dry};
            pg8::gemm_phase<EpiRes, OpsPlain, true>(F.lds, O, S, E, F.tid); tail_res<DM>(F, OV, (const bf16_t*)(W + W_OUT), XNR, SS + (size_t)(2 * layer + 1) * MP, nullptr); }
        else if (PHS(7)) { OpsPlain O{XNR, (const bf16_t*)(W + W_G), DM, DM}; pg8::StaticOrder S; S.init(MP, DFF, F.G, F.bx, 1); EpiStore E{GB, DFF, 1 << 20, SS + (size_t)(2 * layer + 1) * MP};
            pg8::gemm_phase<EpiStore, OpsPlain, true>(F.lds, O, S, E, F.tid); }
        else if (PHS(8)) { OpsPlain O{XNR, (const bf16_t*)(W + W_U), DM, DM}; pg8::StaticOrder S; S.init(MP, DFF, F.G, F.bx, 1);
            EpiGeluMul E{GB, args.in[27] + (size_t)layer * 3 * DFF, args.in[28] + layer * DFF, ACT, F.dry ? DRYVAR : 0, SS + (size_t)(2 * layer + 1) * MP};
            pg8::gemm_phase<EpiGeluMul, OpsPlain, true>(F.lds, O, S, E, F.tid); }
        else if (PHS(9)) { OpsPlain O{ACT, (const bf16_t*)(W + W_D), DFF, DFF}; pg8::StaticOrder S; S.init(TAIL_ROW0, DM, F.G, F.bx, 1);
            float* ssn = last ? nullptr : SS + (size_t)2 * MP; float* outf = last ? F.out : nullptr; EpiRes E{XNR, ssn, outf, F.dry};
            pg8::gemm_phase<EpiRes, OpsPlain, true>(F.lds, O, S, E, F.tid); tail_res<DFF>(F, ACT, (const bf16_t*)(W + W_D), XNR, ssn, outf); }
        if (ph2 + 1 < 2 * args0.ph_hi) { { int z2_ = 0; asm volatile("" : "+v"(z2_)); const int tid2 = wave0 * 64 + __builtin_amdgcn_mbcnt_hi(-1, __builtin_amdgcn_mbcnt_lo(-1, z2_));
              if (args0.use_bar) xcd_barrier(bar, tid2); else __syncthreads(); } }
    }
}

__global__ void fill_k(float* o, size_t n, float v) { size_t i = (size_t)blockIdx.x * blockDim.x + threadIdx.x; for (; i < n; i += (size_t)gridDim.x * blockDim.x) o[i] = v; }
extern "C" void kernel_launch(void* const* d_in, const int* in_sizes, int n_in, void* d_out, int out_size, void* d_ws, size_t ws_size, hipStream_t stream) {
    static int grid = 0;
    if (grid == 0) {
        int dev = 0, cus = 0;
        if (n_in != 30 || out_size != 32768 * DM || ws_size < WS_END || hipGetDevice(&dev) != hipSuccess || hipDeviceGetAttribute(&cus, hipDeviceAttributeMultiprocessorCount, dev) != hipSuccess ||
            hipFuncSetAttribute((const void*)fwd_kernel, hipFuncAttributeMaxDynamicSharedMemorySize, LDS_BYTES) != hipSuccess) { fprintf(stderr, "kernel_launch: bad shapes / workspace / device\n"); grid = -1; }
        else { int per_cu = 0; (void)hipOccupancyMaxActiveBlocksPerMultiprocessor(&per_cu, (const void*)fwd_kernel, NWAVES * 64, LDS_BYTES); (void)hipGetLastError();
            grid = cus * (per_cu >= 1 ? 1 : 0); if (grid <= 0) grid = -1; }
    }
    if (grid < 0) { fill_k<<<1024, 256, 0, stream>>>((float*)d_out, (size_t)out_size, 1e6f); return; }
    (void)hipMemsetAsync((char*)d_ws + WS_CTL, 0, CTL_ZERO_BYTES, stream);
    Args a{};
    for (int i = 0; i < 30; ++i) a.in[i] = (const float*)d_in[i];
    a.out = (float*)d_out; a.ws = (unsigned char*)d_ws;
#if MK_N_LAUNCHES == 1
    a.ph_lo = 0; a.ph_hi = N_PHASES; a.use_bar = 1;
    void* kargs[] = {&a};
    hipError_t e = hipLaunchCooperativeKernel((const void*)fwd_kernel, dim3(grid), dim3(NWAVES * 64), kargs, LDS_BYTES, stream);
    if (e != hipSuccess) fprintf(stderr, "cooperative launch failed: %s\n", hipGetErrorString(e));
#else
    for (int ph = 0; ph < N_PHASES; ++ph) { a.ph_lo = ph; a.ph_hi = ph + 1; a.use_bar = 0;
        hipLaunchKernelGGL(fwd_kernel, dim3(grid), dim3(NWAVES * 64), LDS_BYTES, stream, a); }
#endif
}
```

```cpp
#include <hip/hip_runtime.h>
#include <cstdio>
#include <cstdint>
#include <cmath>

#ifndef DBG
#define DBG 0
#endif
#ifndef DUP_PHASE
#define DUP_PHASE -1
#endif
#ifndef FT_RECOMPUTE
#define FT_RECOMPUTE 0
#endif
#ifndef DRYVAR
#define DRYVAR 0
#endif
#ifndef DUPMASK
#define DUPMASK 65535
#endif
#define DSEL(b) (!F.dry || (DUPMASK & (b)))
#ifndef MK_N_LAUNCHES
#define MK_N_LAUNCHES 1
#endif

#define LAS __attribute__((address_space(3)))
#define GAS __attribute__((address_space(1)))
typedef unsigned short bf16_t;
typedef short bf16x8 __attribute__((ext_vector_type(8)));
typedef float f32x4 __attribute__((ext_vector_type(4)));
typedef float f32x2 __attribute__((ext_vector_type(2)));
typedef float f32x16 __attribute__((ext_vector_type(16)));
typedef unsigned u32x4 __attribute__((ext_vector_type(4)));
typedef unsigned u32x2 __attribute__((ext_vector_type(2)));

constexpr int DM = 1024, INW = 5888, DFF = 2816, NHEAD = 8, HD = 64;
constexpr int LP = 2064, LS = 16400, NMETA = 16;
constexpr int ROWS_P = 8 * LP;
constexpr int MROWS = ROWS_P + LS;
constexpr int MP = 33024;
constexpr int C_Q = 0, C_K = 512, C_V = 640, C_X0 = 768, C_X1 = 1280, C_VV = 1792, C_PU = 2304, C_G = 2816;
constexpr float EPS = 1e-6f;
constexpr int RK_PAD = 256;
constexpr int RKLEN_P = 2 * LP + 512, RKLEN_S = 2 * LS + 512;

constexpr size_t MiB = 1u << 20;
constexpr size_t WS_CTL = 0, CTL_ZERO_BYTES = 1 * MiB;
constexpr size_t WS_XM = 1 * MiB;
constexpr size_t WS_W = 3 * MiB;
constexpr size_t W_IN = 0, W_G = W_IN + (size_t)INW * DM * 2, W_U = W_G + (size_t)DFF * DM * 2, W_D = W_U + (size_t)DFF * DM * 2,
                 W_OUT = W_D + (size_t)DM * DFF * 2, W_MRG = W_OUT + (size_t)DM * DM * 2, W_END = W_MRG + (size_t)3 * DM * 512 * 2;
static_assert(WS_W + W_END <= 36 * MiB, "weights");
constexpr size_t WS_RKP = 36 * MiB;
constexpr size_t WS_RKS = WS_RKP + (size_t)512 * RKLEN_P * 2;
static_assert(WS_RKS + (size_t)512 * RKLEN_S * 2 <= 74 * MiB, "filters");
constexpr size_t WS_XNR = 74 * MiB;
constexpr size_t XNR_BYTES = (size_t)MP * DM * 2;
constexpr size_t WS_PROJ = 139 * MiB;
constexpr size_t WS_END = WS_PROJ + (size_t)MP * INW * 2;
static_assert(WS_XNR + XNR_BYTES <= WS_PROJ && WS_END <= 512 * MiB, "d_ws map");
constexpr int CW_BAR = 4096;
constexpr int CW_SUMS = 16384;
constexpr int CW_SS = 32768;
static_assert((size_t)(CW_SS + 4 * MP) * 4 <= CTL_ZERO_BYTES, "row sums");

namespace pg8 {
constexpr int BM = 256, BK = 64, HALF = 128, HTB = HALF * BK * 2, STAGE_BYTES = 8 * HTB, NXCD = 8, WGM = 8;
__host__ __device__ __forceinline__ int lds_byte(int r, int c) { const int st = (r >> 4) * 2 + (c >> 5), rr = r & 15, cc = c & 31, ob = rr * 64 + cc * 2; return st * 1024 + (ob ^ (((ob >> 9) & 1) << 5)); }
__host__ __device__ __forceinline__ void stage_rc(int b, int& R, int& C) { const int st = b / 1024, sb = b % 1024, swz = sb ^ (((sb >> 9) & 1) << 5); R = (st >> 1) * 16 + swz / 64; C = (st & 1) * 32 + (swz % 64) / 2; }
__host__ __device__ __forceinline__ int perm32(int rho) { const int n = rho >> 4, i = rho & 15; return 8 * (i >> 2) + 4 * n + (i & 3); }

struct Unit { int pm, pn, sub; };
struct StaticOrder {
    int nM, nN, nwg, G, c, nsub;
    __device__ void init(int M, int N, int G_, int c_, int nsub_) { nM = M / BM; nN = N / BM; nwg = nM * nN; G = G_; c = c_; nsub = nsub_; }
    __device__ bool next(int i, Unit& u) const {
        const int tile = i / nsub; u.sub = i - tile * nsub;
        const long L = (long)tile * G + c; if (L >= nwg) return false;
        int wgid = (int)L; { const int q = nwg / NXCD, r = nwg % NXCD, xcd = wgid % NXCD, off = wgid / NXCD; wgid = (xcd < r ? xcd * (q + 1) : r * (q + 1) + (xcd - r) * q) + off; }
        const int nig = WGM * nN, gid = wgid / nig, fm = gid * WGM, gsz = (nM - fm) < WGM ? (nM - fm) : WGM;
        u.pm = fm + ((wgid % nig) % gsz); u.pn = (wgid % nig) / gsz; return true;
    }
};
__device__ __forceinline__ unsigned cvt_pk_bf16(float lo, float hi) { unsigned r; asm volatile("v_cvt_pk_bf16_f32 %0, %1, %2" : "=v"(r) : "v"(lo), "v"(hi)); return r; }
__device__ __forceinline__ f32x2 gelu_pk(f32x2 v) {
    const f32x2 av = __builtin_elementwise_abs(v), d = av * 0.2316418882f + 1.0f;
    f32x2 t; t.x = __builtin_amdgcn_rcpf(d.x); t.y = __builtin_amdgcn_rcpf(d.y);
    f32x2 q = t * 0.5307027145f + (-0.7265760135f); q = q * t + 0.7107068705f; q = q * t + (-0.142248368f); q = q * t + 0.127414796f; q = q * t;
    const f32x2 s = (v * v) * (-0.72134752044f);
    f32x2 e; e.x = __builtin_amdgcn_exp2f(s.x); e.y = __builtin_amdgcn_exp2f(s.y);
    f32x2 mx; mx.x = fmaxf(v.x, 0.f); mx.y = fmaxf(v.y, 0.f);
    return mx - av * (q * e);
}

template <class Epi, class Ops, bool ALIGN_EPI>
__device__ __forceinline__ void gemm_phase(LAS unsigned char* lds, const Ops& O, const StaticOrder& S, const Epi& E, int tid) {
    const int wid = __builtin_amdgcn_readfirstlane(tid >> 6), lane = tid & 63, wr = wid >> 2, wc = wid & 3, fr = lane & 15, fq = lane >> 4;
    const int K = O.K, nt = K / BK, lda = O.lda;
    unsigned voffA[2], voffB[2];
#pragma unroll
    for (int i = 0; i < 2; ++i) { int R, C; stage_rc(tid * 16 + i * 8192, R, C); const int Rb = (R & ~31) + perm32(R & 31);
        voffA[i] = (unsigned)(R * lda + C) * 2u; voffB[i] = (unsigned)(Rb * K + C) * 2u; }
    const size_t kstep = (size_t)(BK * 2);
    const size_t hstepA = (size_t)HALF * lda * 2, hstepB = (size_t)HALF * K * 2;
    const unsigned ldsw = (unsigned)wid * 1024u;
    const int aoff = lds_byte(wr * 64 + fr, fq * 8), boff = lds_byte(wc * 32 + fr, fq * 8);
#define PG8_SA(b, h) (((b) * 2 + (h)) * HTB)
#define PG8_SB(b, h) ((4 + (b) * 2 + (h)) * HTB)
#define PG8_STAGE(bufoff, gbase, voff) do { _Pragma("unroll") for (int _i = 0; _i < 2; ++_i) \
        __builtin_amdgcn_global_load_lds((const unsigned*)((const char*)(gbase) + (voff)[_i]), (LAS unsigned*)(lds + (bufoff) + ldsw + _i * 8192), 16, 0, 0); } while (0)
#define PG8_LDA(dst, b, h) do { _Pragma("unroll") for (int m = 0; m < 4; ++m) _Pragma("unroll") for (int k = 0; k < 2; ++k) dst[m][k] = *(const LAS bf16x8*)(lds + PG8_SA(b, h) + aoff + m * 2048 + k * 1024); } while (0)
#define PG8_LDB(dst, b, h) do { _Pragma("unroll") for (int n = 0; n < 2; ++n) _Pragma("unroll") for (int k = 0; k < 2; ++k) dst[n][k] = *(const LAS bf16x8*)(lds + PG8_SB(b, h) + boff + n * 2048 + k * 1024); } while (0)
#define PG8_MMA(ai, bj, At, Bt) do { __builtin_amdgcn_s_setprio(1); _Pragma("unroll") for (int m = 0; m < 4; ++m) _Pragma("unroll") for (int n = 0; n < 2; ++n) _Pragma("unroll") for (int k = 0; k < 2; ++k) \
        acc[ai][bj][m][n] = __builtin_amdgcn_mfma_f32_16x16x32_bf16(Bt[n][k], At[m][k], acc[ai][bj][m][n], 0, 0, 0); __builtin_amdgcn_s_setprio(0); } while (0)
#define PG8_WAIT_V(n) asm volatile("s_waitcnt vmcnt(" #n ")" ::: "memory")
#define PG8_WAIT_L(n) asm volatile("s_waitcnt lgkmcnt(" #n ")" ::: "memory")
#define PG8_BAR __builtin_amdgcn_s_barrier()
#define PG8_SCHED __builtin_amdgcn_sched_barrier(0)
    Unit cur, nxt; int ui = 0;
    if (!S.next(0, cur)) return;
    f32x4 acc[2][2][4][2];
#pragma unroll
    for (int a = 0; a < 2; ++a)
#pragma unroll
        for (int b = 0; b < 2; ++b)
#pragma unroll
            for (int m = 0; m < 4; ++m)
#pragma unroll
                for (int n = 0; n < 2; ++n) acc[a][b][m][n] = (f32x4){0.f, 0.f, 0.f, 0.f};
    bf16x8 At[4][2], B0[2][2], B1[2][2];
    const char* cA; const char* cB; O.ptrs(cur, cA, cB);
    PG8_STAGE(PG8_SB(0, 0), cB, voffB); PG8_STAGE(PG8_SB(0, 1), cB + hstepB, voffB); PG8_STAGE(PG8_SA(0, 0), cA, voffA); PG8_STAGE(PG8_SA(0, 1), cA + hstepA, voffA);
    if (wr == 1) PG8_BAR;
    PG8_WAIT_V(2); PG8_BAR;
    PG8_STAGE(PG8_SB(1, 0), cB + kstep, voffB); PG8_STAGE(PG8_SA(1, 0), cA + kstep, voffA); PG8_STAGE(PG8_SB(1, 1), cB + hstepB + kstep, voffB);
    PG8_WAIT_V(6); PG8_BAR;
    for (;;) {
        const bool has_next = S.next(ui + 1, nxt);
        const char* nA = cA; const char* nB = cB; if (has_next) O.ptrs(nxt, nA, nB);
        for (int t = 0; t < nt; t += 2) {
            const bool last = (t == nt - 2);
            const char* a1 = cA + (size_t)(t + 1) * kstep;
            const char* a2 = last ? nA : cA + (size_t)(t + 2) * kstep; const char* b2 = last ? nB : cB + (size_t)(t + 2) * kstep;
            const char* a3 = a2 + kstep; const char* b3 = b2 + kstep;
            PG8_LDB(B0, 0, 0); PG8_LDB(B1, 0, 1); PG8_SCHED; PG8_LDA(At, 0, 0); PG8_STAGE(PG8_SA(1, 1), a1 + hstepA, voffA);
            PG8_WAIT_V(8); PG8_WAIT_L(0); PG8_BAR; PG8_MMA(0, 0, At, B0); PG8_MMA(0, 1, At, B1); PG8_BAR; PG8_SCHED;
            PG8_LDA(At, 0, 1); PG8_STAGE(PG8_SB(0, 0), b2, voffB); PG8_STAGE(PG8_SB(0, 1), b2 + hstepB, voffB); PG8_STAGE(PG8_SA(0, 0), a2, voffA);
            PG8_WAIT_V(8); PG8_WAIT_L(0); PG8_BAR; PG8_MMA(1, 0, At, B0); PG8_MMA(1, 1, At, B1); PG8_BAR; PG8_SCHED;
            PG8_LDB(B0, 1, 0); PG8_LDB(B1, 1, 1); PG8_SCHED; PG8_LDA(At, 1, 0); PG8_STAGE(PG8_SA(0, 1), a2 + hstepA, voffA);
            PG8_WAIT_V(8); PG8_WAIT_L(0); PG8_BAR; PG8_MMA(0, 0, At, B0); PG8_MMA(0, 1, At, B1); PG8_BAR; PG8_SCHED;
            PG8_LDA(At, 1, 1); PG8_STAGE(PG8_SB(1, 0), b3, voffB); PG8_STAGE(PG8_SB(1, 1), b3 + hstepB, voffB); PG8_STAGE(PG8_SA(1, 0), a3, voffA);
            PG8_WAIT_V(8); PG8_WAIT_L(0); PG8_BAR; PG8_MMA(1, 0, At, B0); PG8_MMA(1, 1, At, B1); PG8_BAR; PG8_SCHED;
        }
        if constexpr (ALIGN_EPI) { if (wr == 0) PG8_BAR; }
        { int z_ = 0; asm volatile("" : "+v"(z_)); const int l2 = __builtin_amdgcn_mbcnt_hi(-1, __builtin_amdgcn_mbcnt_lo(-1, z_));
          E(acc, cur, wr, wc, l2 & 15, l2 >> 4); }
        if (!E.keep(cur)) {
#pragma unroll
            for (int a = 0; a < 2; ++a)
#pragma unroll
                for (int b = 0; b < 2; ++b)
#pragma unroll
                    for (int m = 0; m < 4; ++m)
#pragma unroll
                        for (int n = 0; n < 2; ++n) acc[a][b][m][n] = (f32x4){0.f, 0.f, 0.f, 0.f};
        }
        if (!has_next) break;
        cur = nxt; cA = nA; cB = nB; ++ui;
        if constexpr (ALIGN_EPI) { if (wr == 1) PG8_BAR; }
    }
    PG8_WAIT_V(0);
    if constexpr (!ALIGN_EPI) { if (wr == 0) PG8_BAR; }
    PG8_BAR;
#undef PG8_SA
#undef PG8_SB
#undef PG8_STAGE
#undef PG8_LDA
#undef PG8_LDB
#undef PG8_MMA
#undef PG8_WAIT_V
#undef PG8_WAIT_L
#undef PG8_BAR
#undef PG8_SCHED
}
}

constexpr int RING_BYTES_C = 131072, LDSCTL_OFF_C = 131072;
__device__ __forceinline__ int seq_of_row(int r) { return r < ROWS_P ? r / LP : 8; }
__device__ __forceinline__ int seq_base(int s) { return s < 8 ? s * LP : ROWS_P; }
__device__ __forceinline__ int seq_len(int s) { return s < 8 ? LP : LS; }
__device__ __forceinline__ float* xrow(float* xreal, float* xm, int r) {
    if (r >= MROWS) return xm + (size_t)(144 + r - MROWS) * DM;
    const int s = seq_of_row(r), p = r - seq_base(s);
    if (p < NMETA) return xm + (size_t)(s * 16 + p) * DM;
    return xreal + (size_t)(r - 16 * (s + 1)) * DM;
}
__device__ __forceinline__ float bflo(unsigned u) { return __uint_as_float(u << 16); }
__device__ __forceinline__ float bfhi(unsigned u) { return __uint_as_float(u & 0xffff0000u); }
__device__ __forceinline__ unsigned pk2(float lo, float hi) { unsigned r; asm("v_cvt_pk_bf16_f32 %0, %1, %2" : "=v"(r) : "v"(lo), "v"(hi)); return r; }
__device__ __forceinline__ unsigned f2bf(float f) { return pk2(f, f); }
__device__ __forceinline__ void unpack8(const u32x4 w, float* f) { f[0] = bflo(w.x); f[1] = bfhi(w.x); f[2] = bflo(w.y); f[3] = bfhi(w.y); f[4] = bflo(w.z); f[5] = bfhi(w.z); f[6] = bflo(w.w); f[7] = bfhi(w.w); }
__device__ __forceinline__ float shx(float v, int o, int lane) { return __int_as_float(__builtin_amdgcn_ds_bpermute((lane ^ o) << 2, __float_as_int(v))); }
__device__ __forceinline__ float wave_sum(float v, int lane) {
#pragma unroll
    for (int o = 1; o < 64; o <<= 1) v += shx(v, o, lane);
    return v;
}
#define LDS_WAIT() asm volatile("s_waitcnt lgkmcnt(0)" ::: "memory")

struct OpsPlain {
    const bf16_t* A; const bf16_t* Bt; int K, lda;
    __device__ __forceinline__ void ptrs(const pg8::Unit& u, const char*& a, const char*& b) const {
        a = (const char*)A + (size_t)u.pm * 256 * lda * 2; b = (const char*)Bt + (size_t)u.pn * 256 * K * 2; }
};
struct OpsMerge {
    const bf16_t* P; const bf16_t* WM; int K, lda;
    __device__ __forceinline__ void ptrs(const pg8::Unit& u, const char*& a, const char*& b) const {
        const int col = u.sub == 0 ? C_Q : (u.sub == 1 ? C_VV : C_X1);
        a = (const char*)P + ((size_t)u.pm * 256 * lda + col) * 2; b = (const char*)WM + ((size_t)u.sub * DM + (size_t)u.pn * 256) * 512 * 2; }
};
typedef f32x4 acc_t[2][2][4][2];
struct EpiStore {
    bf16_t* O; int ldc; int sig_pn; const float* ss;
    __device__ __forceinline__ bool keep(const pg8::Unit&) const { return false; }
    __device__ __forceinline__ void operator()(acc_t& acc, const pg8::Unit& u, int wr, int wc, int fr, int fq) const {
        const int row0 = u.pm * 256 + wr * 64 + fr, col0 = u.pn * 256 + wc * 32 + 8 * fq; const bool sig = u.pn >= sig_pn;
        float rsv[2][4];
#pragma unroll
        for (int ai = 0; ai < 2; ++ai)
#pragma unroll
            for (int m = 0; m < 4; ++m) rsv[ai][m] = ss[row0 + ai * 128 + m * 16];
        asm volatile("" ::: "memory");
#pragma unroll
        for (int ai = 0; ai < 2; ++ai)
#pragma unroll
            for (int m = 0; m < 4; ++m) rsv[ai][m] = __builtin_amdgcn_rsqf(rsv[ai][m] * (1.f / DM) + EPS);
#pragma unroll
        for (int ai = 0; ai < 2; ++ai)
#pragma unroll
            for (int m = 0; m < 4; ++m) { bf16_t* rowp = O + (size_t)(row0 + ai * 128 + m * 16) * ldc + col0;
                const float rs = rsv[ai][m]; u32x2 w8lo = {0u, 0u};
#pragma unroll
                for (int bj = 0; bj < 2; ++bj) {
                    if (sig) {
                        const float rn = rs * -1.4426950408889634f; const f32x4 t0 = acc[ai][bj][m][0] * rn, t1 = acc[ai][bj][m][1] * rn;
                        u32x2 w8 = {0u, 0u};
#pragma unroll
                        for (int e = 0; e < 4; ++e) {
                            const float qa = fmaxf(__builtin_rintf(__builtin_amdgcn_rcpf(__builtin_fmaf(__builtin_amdgcn_exp2f(t0[e]), 1.f / 255.f, 1.f / 255.f))), 1.f);
                            const float qb = fmaxf(__builtin_rintf(__builtin_amdgcn_rcpf(__builtin_fmaf(__builtin_amdgcn_exp2f(t1[e]), 1.f / 255.f, 1.f / 255.f))), 1.f);
                            w8.x = __builtin_amdgcn_cvt_pk_u8_f32(qa, e, w8.x); w8.y = __builtin_amdgcn_cvt_pk_u8_f32(qb, e, w8.y); }
                        if (bj == 0) w8lo = w8;
                        else *(u32x4*)((unsigned char*)(O + (size_t)(row0 + ai * 128 + m * 16) * ldc) + C_G * 2 + (u.pn * 256 - C_G) + wc * 64 + 16 * fq) = (u32x4){w8lo.x, w8lo.y, w8.x, w8.y};
                        continue; }
                    const f32x4 v0 = acc[ai][bj][m][0] * rs, v1 = acc[ai][bj][m][1] * rs;
                    u32x4 w; w.x = pg8::cvt_pk_bf16(v0[0], v0[1]); w.y = pg8::cvt_pk_bf16(v0[2], v0[3]); w.z = pg8::cvt_pk_bf16(v1[0], v1[1]); w.w = pg8::cvt_pk_bf16(v1[2], v1[3]);
                    *(u32x4*)(rowp + bj * 128) = w; } }
    }
};
__device__ __forceinline__ float* out_row(float* out, int r) {
    if (r >= MROWS) return nullptr;
    const int sq = seq_of_row(r), p = r - seq_base(sq);
    return p < NMETA ? nullptr : out + (size_t)(r - 16 * (sq + 1)) * DM;
}
struct EpiRes {
    bf16_t* X; float* ss; float* outf; int dry;
    __device__ __forceinline__ bool keep(const pg8::Unit&) const { return false; }
    __device__ __forceinline__ void operator()(acc_t& acc, const pg8::Unit& u, int wr, int wc, int fr, int fq) const {
        const int row0 = u.pm * 256 + wr * 64 + fr, col0 = u.pn * 256 + wc * 32 + 8 * fq, lane = fr + 16 * fq;
#pragma unroll
        for (int ai = 0; ai < 2; ++ai) { u32x4 xv[4][2];
#pragma unroll
            for (int m = 0; m < 4; ++m)
#pragma unroll
                for (int bj = 0; bj < 2; ++bj) xv[m][bj] = *(const u32x4*)(X + (size_t)(row0 + ai * 128 + m * 16) * DM + col0 + bj * 128);
            asm volatile("" ::: "memory");
#pragma unroll
            for (int m = 0; m < 4; ++m) { const int r = row0 + ai * 128 + m * 16; float sq = 0.f;
                float* po = outf ? out_row(outf, r) : nullptr;
#pragma unroll
                for (int bj = 0; bj < 2; ++bj) { float f[8]; unpack8(xv[m][bj], f);
                    const f32x4 a = (f32x4){f[0], f[1], f[2], f[3]} + acc[ai][bj][m][0], b = (f32x4){f[4], f[5], f[6], f[7]} + acc[ai][bj][m][1];
                    if (outf) { if (po && !dry) { *(f32x4*)(po + col0 + bj * 128) = a; *(f32x4*)(po + col0 + bj * 128 + 4) = b; } }
                    else { u32x4 w; w.x = pk2(a[0], a[1]); w.y = pk2(a[2], a[3]); w.z = pk2(b[0], b[1]); w.w = pk2(b[2], b[3]);
                        if (!dry) *(u32x4*)(X + (size_t)r * DM + col0 + bj * 128) = w;
                        sq += (a[0] * a[0] + a[1] * a[1]) + (a[2] * a[2] + a[3] * a[3]) + (b[0] * b[0] + b[1] * b[1]) + (b[2] * b[2] + b[3] * b[3]); } }
                if (ss) { sq += shx(sq, 16, lane); sq += shx(sq, 32, lane); if (fq == 0 && !dry) atomicAdd(ss + r, sq); } }
            asm volatile("" ::: "memory"); }
    }
};
struct EpiGeluMul {
    const bf16_t* G; const float* cw; const float* cb; bf16_t* O; int dv; const float* ss; const bf16_t* Z;
    __device__ __forceinline__ bool keep(const pg8::Unit&) const { return false; }
    __device__ __forceinline__ void operator()(acc_t& acc, const pg8::Unit& u, int wr, int wc, int fr, int fq) const {
        if (dv == 1) return;
        const int row0 = u.pm * 256 + wr * 64 + fr, col0 = u.pn * 256 + wc * 32 + 8 * fq;
#pragma unroll
        for (int bj = 0; bj < 2; ++bj) { const int col = col0 + bj * 128;
            f32x4 ta[2], tb[2], tc[2], td[2];
#pragma unroll
            for (int h = 0; h < 2; ++h) { ta[h] = *(const f32x4*)(cw + col + 4 * h); tb[h] = *(const f32x4*)(cw + DFF + col + 4 * h); tc[h] = *(const f32x4*)(cw + 2 * DFF + col + 4 * h); td[h] = *(const f32x4*)(cb + col + 4 * h); }
#pragma unroll
            for (int am = 0; am < 4; ++am) { const int ai = am >> 1, mb = (am & 1) * 2;
                int rowl = row0; asm volatile("" : "+v"(rowl));
                u32x4 gm[2], g0[2], gn[2]; float rsv[2];
#pragma unroll
                for (int m = 0; m < 2; ++m) { const int r = rowl + ai * 128 + (mb + m) * 16;
                    const int sq = seq_of_row(r), p = r - seq_base(sq); const bool inb = r < MROWS;
                    const bool hasp = inb && p > 0, hasn = inb && p < seq_len(sq) - 1;
                    const bf16_t* gp = G + (size_t)r * DFF + col;
                    gm[m] = *(const u32x4*)(hasp ? gp - DFF : Z); g0[m] = *(const u32x4*)gp; gn[m] = *(const u32x4*)(hasn ? gp + DFF : Z); rsv[m] = ss[r]; }
                asm volatile("" ::: "memory");
#pragma unroll
                for (int m = 0; m < 2; ++m) { const int r = rowl + ai * 128 + (mb + m) * 16;
                    float fm[8], f0[8], fn[8]; unpack8(gm[m], fm); unpack8(g0[m], f0); unpack8(gn[m], fn);
                    float o[8];
#pragma unroll
                    for (int h = 0; h < 2; ++h)
#pragma unroll
                        for (int e = 0; e < 4; e += 2) { f32x2 x; x.x = ta[h][e] * fm[4 * h + e] + (tb[h][e] * f0[4 * h + e] + (tc[h][e] * fn[4 * h + e] + td[h][e]));
                            x.y = ta[h][e + 1] * fm[4 * h + e + 1] + (tb[h][e + 1] * f0[4 * h + e + 1] + (tc[h][e + 1] * fn[4 * h + e + 1] + td[h][e + 1]));
                            const f32x2 g = pg8::gelu_pk(x); o[4 * h + e] = g.x; o[4 * h + e + 1] = g.y; }
                    const float rs = __builtin_amdgcn_rsqf(rsv[m] * (1.f / DM) + EPS);
                    const f32x4 v0 = acc[ai][bj][mb + m][0] * rs, v1 = acc[ai][bj][mb + m][1] * rs;
                    u32x4 w; w.x = pg8::cvt_pk_bf16(o[0] * v0[0], o[1] * v0[1]); w.y = pg8::cvt_pk_bf16(o[2] * v0[2], o[3] * v0[3]);
                    w.z = pg8::cvt_pk_bf16(o[4] * v1[0], o[5] * v1[1]); w.w = pg8::cvt_pk_bf16(o[6] * v1[2], o[7] * v1[3]);
                    if (dv != 2) *(u32x4*)(O + (size_t)r * DFF + col) = w; else asm volatile("" :: "v"(w.x), "v"(w.y), "v"(w.z), "v"(w.w)); }
                asm volatile("" ::: "memory"); } }
    }
};
__device__ __forceinline__ void unpack8u(const u32x2 w, float* f) {
#pragma unroll
    for (int e = 0; e < 4; ++e) { f[e] = (float)((w.x >> (8 * e)) & 255u) * (1.f / 255.f); f[4 + e] = (float)((w.y >> (8 * e)) & 255u) * (1.f / 255.f); }
}
struct EpiMerge {
    const bf16_t* P; bf16_t* O;
    __device__ __forceinline__ bool keep(const pg8::Unit& u) const { return u.sub < 2; }
    __device__ __forceinline__ void operator()(acc_t& acc, const pg8::Unit& u, int wr, int wc, int fr, int fq) const {
        const int row0 = u.pm * 256 + wr * 64 + fr, col0 = u.pn * 256 + wc * 32 + 8 * fq; const int sub = u.sub;
#pragma unroll
        for (int ai = 0; ai < 2; ++ai)
#pragma unroll
            for (int m = 0; m < 4; ++m) { const int r = row0 + ai * 128 + m * 16;
                const unsigned char* gp = (const unsigned char*)(P + (size_t)r * INW) + C_G * 2 + u.pn * 256 + wc * 64 + 16 * fq;
                const u32x4 ga4 = *(const u32x4*)(gp + sub * DM), gb4 = *(const u32x4*)(gp + (sub < 2 ? sub + 1 : sub) * DM);
#pragma unroll
                for (int bj = 0; bj < 2; ++bj) { const int col = col0 + bj * 128;
                    const u32x2 ga = bj ? (u32x2){ga4.z, ga4.w} : (u32x2){ga4.x, ga4.y}, gb = bj ? (u32x2){gb4.z, gb4.w} : (u32x2){gb4.x, gb4.y};
                    float mu[8];
                    if (sub < 2) {
#pragma unroll
                        for (int e = 0; e < 4; ++e) { mu[e] = (float)((ga.x >> (8 * e)) & 255u) * __builtin_amdgcn_rcpf((float)((gb.x >> (8 * e)) & 255u));
                                                      mu[4 + e] = (float)((ga.y >> (8 * e)) & 255u) * __builtin_amdgcn_rcpf((float)((gb.y >> (8 * e)) & 255u)); } }
                    else unpack8u(ga, mu);
                    f32x4 v0 = acc[ai][bj][m][0], v1 = acc[ai][bj][m][1];
#pragma unroll
                    for (int e = 0; e < 4; ++e) { v0[e] *= mu[e]; v1[e] *= mu[4 + e]; }
                    if (sub < 2) { acc[ai][bj][m][0] = v0; acc[ai][bj][m][1] = v1; }
                    else { u32x4 w; w.x = pg8::cvt_pk_bf16(v0[0], v0[1]); w.y = pg8::cvt_pk_bf16(v0[2], v0[3]); w.z = pg8::cvt_pk_bf16(v1[0], v1[1]); w.w = pg8::cvt_pk_bf16(v1[2], v1[3]);
                        *(u32x4*)(O + (size_t)r * DM + col) = w; } } }
    }
};

#define XB_TMO      128
#define XB_XCNT(j)  (256  + 64 * (j))
#define XB_XSUB(j)  (1280 + 64 * (j))
#define XB_XGEN(j)  (2304 + 64 * (j))
#define XB_TOP      3328
#define XB_TOPGEN   3392
#define XCD_BAR_WORDS 3456
#define XB_SPIN_CAP (1u << 20)
__device__ __forceinline__ unsigned xb_ld(unsigned* p)              { return __hip_atomic_load(p, __ATOMIC_RELAXED, __HIP_MEMORY_SCOPE_AGENT); }
__device__ __forceinline__ unsigned xb_add(unsigned* p, unsigned v) { return __hip_atomic_fetch_add(p, v, __ATOMIC_RELAXED, __HIP_MEMORY_SCOPE_AGENT); }
__device__ __forceinline__ unsigned xb_xcc_id() { return (unsigned)__builtin_amdgcn_s_getreg((3 << 11) | 20) & 0xFu; }
#define XB_SPIN(cond, bar) do { unsigned _sp = 0; while (cond) { __builtin_amdgcn_s_sleep(1); \
    if ((++_sp & 255u) == 0u) { if (xb_ld(&(bar)[XB_TMO])) break; if (_sp > XB_SPIN_CAP) { atomicAdd(&(bar)[XB_TMO], 1u); break; } } } } while (0)
struct XcdBarrier { unsigned* bar; unsigned x; volatile LAS unsigned* st; };
__device__ __forceinline__ XcdBarrier xcd_barrier_post(unsigned* bar, volatile LAS unsigned* st) {
    XcdBarrier b; b.bar = bar; b.x = xb_xcc_id(); b.st = st;
    if (threadIdx.x == 0) (void)xb_add(&bar[XB_XCNT(b.x)], 1u);
    return b;
}
__device__ __forceinline__ void xcd_barrier_complete(unsigned* bar, unsigned x, unsigned& nloc, unsigned& nx) {
    const unsigned G = gridDim.x * gridDim.y * gridDim.z;
    unsigned sum, cnt, mine, sp = 0u;
    for (;;) {
        sum = 0u; cnt = 0u; mine = 0u;
#pragma unroll
        for (unsigned j = 0; j < 16; ++j) { const unsigned c = xb_ld(&bar[XB_XCNT(j)]); sum += c; cnt += (c > 0u) ? 1u : 0u; mine = (j == x) ? c : mine; }
        if (sum == G) break;
        __builtin_amdgcn_s_sleep(1);
        if ((++sp & 255u) == 0u) { if (xb_ld(&bar[XB_TMO])) break; if (sp > XB_SPIN_CAP) { atomicAdd(&bar[XB_TMO], 1u); break; } }
    }
    nloc = mine > 0u ? mine : 1u; nx = cnt > 0u ? cnt : 1u;
}
__device__ __forceinline__ void xcd_barrier(const XcdBarrier& b, int tid) {
    asm volatile("s_waitcnt vmcnt(0)" ::: "memory");
    __syncthreads();
    if (tid == 0) {
        unsigned* bar = b.bar;
        __builtin_amdgcn_s_waitcnt(0);
        unsigned nloc = b.st[0], nx = b.st[1];
        if (nloc == 0u) { xcd_barrier_complete(bar, b.x, nloc, nx); b.st[0] = nloc; b.st[1] = nx; }
        const unsigned old = xb_add(&bar[XB_XSUB(b.x)], 1u);
        const unsigned gen = old / nloc;
        if (old + 1u == (gen + 1u) * nloc) {
            __builtin_amdgcn_fence(__ATOMIC_RELEASE, "agent");
            asm volatile("s_waitcnt vmcnt(0)" ::: "memory");
            const unsigned og = xb_add(&bar[XB_TOP], 1u);
            const unsigned tg = og / nx;
            if (og + 1u == (tg + 1u) * nx) xb_add(&bar[XB_TOPGEN], 1u);
            else XB_SPIN(xb_ld(&bar[XB_TOPGEN]) == tg, bar);
            __builtin_amdgcn_fence(__ATOMIC_ACQUIRE, "agent");
            xb_add(&bar[XB_XGEN(b.x)], 1u);
            asm volatile("s_waitcnt vmcnt(0)" ::: "memory");
        } else {
            XB_SPIN(xb_ld(&bar[XB_XGEN(b.x)]) == gen, bar);
            __builtin_amdgcn_fence(__ATOMIC_ACQUIRE, "agent");
            asm volatile("s_waitcnt vmcnt(0)" ::: "memory");
        }
    }
    __syncthreads();
}

constexpr int NWAVES = 8;
constexpr int RING_BYTES = 131072, LDSCTL_OFF = RING_BYTES, MISC_OFF = LDSCTL_OFF + 320, LDS_BYTES = 147456;
struct Args { const float* in[30]; float* out; unsigned char* ws; int ph_lo, ph_hi, use_bar, pad; };
typedef const __attribute__((address_space(4))) Args CArgs;
struct Frame {
    LAS unsigned char* lds; int tid, lane, wave, G, vcu, bx, dry;
    float* out; unsigned char* ws; float* xm;
};
#define FIN(i) (A.in[i])

__constant__ unsigned char c_bucket[257] = {
15,15,15,15,15,15,15,15,15,15,15,15,15,15,15,15,15,15,15,15,15,15,15,15,15,15,15,15,15,15,15,15,15,15,15,15,15,15,14,14,14,14,14,14,14,14,14,14,14,14,14,14,14,14,14,14,14,14,14,14,14,14,14,14,14,13,13,13,13,13,13,13,13,13,13,13,13,13,13,13,13,13,13,12,12,12,12,12,12,12,12,12,12,12,12,12,12,11,11,11,11,11,11,11,11,11,10,10,10,10,10,10,10,9,9,9,9,8,8,8,8,7,6,5,4,3,2,1,0,17,18,19,20,21,22,23,24,24,24,24,25,25,25,25,26,26,26,26,26,26,26,27,27,27,27,27,27,27,27,27,28,28,28,28,28,28,28,28,28,28,28,28,28,28,29,29,29,29,29,29,29,29,29,29,29,29,29,29,29,29,29,29,30,30,30,30,30,30,30,30,30,30,30,30,30,30,30,30,30,30,30,30,30,30,30,30,30,30,30,31,31,31,31,31,31,31,31,31,31,31,31,31,31,31,31,31,31,31,31,31,31,31,31,31,31,31,31,31,31,31,31,31,31,31,31,31,31};

__device__ __forceinline__ void p0_transpose_item(const float* W, int K, int N, bf16_t* WT, int row_off, LAS float* scr, int item, int lane, const float* gk = nullptr) {
    const int nblk = N / 32, kb = item / nblk, nb = item % nblk, k0 = 64 * kb, n0 = 32 * nb;
    f32x4 v[8];
#pragma unroll
    for (int i = 0; i < 8; ++i) v[i] = *(const f32x4*)(W + (size_t)(k0 + 8 * i + (lane >> 3)) * N + n0 + 4 * (lane & 7));
    if (gk) {
#pragma unroll
        for (int i = 0; i < 8; ++i) v[i] = v[i] * gk[k0 + 8 * i + (lane >> 3)]; }
#pragma unroll
    for (int i = 0; i < 8; ++i) { LAS float* d = scr + (8 * i + (lane >> 3)) * 33 + 4 * (lane & 7); d[0] = v[i].x; d[1] = v[i].y; d[2] = v[i].z; d[3] = v[i].w; }
    LDS_WAIT(); asm volatile("" ::: "memory");
    const int c = lane & 7;
#pragma unroll
    for (int j = 0; j < 4; ++j) { const int n = (lane >> 3) + 8 * j; const LAS float* s = scr + (8 * c) * 33 + n;
        u32x4 o; o.x = pk2(s[0 * 33], s[1 * 33]); o.y = pk2(s[2 * 33], s[3 * 33]); o.z = pk2(s[4 * 33], s[5 * 33]); o.w = pk2(s[6 * 33], s[7 * 33]);
        *(u32x4*)(WT + (size_t)(row_off + n0 + n) * K + k0 + 8 * c) = o; }
    LDS_WAIT(); asm volatile("" ::: "memory");
}
__device__ __forceinline__ void rms_row(const f32x4 (&v)[4], const float* g, bf16_t* orow, int lane) {
    float s = 0.f;
#pragma unroll
    for (int j = 0; j < 4; ++j) s += (v[j].x * v[j].x + v[j].y * v[j].y) + (v[j].z * v[j].z + v[j].w * v[j].w);
    const float rstd = 1.0f / sqrtf(wave_sum(s, lane) * (1.f / DM) + EPS);
    unsigned long long* o8 = (unsigned long long*)orow + lane;
#pragma unroll
    for (int j = 0; j < 4; ++j) { const f32x4 gg = *((const f32x4*)g + lane + 64 * j);
        o8[64 * j] = (unsigned long long)pk2(v[j].x * rstd * gg.x, v[j].y * rstd * gg.y) | ((unsigned long long)pk2(v[j].z * rstd * gg.z, v[j].w * rstd * gg.w) << 32); }
}
constexpr size_t WS_H2F_P = 2 * MiB, WS_H2F_S = WS_END;
constexpr int NCH_P = (LP + 31) / 32, NCH_S = (LS + 31) / 32;
static_assert(WS_H2F_S + (size_t)NCH_S * 32 * 128 <= 512 * MiB && WS_H2F_P + (size_t)NCH_P * 32 * 128 <= WS_W, "h2 scratch");
__device__ __forceinline__ void filt_h2_compute(const CArgs& A, const Frame& F, int layer, int L, int tc, LAS float* h1t, int lane, float (&acc)[32]) {
    const float* w1 = FIN(11) + (size_t)layer * 33 * 64; const float* b1 = FIN(12) + layer * 64;
    const float* w2 = FIN(13) + (size_t)layer * 64 * 64; const float* b2 = FIN(14) + layer * 64; const float* fq_ = FIN(16) + layer * 64;
    const int pos = lane & 31, half = lane >> 5, jb = 32 * half;
    const float tt = (float)tc / (float)(L - 1);
    { f32x4 bv[8], wv[8];
#pragma unroll
      for (int i = 0; i < 8; ++i) { bv[i] = *(const f32x4*)(b1 + jb + 4 * i); wv[i] = *(const f32x4*)(w1 + jb + 4 * i); }
#pragma unroll
      for (int i = 0; i < 8; ++i)
#pragma unroll
          for (int e = 0; e < 4; ++e) acc[4 * i + e] = bv[i][e] + tt * wv[i][e]; }
#pragma unroll 2
    for (int k = 0; k < 16; ++k) {
        const float f = 1e-4f + (float)k * ((15.0f - 1e-4f) / 15.0f);
        const float rev = f * (float)tc * (1.0f / (float)L);
        const float sn = __builtin_amdgcn_sinf(rev), cs = __builtin_amdgcn_cosf(rev);
        f32x4 wc_[8], ws_[8];
#pragma unroll
        for (int i = 0; i < 8; ++i) { wc_[i] = *(const f32x4*)(w1 + (size_t)(1 + k) * 64 + jb + 4 * i); ws_[i] = *(const f32x4*)(w1 + (size_t)(17 + k) * 64 + jb + 4 * i); }
#pragma unroll
        for (int i = 0; i < 8; ++i)
#pragma unroll
            for (int e = 0; e < 4; ++e) acc[4 * i + e] += cs * wc_[i][e] - sn * ws_[i][e];
    }
    { f32x4 fv[8];
#pragma unroll
      for (int i = 0; i < 8; ++i) fv[i] = *(const f32x4*)(fq_ + jb + 4 * i);
#pragma unroll
      for (int i = 0; i < 8; ++i)
#pragma unroll
          for (int e = 0; e < 4; ++e) h1t[(jb + 4 * i + e) * 32 + pos] = __builtin_amdgcn_sinf(fv[i][e] * acc[4 * i + e] * 0.15915494309189535f); }
    LDS_WAIT();
    { f32x4 bv[8];
#pragma unroll
      for (int i = 0; i < 8; ++i) bv[i] = *(const f32x4*)(b2 + jb + 4 * i);
#pragma unroll
      for (int i = 0; i < 8; ++i)
#pragma unroll
          for (int e = 0; e < 4; ++e) acc[4 * i + e] = bv[i][e]; }
#pragma unroll 4
    for (int i2 = 0; i2 < 64; ++i2) { const float h = h1t[i2 * 32 + pos]; f32x4 wv[8];
#pragma unroll
        for (int i = 0; i < 8; ++i) wv[i] = *(const f32x4*)(w2 + (size_t)i2 * 64 + jb + 4 * i);
#pragma unroll
        for (int i = 0; i < 8; ++i)
#pragma unroll
            for (int e = 0; e < 4; ++e) acc[4 * i + e] += h * wv[i][e]; }
}
__device__ __forceinline__ void filt_h2_item(const CArgs& A, const Frame& F, int layer, int item, LAS float* h1t, int lane) {
    const int cls = item >= NCH_P ? 1 : 0, ch = cls ? item - NCH_P : item, L = cls ? LS : LP;
    const int pos = lane & 31, half = lane >> 5, jb = 32 * half;
    const int t = ch * 32 + pos, tc = t < L ? t : L - 1;
    const float* fq_ = FIN(16) + layer * 64;
    float acc[32];
    filt_h2_compute(A, F, layer, L, tc, h1t, lane, acc);
    { f32x4 fv[8]; unsigned hw[16];
#pragma unroll
      for (int i = 0; i < 8; ++i) fv[i] = *(const f32x4*)(fq_ + jb + 4 * i);
#pragma unroll
      for (int i = 0; i < 8; ++i)
#pragma unroll
          for (int e = 0; e < 4; e += 2) { const float a0 = __builtin_amdgcn_sinf(fv[i][e] * acc[4 * i + e] * 0.15915494309189535f), a1 = __builtin_amdgcn_sinf(fv[i][e + 1] * acc[4 * i + e + 1] * 0.15915494309189535f);
              typedef _Float16 h2_t __attribute__((ext_vector_type(2))); const h2_t hv = {(_Float16)a0, (_Float16)a1}; hw[2 * i + (e >> 1)] = __builtin_bit_cast(unsigned, hv); }
      u32x4* dst = (u32x4*)(F.ws + (cls ? WS_H2F_S : WS_H2F_P) + (size_t)t * 128 + half * 64);
#pragma unroll
      for (int i = 0; i < 4; ++i) dst[i] = (u32x4){hw[4 * i], hw[4 * i + 1], hw[4 * i + 2], hw[4 * i + 3]}; }
    LDS_WAIT();
}
constexpr int NI8_P = LP / 8, NI8 = NI8_P + LS / 8;
static_assert(LP % 8 == 0 && LS % 8 == 0, "filter items");
__device__ __forceinline__ void filt_h2_item8(const CArgs& A, const Frame& F, int layer, int item, LAS float* h1t, int lane) {
    const int cls = item >= NI8_P ? 1 : 0, ch = cls ? item - NI8_P : item, L = cls ? LS : LP;
    const float* w1 = FIN(11) + (size_t)layer * 33 * 64; const float* b1 = FIN(12) + layer * 64;
    const float* w2 = FIN(13) + (size_t)layer * 64 * 64; const float* b2 = FIN(14) + layer * 64; const float* fq_ = FIN(16) + layer * 64;
    const int pos = lane & 7, jb = (lane >> 3) * 8, t = ch * 8 + pos;
    const float tt = (float)t / (float)(L - 1);
    float acc[8];
    { const f32x4 ba = *(const f32x4*)(b1 + jb), bb = *(const f32x4*)(b1 + jb + 4), wa = *(const f32x4*)(w1 + jb), wb = *(const f32x4*)(w1 + jb + 4);
#pragma unroll
      for (int e = 0; e < 4; ++e) { acc[e] = ba[e] + tt * wa[e]; acc[4 + e] = bb[e] + tt * wb[e]; } }
#pragma unroll
    for (int k0 = 0; k0 < 16; k0 += 4) { f32x4 ca[4], cb[4], sa[4], sb[4];
#pragma unroll
        for (int q = 0; q < 4; ++q) { const int k = k0 + q; ca[q] = *(const f32x4*)(w1 + (size_t)(1 + k) * 64 + jb); cb[q] = *(const f32x4*)(w1 + (size_t)(1 + k) * 64 + jb + 4);
            sa[q] = *(const f32x4*)(w1 + (size_t)(17 + k) * 64 + jb); sb[q] = *(const f32x4*)(w1 + (size_t)(17 + k) * 64 + jb + 4); }
        asm volatile("" ::: "memory");
#pragma unroll
        for (int q = 0; q < 4; ++q) { const int k = k0 + q;
            const float f = 1e-4f + (float)k * ((15.0f - 1e-4f) / 15.0f);
            const float rev = f * (float)t * (1.0f / (float)L);
            const float sn = __builtin_amdgcn_sinf(rev), cs = __builtin_amdgcn_cosf(rev);
#pragma unroll
            for (int e = 0; e < 4; ++e) { acc[e] += cs * ca[q][e] - sn * sa[q][e]; acc[4 + e] += cs * cb[q][e] - sn * sb[q][e]; } }
        asm volatile("" ::: "memory");
    }
    const f32x4 fa = *(const f32x4*)(fq_ + jb), fb = *(const f32x4*)(fq_ + jb + 4);
#pragma unroll
    for (int e = 0; e < 4; ++e) { h1t[(jb + e) * 8 + pos] = __builtin_amdgcn_sinf(fa[e] * acc[e] * 0.15915494309189535f); h1t[(jb + 4 + e) * 8 + pos] = __builtin_amdgcn_sinf(fb[e] * acc[4 + e] * 0.15915494309189535f); }
    LDS_WAIT();
    { const f32x4 ba = *(const f32x4*)(b2 + jb), bb = *(const f32x4*)(b2 + jb + 4);
#pragma unroll
      for (int e = 0; e < 4; ++e) { acc[e] = ba[e]; acc[4 + e] = bb[e]; } }
#pragma unroll
    for (int i0 = 0; i0 < 64; i0 += 8) { f32x4 wa[8], wb[8];
#pragma unroll
        for (int q = 0; q < 8; ++q) { wa[q] = *(const f32x4*)(w2 + (size_t)(i0 + q) * 64 + jb); wb[q] = *(const f32x4*)(w2 + (size_t)(i0 + q) * 64 + jb + 4); }
        asm volatile("" ::: "memory");
#pragma unroll
        for (int q = 0; q < 8; ++q) { const float h = h1t[(i0 + q) * 8 + pos];
#pragma unroll
            for (int e = 0; e < 4; ++e) { acc[e] += h * wa[q][e]; acc[4 + e] += h * wb[q][e]; } }
        asm volatile("" ::: "memory");
    }
    unsigned hw[4];
#pragma unroll
    for (int e = 0; e < 4; e += 2) { typedef _Float16 h2_t __attribute__((ext_vector_type(2)));
        const h2_t ha = {(_Float16)__builtin_amdgcn_sinf(fa[e] * acc[e] * 0.15915494309189535f), (_Float16)__builtin_amdgcn_sinf(fa[e + 1] * acc[e + 1] * 0.15915494309189535f)};
        const h2_t hb = {(_Float16)__builtin_amdgcn_sinf(fb[e] * acc[4 + e] * 0.15915494309189535f), (_Float16)__builtin_amdgcn_sinf(fb[e + 1] * acc[4 + e + 1] * 0.15915494309189535f)};
        hw[e >> 1] = __builtin_bit_cast(unsigned, ha); hw[2 + (e >> 1)] = __builtin_bit_cast(unsigned, hb); }
    *(u32x4*)(F.ws + (cls ? WS_H2F_S : WS_H2F_P) + (size_t)t * 128 + jb * 2) = (u32x4){hw[0], hw[1], hw[2], hw[3]};
    LDS_WAIT();
}
constexpr int NCHF_P = (LP - 1 + 31) / 32 + 1, NCHB_P = (LP + 31) / 32, NCHF_S = (LS - 1 + 31) / 32 + 1, NCHB_S = (LS + 31) / 32;
constexpr int NFI_P = NCHF_P + NCHB_P, NFI = NFI_P + NCHF_S + NCHB_S;
__device__ __forceinline__ void filt_tile_item(const CArgs& A, const Frame& F, int layer, int item, int lane) {
    const int ct = item & 15; int cls = 0, it = item >> 4; if (it >= NFI_P) { cls = 1; it -= NFI_P; }
    const int nchf = cls ? NCHF_S : NCHF_P, L = cls ? LS : LP;
    bool bwd; int ch; if (it < nchf) { bwd = false; ch = it - 1; } else { bwd = true; ch = it - nchf; }
    const int tsh = bwd ? 0 : 1;
    const float* w3 = FIN(15) + (size_t)layer * 64 * 1024;
    const int pos = lane & 31, half = lane >> 5;
    const int t = ch * 32 + pos + tsh, tc = t < 0 ? 0 : (t < L ? t : L - 1);
    float acc[32];
#if FT_RECOMPUTE
    if (FT_RECOMPUTE == 1 || FT_RECOMPUTE == 9 || (FT_RECOMPUTE == 2 && cls == 0) || (FT_RECOMPUTE == 3 && cls == 1)) { LAS float* h1t = (LAS float*)(F.lds + F.wave * 16384); filt_h2_compute(A, F, layer, L, tc, h1t, lane, acc); const float* fq_ = FIN(16) + layer * 64;
#pragma unroll
      for (int k = 0; k < 32; ++k) acc[k] = __builtin_amdgcn_sinf(fq_[32 * half + k] * acc[k] * 0.15915494309189535f); LDS_WAIT(); }
    else
#endif
    { const u32x4* src = (const u32x4*)(F.ws + (cls ? WS_H2F_S : WS_H2F_P) + (size_t)tc * 128 + half * 64);
      u32x4 hv[4];
#pragma unroll
      for (int i = 0; i < 4; ++i) hv[i] = src[i];
#pragma unroll
      for (int i = 0; i < 4; ++i)
#pragma unroll
          for (int e = 0; e < 4; ++e) { typedef _Float16 h2_t __attribute__((ext_vector_type(2))); const unsigned wv_ = hv[i][e];
              const h2_t p = __builtin_bit_cast(h2_t, wv_); acc[8 * i + 2 * e] = (float)p[0]; acc[8 * i + 2 * e + 1] = (float)p[1]; } }
#if FT_RECOMPUTE == 9
    float bad = 0.f;
    { const u32x4* src = (const u32x4*)(F.ws + (cls ? WS_H2F_S : WS_H2F_P) + (size_t)tc * 128 + half * 64);
#pragma unroll
      for (int i = 0; i < 4; ++i) { const u32x4 hvv = src[i];
#pragma unroll
          for (int e = 0; e < 4; ++e) { typedef _Float16 h2_t __attribute__((ext_vector_type(2))); const h2_t p = __builtin_bit_cast(h2_t, hvv[e]);
              if (fabsf((float)p[0] - acc[8 * i + 2 * e]) > 2e-3f || fabsf((float)p[1] - acc[8 * i + 2 * e + 1]) > 2e-3f) bad = 1e4f; } } }
#else
    const float bad = 0.f;
#endif
    bf16_t* RK = (bf16_t*)(F.ws + (cls ? WS_RKS : WS_RKP)); const int rklen = cls ? RKLEN_S : RKLEN_P;
    float* sums = (float*)(F.ws + WS_CTL) + CW_SUMS + (layer * 2 + cls) * 512;
    const float da = -15.350567286626973f, db = -3.0701134573253945f;
    {
        const int col0 = (bwd ? 512 : 0) + ct * 32;
        float bw[32];
#pragma unroll
        for (int ks = 0; ks < 32; ++ks) bw[ks] = w3[(size_t)(32 * half + ks) * 1024 + col0 + pos];
        f32x16 d = {};
#pragma unroll
        for (int ks = 0; ks < 32; ++ks) d = __builtin_amdgcn_mfma_f32_32x32x2f32(acc[ks], bw[ks], d, 0, 0, 0);
        const int c = (col0 + pos) & 511;
        const float delta = fabsf(da + (db - da) * ((float)c / 511.0f));
        bf16_t* rk = RK + (size_t)c * rklen + RK_PAD + L;
        float asum = 0.f;
#pragma unroll
        for (int g = 0; g < 4; ++g) { const int t0 = ch * 32 + 8 * g + 4 * half + tsh; float v[4];
#pragma unroll
            for (int e = 0; e < 4; ++e) { const int tp = t0 + e; const bool ok = tp >= 0 && tp < L && !(bwd && tp == 0);
                const float tq = (float)tp / (float)(L - 1); v[e] = ok ? d[4 * g + e] * __expf(-tq * delta) + bad : 0.f; asum += fabsf(v[e]); }
            if (bwd) { if (t0 >= 4 && t0 + 3 < L) { u32x2 w; w.x = pk2(v[0], v[1]); w.y = pk2(v[2], v[3]); *(u32x2*)(rk + t0) = w; }
                       else {
#pragma unroll
                           for (int e = 0; e < 4; ++e) if (t0 + e >= 1 && t0 + e < L) rk[t0 + e] = (bf16_t)f2bf(v[e]); } }
            else { if (t0 >= 0 && t0 + 3 < L) { u32x2 w; w.x = pk2(v[3], v[2]); w.y = pk2(v[1], v[0]); *(u32x2*)(rk - t0 - 3) = w; }
                   else {
#pragma unroll
                       for (int e = 0; e < 4; ++e) if (t0 + e >= 0 && t0 + e < L) rk[-(t0 + e)] = (bf16_t)f2bf(v[e]); } } }
        asum += shx(asum, 32, lane);
        if (half == 0 && !F.dry) atomicAdd(sums + c, asum);
    }
}
constexpr int FT_RUN = 10;
constexpr int FT_RF_P = (NCHF_P + FT_RUN - 1) / FT_RUN, FT_RB_P = (NCHB_P + FT_RUN - 1) / FT_RUN, FT_RF_S = (NCHF_S + FT_RUN - 1) / FT_RUN, FT_RB_S = (NCHB_S + FT_RUN - 1) / FT_RUN;
constexpr int FT_UNITS = 16 * (FT_RF_P + FT_RB_P + FT_RF_S + FT_RB_S);
typedef _Float16 f16x8 __attribute__((ext_vector_type(8)));
__device__ __forceinline__ void filt_tile_run(const CArgs& A, const Frame& F, int layer, int unit, int lane) {
    const int ct = unit & 15; int rr = unit >> 4, cls, bwd, nch;
    if (rr < FT_RF_P) { cls = 0; bwd = 0; nch = NCHF_P; }
    else if (rr < FT_RF_P + FT_RB_P) { rr -= FT_RF_P; cls = 0; bwd = 1; nch = NCHB_P; }
    else if (rr < FT_RF_P + FT_RB_P + FT_RF_S) { rr -= FT_RF_P + FT_RB_P; cls = 1; bwd = 0; nch = NCHF_S; }
    else { rr -= FT_RF_P + FT_RB_P + FT_RF_S; cls = 1; bwd = 1; nch = NCHB_S; }
    const int L = cls ? LS : LP, it0 = rr * FT_RUN, it1 = it0 + FT_RUN < nch ? it0 + FT_RUN : nch, toff = bwd ? 0 : -31;
    const float* w3 = FIN(15) + (size_t)layer * 64 * 1024;
    const int pos = lane & 31, half = lane >> 5, col0 = (bwd ? 512 : 0) + ct * 32, c = (col0 + pos) & 511;
    f16x8 bw[4];
    { float wf[32];
#pragma unroll
      for (int q = 0; q < 32; ++q) wf[q] = w3[(size_t)(16 * (q >> 3) + 8 * half + (q & 7)) * 1024 + col0 + pos];
#pragma unroll
      for (int q = 0; q < 32; ++q) bw[q >> 3][q & 7] = (_Float16)wf[q]; }
    const float da = -15.350567286626973f, db = -3.0701134573253945f;
    const float e2 = fabsf(da + (db - da) * ((float)c / 511.0f)) * (1.4426950408889634f / (float)(L - 1));
    bf16_t* rk = (bf16_t*)(F.ws + (cls ? WS_RKS : WS_RKP)) + (size_t)c * (cls ? RKLEN_S : RKLEN_P) + RK_PAD + L;
    const unsigned char* hbase = F.ws + (cls ? WS_H2F_S : WS_H2F_P) + half * 16;
    float asum = 0.f;
    u32x4 hv[4];
    { const int t = 32 * it0 + toff + pos, tc = t < 0 ? 0 : (t < L ? t : L - 1);
#pragma unroll
      for (int kb = 0; kb < 4; ++kb) hv[kb] = *(const u32x4*)(hbase + (size_t)tc * 128 + kb * 32); }
    for (int it = it0; it < it1; ++it) {
        u32x4 hn[4];
        { const int itn = it + 1 < it1 ? it + 1 : it, t = 32 * itn + toff + pos, tc = t < 0 ? 0 : (t < L ? t : L - 1);
#pragma unroll
          for (int kb = 0; kb < 4; ++kb) hn[kb] = *(const u32x4*)(hbase + (size_t)tc * 128 + kb * 32); }
        f32x16 d = {};
#pragma unroll
        for (int kb = 0; kb < 4; ++kb) d = __builtin_amdgcn_mfma_f32_32x32x16_f16(__builtin_bit_cast(f16x8, hv[kb]), bw[kb], d, 0, 0, 0);
        const int tb = 32 * it + toff;
        float v[16];
#pragma unroll
        for (int i = 0; i < 16; ++i) { const int tp = tb + 8 * (i >> 2) + 4 * half + (i & 3); const bool ok = tp >= bwd && tp < L;
            v[i] = ok ? d[i] * __builtin_amdgcn_exp2f(-(float)tp * e2) : 0.f; asum += fabsf(v[i]); }
        if (tb >= bwd && tb + 31 < L) {
            unsigned g[4][2];
#pragma unroll
            for (int q = 0; q < 4; ++q) { if (bwd) { g[q][0] = pk2(v[4 * q], v[4 * q + 1]); g[q][1] = pk2(v[4 * q + 2], v[4 * q + 3]); }
                                          else { g[q][0] = pk2(v[4 * q + 3], v[4 * q + 2]); g[q][1] = pk2(v[4 * q + 1], v[4 * q]); } }
            unsigned pc[4][2];
#pragma unroll
            for (int w = 0; w < 2; ++w) { const u32x2 s0 = __builtin_amdgcn_permlane32_swap(g[0][w], g[2][w], false, false), s1 = __builtin_amdgcn_permlane32_swap(g[1][w], g[3][w], false, false);
                pc[0][w] = s0[0]; pc[1][w] = s0[1]; pc[2][w] = s1[0]; pc[3][w] = s1[1]; }
            const int p0 = tb + 16 * half;
            if (bwd) { u32x4* dst = (u32x4*)(rk + p0); dst[0] = (u32x4){pc[0][0], pc[0][1], pc[1][0], pc[1][1]}; dst[1] = (u32x4){pc[2][0], pc[2][1], pc[3][0], pc[3][1]}; }
            else { u32x4* dst = (u32x4*)(rk - p0 - 15); dst[0] = (u32x4){pc[3][0], pc[3][1], pc[2][0], pc[2][1]}; dst[1] = (u32x4){pc[1][0], pc[1][1], pc[0][0], pc[0][1]}; }
        } else {
#pragma unroll
            for (int i = 0; i < 16; ++i) { const int tp = tb + 8 * (i >> 2) + 4 * half + (i & 3); if (tp >= bwd && tp < L) rk[bwd ? tp : -tp] = (bf16_t)f2bf(v[i]); }
        }
#pragma unroll
        for (int kb = 0; kb < 4; ++kb) hv[kb] = hn[kb];
    }
    asum += shx(asum, 32, lane);
    if (half == 0 && !F.dry) atomicAdd((float*)(F.ws + WS_CTL) + CW_SUMS + (layer * 2 + cls) * 512 + c, asum);
}
__device__ __forceinline__ void p_filt_tiles(const CArgs& A, const Frame& F, int layer) {
    const int gw = F.vcu * NWAVES + F.wave, NGW = F.G * NWAVES;
#if FT_RECOMPUTE
    for (int it = gw; it < 16 * NFI; it += NGW) filt_tile_item(A, F, layer, it, F.lane);
#else
    for (int u = NGW - 1 - gw; u < FT_UNITS; u += NGW) filt_tile_run(A, F, layer, u, F.lane);
#endif
}
__device__ __forceinline__ void p_prep(const CArgs& A, const Frame& F, int layer) {
    const int gw = F.vcu * NWAVES + F.wave, NGW = F.G * NWAVES, lane = F.lane;
    const bool filt_first = false;
    if (filt_first && DSEL(8)) { LAS float* scr = (LAS float*)(F.lds + F.wave * 16384); for (int it = gw; it < NI8; it += NGW) filt_h2_item8(A, F, layer, it, scr, lane); }
    if (layer == 0 && DSEL(1)) {
        bf16_t* XB = (bf16_t*)(F.ws + WS_XNR); float* ss = (float*)(F.ws + WS_CTL) + CW_SS;
        for (int r0 = gw; r0 < MP; r0 += 4 * NGW) {
            f32x4 v[4][4]; const int rr[4] = {r0, r0 + NGW, r0 + 2 * NGW, r0 + 3 * NGW};
#pragma unroll
            for (int q = 0; q < 4; ++q) { const int r = rr[q];
                if (r >= MP) continue;
                if (r >= MROWS) {
#pragma unroll
                    for (int j = 0; j < 4; ++j) v[q][j] = (f32x4){0.f, 0.f, 0.f, 0.f};
                } else {
                    const int sq = seq_of_row(r), p = r - seq_base(sq);
                    const float* src = p < NMETA ? FIN(2) + (size_t)p * DM : (sq < 8 ? FIN(0) + ((size_t)sq * 2048 + (p - NMETA)) * DM : FIN(1) + (size_t)(p - NMETA) * DM);
                    const f32x4* sr = (const f32x4*)src + lane;
#pragma unroll
                    for (int j = 0; j < 4; ++j) v[q][j] = sr[64 * j];
                } }
            asm volatile("" ::: "memory");
#pragma unroll
            for (int q = 0; q < 4; ++q) { const int r = rr[q];
                if (r >= MP) continue;
                float a = 0.f;
#pragma unroll
                for (int j = 0; j < 4; ++j) a += (v[q][j].x * v[q][j].x + v[q][j].y * v[q][j].y) + (v[q][j].z * v[q][j].z + v[q][j].w * v[q][j].w);
                a = wave_sum(a, lane); if (lane == 0) ss[r] = a;
                unsigned long long* o8 = (unsigned long long*)(XB + (size_t)r * DM) + lane;
#pragma unroll
                for (int j = 0; j < 4; ++j) o8[64 * j] = (unsigned long long)pk2(v[q][j].x, v[q][j].y) | ((unsigned long long)pk2(v[q][j].z, v[q][j].w) << 32); }
        }
    }
    {
        LAS float* scr = (LAS float*)(F.lds + F.wave * 16384);
        unsigned char* W = F.ws + WS_W;
        constexpr int I_IN = (DM / 64) * (INW / 32), I_G = (DM / 64) * (DFF / 32), I_D = (DFF / 64) * (DM / 32), I_O = (DM / 64) * (DM / 32), I_M = (512 / 64) * (DM / 32);
        constexpr int NIT = I_IN + 2 * I_G + I_D + I_O + 2 * I_M;
        if (DSEL(2)) for (int it = gw; it < NIT; it += NGW) {
            int r = it;
            if (r < I_IN) { p0_transpose_item(FIN(5) + (size_t)layer * DM * INW, DM, INW, (bf16_t*)(W + W_IN), 0, scr, r, lane, FIN(4) + layer * DM); continue; } r -= I_IN;
            if (r < I_G) { p0_transpose_item(FIN(25) + (size_t)layer * DM * DFF, DM, DFF, (bf16_t*)(W + W_G), 0, scr, r, lane, FIN(24) + layer * DM); continue; } r -= I_G;
            if (r < I_G) { p0_transpose_item(FIN(26) + (size_t)layer * DM * DFF, DM, DFF, (bf16_t*)(W + W_U), 0, scr, r, lane, FIN(24) + layer * DM); continue; } r -= I_G;
            if (r < I_D) { p0_transpose_item(FIN(29) + (size_t)layer * DFF * DM, DFF, DM, (bf16_t*)(W + W_D), 0, scr, r, lane); continue; } r -= I_D;
            if (r < I_O) { p0_transpose_item(FIN(23) + (size_t)layer * DM * DM, DM, DM, (bf16_t*)(W + W_OUT), 0, scr, r, lane); continue; } r -= I_O;
            if (r < I_M) { p0_transpose_item(FIN(20) + (size_t)layer * 512 * DM, 512, DM, (bf16_t*)(W + W_MRG), 0, scr, r, lane); continue; } r -= I_M;
            p0_transpose_item(FIN(21) + (size_t)layer * 512 * DM, 512, DM, (bf16_t*)(W + W_MRG), DM, scr, r, lane);
        }
        const float* pw = FIN(18) + (size_t)layer * 4 * 128 * 128; const float* psc = FIN(19) + layer * 512; const float* wpo = FIN(22) + (size_t)layer * 512 * DM;
        bf16_t* WT = (bf16_t*)(W + W_MRG) + (size_t)2 * DM * 512;
        const int gt = (F.vcu * NWAVES + F.wave) * 64 + lane, NGT = NGW * 64;
        if (DSEL(4)) for (int st = NGW - 1 - gw; st < (512 / 8) * (DM / 64); st += NGW) {
            const int c0 = (st >> 4) * 8, j = (st & 15) * 64 + lane, g = c0 >> 7;
            { const int cr = lane >> 3, d0 = (lane & 7) * 16; const float* pr = pw + ((size_t)c0 + cr) * 128 + d0; const float* ps = psc + g * 128 + d0;
#pragma unroll
              for (int q = 0; q < 4; ++q) { const f32x4 a = *(const f32x4*)(pr + 4 * q), b = *(const f32x4*)(ps + 4 * q); *(LAS f32x4*)(scr + cr * 128 + d0 + 4 * q) = a * b; } }
            LDS_WAIT(); asm volatile("" ::: "memory");
            const float* wp = wpo + (size_t)(g * 128) * DM + j;
            float a[8];
#pragma unroll
            for (int c = 0; c < 8; ++c) a[c] = 0.f;
#pragma unroll 1
            for (int d0 = 0; d0 < 128; d0 += 16) { float w[16];
#pragma unroll
                for (int q = 0; q < 16; ++q) w[q] = wp[(size_t)(d0 + q) * DM];
                asm volatile("" ::: "memory");
#pragma unroll
                for (int c = 0; c < 8; ++c)
#pragma unroll
                    for (int q4 = 0; q4 < 4; ++q4) { const f32x4 cf = *(const LAS f32x4*)(scr + c * 128 + d0 + 4 * q4);
#pragma unroll
                        for (int e = 0; e < 4; ++e) a[c] += cf[e] * w[4 * q4 + e]; }
                asm volatile("" ::: "memory");
            }
            u32x4 o; o.x = pk2(a[0], a[1]); o.y = pk2(a[2], a[3]); o.z = pk2(a[4], a[5]); o.w = pk2(a[6], a[7]);
            *(u32x4*)(WT + (size_t)j * 512 + c0) = o;
            LDS_WAIT(); asm volatile("" ::: "memory");
        }
        if (layer == 0)   for (int idx = gt; idx < 2 * 512 * 513; idx += NGT) { const int k = idx % 513, cc = (idx / 513) & 511, cls = idx / (513 * 512);
            const int L = cls ? LS : LP, rklen = cls ? RKLEN_S : RKLEN_P; bf16_t* RK = (bf16_t*)(F.ws + (cls ? WS_RKS : WS_RKP)) + (size_t)cc * rklen;
            RK[k <= 256 ? k : 256 + 2 * L + (k - 257)] = 0; }
        if (!filt_first && DSEL(8)) for (int it = gw; it < NI8; it += NGW) filt_h2_item8(A, F, layer, it, scr, lane);
    }
}

__device__ __forceinline__ void p_attn_ref(const CArgs& A, const Frame& F, int layer) {
    bf16_t* P = (bf16_t*)(F.ws + WS_PROJ);
    const float* qg = FIN(6) + layer * HD; const float* kg = FIN(7) + layer * HD; const float* sink = FIN(8) + layer * NHEAD; const float* rb = FIN(3);
    const int gt = (F.vcu * NWAVES + F.wave) * 64 + F.lane, NGT = F.G * NWAVES * 64;
    for (int idx = gt; idx < MROWS * NHEAD; idx += NGT) {
        const int r = idx >> 3, h = idx & 7, hk = h >> 2;
        const int s = seq_of_row(r), base = seq_base(s), L = seq_len(s), p = r - base;
        unsigned qs[32]; float o[64];
        { const u32x4* qp = (const u32x4*)(P + (size_t)r * INW + C_Q + 64 * h); float ss = 0.f;
#pragma unroll
          for (int c = 0; c < 8; ++c) { const u32x4 w = qp[c]; qs[4 * c] = w.x; qs[4 * c + 1] = w.y; qs[4 * c + 2] = w.z; qs[4 * c + 3] = w.w; }
#pragma unroll
          for (int d = 0; d < 32; ++d) { const float a = bflo(qs[d]), b = bfhi(qs[d]); ss += a * a + b * b; }
          const float rs = 1.0f / sqrtf(ss * (1.f / 64) + EPS) * 0.125f;
#pragma unroll
          for (int d = 0; d < 32; ++d) { qs[d] = pk2(bflo(qs[d]) * rs * qg[2 * d], bfhi(qs[d]) * rs * qg[2 * d + 1]); o[2 * d] = 0.f; o[2 * d + 1] = 0.f; } }
        float m = sink[h], l = 1.f;
        const int lo = p - 128 < 0 ? 0 : p - 128, hi = p + 128 > L - 1 ? L - 1 : p + 128;
        for (int pk = lo; pk <= hi; ++pk) {
            const bf16_t* kr = P + (size_t)(base + pk) * INW;
            const u32x4* kp = (const u32x4*)(kr + C_K + 64 * hk); const u32x4* vp = (const u32x4*)(kr + C_V + 64 * hk);
            float ss = 0.f, dt = 0.f;
#pragma unroll
            for (int c = 0; c < 8; ++c) { float kk[8]; unpack8(kp[c], kk);
#pragma unroll
                for (int e = 0; e < 8; ++e) { ss += kk[e] * kk[e]; const unsigned qw = qs[4 * c + (e >> 1)]; dt += kk[e] * kg[8 * c + e] * ((e & 1) ? bfhi(qw) : bflo(qw)); }
                asm volatile("" ::: "memory"); }
            const float sc = dt / sqrtf(ss * (1.f / 64) + EPS) + rb[c_bucket[pk - p + 128] * NHEAD + h];
            const float mn = fmaxf(m, sc), f = __expf(m - mn), pe = __expf(sc - mn);
            l = l * f + pe; m = mn;
#pragma unroll
            for (int c = 0; c < 8; ++c) { float vv[8]; unpack8(vp[c], vv);
#pragma unroll
                for (int e = 0; e < 8; ++e) o[8 * c + e] = o[8 * c + e] * f + pe * vv[e];
                asm volatile("" ::: "memory"); }
        }
        const float il = (DBG & 4) ? 0.f : 1.f / l; u32x4* op = (u32x4*)(P + (size_t)r * INW + C_Q + 64 * h);
#pragma unroll
        for (int c = 0; c < 8; ++c) { u32x4 w; w.x = pk2(o[8 * c] * il, o[8 * c + 1] * il); w.y = pk2(o[8 * c + 2] * il, o[8 * c + 3] * il); w.z = pk2(o[8 * c + 4] * il, o[8 * c + 5] * il); w.w = pk2(o[8 * c + 6] * il, o[8 * c + 7] * il); op[c] = w; }
    }
}

constexpr int AT_K = 0, AT_V = 49152, AT_VSTR = 776, AT_B = AT_V + 64 * AT_VSTR, AT_BSTR = 324;
constexpr float AT_LOG2E = 1.4426950408889634f;
__device__ __forceinline__ void p_attn(const CArgs& A, const Frame& F, int layer) {
    bf16_t* P = (bf16_t*)(F.ws + WS_PROJ);
    const float* qg = FIN(6) + layer * HD; const float* kg = FIN(7) + layer * HD; const float* sink = FIN(8) + layer * NHEAD; const float* rb = FIN(3);
    const int lane = F.lane, wave = F.wave, tid = F.tid, r32 = lane & 31, hi = lane >> 5;
    LAS unsigned char* lds = F.lds;
    for (int unit = F.vcu; unit < 265 * 4; unit += F.G) {
        const int gb = unit >> 2, hk = (unit >> 1) & 1, gh = unit & 1;
        const int s = gb < 136 ? gb / 17 : 8, nb = gb < 136 ? gb - 17 * s : gb - 136;
        const int base = seq_base(s), L = seq_len(s);
        const int pk0 = 128 * nb - 240;
        u32x4 kws[6], vws[6];
#pragma unroll
        for (int it = 0; it < 6; ++it) { const int idx = tid + it * 512, key = idx >> 3, ch = idx & 7, pk = pk0 + key; const bool ok = pk >= 0 && pk < L;
            const bf16_t* rowp = P + (size_t)(base + (ok ? pk : 0)) * INW + 64 * hk + 8 * ch;
            kws[it] = *(const u32x4*)(rowp + C_K); vws[it] = *(const u32x4*)(rowp + C_V); }
#pragma unroll
        for (int it = 0; it < 6; ++it) { const int idx = tid + it * 512, key = idx >> 3, ch = idx & 7, pk = pk0 + key; const bool ok = pk >= 0 && pk < L;
            u32x4 kw = kws[it], vw = vws[it];
            float kf[8]; unpack8(kw, kf); float ss = 0.f;
#pragma unroll
            for (int e = 0; e < 8; ++e) ss += kf[e] * kf[e];
            ss += shx(ss, 1, lane); ss += shx(ss, 2, lane); ss += shx(ss, 4, lane);
            const float rs = ok ? 1.0f / sqrtf(ss * (1.f / 64) + EPS) : 0.f;
            u32x4 ko; ko.x = pk2(kf[0] * rs * kg[8 * ch], kf[1] * rs * kg[8 * ch + 1]); ko.y = pk2(kf[2] * rs * kg[8 * ch + 2], kf[3] * rs * kg[8 * ch + 3]);
            ko.z = pk2(kf[4] * rs * kg[8 * ch + 4], kf[5] * rs * kg[8 * ch + 5]); ko.w = pk2(kf[6] * rs * kg[8 * ch + 6], kf[7] * rs * kg[8 * ch + 7]);
            *(LAS u32x4*)(lds + AT_K + key * 128 + ((ch ^ (key & 7)) << 4)) = ko;
            if (!ok) vw = (u32x4){0u, 0u, 0u, 0u};
            LAS bf16_t* vt = (LAS bf16_t*)(lds + AT_V + (8 * ch) * AT_VSTR) + key;
            vt[0] = (bf16_t)(vw.x & 0xffffu); *(LAS bf16_t*)((LAS unsigned char*)vt + AT_VSTR) = (bf16_t)(vw.x >> 16);
            *(LAS bf16_t*)((LAS unsigned char*)vt + 2 * AT_VSTR) = (bf16_t)(vw.y & 0xffffu); *(LAS bf16_t*)((LAS unsigned char*)vt + 3 * AT_VSTR) = (bf16_t)(vw.y >> 16);
            *(LAS bf16_t*)((LAS unsigned char*)vt + 4 * AT_VSTR) = (bf16_t)(vw.z & 0xffffu); *(LAS bf16_t*)((LAS unsigned char*)vt + 5 * AT_VSTR) = (bf16_t)(vw.z >> 16);
            *(LAS bf16_t*)((LAS unsigned char*)vt + 6 * AT_VSTR) = (bf16_t)(vw.w & 0xffffu); *(LAS bf16_t*)((LAS unsigned char*)vt + 7 * AT_VSTR) = (bf16_t)(vw.w >> 16); }
        for (int i = tid; i < 2 * 257; i += 512) { const int hh = i >= 257 ? 1 : 0, rr = i - 257 * hh; ((LAS float*)(lds + AT_B))[hh * AT_BSTR + 32 + rr] = AT_LOG2E * rb[c_bucket[rr] * NHEAD + 4 * hk + 2 * gh + hh]; }
        __syncthreads();
        const int hh = wave >> 2, head = 4 * hk + 2 * gh + hh, qt = wave & 3, qi = 32 * qt + r32, pq = 128 * nb - 112 + qi; const bool qok = pq >= 0;
        const LAS float* bias = (const LAS float*)(lds + AT_B) + hh * AT_BSTR + 32;
        const bool edge = pk0 < 0 || pk0 + 384 > L;
        bf16x8 qf[4];
        { const bf16_t* qp = P + (size_t)(base + (qok ? pq : 0)) * INW + C_Q + 64 * head + 8 * hi; u32x4 qw[4]; float ss = 0.f;
#pragma unroll
          for (int ds = 0; ds < 4; ++ds) { qw[ds] = *(const u32x4*)(qp + 16 * ds); float f[8]; unpack8(qw[ds], f);
#pragma unroll
              for (int e = 0; e < 8; ++e) ss += f[e] * f[e]; }
          ss += shx(ss, 32, lane);
          const float rs = (0.125f * AT_LOG2E) / sqrtf(ss * (1.f / 64) + EPS);
#pragma unroll
          for (int ds = 0; ds < 4; ++ds) { float f[8]; unpack8(qw[ds], f); const float* g = qg + 16 * ds + 8 * hi; u32x4 o;
              o.x = pk2(f[0] * rs * g[0], f[1] * rs * g[1]); o.y = pk2(f[2] * rs * g[2], f[3] * rs * g[3]); o.z = pk2(f[4] * rs * g[4], f[5] * rs * g[5]); o.w = pk2(f[6] * rs * g[6], f[7] * rs * g[7]);
              qf[ds] = __builtin_bit_cast(bf16x8, o); } }
        float m = AT_LOG2E * sink[head], lp = hi == 0 ? 1.f : 0.f;
        f32x16 o0 = {}, o1 = {};
#define ATT_TILE(MODE, KT) do { const int kt = (KT); \
            f32x16 st = {}; \
            _Pragma("unroll") for (int ds = 0; ds < 4; ++ds) { const int key = 32 * kt + r32, chn = 2 * ds + hi; \
                const bf16x8 kfr = *(const LAS bf16x8*)(lds + AT_K + key * 128 + ((chn ^ (key & 7)) << 4)); \
                st = __builtin_amdgcn_mfma_f32_32x32x16_bf16(kfr, qf[ds], st, 0, 0, 0); } \
            const LAS float* bj = bias + 32 * (kt - qt) - r32 + 4 * hi; float bv[16]; \
            _Pragma("unroll") for (int i = 0; i < 16; ++i) bv[i] = bj[(i & 3) + 8 * (i >> 2)]; \
            float tmax = -1e30f; \
            _Pragma("unroll") for (int i = 0; i < 16; ++i) { const int ci = (i & 3) + 8 * (i >> 2); bool ok = true; \
                if (MODE == 0) ok = ci >= thr; else if (MODE == 2) ok = ci <= thr; \
                else if (MODE == 3) { const int kj = 32 * kt + ci + 4 * hi, rel = kj - 128 - qi, pk = pk0 + kj; ok = rel >= -128 && rel <= 128 && pk >= 0 && pk < L; } \
                const float v = ok ? st[i] + bv[i] : -1e30f; st[i] = v; tmax = fmaxf(tmax, v); } \
            tmax = fmaxf(tmax, shx(tmax, 32, lane)); \
            const bool resc = __builtin_amdgcn_ballot_w64(tmax - m > 8.f) != 0ull;        \
            const float mn = resc ? fmaxf(m, tmax) : m, f = resc ? __builtin_amdgcn_exp2f(m - mn) : 1.f; m = mn; \
            float ps = 0.f; \
            _Pragma("unroll") for (int i = 0; i < 16; ++i) { st[i] = __builtin_amdgcn_exp2f(st[i] - mn); ps += st[i]; } \
            lp = lp * f + ps; \
            if (resc) { _Pragma("unroll") for (int i = 0; i < 16; ++i) { o0[i] *= f; o1[i] *= f; } } \
            _Pragma("unroll") for (int s2 = 0; s2 < 2; ++s2) { \
                u32x4 pw; pw.x = pk2(st[8 * s2], st[8 * s2 + 1]); pw.y = pk2(st[8 * s2 + 2], st[8 * s2 + 3]); pw.z = pk2(st[8 * s2 + 4], st[8 * s2 + 5]); pw.w = pk2(st[8 * s2 + 6], st[8 * s2 + 7]); \
                const bf16x8 pf = __builtin_bit_cast(bf16x8, pw); \
                _Pragma("unroll") for (int dt = 0; dt < 2; ++dt) { const LAS unsigned char* vp = lds + AT_V + (32 * dt + r32) * AT_VSTR + (32 * kt + 16 * s2 + 4 * hi) * 2; \
                    const u32x2 a0 = *(const LAS u32x2*)vp, a1 = *(const LAS u32x2*)(vp + 16); \
                    const bf16x8 vf = __builtin_bit_cast(bf16x8, (u32x4){a0.x, a0.y, a1.x, a1.y}); \
                    if (dt == 0) o0 = __builtin_amdgcn_mfma_f32_32x32x16_bf16(vf, pf, o0, 0, 0, 0); else o1 = __builtin_amdgcn_mfma_f32_32x32x16_bf16(vf, pf, o1, 0, 0, 0); } } } while (0)
        const int thr = r32 - 4 * hi;
        if (edge) { for (int j = 0; j <= 8; ++j) ATT_TILE(3, qt + j); }
        else { ATT_TILE(0, qt); for (int j = 1; j < 8; ++j) ATT_TILE(1, qt + j); ATT_TILE(2, qt + 8); }
#undef ATT_TILE
        const float il = (DBG & 4) ? 0.f : 1.f / (lp + shx(lp, 32, lane));
        { u32x2 w0[4], w1[4];
#pragma unroll
          for (int g = 0; g < 4; ++g) { w0[g].x = pk2(o0[4 * g] * il, o0[4 * g + 1] * il); w0[g].y = pk2(o0[4 * g + 2] * il, o0[4 * g + 3] * il);
              w1[g].x = pk2(o1[4 * g] * il, o1[4 * g + 1] * il); w1[g].y = pk2(o1[4 * g + 2] * il, o1[4 * g + 3] * il); }
          u32x4 q0[2], q1[2];
#pragma unroll
          for (int k = 0; k < 2; ++k) {
              const u32x2 a0 = __builtin_amdgcn_permlane32_swap(w0[2 * k].x, w0[2 * k + 1].x, false, false), a1 = __builtin_amdgcn_permlane32_swap(w0[2 * k].y, w0[2 * k + 1].y, false, false);
              const u32x2 b0 = __builtin_amdgcn_permlane32_swap(w1[2 * k].x, w1[2 * k + 1].x, false, false), b1 = __builtin_amdgcn_permlane32_swap(w1[2 * k].y, w1[2 * k + 1].y, false, false);
              q0[k] = (u32x4){a0[0], a1[0], a0[1], a1[1]}; q1[k] = (u32x4){b0[0], b1[0], b0[1], b1[1]}; }
          if (qok && !F.dry) { bf16_t* op = P + (size_t)(base + pq) * INW + C_Q + 64 * head + 8 * hi;
#pragma unroll
              for (int k = 0; k < 2; ++k) { *(u32x4*)(op + 16 * k) = q0[k]; *(u32x4*)(op + 32 + 16 * k) = q1[k]; } } }
        __syncthreads();
    }
}
__device__ __forceinline__ void dwconv8(const bf16_t* P, int r, int col, const float* cw, const float* cb, int ucol, float* out) {
    const int s = seq_of_row(r), p = r - seq_base(s); const bool hasp = p > 0, hasn = p < seq_len(s) - 1;
    const bf16_t* gp = P + (size_t)r * INW + col;
    const u32x4 gm = *(const u32x4*)(gp - (hasp ? INW : 0)), g0 = *(const u32x4*)gp, gn = *(const u32x4*)(gp + (hasn ? INW : 0));
    float fm[8], f0[8], fn[8]; unpack8(gm, fm); unpack8(g0, f0); unpack8(gn, fn);
    const float mp_ = hasp ? 1.f : 0.f, mn_ = hasn ? 1.f : 0.f;
#pragma unroll
    for (int e = 0; e < 8; ++e) { fm[e] *= mp_; fn[e] *= mn_; }
#pragma unroll
    for (int e = 0; e < 8; ++e) out[e] = cw[ucol + e] * fm[e] + cw[1536 + ucol + e] * f0[e] + cw[2 * 1536 + ucol + e] * fn[e] + cb[ucol + e];
}
struct DwRows { u32x4 gm, g0, gn; float mp_, mn_; };
struct DwTaps { f32x4 a[2], b[2], c[2], d[2]; };
__device__ __forceinline__ void dw_load(const bf16_t* P, int r, int col, DwRows& d) {
    const int s = seq_of_row(r), p = r - seq_base(s); const bool hasp = p > 0, hasn = p < seq_len(s) - 1;
    const bf16_t* gp = P + (size_t)r * INW + col;
    d.gm = *(const u32x4*)(gp - (hasp ? INW : 0)); d.g0 = *(const u32x4*)gp; d.gn = *(const u32x4*)(gp + (hasn ? INW : 0));
    d.mp_ = hasp ? 1.f : 0.f; d.mn_ = hasn ? 1.f : 0.f;
}
__device__ __forceinline__ void dw_taps(const float* cw, const float* cb, int ucol, DwTaps& w) {
#pragma unroll
    for (int h = 0; h < 2; ++h) { w.a[h] = *(const f32x4*)(cw + ucol + 4 * h); w.b[h] = *(const f32x4*)(cw + 1536 + ucol + 4 * h); w.c[h] = *(const f32x4*)(cw + 2 * 1536 + ucol + 4 * h); w.d[h] = *(const f32x4*)(cb + ucol + 4 * h); }
}
__device__ __forceinline__ void dw_apply(const DwRows& d, const DwTaps& w, float* out) {
    float fm[8], f0[8], fn[8]; unpack8(d.gm, fm); unpack8(d.g0, f0); unpack8(d.gn, fn);
#pragma unroll
    for (int e = 0; e < 8; ++e) out[e] = w.a[e >> 2][e & 3] * (fm[e] * d.mp_) + w.b[e >> 2][e & 3] * f0[e] + w.c[e >> 2][e & 3] * (fn[e] * d.mn_) + w.d[e >> 2][e & 3];
}
constexpr int NS8 = MROWS / 8, NS8_P = ROWS_P / 8;
static_assert(MROWS % 8 == 0 && ROWS_P % 64 == 0 && NWAVES == 8, "row steps");
__device__ __forceinline__ bool dw_item(int ii, int vcu, int G, int& sb, int& ns) {
    const int k = (NS8 / 8) / G;
    if (ii < k) { sb = (vcu * k + ii) * 8; ns = 8; return true; }
    sb = k * G * 8 + vcu + (ii - k) * G; ns = 1; return sb < NS8;
}
__device__ __forceinline__ void p_h1(const CArgs& A, const Frame& F, int layer) {
    const bf16_t* P = (const bf16_t*)(F.ws + WS_PROJ); bf16_t* ZT = (bf16_t*)F.out;
    const float* cw = FIN(9) + (size_t)layer * 3 * 1536; const float* cb = FIN(10) + layer * 1536;
    LAS bf16_t* scr = (LAS bf16_t*)(F.lds + F.wave * 16384);
    const int lane = F.lane, rs = lane >> 3, ck = lane & 7, cc = F.wave, c0 = cc * 64 + ck * 8;
    DwTaps wa, wb; dw_taps(cw, cb, 512 + c0, wa); dw_taps(cw, cb, 1024 + c0, wb);
    for (int ii = 0;; ++ii) {
        int sb, ns; if (!dw_item(ii, F.vcu, F.G, sb, ns)) break;
        const int rbase = sb * 8;
#pragma unroll
        for (int hb = 0; hb < 2; ++hb) { DwRows da[4], db[4];
#pragma unroll
            for (int q = 0; q < 4; ++q) { const int st = hb * 4 + q, r = rbase + (st < ns ? st : 0) * 8 + rs; dw_load(P, r, C_X1 + c0, da[q]); dw_load(P, r, C_VV + c0, db[q]); }
            asm volatile("" ::: "memory");
#pragma unroll
            for (int q = 0; q < 4; ++q) { const int lr = (hb * 4 + q) * 8 + rs; float a[8], b[8]; dw_apply(da[q], wa, a); dw_apply(db[q], wb, b);
#pragma unroll
                for (int e = 0; e < 8; ++e) scr[(ck * 8 + e) * 72 + lr] = (bf16_t)f2bf(a[e] * b[e]); }
            asm volatile("" ::: "memory"); }
        LDS_WAIT();
#pragma unroll
        for (int j = 0; j < 8; ++j) { const int chn = (lane >> 3) + 8 * j, pc = lane & 7;
            const u32x4 w = *(const LAS u32x4*)(scr + chn * 72 + pc * 8);
            if (pc < ns) *(u32x4*)(ZT + (size_t)(cc * 64 + chn) * MP + rbase + pc * 8) = w; }
        LDS_WAIT();
    }
}

__device__ __forceinline__ void p_h2_ref(const CArgs& A, const Frame& F) {
    const bf16_t* ZT = (const bf16_t*)F.out; bf16_t* CT = (bf16_t*)F.out + (size_t)512 * MP;
    const int gt = (F.vcu * NWAVES + F.wave) * 64 + F.lane, NGT = F.G * NWAVES * 64;
    for (long idx = gt; idx < (long)512 * MP; idx += NGT) {
        const int c = (int)(idx / MP), r = (int)(idx - (long)c * MP);
        float acc = 0.f;
        if (r < MROWS) {
            const int s = seq_of_row(r), base = seq_base(s), L = seq_len(s), p = r - base, cls = s < 8 ? 0 : 1;
            const bf16_t* rk = (const bf16_t*)(F.ws + (cls ? WS_RKS : WS_RKP)) + (size_t)c * (cls ? RKLEN_S : RKLEN_P) + RK_PAD + L - p;
            const bf16_t* z = ZT + (size_t)c * MP + base;
            for (int s8 = 0; s8 < L; s8 += 8) { const u32x4 zw = *(const u32x4*)(z + s8); float zf[8]; unpack8(zw, zf);
#pragma unroll
                for (int e = 0; e < 8; ++e) acc += zf[e] * __uint_as_float((unsigned)rk[s8 + e] << 16); }
        }
        CT[idx] = (bf16_t)f2bf(acc);
    }
}
constexpr int H2_ZOFF_S = ((RKLEN_S * 2 + 1023) >> 10) << 10, H2_ZOFF_P = ((RKLEN_P * 2 + 1023) >> 10) << 10;
constexpr int H2_ZPADL_S = 4096, H2_ZSLOTS_S = 24704, H2_ZPADL_P = 512, H2_ZSLOTS_P = 3072, H2_SZP = 6976;
static_assert(H2_ZOFF_S + (H2_ZSLOTS_S + (H2_ZSLOTS_S >> 7) * 16) * 2 <= RING_BYTES_C && H2_ZOFF_P + 8 * H2_SZP <= RING_BYTES_C, "H2 LDS");
__device__ __forceinline__ void p_h2(const Frame& F) {
    const bf16_t* ZT = (const bf16_t*)F.out; bf16_t* CT = (bf16_t*)F.out + (size_t)512 * MP;
    const int lane = F.lane, wave = F.wave, tid = F.tid;
    LAS float* red = (LAS float*)(F.lds + LDSCTL_OFF_C + 1024);
    for (int item = F.vcu; item < 1024; item += F.G) {
        const int cls = item < 512 ? 1 : 0, c = item & 511;
        const int L = cls ? LS : LP, rklen = cls ? RKLEN_S : RKLEN_P, ZPADL = cls ? H2_ZPADL_S : H2_ZPADL_P, zs8 = (cls ? H2_ZSLOTS_S : H2_ZSLOTS_P) / 8;
        LAS unsigned char* rkl = F.lds; LAS unsigned char* zl = F.lds + (cls ? H2_ZOFF_S : H2_ZOFF_P);
        {
          const char* rkg = (const char*)((const bf16_t*)(F.ws + (cls ? WS_RKS : WS_RKP)) + (size_t)c * rklen);
          const int npc = (rklen * 2 + 1023) >> 10;
          for (int pc = wave; pc < npc; pc += NWAVES)
              __builtin_amdgcn_global_load_lds((const unsigned*)(rkg + (size_t)pc * 1024 + lane * 16), (LAS unsigned*)(rkl + pc * 1024), 16, 0, 0);
          const int nsl = (cls ? 1 : 8) * zs8; u32x4 zv[7];
#pragma unroll
          for (int j = 0; j < 7; ++j) { const int i = tid + j * (NWAVES * 64); const int sq = i / zs8, i8 = i - sq * zs8, sp = i8 * 8 - ZPADL;
              zv[j] = (u32x4){0u, 0u, 0u, 0u};
              if (i < nsl && sp >= 0 && sp < L) zv[j] = *(const u32x4*)(ZT + (size_t)c * MP + (cls ? ROWS_P : sq * LP) + sp); }
#pragma unroll
          for (int j = 0; j < 7; ++j) { const int i = tid + j * (NWAVES * 64); const int sq = i / zs8, i8 = i - sq * zs8; const int pos = i8 * 8, el = pos + ((pos >> 7) << 4);
              if (i < nsl) *(LAS u32x4*)(zl + sq * H2_SZP + el * 2) = zv[j]; }
          asm volatile("s_waitcnt vmcnt(0)" ::: "memory"); }
        __syncthreads();
        { float m[16];
#pragma unroll
          for (int t = 0; t < 16; ++t) m[t] = 0.f;
          const int nchunk = L / 8, cstep = cls ? NWAVES * 64 : 64; const int zb2 = cls ? 0 : wave * H2_SZP;
          for (int ck = cls ? tid : lane; ck < nchunk; ck += cstep) { const int s0 = ck * 8, i0 = s0 + ZPADL, e0 = i0 + ((i0 >> 7) << 4);
              const u32x4 zw = *(const LAS u32x4*)(zl + zb2 + e0 * 2);
              const LAS unsigned char* rp = rkl + (RK_PAD + L + s0 - 16) * 2;
              const u32x4 r0 = *(const LAS u32x4*)rp, r1 = *(const LAS u32x4*)(rp + 16), r2 = *(const LAS u32x4*)(rp + 32);
              float zf[8], rf[24]; unpack8(zw, zf); unpack8(r0, rf); unpack8(r1, rf + 8); unpack8(r2, rf + 16);
#pragma unroll
              for (int t = 0; t < 16; ++t)
#pragma unroll
                  for (int e = 0; e < 8; ++e) m[t] += zf[e] * rf[16 + e - t]; }
#pragma unroll
          for (int t = 0; t < 16; ++t) m[t] = wave_sum(m[t], lane);
          float mine = 0.f;
#pragma unroll
          for (int t = 0; t < 16; ++t) mine = (lane == t) ? m[t] : mine;
          if (cls) { if (lane < 16) red[wave * 16 + lane] = mine; }
          else if (lane < 16) CT[(size_t)c * MP + wave * LP + lane] = (bf16_t)f2bf(mine); }
        const int n = lane & 15, h = lane >> 4, cg2 = wave & 1, us4 = wave >> 1;
        int T0a, zb, T0min, T0max, rowbase;
        const int T0g = cls ? 128 * 16 : 256; const int zg1 = (T0g + (T0g >> 7) * 16) * 2;
        if (cls) { T0min = 16 + 128 * 64 * cg2; T0max = T0min + 128 * 63; T0a = T0min + 128 * n; zb = 0; rowbase = ROWS_P; }
        else { const int sq = n >> 1; T0min = 16 + 1024 * cg2; T0max = T0min + 3 * 256 + 128; T0a = T0min + 128 * (n & 1); zb = sq * H2_SZP; rowbase = sq * LP; }
        const int u_lo = -(((T0max + 7 + 31) >> 5) << 5), u_hi = ((L - 32 - T0min + 31) >> 5) << 5;
        const int nst = (u_hi - u_lo) / 32 + 1, nq = (nst + 3) >> 2;
        const int u_a = u_lo + 32 * nq * us4, u_b = (us4 == 3 || u_a + 32 * (nq - 1) > u_hi) ? u_hi : u_a + 32 * (nq - 1);
        const int abase = RK_PAD + L - 8 * n + 8 * h;
        f32x4 acc[4][8];
#pragma unroll
        for (int g = 0; g < 4; ++g)
#pragma unroll
            for (int t = 0; t < 8; ++t) acc[g][t] = (f32x4){0.f, 0.f, 0.f, 0.f};
        { const int gspan = cls ? 128 * 15 : 128;
          int glo[4], ghi[4];
#pragma unroll
          for (int g = 0; g < 4; ++g) { int a = -(T0min + g * T0g + gspan + 39); a = a >= 0 ? ((a + 31) >> 5) << 5 : -((-a) >> 5 << 5);
              int b = L - (T0min + g * T0g); b = b >= 0 ? ((b + 31) >> 5) << 5 : -((-b) >> 5 << 5); glo[g] = a; ghi[g] = b; }
#define H2_STEPG(GA, GB) do { \
              const LAS unsigned char* ap = rkl + (abase + u) * 2; \
              const u32x4 Lo = *(const LAS u32x4*)(ap - 16), Hi = *(const LAS u32x4*)ap; \
              const int i0 = T0a + u + 8 * h + ZPADL, e0 = i0 + ((i0 >> 7) << 4); const LAS unsigned char* zp = zl + zb + e0 * 2; \
              bf16x8 Bz[4]; \
              _Pragma("unroll") for (int g = (GA); g <= (GB); ++g) Bz[g] = *(const LAS bf16x8*)(zp + g * zg1); \
              unsigned W[8] = {Lo.x, Lo.y, Lo.z, Lo.w, Hi.x, Hi.y, Hi.z, Hi.w}, Od[7]; \
              _Pragma("unroll") for (int k = 0; k < 7; ++k) Od[k] = __builtin_amdgcn_alignbit(W[k + 1], W[k], 16); \
              _Pragma("unroll") for (int th = 0; th < 2; ++th) { bf16x8 Af[4]; \
                  _Pragma("unroll") for (int tt = 0; tt < 4; ++tt) { const int t = 4 * th + tt, i = 4 - ((t + 1) >> 1); \
                      const u32x4 fw = (t & 1) ? (u32x4){Od[i], Od[i + 1], Od[i + 2], Od[i + 3]} : (u32x4){W[i], W[i + 1], W[i + 2], W[i + 3]}; Af[tt] = __builtin_bit_cast(bf16x8, fw); } \
                  _Pragma("unroll") for (int g = (GA); g <= (GB); ++g) \
                      _Pragma("unroll") for (int tt = 0; tt < 4; ++tt) acc[g][4 * th + tt] = __builtin_amdgcn_mfma_f32_16x16x32_bf16(Af[tt], Bz[g], acc[g][4 * th + tt], 0, 0, 0); } } while (0)
#define H2_SEG(GA, GB, BOUND) do { const int be = (BOUND) < ue ? (BOUND) : ue; for (; u < be; u += 32) H2_STEPG(GA, GB); } while (0)
          int u = u_a; const int ue = u_b + 32;
          H2_SEG(3, 3, glo[2]); H2_SEG(2, 3, glo[1]); H2_SEG(1, 3, glo[0]); H2_SEG(0, 3, ghi[3]); H2_SEG(0, 2, ghi[2]); H2_SEG(0, 1, ghi[1]); H2_SEG(0, 0, ue);
#undef H2_SEG
#undef H2_STEPG
        }
        __syncthreads();
        if (us4 & 1) {
#pragma unroll
            for (int g = 0; g < 4; ++g)
#pragma unroll
                for (int t = 0; t < 8; ++t) *(LAS f32x4*)(F.lds + (cg2 * 2 + (us4 >> 1)) * 32768 + (g * 8 + t) * 1024 + lane * 16) = acc[g][t]; }
        if (cls && tid < 16) { float a = 0.f;
#pragma unroll
            for (int w = 0; w < 8; ++w) a += red[w * 16 + tid];
            CT[(size_t)c * MP + ROWS_P + tid] = (bf16_t)f2bf(a); }
        __syncthreads();
        if (!(us4 & 1)) {
#pragma unroll
            for (int g = 0; g < 4; ++g)
#pragma unroll
                for (int t = 0; t < 8; ++t) acc[g][t] += *(const LAS f32x4*)(F.lds + (cg2 * 2 + (us4 >> 1)) * 32768 + (g * 8 + t) * 1024 + lane * 16); }
        __syncthreads();
        if (us4 == 2) {
#pragma unroll
            for (int g = 0; g < 4; ++g)
#pragma unroll
                for (int t = 0; t < 8; ++t) *(LAS f32x4*)(F.lds + cg2 * 32768 + (g * 8 + t) * 1024 + lane * 16) = acc[g][t]; }
        __syncthreads();
        if (us4 == 0) {
#pragma unroll
            for (int g = 0; g < 4; ++g) {
#pragma unroll
                for (int t = 0; t < 8; ++t) acc[g][t] += *(const LAS f32x4*)(F.lds + cg2 * 32768 + (g * 8 + t) * 1024 + lane * 16);
                bf16_t* op = CT + (size_t)c * MP + rowbase + T0a + g * T0g + 32 * h;
#pragma unroll
                for (int i = 0; i < 4; ++i) { u32x4 w; w.x = pk2(acc[g][0][i], acc[g][1][i]); w.y = pk2(acc[g][2][i], acc[g][3][i]); w.z = pk2(acc[g][4][i], acc[g][5][i]); w.w = pk2(acc[g][6][i], acc[g][7][i]);
                    *(u32x4*)(op + 8 * i) = w; } } }
        __syncthreads();
    }
}
__device__ __forceinline__ void p_pool(const CArgs& A, const Frame& F) {
    bf16_t* P = (bf16_t*)(F.ws + WS_PROJ);
    const int gw = F.vcu * NWAVES + F.wave, NGW = F.G * NWAVES, lane = F.lane, c0 = lane * 8, hw = 1 << (lane >> 4);
    for (int run = gw; run < MROWS / 16; run += NGW) {
        const int r0 = run * 16, s = seq_of_row(r0), base = seq_base(s), L = seq_len(s), p0 = r0 - base;
        const bf16_t* ub = P + (size_t)base * INW + C_PU + c0;
        float S[8];
#pragma unroll
        for (int e = 0; e < 8; ++e) S[e] = 0.f;
#pragma unroll
        for (int i = 0; i < 16; ++i) { const int pp = p0 - hw + i; const bool ok = i < 2 * hw && pp >= 0 && pp < L;
            const u32x4 w = *(const u32x4*)(ub + (size_t)(ok ? pp : p0) * INW); float f[8]; unpack8(w, f); const float mk = ok ? 1.f : 0.f;
#pragma unroll
            for (int e = 0; e < 8; ++e) S[e] += mk * f[e]; }
#pragma unroll 4
        for (int k = 0; k < 16; ++k) { const int p = p0 + k, pn = p + hw, po = p - hw; const bool okn = pn < L, oko = po >= 0;
            const u32x4 ws_ = *(const u32x4*)(ub + (size_t)p * INW), wn = *(const u32x4*)(ub + (size_t)(okn ? pn : p) * INW), wo = *(const u32x4*)(ub + (size_t)(oko ? po : p) * INW);
            float fs[8], fn[8], fo[8]; unpack8(ws_, fs); unpack8(wn, fn); unpack8(wo, fo);
            const int lo = po < 0 ? 0 : po, hi = pn > L ? L : pn; const float ic = 1.f / (float)(hi - lo);
            float a[8];
#pragma unroll
            for (int e = 0; e < 8; ++e) a[e] = (DBG & 16) ? 0.f : S[e] * ic - fs[e];
            u32x4 w; w.x = pk2(a[0], a[1]); w.y = pk2(a[2], a[3]); w.z = pk2(a[4], a[5]); w.w = pk2(a[6], a[7]);
            *(u32x4*)(P + (size_t)(r0 + k) * INW + C_X1 + c0) = w;
            const float mn = okn ? 1.f : 0.f, mo = oko ? 1.f : 0.f;
#pragma unroll
            for (int e = 0; e < 8; ++e) S[e] += mn * fn[e] - mo * fo[e]; }
    }
}
__device__ __forceinline__ void p_final(const CArgs& A, const Frame& F, int layer) {
    bf16_t* P = (bf16_t*)(F.ws + WS_PROJ); const bf16_t* ZT = (const bf16_t*)F.out; const bf16_t* CT = ZT + (size_t)512 * MP;
    const float* cw = FIN(9) + (size_t)layer * 3 * 1536; const float* cb = FIN(10) + layer * 1536; const float* skip = FIN(17) + layer * 512;
    LAS bf16_t* sz = (LAS bf16_t*)(F.lds + F.wave * 16384); LAS bf16_t* sc = sz + 64 * 64;
    const int lane = F.lane, rs = lane >> 3, ck = lane & 7, cc = F.wave, c0 = cc * 64 + ck * 8;
    DwTaps wt; dw_taps(cw, cb, c0, wt); float sk[8];
    { const f32x4 k0 = *(const f32x4*)(skip + c0), k1 = *(const f32x4*)(skip + c0 + 4);
#pragma unroll
      for (int e = 0; e < 4; ++e) { sk[e] = k0[e]; sk[4 + e] = k1[e]; } }
    for (int ii = 0;; ++ii) {
        int sb, ns; if (!dw_item(ii, F.vcu, F.G, sb, ns)) break;
        const int rbase = sb * 8, cls = rbase < ROWS_P ? 0 : 1;
        const float* sums = (const float*)(F.ws + WS_CTL) + CW_SUMS + (layer * 2 + cls) * 512;
        u32x4 zt[8], ct[8]; DwRows dr[4];
        const f32x4 sm0 = *(const f32x4*)(sums + c0), sm1 = *(const f32x4*)(sums + c0 + 4);
#pragma unroll
        for (int j = 0; j < 8; ++j) { const int chn = (lane >> 3) + 8 * j, pc = lane & 7; const size_t off = (size_t)(cc * 64 + chn) * MP + rbase + (pc < ns ? pc : 0) * 8;
            zt[j] = *(const u32x4*)(ZT + off); ct[j] = *(const u32x4*)(CT + off); }
        asm volatile("" ::: "memory");
#pragma unroll
        for (int j = 0; j < 8; ++j) { const int chn = (lane >> 3) + 8 * j, pc = lane & 7; *(LAS u32x4*)(sz + chn * 64 + pc * 8) = zt[j]; *(LAS u32x4*)(sc + chn * 64 + pc * 8) = ct[j]; }
#pragma unroll
        for (int q = 0; q < 4; ++q) dw_load(P, rbase + (q < ns ? q : 0) * 8 + rs, C_X0 + c0, dr[q]);
        asm volatile("" ::: "memory");
        float isum[8];
#pragma unroll
        for (int e = 0; e < 4; ++e) { isum[e] = 1.f / sm0[e]; isum[4 + e] = 1.f / sm1[e]; }
        LDS_WAIT();
#pragma unroll
        for (int hb = 0; hb < 2; ++hb) {
            if (hb == 1) {
#pragma unroll
                for (int q = 0; q < 4; ++q) dw_load(P, rbase + (4 + q < ns ? 4 + q : 0) * 8 + rs, C_X0 + c0, dr[q]);
                asm volatile("" ::: "memory"); }
#pragma unroll
            for (int q = 0; q < 4; ++q) { const int st = hb * 4 + q, lr = st * 8 + rs, r = rbase + lr; float x0[8], o[8]; dw_apply(dr[q], wt, x0);
#pragma unroll
                for (int e = 0; e < 8; ++e) { const float z = __uint_as_float((unsigned)sz[(ck * 8 + e) * 64 + lr] << 16), cv = __uint_as_float((unsigned)sc[(ck * 8 + e) * 64 + lr] << 16);
                    o[e] = (DBG & 8) ? 0.f : (((DBG & 64) ? 0.f : cv * isum[e]) + ((DBG & 128) ? 0.f : z * sk[e])) * x0[e]; }
                u32x4 w; w.x = pk2(o[0], o[1]); w.y = pk2(o[2], o[3]); w.z = pk2(o[4], o[5]); w.w = pk2(o[6], o[7]);
                if (st < ns) *(u32x4*)(P + (size_t)r * INW + C_VV + c0) = w; }
            asm volatile("" ::: "memory"); }
        LDS_WAIT();
    }
}
constexpr int TAIL_ROW0 = 32768, TAIL_ITEMS = ((MROWS - TAIL_ROW0) / 16) * 16;
static_assert(MROWS - TAIL_ROW0 == 144 && TAIL_ROW0 % 256 == 0, "tail rows");
template <int NS>
__device__ __forceinline__ void tail_partial(f32x4 (&acc)[4], const bf16_t* ap, const bf16_t* bp, size_t bstride16) {
#pragma unroll
    for (int s0 = 0; s0 < NS; s0 += 6) {
        bf16x8 a[6], b[6][4];
#pragma unroll
        for (int s = 0; s < 6; ++s) if (s0 + s < NS) { a[s] = *(const bf16x8*)(ap + (s0 + s) * 32);
#pragma unroll
            for (int j = 0; j < 4; ++j) b[s][j] = *(const bf16x8*)(bp + j * bstride16 + (s0 + s) * 32); }
#pragma unroll
        for (int s = 0; s < 6; ++s) if (s0 + s < NS) {
#pragma unroll
            for (int j = 0; j < 4; ++j) acc[j] = __builtin_amdgcn_mfma_f32_16x16x32_bf16(b[s][j], a[s], acc[j], 0, 0, 0); }
        asm volatile("" ::: "memory");
    }
}
template <int K>
__device__ __forceinline__ void tail_res(const Frame& F, const bf16_t* A, const bf16_t* Bt, bf16_t* X, float* ss, float* outf) {
    constexpr int KW = K / 8, NS = KW / 32; static_assert(K % 256 == 0, "K split");
    const int lane = F.lane, fr = lane & 15, fq = lane >> 4, tid = F.tid;
    for (int item = F.bx; item < TAIL_ITEMS; item += F.G) {
        const int row0 = TAIL_ROW0 + (item >> 4) * 16, col0 = (item & 15) * 64;
        f32x4 acc[4];
#pragma unroll
        for (int j = 0; j < 4; ++j) acc[j] = (f32x4){0.f, 0.f, 0.f, 0.f};
        tail_partial<NS>(acc, A + (size_t)(row0 + fr) * K + F.wave * KW + fq * 8, Bt + (size_t)(col0 + fr) * K + F.wave * KW + fq * 8, (size_t)16 * K);
#pragma unroll
        for (int j = 0; j < 4; ++j) *(LAS f32x4*)(F.lds + F.wave * 4096 + j * 1024 + lane * 16) = acc[j];
        __syncthreads();
        f32x2 sm = {0.f, 0.f};
#pragma unroll
        for (int w = 0; w < 8; ++w) sm += *(const LAS f32x2*)(F.lds + w * 4096 + tid * 8);
        const int j = tid >> 7, l = (tid & 127) >> 1, r2 = (tid & 1) * 2, row = row0 + (l & 15), col = col0 + j * 16 + 4 * (l >> 4) + r2;
        unsigned* xp = (unsigned*)(X + (size_t)row * DM + col); const unsigned xw = *xp;
        const float a = bflo(xw) + sm.x, b = bfhi(xw) + sm.y;
        if (outf) { float* po = out_row(outf, row); if (po && !F.dry) *(f32x2*)(po + col) = (f32x2){a, b}; }
        else { if (!F.dry) *xp = pk2(a, b);
            if (ss) { float sq = a * a + b * b; sq += shx(sq, 1, lane); sq += shx(sq, 32, lane);
                if ((lane & 33) == 0 && !F.dry) atomicAdd(ss + row, sq); } }
        __syncthreads();
    }
}
__device__ __forceinline__ void tail_merge(const Frame& F, const bf16_t* P, const bf16_t* WM, bf16_t* O) {
    const int lane = F.lane, fr = lane & 15, fq = lane >> 4, tid = F.tid;
    for (int item = F.bx; item < TAIL_ITEMS; item += F.G) {
        const int row0 = TAIL_ROW0 + (item >> 4) * 16, col0 = (item & 15) * 64;
#pragma unroll
        for (int s = 0; s < 3; ++s) { const int col = s == 0 ? C_Q : (s == 1 ? C_VV : C_X1);
            f32x4 acc[4];
#pragma unroll
            for (int j = 0; j < 4; ++j) acc[j] = (f32x4){0.f, 0.f, 0.f, 0.f};
            tail_partial<2>(acc, P + (size_t)(row0 + fr) * INW + col + F.wave * 64 + fq * 8, WM + ((size_t)s * DM + col0 + fr) * 512 + F.wave * 64 + fq * 8, (size_t)16 * 512);
#pragma unroll
            for (int j = 0; j < 4; ++j) *(LAS f32x4*)(F.lds + s * 32768 + F.wave * 4096 + j * 1024 + lane * 16) = acc[j]; }
        __syncthreads();
        const int j = tid >> 7, l = (tid & 127) >> 1, r = (tid & 1) * 2, row = row0 + (l & 15), colo = col0 + j * 16 + 4 * (l >> 4) + r;
        const int cl = colo & 255; const unsigned char* gp = (const unsigned char*)(P + (size_t)row * INW) + C_G * 2 + (colo & ~255) + ((cl & 127) >> 5) * 64 + ((cl & 31) >> 3) * 16 + (cl >> 7) * 8 + (cl & 7);
        f32x2 o = {0.f, 0.f};
#pragma unroll
        for (int s = 0; s < 3; ++s) { f32x2 t = {0.f, 0.f};
#pragma unroll
            for (int w = 0; w < 8; ++w) t += *(const LAS f32x2*)(F.lds + s * 32768 + w * 4096 + tid * 8);
            const unsigned g2 = *(const unsigned short*)(gp + s * DM);
            o.x += t.x * ((float)(g2 & 255u) * (1.f / 255.f)); o.y += t.y * ((float)(g2 >> 8) * (1.f / 255.f)); }
        *(unsigned*)(O + (size_t)row * DM + colo) = pg8::cvt_pk_bf16(o.x, o.y);
        __syncthreads();
    }
}

constexpr int PH_PER_LAYER = 10, N_PHASES = 2 * PH_PER_LAYER;
__global__ void __launch_bounds__(NWAVES * 64, 2) fwd_kernel(Args args0) {
    extern __shared__ __attribute__((aligned(16))) unsigned char lds_raw[];
    const int wave0 = __builtin_amdgcn_readfirstlane(threadIdx.x >> 6);
    {
        for (int u = threadIdx.x; u < (LDS_BYTES - LDSCTL_OFF) / 4; u += NWAVES * 64) ((LAS unsigned*)((LAS unsigned char*)lds_raw + LDSCTL_OFF))[u] = 0u;
        __syncthreads();
    }
    XcdBarrier bar; bar.bar = (unsigned*)(args0.ws + WS_CTL) + CW_BAR; bar.x = 0; bar.st = nullptr;
    if (args0.use_bar) bar = xcd_barrier_post((unsigned*)(args0.ws + WS_CTL) + CW_BAR, (volatile LAS unsigned*)((LAS unsigned char*)lds_raw + MISC_OFF) + 8);
    for (int ph2 = 2 * args0.ph_lo; ph2 < 2 * args0.ph_hi; ++ph2) {
        const int ph = ph2 >> 1, rep = ph2 & 1;
        const int layer = ph / PH_PER_LAYER, k = ph % PH_PER_LAYER;
        if (rep == 1 && !(DUP_PHASE >= 0 && k == DUP_PHASE && args0.pad == 0)) continue;
        const __attribute__((address_space(4))) Args* ap = (const __attribute__((address_space(4))) Args*)__builtin_amdgcn_kernarg_segment_ptr();
        asm volatile("" : "+s"(ap));
        const __attribute__((address_space(4))) Args& args = *ap;
        Frame F;
        { int w_ = wave0; asm volatile("" : "+s"(w_)); int z_ = 0; asm volatile("" : "+v"(z_)); const int l_ = __builtin_amdgcn_mbcnt_hi(-1, __builtin_amdgcn_mbcnt_lo(-1, z_));
          F.lane = l_; F.wave = w_; F.tid = w_ * 64 + l_;
          int bx = blockIdx.x, G_ = gridDim.x; asm volatile("" : "+s"(bx), "+s"(G_)); F.G = G_; F.vcu = (G_ % 8 == 0) ? (bx % 8) * (G_ / 8) + bx / 8 : bx; F.bx = bx;
          F.dry = rep; F.lds = (LAS unsigned char*)lds_raw; F.ws = args.ws; F.out = args.out; F.xm = (float*)(args.ws + WS_XM); }
        unsigned char* W = F.ws + WS_W;
        bf16_t* XNR = (bf16_t*)(F.ws + WS_XNR); bf16_t* PROJ = (bf16_t*)(F.ws + WS_PROJ);
        bf16_t* GB = PROJ; bf16_t* ACT = PROJ + (size_t)MP * DFF;
#ifndef ONLY_PHASE
#define ONLY_PHASE -1
#endif
#define PHS(x) ((ONLY_PHASE < 0 || ONLY_PHASE == (x)) && k == (x))
        float* SS = (float*)(F.ws + WS_CTL) + CW_SS; bf16_t* OV = (bf16_t*)F.out;
        const bool last = layer == 1;
        if (PHS(0)) p_prep(args, F, layer);
        else if (PHS(1)) { OpsPlain O{XNR, (const bf16_t*)(W + W_IN), DM, DM}; pg8::StaticOrder S; S.init(MP, INW, F.G, F.bx, 1); EpiStore E{PROJ, INW, C_G / 256, SS + (size_t)(2 * layer) * MP};
            pg8::gemm_phase<EpiStore, OpsPlain, true>(F.lds, O, S, E, F.tid); }
        else if (PHS(2)) { if (DBG & 512) p_attn_ref(args, F, layer); else if (DSEL(64)) p_attn(args, F, layer); if (DSEL(128)) p_h1(args, F, layer); if (DSEL(256)) p_filt_tiles(args, F, layer); }
        else if (PHS(3)) { if (DBG & 256) p_h2_ref(args, F); else if (DSEL(16)) p_h2(F); if (DSEL(32)) p_pool(args, F); }
        else if (PHS(4)) p_final(args, F, layer);
        else if (PHS(5)) { OpsMerge O{PROJ, (const bf16_t*)(W + W_MRG), 512, INW}; pg8::StaticOrder S; S.init(TAIL_ROW0, DM, F.G, F.bx, 3); EpiMerge E{PROJ, OV};
            pg8::gemm_phase<EpiMerge, OpsMerge, true>(F.lds, O, S, E, F.tid); tail_merge(F, PROJ, (const bf16_t*)(W + W_MRG), OV); }
        else if (PHS(6)) { OpsPlain O{OV, (const bf16_t*)(W + W_OUT), DM, DM}; pg8::StaticOrder S; S.init(TAIL_ROW0, DM, F.G, F.bx, 1); EpiRes E{XNR, SS + (size_t)(2 * layer + 1) * MP, nullptr, F.dry};
            pg8::gemm_phase<EpiRes, OpsPlain, true>(F.lds, O, S, E, F.tid); tail_res<DM>(F, OV, (const bf16_t*)(W + W_OUT), XNR, SS + (size_t)(2 * layer + 1) * MP, nullptr); }
        else if (PHS(7)) { OpsPlain O{XNR, (const bf16_t*)(W + W_G), DM, DM}; pg8::StaticOrder S; S.init(MP, DFF, F.G, F.bx, 1); EpiStore E{GB, DFF, 1 << 20, SS + (size_t)(2 * layer + 1) * MP};
            pg8::gemm_phase<EpiStore, OpsPlain, true>(F.lds, O, S, E, F.tid); }
        else if (PHS(8)) { OpsPlain O{XNR, (const bf16_t*)(W + W_U), DM, DM}; pg8::StaticOrder S; S.init(MP, DFF, F.G, F.bx, 1);
            EpiGeluMul E{GB, args.in[27] + (size_t)layer * 3 * DFF, args.in[28] + layer * DFF, ACT, F.dry ? DRYVAR : 0, SS + (size_t)(2 * layer + 1) * MP, (const bf16_t*)(F.ws + WS_CTL)};
            pg8::gemm_phase<EpiGeluMul, OpsPlain, true>(F.lds, O, S, E, F.tid); }
        else if (PHS(9)) { OpsPlain O{ACT, (const bf16_t*)(W + W_D), DFF, DFF}; pg8::StaticOrder S; S.init(TAIL_ROW0, DM, F.G, F.bx, 1);
            float* ssn = last ? nullptr : SS + (size_t)2 * MP; float* outf = last ? F.out : nullptr; EpiRes E{XNR, ssn, outf, F.dry};
            pg8::gemm_phase<EpiRes, OpsPlain, true>(F.lds, O, S, E, F.tid); tail_res<DFF>(F, ACT, (const bf16_t*)(W + W_D), XNR, ssn, outf); }
        if (ph2 + 1 < 2 * args0.ph_hi) { { int z2_ = 0; asm volatile("" : "+v"(z2_)); const int tid2 = wave0 * 64 + __builtin_amdgcn_mbcnt_hi(-1, __builtin_amdgcn_mbcnt_lo(-1, z2_));
              if (args0.use_bar) xcd_barrier(bar, tid2); else __syncthreads(); } }
    }
}

__global__ void fill_k(float* o, size_t n, float v) { size_t i = (size_t)blockIdx.x * blockDim.x + threadIdx.x; for (; i < n; i += (size_t)gridDim.x * blockDim.x) o[i] = v; }
extern "C" void kernel_launch(void* const* d_in, const int* in_sizes, int n_in, void* d_out, int out_size, void* d_ws, size_t ws_size, hipStream_t stream) {
    static int grid = 0;
    if (grid == 0) {
        int dev = 0, cus = 0;
        if (n_in != 30 || out_size != 32768 * DM || ws_size < WS_END || hipGetDevice(&dev) != hipSuccess || hipDeviceGetAttribute(&cus, hipDeviceAttributeMultiprocessorCount, dev) != hipSuccess ||
            hipFuncSetAttribute((const void*)fwd_kernel, hipFuncAttributeMaxDynamicSharedMemorySize, LDS_BYTES) != hipSuccess) { fprintf(stderr, "kernel_launch: bad shapes / workspace / device\n"); grid = -1; }
        else { int per_cu = 0; (void)hipOccupancyMaxActiveBlocksPerMultiprocessor(&per_cu, (const void*)fwd_kernel, NWAVES * 64, LDS_BYTES); (void)hipGetLastError();
            grid = cus * (per_cu >= 1 ? 1 : 0); if (grid <= 0) grid = -1; }
    }
    if (grid < 0) { fill_k<<<1024, 256, 0, stream>>>((float*)d_out, (size_t)out_size, 1e6f); return; }
    (void)hipMemsetAsync((char*)d_ws + WS_CTL, 0, CTL_ZERO_BYTES, stream);
    Args a{};
    for (int i = 0; i < 30; ++i) a.in[i] = (const float*)d_in[i];
    a.out = (float*)d_out; a.ws = (unsigned char*)d_ws;
#if MK_N_LAUNCHES == 1
    a.ph_lo = 0; a.ph_hi = N_PHASES; a.use_bar = 1;
    void* kargs[] = {&a};
    hipError_t e = hipLaunchCooperativeKernel((const void*)fwd_kernel, dim3(grid), dim3(NWAVES * 64), kargs, LDS_BYTES, stream);
    if (e != hipSuccess) fprintf(stderr, "cooperative launch failed: %s\n", hipGetErrorString(e));
#else
    for (int ph = 0; ph < N_PHASES; ++ph) { a.ph_lo = ph; a.ph_hi = ph + 1; a.use_bar = 0;
        hipLaunchKernelGGL(fwd_kernel, dim3(grid), dim3(NWAVES * 64), LDS_BYTES, stream, a); }
#endif
}
```
